# Optimizing an MI355X kernel written in HIP

```python
import jax, jax.numpy as jnp
from jax import lax
import numpy as np

D_MODEL = 1024
BATCH = 4
SEQ = 4096
DEPTH = 2
DEC_BATCH = 128
DEC_SEQ = 8
PAST_LEN = 16384
PAGE_SIZE = 128

N_META = 16
WINDOW = 128
BLOCK = 128
PAD_LEN = BLOCK - N_META
N_HEADS = 8
N_KV_HEADS = 2
Q_PER_KV = N_HEADS // N_KV_HEADS
HEAD_DIM = 64
ATT_SCALE = HEAD_DIM ** -0.5
ATT_Q_W = N_HEADS * HEAD_DIM
ATT_KV_W = N_KV_HEADS * HEAD_DIM
GLA_HEADS = 4
GLA_DK = 64
GLA_DV = 128
GLA_K_W = GLA_HEADS * GLA_DK
GLA_V_W = GLA_HEADS * GLA_DV
GATE_RANK = 16
GATE_NORMALIZER = 16.0
GLA_CHUNK = 128
D_MIX = ATT_Q_W + GLA_V_W
IN_W = ATT_Q_W + 2 * ATT_KV_W + 2 * GLA_K_W + GLA_V_W + GATE_RANK + GLA_V_W
D_FFN = ((8 * D_MODEL + 3 * 256 - 1) // (3 * 256)) * 256
RMS_EPS = 1e-6
MASK_VALUE = -1e30

kernel_name = 'hymba_swa_sink_gla_decode_step'


def rms_norm(x, g, eps=RMS_EPS):
    xf = x.astype(jnp.float32)
    y = xf * lax.rsqrt(jnp.mean(xf * xf, axis=-1, keepdims=True) + eps)
    return (y * g.astype(jnp.float32)).astype(x.dtype)


def project(h, w_in, q_norm, k_norm, w_g2, b_g):
    b, t, _ = h.shape
    z = jnp.einsum('btd,de->bte', h, w_in)
    sizes = (ATT_Q_W, ATT_KV_W, ATT_KV_W, GLA_K_W, GLA_K_W, GLA_V_W, GATE_RANK, GLA_V_W)
    offs = []
    acc = 0
    for s in sizes[:-1]:
        acc += s
        offs.append(acc)
    q, k, v, gq, gk, gv, g_low, og = jnp.split(z, offs, axis=-1)
    q = rms_norm(q.reshape(b, t, N_HEADS, HEAD_DIM), q_norm)
    k = rms_norm(k.reshape(b, t, N_KV_HEADS, HEAD_DIM), k_norm)
    v = v.reshape(b, t, N_KV_HEADS, HEAD_DIM)
    gq = gq.reshape(b, t, GLA_HEADS, GLA_DK) * (GLA_DK ** -0.5)
    gk = gk.reshape(b, t, GLA_HEADS, GLA_DK)
    gv = gv.reshape(b, t, GLA_HEADS, GLA_DV)
    logit = jnp.einsum('btr,re->bte', g_low, w_g2) + b_g
    log_decay = (jax.nn.log_sigmoid(logit.astype(jnp.float32)) / GATE_NORMALIZER).reshape(b, t, GLA_HEADS, GLA_DK)
    return q, k, v, gq, gk, gv, log_decay, og


def sink_softmax(scores, mask, sinks):
    sk = sinks.astype(jnp.float32).reshape(N_KV_HEADS, Q_PER_KV)
    s = jnp.where(mask, scores, MASK_VALUE)
    sink_col = jnp.broadcast_to(sk[:, :, None, None], s.shape[:-1] + (1,))
    return jax.nn.softmax(jnp.concatenate([s, sink_col], axis=-1), axis=-1)[..., :-1]


def window_attention_prompt(q, k, v, pos, sinks):
    b, L = q.shape[:2]
    nb = L // BLOCK
    qb = q.reshape(b, nb, BLOCK, N_KV_HEADS, Q_PER_KV, HEAD_DIM)
    kb = k.reshape(b, nb, BLOCK, N_KV_HEADS, HEAD_DIM)
    vb = v.reshape(b, nb, BLOCK, N_KV_HEADS, HEAD_DIM)
    shift = lambda a: jnp.concatenate([jnp.zeros_like(a[:, :1]), a[:, :-1]], axis=1)
    kk = jnp.concatenate([shift(kb), kb], axis=2)
    vv = jnp.concatenate([shift(vb), vb], axis=2)
    pb = pos.reshape(nb, BLOCK)
    pk = jnp.concatenate([pb - BLOCK, pb], axis=1)
    qp = pb[:, :, None]
    kp = pk[:, None, :]
    mask = (kp <= qp) & (qp - kp < WINDOW) & (kp >= 0)
    scores = jnp.einsum('bnqhgd,bnkhd->bnhgqk', qb, kk, preferred_element_type=jnp.float32) * ATT_SCALE
    p = sink_softmax(scores, mask[None, :, None, None], sinks)
    o = jnp.einsum('bnhgqk,bnkhd->bnqhgd', p.astype(v.dtype), vv)
    return o.reshape(b, L, ATT_Q_W)


def window_attention_sample(q, k, v, buf_k, buf_v, sinks):
    b, t = q.shape[:2]
    nbuf = buf_k.shape[1]
    kk = jnp.concatenate([buf_k.astype(k.dtype), k], axis=1)
    vv = jnp.concatenate([buf_v.astype(v.dtype), v], axis=1)
    qp = PAST_LEN + jnp.arange(t)
    kp = PAST_LEN - nbuf + jnp.arange(nbuf + t)
    mask = (kp[None, :] <= qp[:, None]) & (qp[:, None] - kp[None, :] < WINDOW)
    qg = q.reshape(b, t, N_KV_HEADS, Q_PER_KV, HEAD_DIM)
    scores = jnp.einsum('bqhgd,bkhd->bhgqk', qg, kk, preferred_element_type=jnp.float32) * ATT_SCALE
    p = sink_softmax(scores, mask, sinks)
    o = jnp.einsum('bhgqk,bkhd->bqhgd', p.astype(v.dtype), vv).reshape(b, t, ATT_Q_W)
    return o, kk[:, -nbuf:], vv[:, -nbuf:]


def gla_chunked(q, k, v, log_decay, s0, chunk):
    b, t, hg, dk = q.shape
    dv = v.shape[-1]
    nc = t // chunk
    to_chunks = lambda a: a.reshape((b, nc, chunk) + a.shape[2:]).swapaxes(0, 1).astype(jnp.float32)
    tri = jnp.tril(jnp.ones((chunk, chunk), dtype=bool))

    def step(S, xs):
        qc, kc, vc, gc = xs
        G = jnp.cumsum(gc, axis=1)
        o_inter = jnp.einsum('bthk,bhkv->bthv', qc * jnp.exp(G), S)
        diff = jnp.where(tri[None, :, :, None, None], G[:, :, None] - G[:, None, :], -jnp.inf)
        A = jnp.einsum('bthk,bshk,btshk->bths', qc, kc, jnp.exp(diff))
        o_intra = jnp.einsum('bths,bshv->bthv', A, vc)
        g_last = G[:, -1]
        S = jnp.exp(g_last)[..., None] * S + jnp.einsum('bshk,bshv->bhkv', kc * jnp.exp(g_last[:, None] - G), vc)
        return S, o_inter + o_intra

    S, o = lax.scan(step, s0.astype(jnp.float32), (to_chunks(q), to_chunks(k), to_chunks(v), to_chunks(log_decay)))
    return o.swapaxes(0, 1).reshape(b, t, hg, dv), S


def merge_heads(a, o_gla, og, gla_norm, w_o):
    b, t = a.shape[:2]
    g = rms_norm(o_gla.astype(a.dtype), gla_norm) * jax.nn.silu(og.reshape(b, t, GLA_HEADS, GLA_DV))
    merged = jnp.concatenate([a, g.reshape(b, t, GLA_V_W)], axis=-1)
    return jnp.einsum('bte,ed->btd', merged, w_o)


def swiglu(h, w_gate, w_up, w_down):
    u = jax.nn.silu(jnp.einsum('btd,df->btf', h, w_gate)) * jnp.einsum('btd,df->btf', h, w_up)
    return jnp.einsum('btf,fd->btd', u, w_down)


def setup_inputs(seed: int = 0) -> dict:
    key = jax.random.key(seed)
    ks = jax.random.split(key, 20)
    f32 = jnp.float32
    nrm = lambda k, shape, scale: jax.random.normal(k, shape, f32) * scale
    return {
        'x_prompt': nrm(ks[0], (BATCH, SEQ, D_MODEL), 1.0),
        'x_sample': nrm(ks[1], (DEC_BATCH, DEC_SEQ, D_MODEL), 1.0),
        'cache_k': nrm(ks[2], (DEPTH, DEC_BATCH, WINDOW, N_KV_HEADS, HEAD_DIM), 1.0),
        'cache_v': nrm(ks[3], (DEPTH, DEC_BATCH, WINDOW, N_KV_HEADS, HEAD_DIM), 1.0),
        'state_gla': nrm(ks[4], (DEPTH, DEC_BATCH, GLA_HEADS, GLA_DK, GLA_DV), 0.5),
        'meta': nrm(ks[5], (N_META, D_MODEL), 1.0),
        'norm1': 1.0 + nrm(ks[6], (DEPTH, D_MODEL), 0.02),
        'w_in': nrm(ks[7], (DEPTH, D_MODEL, IN_W), D_MODEL ** -0.5),
        'q_norm': 1.0 + nrm(ks[8], (DEPTH, HEAD_DIM), 0.02),
        'k_norm': 1.0 + nrm(ks[9], (DEPTH, HEAD_DIM), 0.02),
        'sinks': nrm(ks[10], (DEPTH, N_HEADS), 0.5),
        'w_g2': nrm(ks[11], (DEPTH, GATE_RANK, GLA_K_W), GATE_RANK ** -0.5),
        'b_g': nrm(ks[12], (DEPTH, GLA_K_W), 0.1),
        'gla_norm': 1.0 + nrm(ks[13], (DEPTH, GLA_DV), 0.02),
        'w_o': nrm(ks[14], (DEPTH, D_MIX, D_MODEL), D_MIX ** -0.5),
        'norm2': 1.0 + nrm(ks[15], (DEPTH, D_MODEL), 0.02),
        'w_gate': nrm(ks[16], (DEPTH, D_MODEL, D_FFN), D_MODEL ** -0.5),
        'w_up': nrm(ks[17], (DEPTH, D_MODEL, D_FFN), D_MODEL ** -0.5),
        'w_down': nrm(ks[18], (DEPTH, D_FFN, D_MODEL), D_FFN ** -0.5),
    }


def reference(x_prompt, x_sample, cache_k, cache_v, state_gla, meta, norm1, w_in, q_norm, k_norm, sinks,
              w_g2, b_g, gla_norm, w_o, norm2, w_gate, w_up, w_down):
    b = x_prompt.shape[0]
    dt = x_prompt.dtype
    x = jnp.concatenate([jnp.zeros((b, PAD_LEN, D_MODEL), dt),
                         jnp.broadcast_to(meta.astype(dt)[None], (b, N_META, D_MODEL)),
                         x_prompt], axis=1)
    pos = jnp.arange(x.shape[1]) - PAD_LEN
    valid = (pos >= 0).astype(dt)
    xs = x_sample
    pk, pv, ps, sk, sv, ss = [], [], [], [], [], []
    for l in range(DEPTH):
        h = rms_norm(x, norm1[l])
        q, k, v, gq, gk, gv, ld, og = project(h, w_in[l], q_norm[l], k_norm[l], w_g2[l], b_g[l])
        a = window_attention_prompt(q, k, v, pos, sinks[l])
        gk = gk * valid[None, :, None, None]
        o, s_fin = gla_chunked(gq, gk, gv, ld, jnp.zeros((b, GLA_HEADS, GLA_DK, GLA_DV), jnp.float32), GLA_CHUNK)
        x = x + merge_heads(a, o, og, gla_norm[l], w_o[l])
        x = x + swiglu(rms_norm(x, norm2[l]), w_gate[l], w_up[l], w_down[l])
        pk.append(k[:, -WINDOW:])
        pv.append(v[:, -WINDOW:])
        ps.append(s_fin)
        h = rms_norm(xs, norm1[l])
        q, k, v, gq, gk, gv, ld, og = project(h, w_in[l], q_norm[l], k_norm[l], w_g2[l], b_g[l])
        a, kbuf, vbuf = window_attention_sample(q, k, v, cache_k[l], cache_v[l], sinks[l])
        o, s_fin = gla_chunked(gq, gk, gv, ld, state_gla[l], xs.shape[1])
        xs = xs + merge_heads(a, o, og, gla_norm[l], w_o[l])
        xs = xs + swiglu(rms_norm(xs, norm2[l]), w_gate[l], w_up[l], w_down[l])
        sk.append(kbuf)
        sv.append(vbuf)
        ss.append(s_fin)
    y_prompt = x[:, PAD_LEN + N_META:]
    return (y_prompt, xs, jnp.stack(pk), jnp.stack(pv), jnp.stack(ps), jnp.stack(sk), jnp.stack(sv), jnp.stack(ss))
```

```cpp
#include <hip/hip_runtime.h>
#include <hip/hip_cooperative_groups.h>
#include <cstdio>
#include <cstdint>
namespace cg = cooperative_groups;

#define DI __device__ __forceinline__
#define LAS __attribute__((address_space(3)))
typedef unsigned short bf16_t;
typedef short bf16x8 __attribute__((ext_vector_type(8)));
typedef float f32x4 __attribute__((ext_vector_type(4)));
typedef float f32x2 __attribute__((ext_vector_type(2)));
typedef unsigned u32x4 __attribute__((ext_vector_type(4)));
typedef unsigned u32x2 __attribute__((ext_vector_type(2)));
typedef __bf16 bf16x2_t __attribute__((ext_vector_type(2)));

constexpr int DM = 1024, NBATCH = 4, SEQ = 4096, LP = 4112  , DEPTH = 2, DECB = 128, DECT = 8;
constexpr int MPROMPT = NBATCH * LP, MREAL = MPROMPT + DECB * DECT, MP = 17664  ;
constexpr int INW = 2320, ZP = 2304, NIN = 2560, DFFN = 2816, NGU = 5632;
constexpr int ZQ = 0, ZK = 512, ZV = 640, ZGQ = 768, ZGK = 1024, ZGV = 1280, ZOG = 1792;
constexpr int NCH = 33;
constexpr float EPS = 1e-6f, LOG2E = 1.4426950408889634f;
constexpr size_t O_YP = 0, O_YS = 16777216, O_CKP = 17825792, O_CVP = 17956864, O_SP = 18087936, O_CKS = 18350080, O_CVS = 22544384, O_SS = 26738688, O_END = 35127296;

DI unsigned pk2(float lo, float hi) { f32x2 v = {lo, hi}; bf16x2_t b = __builtin_convertvector(v, bf16x2_t); return __builtin_bit_cast(unsigned, b); }
DI float bflo(unsigned w) { return __uint_as_float(w << 16); }
DI float bfhi(unsigned w) { return __uint_as_float(w & 0xffff0000u); }
DI float bf2f(bf16_t h) { return __uint_as_float((unsigned)h << 16); }
DI void unpack8(const u32x4 w, float* f) { f[0] = bflo(w.x); f[1] = bfhi(w.x); f[2] = bflo(w.y); f[3] = bfhi(w.y); f[4] = bflo(w.z); f[5] = bfhi(w.z); f[6] = bflo(w.w); f[7] = bfhi(w.w); }
DI float silu_f(float x) { return x * __builtin_amdgcn_rcpf(1.0f + __expf(-x)); }

struct RowMap { const float* xp; const float* xs; const float* meta; float* yp; float* ys; float* xmeta; };
DI const float* row_in(const RowMap& rm, int row) {
    if (row < MPROMPT) { const int b = row / LP, p = row - b * LP; return p < 16 ? rm.meta + (size_t)p * DM : rm.xp + ((size_t)b * SEQ + (p - 16)) * DM; }
    if (row < MREAL) return rm.xs + (size_t)(row - MPROMPT) * DM;
    return nullptr;
}
DI float* row_out(const RowMap& rm, int row) {
    if (row < MPROMPT) { const int b = row / LP, p = row - b * LP; return p < 16 ? rm.xmeta + (size_t)(b * 16 + p) * DM : rm.yp + ((size_t)b * SEQ + (p - 16)) * DM; }
    if (row < MREAL) return rm.ys + (size_t)(row - MPROMPT) * DM;
    return nullptr;
}
namespace pg8 {
#define PG8_LAS __attribute__((address_space(3)))
typedef unsigned short bf16_t;
typedef short bf16x8 __attribute__((ext_vector_type(8)));
typedef float f32x4 __attribute__((ext_vector_type(4)));
typedef unsigned u32x4 __attribute__((ext_vector_type(4)));
constexpr int BM = 256, BK = 64, HALF = 128, HTB = HALF * BK * 2  , STAGE_BYTES = 8 * HTB, NXCD = 8, WGM = 8;

__host__ __device__ __forceinline__ int lds_byte(int r, int c) { const int st = (r >> 4) * 2 + (c >> 5), rr = r & 15, cc = c & 31, ob = rr * 64 + cc * 2; return st * 1024 + (ob ^ (((ob >> 9) & 1) << 5)); }
__host__ __device__ __forceinline__ void stage_rc(int b, int& R, int& C) { const int st = b / 1024, sb = b % 1024, swz = sb ^ (((sb >> 9) & 1) << 5); R = (st >> 1) * 16 + swz / 64; C = (st & 1) * 32 + (swz % 64) / 2; }
__host__ __device__ __forceinline__ int perm32(int rho) { const int n = rho >> 4, i = rho & 15; return 8 * (i >> 2) + 4 * n + (i & 3); }

struct Unit { int pm, pn; };
struct Gemm { const bf16_t* A; const bf16_t* Bt; int M, N, K; };

struct StaticOrder {
    int nM, nN, nwg, G, c;
    __host__ __device__ void init(int M, int N, int G_, int c_) { nM = M / BM; nN = N / BM; nwg = nM * nN; G = G_; c = c_; }
    __host__ __device__ bool next(int i, Unit& u) const {
        const long L = (long)i * G + c; if (L >= nwg) return false;
        int wgid = (int)L; { const int q = nwg / NXCD, r = nwg % NXCD, xcd = wgid % NXCD, off = wgid / NXCD; wgid = (xcd < r ? xcd * (q + 1) : r * (q + 1) + (xcd - r) * q) + off; }
        const int nig = WGM * nN, gid = wgid / nig, fm = gid * WGM, gsz = (nM - fm) < WGM ? (nM - fm) : WGM;
        u.pm = fm + ((wgid % nig) % gsz); u.pn = (wgid % nig) / gsz; return true;
    }
    __device__ __forceinline__ void a_ready(const Unit&) const {}
    __device__ __forceinline__ void done(const Unit&) const {}
};


DI float rstd_from_slots(const float* ssq, int row) {
    const f32x4* p = (const f32x4*)(ssq + (size_t)row * 16);
    const f32x4 a = p[0], b = p[1], c = p[2], d = p[3];
    const float s = ((a[0] + a[1]) + (a[2] + a[3])) + ((b[0] + b[1]) + (b[2] + b[3])) + ((c[0] + c[1]) + (c[2] + c[3])) + ((d[0] + d[1]) + (d[2] + d[3]));
    return rsqrtf(s * (1.0f / 1024.0f) + EPS);
}
struct EpiIn {
    static constexpr bool PERM = true, AFTER_DRAIN = false;
    bf16_t* Z; float* LD; const float* ssq; const float* bg;
    __device__ __forceinline__ void operator()(const f32x4 (&acc)[2][2][4][2], const Unit& u, int wr, int wc, int fr, int fq) const {
        const int row0 = u.pm * BM + wr * 64 + fr;
        if (u.pn < 9) {
#pragma unroll
            for (int ai = 0; ai < 2; ++ai)
#pragma unroll
                for (int m = 0; m < 4; ++m) { const int row = row0 + ai * HALF + m * 16; const float rs = rstd_from_slots(ssq, row);
                    bf16_t* rowp = Z + (size_t)row * ZP + u.pn * BM + wc * 32 + 8 * fq;
#pragma unroll
                    for (int bj = 0; bj < 2; ++bj) { const f32x4 v0 = acc[ai][bj][m][0] * rs, v1 = acc[ai][bj][m][1] * rs;
                        u32x4 w; w.x = pk2(v0[0], v0[1]); w.y = pk2(v0[2], v0[3]); w.z = pk2(v1[0], v1[1]); w.w = pk2(v1[2], v1[3]);
                        *(u32x4*)(rowp + bj * HALF) = w; }
                    asm volatile("" ::: "memory"); }
        } else {
            const int e0 = wc * 32 + 8 * fq;
#pragma unroll
            for (int bj = 0; bj < 2; ++bj) { const f32x4 b0 = *(const f32x4*)(bg + e0 + bj * HALF), b1 = *(const f32x4*)(bg + e0 + bj * HALF + 4);
#pragma unroll
                for (int ai = 0; ai < 2; ++ai)
#pragma unroll
                    for (int m = 0; m < 4; ++m) { const int row = row0 + ai * HALF + m * 16; const float rs = rstd_from_slots(ssq, row);
                        const f32x4 x0 = acc[ai][bj][m][0] * rs + b0, x1 = acc[ai][bj][m][1] * rs + b1; f32x4 o0, o1;
#pragma unroll
                        for (int i = 0; i < 4; ++i) { o0[i] = (fminf(x0[i], 0.f) - __logf(1.0f + __expf(-fabsf(x0[i])))) * 0.0625f; o1[i] = (fminf(x1[i], 0.f) - __logf(1.0f + __expf(-fabsf(x1[i])))) * 0.0625f; }
                        float* lp = LD + (size_t)row * 256 + e0 + bj * HALF; *(f32x4*)lp = o0; *(f32x4*)(lp + 4) = o1; asm volatile("" ::: "memory"); } }
        }
    }
};
struct EpiRes {
    static constexpr bool PERM = true, AFTER_DRAIN = false;
    RowMap rm; int first; bf16_t* XB; float* ssq;
    __device__ __forceinline__ void operator()(const f32x4 (&acc)[2][2][4][2], const Unit& u, int wr, int wc, int fr, int fq) const {
        const int row0 = u.pm * BM + wr * 64 + fr, col0 = u.pn * BM + wc * 32 + 8 * fq;
#pragma unroll
        for (int ai = 0; ai < 2; ++ai)
#pragma unroll
            for (int m = 0; m < 4; ++m) { const int row = row0 + ai * HALF + m * 16;
                float* op = row_out(rm, row); const float* ip = first ? row_in(rm, row) : op; float ss = 0.f;
                if (op) {
#pragma unroll
                    for (int bj = 0; bj < 2; ++bj) { const int col = col0 + bj * HALF;
                        const f32x4 v0 = acc[ai][bj][m][0] + *(const f32x4*)(ip + col), v1 = acc[ai][bj][m][1] + *(const f32x4*)(ip + col + 4);
                        *(f32x4*)(op + col) = v0; *(f32x4*)(op + col + 4) = v1;
                        u32x4 w; w.x = pk2(v0[0], v0[1]); w.y = pk2(v0[2], v0[3]); w.z = pk2(v1[0], v1[1]); w.w = pk2(v1[2], v1[3]);
                        *(u32x4*)(XB + (size_t)row * DM + col) = w;
                        ss += (v0[0] * v0[0] + v0[1] * v0[1]) + (v0[2] * v0[2] + v0[3] * v0[3]) + (v1[0] * v1[0] + v1[1] * v1[1]) + (v1[2] * v1[2] + v1[3] * v1[3]); }
                }
                ss += __shfl_xor(ss, 16); ss += __shfl_xor(ss, 32);
                if (fq == 0) ssq[(size_t)row * 16 + u.pn * 4 + wc] = ss; asm volatile("" ::: "memory"); }
    }
};
struct EpiGU {
    static constexpr bool PERM = true, AFTER_DRAIN = false;
    bf16_t* U; const float* ssq;
    __device__ __forceinline__ void operator()(const f32x4 (&acc)[2][2][4][2], const Unit& u, int wr, int wc, int fr, int fq) const {
        const int row0 = u.pm * BM + wr * 64 + fr, f0 = u.pn * HALF + wc * 32 + 8 * fq;
#pragma unroll
        for (int ai = 0; ai < 2; ++ai)
#pragma unroll
            for (int m = 0; m < 4; ++m) { const int row = row0 + ai * HALF + m * 16; const float rs = rstd_from_slots(ssq, row);
                float o[8];
#pragma unroll
                for (int n = 0; n < 2; ++n)
#pragma unroll
                    for (int i = 0; i < 4; ++i) { const float g = acc[ai][0][m][n][i] * rs, up = acc[ai][1][m][n][i] * rs; o[4 * n + i] = silu_f(g) * up; }
                u32x4 w; w.x = pk2(o[0], o[1]); w.y = pk2(o[2], o[3]); w.z = pk2(o[4], o[5]); w.w = pk2(o[6], o[7]);
                *(u32x4*)(U + (size_t)row * DFFN + f0) = w; asm volatile("" ::: "memory"); }
    }
};
template <class Epi, class Sched, bool ALIGN_EPI = false, bool SP2 = false>
__device__ __forceinline__ void gemm_phase(PG8_LAS unsigned char* lds, const Gemm g, const Sched& S, const Epi& E, const int tid_in) {
    const int tid = tid_in, wid = __builtin_amdgcn_readfirstlane(tid >> 6), lane = tid & 63, wr = wid >> 2, wc = wid & 3, fr = lane & 15, fq = lane >> 4;
    const int K = g.K, nt = K / BK;
    unsigned voffA[2], voffB[2];
#pragma unroll
    for (int i = 0; i < 2; ++i) { int R, C; stage_rc(tid * 16 + i * 8192, R, C); const int Rb = Epi::PERM ? ((R & ~31) + perm32(R & 31)) : R;
        voffA[i] = (unsigned)(R * K + C) * 2u; voffB[i] = (unsigned)(Rb * K + C) * 2u; }
    const size_t kstep = (size_t)(BK * 2);
    const size_t hstep = (size_t)HALF * K * 2;
    const size_t tstep = 2 * hstep;
    const unsigned ldsw = (unsigned)wid * 1024u;
    const int aoff = lds_byte(wr * 64 + fr, fq * 8), boff = lds_byte(wc * 32 + fr, fq * 8);
#define PG8_SA(b, h) (((b) * 2 + (h)) * HTB)
#define PG8_SB(b, h) ((4 + (b) * 2 + (h)) * HTB)
#define PG8_STAGE(bufoff, gbase, voff) do { _Pragma("unroll") for (int _i = 0; _i < 2; ++_i) \
        __builtin_amdgcn_global_load_lds((const unsigned*)((const char*)(gbase) + (voff)[_i]), (PG8_LAS unsigned*)(lds + (bufoff) + ldsw + _i * 8192), 16, 0, 0); } while (0)
#define PG8_LDA(dst, b, h) do { _Pragma("unroll") for (int m = 0; m < 4; ++m) _Pragma("unroll") for (int k = 0; k < 2; ++k) dst[m][k] = *(const PG8_LAS bf16x8*)(lds + PG8_SA(b, h) + aoff + m * 2048 + k * 1024); } while (0)
#define PG8_LDB(dst, b, h) do { _Pragma("unroll") for (int n = 0; n < 2; ++n) _Pragma("unroll") for (int k = 0; k < 2; ++k) dst[n][k] = *(const PG8_LAS bf16x8*)(lds + PG8_SB(b, h) + boff + n * 2048 + k * 1024); } while (0)
#define PG8_MMA(ai, bj, At, Bt) do { __builtin_amdgcn_s_setprio(1); _Pragma("unroll") for (int m = 0; m < 4; ++m) _Pragma("unroll") for (int n = 0; n < 2; ++n) _Pragma("unroll") for (int k = 0; k < 2; ++k) \
        acc[ai][bj][m][n] = __builtin_amdgcn_mfma_f32_16x16x32_bf16(Bt[n][k], At[m][k], acc[ai][bj][m][n], 0, 0, 0); __builtin_amdgcn_s_setprio(0); } while (0)
#define PG8_WAIT_V(n) asm volatile("s_waitcnt vmcnt(" #n ")" ::: "memory")
#define PG8_WAIT_L(n) asm volatile("s_waitcnt lgkmcnt(" #n ")" ::: "memory")
#define PG8_BAR __builtin_amdgcn_s_barrier()
#define PG8_SCHED __builtin_amdgcn_sched_barrier(0)
    Unit cur, nxt; int ui = 0;
    if (!S.next(0, cur)) return;
    f32x4 acc[2][2][4][2];
#pragma unroll
    for (int a = 0; a < 2; ++a)
#pragma unroll
        for (int b = 0; b < 2; ++b)
#pragma unroll
            for (int m = 0; m < 4; ++m)
#pragma unroll
                for (int n = 0; n < 2; ++n) acc[a][b][m][n] = (f32x4){0.f, 0.f, 0.f, 0.f};
    bf16x8 At[4][2], B0[2][2], B1[2][2];
    const char* cA = (const char*)g.A + (size_t)cur.pm * tstep; const char* cB = (const char*)g.Bt + (size_t)cur.pn * tstep;
    S.a_ready(cur);
    if constexpr (SP2) {
        PG8_STAGE(PG8_SB(0, 0), cB, voffB); PG8_STAGE(PG8_SB(0, 1), cB + hstep, voffB); PG8_STAGE(PG8_SA(0, 0), cA, voffA); PG8_STAGE(PG8_SA(0, 1), cA + hstep, voffA);
        if (wr == 1) PG8_BAR;
        PG8_WAIT_V(2); PG8_BAR;
        PG8_STAGE(PG8_SB(1, 0), cB + kstep, voffB); PG8_STAGE(PG8_SA(1, 0), cA + kstep, voffA); PG8_STAGE(PG8_SB(1, 1), cB + hstep + kstep, voffB);
        PG8_WAIT_V(6); PG8_BAR;
    } else {
        PG8_STAGE(PG8_SB(0, 0), cB, voffB); PG8_STAGE(PG8_SA(0, 0), cA, voffA); PG8_STAGE(PG8_SB(0, 1), cB + hstep, voffB); PG8_STAGE(PG8_SA(0, 1), cA + hstep, voffA);
        if (wr == 1) PG8_BAR;
        PG8_WAIT_V(4); PG8_BAR;
        PG8_STAGE(PG8_SB(1, 0), cB + kstep, voffB); PG8_STAGE(PG8_SA(1, 0), cA + kstep, voffA); PG8_STAGE(PG8_SB(1, 1), cB + hstep + kstep, voffB);
        PG8_WAIT_V(6); PG8_BAR;
    }
    for (;;) {
        const bool has_next = S.next(ui + 1, nxt);
        const char* nA = has_next ? (const char*)g.A + (size_t)nxt.pm * tstep : cA; const char* nB = has_next ? (const char*)g.Bt + (size_t)nxt.pn * tstep : cB;
        for (int t = 0; t < nt; t += 2) {
            const bool last = (t == nt - 2);
            const char* a1 = cA + (size_t)(t + 1) * kstep;
            const char* a2 = last ? nA : cA + (size_t)(t + 2) * kstep; const char* b2 = last ? nB : cB + (size_t)(t + 2) * kstep;
            const char* a3 = a2 + kstep; const char* b3 = b2 + kstep;
            if (last && has_next) S.a_ready(nxt);
            if constexpr (SP2) {
            PG8_LDB(B0, 0, 0); PG8_LDB(B1, 0, 1); PG8_SCHED; PG8_LDA(At, 0, 0); PG8_STAGE(PG8_SA(1, 1), a1 + hstep, voffA);
            PG8_WAIT_V(8); PG8_WAIT_L(0); PG8_BAR; PG8_MMA(0, 0, At, B0); PG8_MMA(0, 1, At, B1); PG8_BAR; PG8_SCHED;
            PG8_LDA(At, 0, 1); PG8_STAGE(PG8_SB(0, 0), b2, voffB); PG8_STAGE(PG8_SB(0, 1), b2 + hstep, voffB); PG8_STAGE(PG8_SA(0, 0), a2, voffA);
            PG8_WAIT_V(8); PG8_WAIT_L(0); PG8_BAR; PG8_MMA(1, 0, At, B0); PG8_MMA(1, 1, At, B1); PG8_BAR; PG8_SCHED;
            PG8_LDB(B0, 1, 0); PG8_LDB(B1, 1, 1); PG8_SCHED; PG8_LDA(At, 1, 0); PG8_STAGE(PG8_SA(0, 1), a2 + hstep, voffA);
            PG8_WAIT_V(8); PG8_WAIT_L(0); PG8_BAR; PG8_MMA(0, 0, At, B0); PG8_MMA(0, 1, At, B1); PG8_BAR; PG8_SCHED;
            PG8_LDA(At, 1, 1); PG8_STAGE(PG8_SB(1, 0), b3, voffB); PG8_STAGE(PG8_SB(1, 1), b3 + hstep, voffB); PG8_STAGE(PG8_SA(1, 0), a3, voffA);
            PG8_WAIT_V(8); PG8_WAIT_L(0); PG8_BAR; PG8_MMA(1, 0, At, B0); PG8_MMA(1, 1, At, B1); PG8_BAR; PG8_SCHED;
            } else {
            PG8_LDB(B0, 0, 0); PG8_SCHED; PG8_LDA(At, 0, 0); PG8_STAGE(PG8_SA(1, 1), a1 + hstep, voffA);
            PG8_WAIT_L(8); PG8_BAR; PG8_WAIT_L(0); PG8_MMA(0, 0, At, B0); PG8_BAR; PG8_SCHED;
            PG8_LDB(B1, 0, 1); PG8_STAGE(PG8_SB(0, 0), b2, voffB);
            PG8_BAR; PG8_WAIT_L(0); PG8_MMA(0, 1, At, B1); PG8_BAR;
            PG8_LDA(At, 0, 1); PG8_STAGE(PG8_SA(0, 0), a2, voffA);
            PG8_BAR; PG8_WAIT_L(0); PG8_MMA(1, 0, At, B0); PG8_BAR; PG8_SCHED;
            PG8_STAGE(PG8_SB(0, 1), b2 + hstep, voffB);
            PG8_WAIT_V(6); PG8_BAR; PG8_MMA(1, 1, At, B1); PG8_BAR;
            PG8_LDB(B0, 1, 0); PG8_SCHED; PG8_LDA(At, 1, 0); PG8_STAGE(PG8_SA(0, 1), a2 + hstep, voffA);
            PG8_WAIT_L(8); PG8_BAR; PG8_WAIT_L(0); PG8_MMA(0, 0, At, B0); PG8_BAR; PG8_SCHED;
            PG8_LDB(B1, 1, 1); PG8_STAGE(PG8_SB(1, 0), b3, voffB);
            PG8_BAR; PG8_WAIT_L(0); PG8_MMA(0, 1, At, B1); PG8_BAR;
            PG8_LDA(At, 1, 1); PG8_STAGE(PG8_SA(1, 0), a3, voffA);
            PG8_BAR; PG8_WAIT_L(0); PG8_MMA(1, 0, At, B0); PG8_BAR; PG8_SCHED;
            PG8_STAGE(PG8_SB(1, 1), b3 + hstep, voffB);
            PG8_WAIT_V(6); PG8_BAR; PG8_MMA(1, 1, At, B1); PG8_BAR;
            }
        }
        if constexpr (ALIGN_EPI) { if (wr == 0) PG8_BAR; }
        if constexpr (!Epi::AFTER_DRAIN) { E(acc, cur, wr, wc, fr, fq); S.done(cur); }
        if (!has_next) break;
#pragma unroll
        for (int a = 0; a < 2; ++a)
#pragma unroll
            for (int b = 0; b < 2; ++b)
#pragma unroll
                for (int m = 0; m < 4; ++m)
#pragma unroll
                    for (int n = 0; n < 2; ++n) acc[a][b][m][n] = (f32x4){0.f, 0.f, 0.f, 0.f};
        cur = nxt; cA = nA; cB = nB; ++ui;
        if constexpr (ALIGN_EPI) { if (wr == 1) PG8_BAR; }
    }
    PG8_WAIT_V(0);
    if constexpr (!ALIGN_EPI) { if (wr == 0) PG8_BAR; }
    PG8_BAR;
    if constexpr (Epi::AFTER_DRAIN) { E.fused(acc, cur, wr, wc, fr, fq, lds, wid, lane); S.done(cur); }
#undef PG8_SA
#undef PG8_SB
#undef PG8_STAGE
#undef PG8_LDA
#undef PG8_LDB
#undef PG8_MMA
#undef PG8_WAIT_V
#undef PG8_WAIT_L
#undef PG8_BAR
#undef PG8_SCHED
}
}

constexpr size_t SZ_WIN = (size_t)NIN * DM * 2, SZ_WO = (size_t)DM * DM * 2, SZ_WGU = (size_t)NGU * DM * 2, SZ_WD = (size_t)DM * DFFN * 2, SZ_WL = SZ_WIN + SZ_WO + SZ_WGU + SZ_WD;
constexpr size_t WS_CTL = 0;
constexpr size_t WS_W = 4096;
constexpr size_t WS_XB = WS_W + DEPTH * SZ_WL;
constexpr size_t WS_MRG = WS_XB + (size_t)MP * DM * 2;
constexpr size_t WS_Z = WS_MRG + (size_t)MP * DM * 2;
constexpr size_t WS_LD = WS_Z + (size_t)MP * ZP * 2;
constexpr size_t WS_U = WS_Z;
constexpr size_t WS_DS = WS_LD + (size_t)MP * 256 * 4;
constexpr size_t WS_SC = WS_DS + (size_t)16 * NCH * 64 * 128 * 4;
constexpr size_t WS_GL = WS_SC + (size_t)16 * NCH * 64 * 128 * 2;
constexpr size_t WS_SSQA = WS_GL + (size_t)16 * NCH * 64 * 4;
constexpr size_t WS_SSQB = WS_SSQA + (size_t)MP * 16 * 4;
constexpr size_t WS_XMETA = WS_SSQB + (size_t)MP * 16 * 4;
constexpr size_t WS_END = WS_XMETA + (size_t)64 * DM * 4;
static_assert((size_t)MP * DFFN * 2 <= (size_t)MP * ZP * 2 + (size_t)MP * 256 * 4, "U overlay fits Z|LD");
static_assert(WS_END <= 268435456ull, "workspace map fits 256 MiB");

constexpr int LDS_BYTES = 147456;
constexpr int NPHASE = 1 + 7 * DEPTH;

struct Args { const float* in[19]; float* out; unsigned char* ws; int ph_lo, ph_hi; };

DI bf16x8 mk8(u32x2 lo, u32x2 hi) { u32x4 w; w.x = lo.x; w.y = lo.y; w.z = hi.x; w.w = hi.y; return __builtin_bit_cast(bf16x8, w); }
#define MFMA16(a, b, c) __builtin_amdgcn_mfma_f32_16x16x32_bf16((a), (b), (c), 0, 0, 0)

DI void attn_wave(const LAS unsigned char* Ks, const LAS unsigned char* Vt, const int VPB, const bf16_t* qrow, const float* qnw, const float sink2, const int jmin, const int c, const int fq, bf16_t* orow) {
    float qf[16];
    if (qrow) { const u32x4 a = *(const u32x4*)(qrow + 8 * fq), b = *(const u32x4*)(qrow + 32 + 8 * fq); unpack8(a, qf); unpack8(b, qf + 8); }
    else {
#pragma unroll
        for (int i = 0; i < 16; ++i) qf[i] = 0.f; }
    float ss = 0.f;
#pragma unroll
    for (int i = 0; i < 16; ++i) ss += qf[i] * qf[i];
    ss += __shfl_xor(ss, 16); ss += __shfl_xor(ss, 32);
    const float rs = rsqrtf(ss * (1.0f / 64.0f) + EPS) * (0.125f * LOG2E);
    const f32x4 w0 = *(const f32x4*)(qnw + 8 * fq), w1 = *(const f32x4*)(qnw + 8 * fq + 4), w2 = *(const f32x4*)(qnw + 32 + 8 * fq), w3 = *(const f32x4*)(qnw + 36 + 8 * fq);
#pragma unroll
    for (int i = 0; i < 4; ++i) { qf[i] *= rs * w0[i]; qf[4 + i] *= rs * w1[i]; qf[8 + i] *= rs * w2[i]; qf[12 + i] *= rs * w3[i]; }
    u32x4 q0, q1; q0.x = pk2(qf[0], qf[1]); q0.y = pk2(qf[2], qf[3]); q0.z = pk2(qf[4], qf[5]); q0.w = pk2(qf[6], qf[7]);
    q1.x = pk2(qf[8], qf[9]); q1.y = pk2(qf[10], qf[11]); q1.z = pk2(qf[12], qf[13]); q1.w = pk2(qf[14], qf[15]);
    const bf16x8 qB0 = __builtin_bit_cast(bf16x8, q0), qB1 = __builtin_bit_cast(bf16x8, q1);
    f32x4 acc[9];
    float mx = sink2;
#pragma unroll
    for (int T = 0; T < 9; ++T) {
        const LAS unsigned char* kp = Ks + (16 * T + c) * 144 + 16 * fq;
        const bf16x8 a0 = *(const LAS bf16x8*)kp, a1 = *(const LAS bf16x8*)(kp + 64);
        f32x4 s = {0.f, 0.f, 0.f, 0.f};
        s = MFMA16(a0, qB0, s); s = MFMA16(a1, qB1, s);
#pragma unroll
        for (int r = 0; r < 4; ++r) { const int jrel = 16 * T + 4 * fq + r, d = 128 + c - jrel; const bool ok = ((unsigned)d < 128u) && (jrel >= jmin); s[r] = ok ? s[r] : -1e30f; mx = fmaxf(mx, s[r]); }
        acc[T] = s;
    }
    mx = fmaxf(mx, __shfl_xor(mx, 16)); mx = fmaxf(mx, __shfl_xor(mx, 32));
    float sum = 0.f;
#pragma unroll
    for (int T = 0; T < 9; ++T)
#pragma unroll
        for (int r = 0; r < 4; ++r) { const float p = __builtin_amdgcn_exp2f(acc[T][r] - mx); acc[T][r] = p; sum += p; }
    sum += __shfl_xor(sum, 16); sum += __shfl_xor(sum, 32);
    const float inv = 1.0f / (sum + __builtin_amdgcn_exp2f(sink2 - mx));
    f32x4 o[4];
#pragma unroll
    for (int i = 0; i < 4; ++i) o[i] = (f32x4){0.f, 0.f, 0.f, 0.f};
#pragma unroll
    for (int kk = 0; kk < 5; ++kk) {
        u32x4 pw; pw.x = pk2(acc[2 * kk][0], acc[2 * kk][1]); pw.y = pk2(acc[2 * kk][2], acc[2 * kk][3]);
        if (kk < 4) { pw.z = pk2(acc[2 * kk + 1][0], acc[2 * kk + 1][1]); pw.w = pk2(acc[2 * kk + 1][2], acc[2 * kk + 1][3]); } else { pw.z = 0u; pw.w = 0u; }
        const bf16x8 pB = __builtin_bit_cast(bf16x8, pw);
#pragma unroll
        for (int Mt = 0; Mt < 4; ++Mt) {
            const LAS unsigned char* vp = Vt + (16 * Mt + c) * VPB + (32 * kk + 4 * fq) * 2;
            const u32x2 lo = *(const LAS u32x2*)vp, hi = *(const LAS u32x2*)(vp + 32);
            o[Mt] = MFMA16(mk8(lo, hi), pB, o[Mt]);
        }
    }
    if (orow) {
#pragma unroll
        for (int Mt = 0; Mt < 4; ++Mt) { u32x2 w; w.x = pk2(o[Mt][0] * inv, o[Mt][1] * inv); w.y = pk2(o[Mt][2] * inv, o[Mt][3] * inv); *(u32x2*)(orow + 16 * Mt + 4 * fq) = w; }
    }
}

struct Ctx {
    int l;
    const bf16_t* Z; float* LD; bf16_t* MRG; float* DS; bf16_t* SC; float* GL;
    const float *qnw, *knw, *sinks, *gnw;
    const float *cache_k, *cache_v, *state;
    float* out;
};

DI void attn_prompt_unit(const Ctx& C, int uidx, LAS unsigned char* lds, int tid) {
    const int jb = uidx % 65, g = (uidx / 65) & 1, b = uidx / 130;
    const int p0 = 64 * jb, kbase = p0 - 128, rowbase = b * LP, nq = (LP - p0) < 64 ? (LP - p0) : 64;
    LAS unsigned char* Ks = lds; LAS unsigned char* Vt = lds + 208 * 144;
    const int lane = tid & 63, w = tid >> 6;
    {
        const int dc = tid & 7;
        const f32x4 kw0 = *(const f32x4*)(C.knw + dc * 8), kw1 = *(const f32x4*)(C.knw + dc * 8 + 4);
#pragma unroll
        for (int i = 0; i < 4; ++i) { const int j = (tid >> 3) + 64 * i, kp = kbase + j; const bool valid = (j < 192) && (kp >= 0) && (kp < LP);
            u32x4 raw = {0u, 0u, 0u, 0u}; if (valid) raw = *(const u32x4*)(C.Z + (size_t)(rowbase + kp) * ZP + ZK + g * 64 + dc * 8);
            float f[8]; unpack8(raw, f); float ss = 0.f;
#pragma unroll
            for (int e = 0; e < 8; ++e) ss += f[e] * f[e];
            ss += __shfl_xor(ss, 1); ss += __shfl_xor(ss, 2); ss += __shfl_xor(ss, 4);
            const float rs = rsqrtf(ss * (1.0f / 64.0f) + EPS);
#pragma unroll
            for (int e = 0; e < 4; ++e) { f[e] *= rs * kw0[e]; f[4 + e] *= rs * kw1[e]; }
            if (j < 208) { u32x4 o; o.x = pk2(f[0], f[1]); o.y = pk2(f[2], f[3]); o.z = pk2(f[4], f[5]); o.w = pk2(f[6], f[7]); *(LAS u32x4*)(Ks + j * 144 + dc * 16) = o; }
            if (valid && j >= 128 && kp >= LP - 128) { float* op = C.out + O_CKP + ((size_t)((C.l * NBATCH + b) * 128 + (kp - (LP - 128))) * 2 + g) * 64 + dc * 8;
                *(f32x4*)op = (f32x4){f[0], f[1], f[2], f[3]}; *(f32x4*)(op + 4) = (f32x4){f[4], f[5], f[6], f[7]}; } asm volatile("" ::: "memory"); }
    }
    {
        const int dc = w;
#pragma unroll
        for (int i = 0; i < 4; ++i) { const int j = lane + 64 * i, kp = kbase + j; const bool valid = (j < 192) && (kp >= 0) && (kp < LP);
            u32x4 raw = {0u, 0u, 0u, 0u}; if (valid) raw = *(const u32x4*)(C.Z + (size_t)(rowbase + kp) * ZP + ZV + g * 64 + dc * 8);
            if (j < 216) { LAS bf16_t* vp = (LAS bf16_t*)(Vt + (dc * 8) * 432 + j * 2);
                vp[0 * 216] = (bf16_t)(raw.x & 0xffffu); vp[1 * 216] = (bf16_t)(raw.x >> 16); vp[2 * 216] = (bf16_t)(raw.y & 0xffffu); vp[3 * 216] = (bf16_t)(raw.y >> 16);
                vp[4 * 216] = (bf16_t)(raw.z & 0xffffu); vp[5 * 216] = (bf16_t)(raw.z >> 16); vp[6 * 216] = (bf16_t)(raw.w & 0xffffu); vp[7 * 216] = (bf16_t)(raw.w >> 16); }
            if (valid && j >= 128 && kp >= LP - 128) { float f[8]; unpack8(raw, f); float* op = C.out + O_CVP + ((size_t)((C.l * NBATCH + b) * 128 + (kp - (LP - 128))) * 2 + g) * 64 + dc * 8;
                *(f32x4*)op = (f32x4){f[0], f[1], f[2], f[3]}; *(f32x4*)(op + 4) = (f32x4){f[4], f[5], f[6], f[7]}; } asm volatile("" ::: "memory"); }
    }
    __syncthreads();
    {
        const int s = w & 3, hp = w >> 2, c = lane & 15, fq = lane >> 4;
        if (16 * s < nq) {
#pragma unroll 1
            for (int hh = 0; hh < 2; ++hh) { const int h = g * 4 + hp * 2 + hh, qp = p0 + 16 * s + c; const bool qv = qp < LP;
                const bf16_t* qrow = qv ? C.Z + (size_t)(rowbase + qp) * ZP + ZQ + h * 64 : nullptr;
                bf16_t* orow = qv ? C.MRG + (size_t)(rowbase + qp) * DM + h * 64 : nullptr;
                attn_wave(Ks + 16 * s * 144, Vt + 16 * s * 2, 432, qrow, C.qnw, C.sinks[h] * LOG2E, 128 - p0 - 16 * s, c, fq, orow); }
        }
    }
    __syncthreads();
}

DI void attn_sample_unit(const Ctx& C, int b, LAS unsigned char* lds, int tid) {
    const int lane = tid & 63, w = tid >> 6;
    constexpr int KSG = 160 * 144, VTG = 64 * 336, VT0 = 2 * KSG;
    const int row0 = MPROMPT + b * DECT;
    const size_t cbase = (size_t)(C.l * DECB + b) * 128;
#pragma unroll
    for (int i = 0; i < 4; ++i) {
        const int idx = tid + 512 * i, dc = idx & 7, j = (idx >> 3) & 127, g = idx >> 10;
        const float* sp = C.cache_k + ((cbase + j) * 2 + g) * 64 + dc * 8; const f32x4 a = *(const f32x4*)sp, bq = *(const f32x4*)(sp + 4);
        u32x4 o; o.x = pk2(a[0], a[1]); o.y = pk2(a[2], a[3]); o.z = pk2(bq[0], bq[1]); o.w = pk2(bq[2], bq[3]);
        *(LAS u32x4*)(lds + g * KSG + j * 144 + dc * 16) = o;
        if (j >= 8) { float* op = C.out + O_CKS + ((cbase + j - 8) * 2 + g) * 64 + dc * 8; *(f32x4*)op = a; *(f32x4*)(op + 4) = bq; }
        asm volatile("" ::: "memory");
    }
    if (w < 2) {
        const int dc = tid & 7, t = (tid >> 3) & 7, g = tid >> 6;
        const u32x4 raw = *(const u32x4*)(C.Z + (size_t)(row0 + t) * ZP + ZK + g * 64 + dc * 8);
        float f[8]; unpack8(raw, f); float ss = 0.f;
#pragma unroll
        for (int e = 0; e < 8; ++e) ss += f[e] * f[e];
        ss += __shfl_xor(ss, 1); ss += __shfl_xor(ss, 2); ss += __shfl_xor(ss, 4);
        const float rs = rsqrtf(ss * (1.0f / 64.0f) + EPS);
        const f32x4 kw0 = *(const f32x4*)(C.knw + dc * 8), kw1 = *(const f32x4*)(C.knw + dc * 8 + 4);
#pragma unroll
        for (int e = 0; e < 4; ++e) { f[e] *= rs * kw0[e]; f[4 + e] *= rs * kw1[e]; }
        u32x4 o; o.x = pk2(f[0], f[1]); o.y = pk2(f[2], f[3]); o.z = pk2(f[4], f[5]); o.w = pk2(f[6], f[7]);
        *(LAS u32x4*)(lds + g * KSG + (128 + t) * 144 + dc * 16) = o;
        float* op = C.out + O_CKS + ((cbase + 120 + t) * 2 + g) * 64 + dc * 8;
        *(f32x4*)op = (f32x4){f[0], f[1], f[2], f[3]}; *(f32x4*)(op + 4) = (f32x4){f[4], f[5], f[6], f[7]};
    } else if (w < 8) {
        const int idx = tid - 128, dc = idx & 7, r = (idx >> 3) % 24, g = idx / 192;
        unsigned z0 = 0u; asm volatile("" : "+v"(z0)); *(LAS u32x4*)(lds + g * KSG + (136 + r) * 144 + dc * 16) = (u32x4){z0, z0, z0, z0};
    }
#pragma unroll
    for (int i = 0; i < 4; ++i) {
        const int idx = tid + 512 * i, j = idx & 127, dc = (idx >> 7) & 7, g = idx >> 10;
        const float* sp = C.cache_v + ((cbase + j) * 2 + g) * 64 + dc * 8; const f32x4 a = *(const f32x4*)sp, bq = *(const f32x4*)(sp + 4);
        LAS bf16_t* vp = (LAS bf16_t*)(lds + VT0 + g * VTG + (dc * 8) * 336 + j * 2);
        const unsigned p0 = pk2(a[0], a[1]), p1 = pk2(a[2], a[3]), p2 = pk2(bq[0], bq[1]), p3 = pk2(bq[2], bq[3]);
        vp[0 * 168] = (bf16_t)(p0 & 0xffffu); vp[1 * 168] = (bf16_t)(p0 >> 16); vp[2 * 168] = (bf16_t)(p1 & 0xffffu); vp[3 * 168] = (bf16_t)(p1 >> 16);
        vp[4 * 168] = (bf16_t)(p2 & 0xffffu); vp[5 * 168] = (bf16_t)(p2 >> 16); vp[6 * 168] = (bf16_t)(p3 & 0xffffu); vp[7 * 168] = (bf16_t)(p3 >> 16);
        if (j >= 8) { float* op = C.out + O_CVS + ((cbase + j - 8) * 2 + g) * 64 + dc * 8; *(f32x4*)op = a; *(f32x4*)(op + 4) = bq; }
        asm volatile("" ::: "memory");
    }
    if (tid < 128) {
        const int t = tid & 7, dc = (tid >> 3) & 7, g = tid >> 6;
        const u32x4 raw = *(const u32x4*)(C.Z + (size_t)(row0 + t) * ZP + ZV + g * 64 + dc * 8);
        LAS bf16_t* vp = (LAS bf16_t*)(lds + VT0 + g * VTG + (dc * 8) * 336 + (128 + t) * 2);
        vp[0 * 168] = (bf16_t)(raw.x & 0xffffu); vp[1 * 168] = (bf16_t)(raw.x >> 16); vp[2 * 168] = (bf16_t)(raw.y & 0xffffu); vp[3 * 168] = (bf16_t)(raw.y >> 16);
        vp[4 * 168] = (bf16_t)(raw.z & 0xffffu); vp[5 * 168] = (bf16_t)(raw.z >> 16); vp[6 * 168] = (bf16_t)(raw.w & 0xffffu); vp[7 * 168] = (bf16_t)(raw.w >> 16);
        float f[8]; unpack8(raw, f); float* op = C.out + O_CVS + ((cbase + 120 + t) * 2 + g) * 64 + dc * 8;
        *(f32x4*)op = (f32x4){f[0], f[1], f[2], f[3]}; *(f32x4*)(op + 4) = (f32x4){f[4], f[5], f[6], f[7]};
    }
#pragma unroll
    for (int i = 0; i < 2; ++i) {
        const int idx = tid + 512 * i, part = idx & 7, d = (idx >> 3) & 63, g = idx >> 9;
        unsigned z0 = 0u; asm volatile("" : "+v"(z0)); *(LAS u32x2*)(lds + VT0 + g * VTG + d * 336 + 272 + part * 8) = (u32x2){z0, z0};
    }
    __syncthreads();
    {
        const int g = w >> 2, h = w, c = lane & 15, fq = lane >> 4;
        const bool qv = c < 8;
        const bf16_t* qrow = qv ? C.Z + (size_t)(row0 + c) * ZP + ZQ + h * 64 : nullptr;
        bf16_t* orow = qv ? C.MRG + (size_t)(row0 + c) * DM + h * 64 : nullptr;
        attn_wave(lds + g * KSG, lds + VT0 + g * VTG, 336, qrow, C.qnw, C.sinks[h] * LOG2E, 0, c, fq, orow);
    }
    __syncthreads();
}

DI void gla_sample_unit(const Ctx& C, int uidx, LAS unsigned char* lds, int tid) {
    const int h = uidx & 3, b = uidx >> 2, row0 = MPROMPT + b * DECT;
    LAS float* qs = (LAS float*)lds; LAS float* ks = qs + 512; LAS float* dec = ks + 512; LAS float* vs = dec + 512; LAS float* red = vs + 1024;
    {
        const int t = tid >> 6, k = tid & 63; const bf16_t* zr = C.Z + (size_t)(row0 + t) * ZP;
        qs[tid] = bf2f(zr[ZGQ + h * 64 + k]); ks[tid] = bf2f(zr[ZGK + h * 64 + k]); dec[tid] = __expf(C.LD[(size_t)(row0 + t) * 256 + h * 64 + k]);
#pragma unroll
        for (int i = 0; i < 2; ++i) { const int idx = tid + 512 * i, tt = idx >> 7, v = idx & 127; vs[idx] = bf2f(C.Z[(size_t)(row0 + tt) * ZP + ZGV + h * 128 + v]); }
    }
    const int v = tid & 127, kq = tid >> 7;
    const size_t sbase = ((size_t)((C.l * DECB + b) * 4 + h) * 64 + 16 * kq) * 128 + v;
    float S[16];
#pragma unroll
    for (int i = 0; i < 16; ++i) S[i] = C.state[sbase + (size_t)i * 128];
    __syncthreads();
#pragma unroll
    for (int t = 0; t < 8; ++t) { float a = 0.f; const float vv = vs[t * 128 + v];
#pragma unroll
        for (int i = 0; i < 16; ++i) { const int k = 16 * kq + i; S[i] = dec[t * 64 + k] * S[i] + ks[t * 64 + k] * vv; a += qs[t * 64 + k] * S[i]; }
        red[(kq * 8 + t) * 128 + v] = a; }
    float* so = C.out + O_SS + sbase;
#pragma unroll
    for (int i = 0; i < 16; ++i) so[(size_t)i * 128] = S[i];
    __syncthreads();
    {
        const int t = tid >> 6, lane = tid & 63; float o[2]; float ss = 0.f;
#pragma unroll
        for (int i = 0; i < 2; ++i) { const int vv = lane + 64 * i; o[i] = (red[(0 * 8 + t) * 128 + vv] + red[(1 * 8 + t) * 128 + vv]) + (red[(2 * 8 + t) * 128 + vv] + red[(3 * 8 + t) * 128 + vv]); ss += o[i] * o[i]; }
#pragma unroll
        for (int m = 1; m < 64; m <<= 1) ss += __shfl_xor(ss, m);
        const float rs = rsqrtf(ss * (1.0f / 128.0f) + EPS);
#pragma unroll
        for (int i = 0; i < 2; ++i) { const int vv = lane + 64 * i; const float og = bf2f(C.Z[(size_t)(row0 + t) * ZP + ZOG + h * 128 + vv]);
            const float y = o[i] * rs * C.gnw[vv] * silu_f(og); C.MRG[(size_t)(row0 + t) * DM + 512 + h * 128 + vv] = (bf16_t)(pk2(y, 0.f) & 0xffffu); }
    }
    __syncthreads();
}

DI void gla1_unit(const Ctx& C, int unit, LAS unsigned char* lds, int tid) {
    const int c = unit % NCH, bh = unit / NCH, h = bh & 3, b = bh >> 2;
    const int r0 = b * LP + 128 * c, nv = (LP - 128 * c) < 128 ? (LP - 128 * c) : 128;
    LAS float* Gs = (LAS float*)lds; LAS float* segtot = (LAS float*)(lds + 33280); LAS float* gl = (LAS float*)(lds + 35328);
    LAS unsigned char* kdT = lds + 35840; LAS unsigned char* vT = lds + 53248;
    const int lane = tid & 63, w = tid >> 6;
    {
        const int k = lane, seg = w; float g[16];
#pragma unroll
        for (int i = 0; i < 16; ++i) { const int t = 16 * seg + i; g[i] = t < nv ? C.LD[(size_t)(r0 + t) * 256 + h * 64 + k] : 0.f; }
#pragma unroll
        for (int i = 1; i < 16; ++i) g[i] += g[i - 1];
        segtot[seg * 64 + k] = g[15];
        __syncthreads();
        float off = 0.f, tot = 0.f;
#pragma unroll
        for (int s = 0; s < 8; ++s) { const float x = segtot[s * 64 + k]; off += (s < seg) ? x : 0.f; tot += x; }
#pragma unroll
        for (int i = 0; i < 16; ++i) { const int t = 16 * seg + i; const float x = g[i] + off; Gs[t * 65 + k] = x; if (t < nv) C.LD[(size_t)(r0 + t) * 256 + h * 64 + k] = x; }
        if (seg == 0) { gl[k] = tot; C.GL[(size_t)unit * 64 + k] = tot; }
    }
    __syncthreads();
    {
        const int t = tid & 127;
#pragma unroll
        for (int i = 0; i < 2; ++i) { const int kc = (tid >> 7) + 4 * i; u32x4 raw = {0u, 0u, 0u, 0u};
            if (t < nv) raw = *(const u32x4*)(C.Z + (size_t)(r0 + t) * ZP + ZGK + h * 64 + kc * 8);
            float f[8]; unpack8(raw, f);
#pragma unroll
            for (int e = 0; e < 8; ++e) { const float kd = f[e] * __expf(gl[kc * 8 + e] - Gs[t * 65 + kc * 8 + e]); *(LAS bf16_t*)(kdT + (kc * 8 + e) * 272 + t * 2) = (bf16_t)(pk2(kd, 0.f) & 0xffffu); } }
#pragma unroll
        for (int i = 0; i < 4; ++i) { const int vc = (tid >> 7) + 4 * i; u32x4 raw = {0u, 0u, 0u, 0u};
            if (t < nv) raw = *(const u32x4*)(C.Z + (size_t)(r0 + t) * ZP + ZGV + h * 128 + vc * 8);
            LAS bf16_t* vp = (LAS bf16_t*)(vT + (vc * 8) * 272 + t * 2);
            vp[0 * 136] = (bf16_t)(raw.x & 0xffffu); vp[1 * 136] = (bf16_t)(raw.x >> 16); vp[2 * 136] = (bf16_t)(raw.y & 0xffffu); vp[3 * 136] = (bf16_t)(raw.y >> 16);
            vp[4 * 136] = (bf16_t)(raw.z & 0xffffu); vp[5 * 136] = (bf16_t)(raw.z >> 16); vp[6 * 136] = (bf16_t)(raw.w & 0xffffu); vp[7 * 136] = (bf16_t)(raw.w >> 16); }
    }
    __syncthreads();
    {
        const int cc = lane & 15, fq = lane >> 4;
#pragma unroll
        for (int kt = 0; kt < 4; ++kt) { f32x4 acc = {0.f, 0.f, 0.f, 0.f};
#pragma unroll
            for (int ks = 0; ks < 4; ++ks) { const bf16x8 a = *(const LAS bf16x8*)(kdT + (16 * kt + cc) * 272 + (32 * ks + 8 * fq) * 2), bb = *(const LAS bf16x8*)(vT + (16 * w + cc) * 272 + (32 * ks + 8 * fq) * 2); acc = MFMA16(a, bb, acc); }
#pragma unroll
            for (int r = 0; r < 4; ++r) C.DS[((size_t)unit * 64 + 16 * kt + 4 * fq + r) * 128 + 16 * w + cc] = acc[r]; }
    }
    __syncthreads();
}

DI void gla3_unit(const Ctx& C, int unit, LAS unsigned char* lds, int tid) {
    const int c = unit % NCH, bh = unit / NCH, h = bh & 3, b = bh >> 2;
    const int r0 = b * LP + 128 * c, nv = (LP - 128 * c) < 128 ? (LP - 128 * c) : 128;
    LAS unsigned char* qg = lds; LAS unsigned char* kg = lds + 18432; LAS unsigned char* vT = lds + 36864; LAS unsigned char* ScT = lds + 71680;
    const int lane = tid & 63, w = __builtin_amdgcn_readfirstlane(tid >> 6);
    {
        const int kc = tid & 7;
#pragma unroll
        for (int i = 0; i < 2; ++i) { const int t = (tid >> 3) + 64 * i; u32x4 rq = {0u, 0u, 0u, 0u}, rk = {0u, 0u, 0u, 0u}; f32x4 g0 = {0.f, 0.f, 0.f, 0.f}, g1 = g0;
            if (t < nv) { const bf16_t* zr = C.Z + (size_t)(r0 + t) * ZP + h * 64 + kc * 8; rq = *(const u32x4*)(zr + ZGQ); rk = *(const u32x4*)(zr + ZGK);
                const float* gp = C.LD + (size_t)(r0 + t) * 256 + h * 64 + kc * 8; g0 = *(const f32x4*)gp; g1 = *(const f32x4*)(gp + 4); }
            float fq_[8], fk_[8]; unpack8(rq, fq_); unpack8(rk, fk_);
#pragma unroll
            for (int e = 0; e < 4; ++e) { const float e0 = __expf(g0[e]), e1 = __expf(g1[e]); fq_[e] *= e0; fq_[4 + e] *= e1; fk_[e] *= __builtin_amdgcn_rcpf(e0); fk_[4 + e] *= __builtin_amdgcn_rcpf(e1); }
            u32x4 oq, ok; oq.x = pk2(fq_[0], fq_[1]); oq.y = pk2(fq_[2], fq_[3]); oq.z = pk2(fq_[4], fq_[5]); oq.w = pk2(fq_[6], fq_[7]);
            ok.x = pk2(fk_[0], fk_[1]); ok.y = pk2(fk_[2], fk_[3]); ok.z = pk2(fk_[4], fk_[5]); ok.w = pk2(fk_[6], fk_[7]);
            *(LAS u32x4*)(qg + t * 144 + kc * 16) = oq; *(LAS u32x4*)(kg + t * 144 + kc * 16) = ok; }
        const int t = tid & 127;
#pragma unroll
        for (int i = 0; i < 4; ++i) { const int vc = (tid >> 7) + 4 * i; u32x4 raw = {0u, 0u, 0u, 0u};
            if (t < nv) raw = *(const u32x4*)(C.Z + (size_t)(r0 + t) * ZP + ZGV + h * 128 + vc * 8);
            LAS bf16_t* vp = (LAS bf16_t*)(vT + (vc * 8) * 272 + t * 2);
            vp[0 * 136] = (bf16_t)(raw.x & 0xffffu); vp[1 * 136] = (bf16_t)(raw.x >> 16); vp[2 * 136] = (bf16_t)(raw.y & 0xffffu); vp[3 * 136] = (bf16_t)(raw.y >> 16);
            vp[4 * 136] = (bf16_t)(raw.z & 0xffffu); vp[5 * 136] = (bf16_t)(raw.z >> 16); vp[6 * 136] = (bf16_t)(raw.w & 0xffffu); vp[7 * 136] = (bf16_t)(raw.w >> 16); }
        const int k = tid & 63;
#pragma unroll
        for (int i = 0; i < 2; ++i) { const int vc = (tid >> 6) + 8 * i; const u32x4 raw = *(const u32x4*)(C.SC + ((size_t)unit * 64 + k) * 128 + vc * 8);
            LAS bf16_t* sp = (LAS bf16_t*)(ScT + (vc * 8) * 144 + k * 2);
            sp[0 * 72] = (bf16_t)(raw.x & 0xffffu); sp[1 * 72] = (bf16_t)(raw.x >> 16); sp[2 * 72] = (bf16_t)(raw.y & 0xffffu); sp[3 * 72] = (bf16_t)(raw.y >> 16);
            sp[4 * 72] = (bf16_t)(raw.z & 0xffffu); sp[5 * 72] = (bf16_t)(raw.z >> 16); sp[6 * 72] = (bf16_t)(raw.w & 0xffffu); sp[7 * 72] = (bf16_t)(raw.w >> 16); }
    }
    __syncthreads();
    {
        const int cc = lane & 15, fq = lane >> 4;
        const bf16x8 qB0 = *(const LAS bf16x8*)(qg + (16 * w + cc) * 144 + 16 * fq), qB1 = *(const LAS bf16x8*)(qg + (16 * w + cc) * 144 + 64 + 16 * fq);
        f32x4 A[8];
#pragma unroll
        for (int T = 0; T < 8; ++T) { f32x4 s = {0.f, 0.f, 0.f, 0.f};
            if (T <= w) { const LAS unsigned char* kp = kg + (16 * T + cc) * 144 + 16 * fq; const bf16x8 a0 = *(const LAS bf16x8*)kp, a1 = *(const LAS bf16x8*)(kp + 64);
                s = MFMA16(a0, qB0, s); s = MFMA16(a1, qB1, s);
                if (T == w) {
#pragma unroll
                    for (int r = 0; r < 4; ++r) s[r] = (4 * fq + r > cc) ? 0.f : s[r]; } }
            A[T] = s; }
        bf16x8 P[4];
#pragma unroll
        for (int kk = 0; kk < 4; ++kk) { u32x4 pw; pw.x = pk2(A[2 * kk][0], A[2 * kk][1]); pw.y = pk2(A[2 * kk][2], A[2 * kk][3]); pw.z = pk2(A[2 * kk + 1][0], A[2 * kk + 1][1]); pw.w = pk2(A[2 * kk + 1][2], A[2 * kk + 1][3]); P[kk] = __builtin_bit_cast(bf16x8, pw); }
        f32x4 o[8]; float ss = 0.f;
#pragma unroll
        for (int Mt = 0; Mt < 8; ++Mt) { f32x4 acc = {0.f, 0.f, 0.f, 0.f};
#pragma unroll
            for (int kk = 0; kk < 4; ++kk) if (2 * kk <= w) { const LAS unsigned char* vp = vT + (16 * Mt + cc) * 272 + (32 * kk + 4 * fq) * 2; const u32x2 lo = *(const LAS u32x2*)vp, hi = *(const LAS u32x2*)(vp + 32); acc = MFMA16(mk8(lo, hi), P[kk], acc); }
            { const LAS unsigned char* sp = ScT + (16 * Mt + cc) * 144 + 16 * fq; const bf16x8 a0 = *(const LAS bf16x8*)sp, a1 = *(const LAS bf16x8*)(sp + 64); acc = MFMA16(a0, qB0, acc); acc = MFMA16(a1, qB1, acc); }
            o[Mt] = acc; ss += (acc[0] * acc[0] + acc[1] * acc[1]) + (acc[2] * acc[2] + acc[3] * acc[3]); }
        ss += __shfl_xor(ss, 16); ss += __shfl_xor(ss, 32);
        const float rs = rsqrtf(ss * (1.0f / 128.0f) + EPS);
        const int t = 16 * w + cc;
        if (t < nv) { const size_t row = (size_t)(r0 + t);
#pragma unroll
            for (int Mt = 0; Mt < 8; ++Mt) { const int v0 = 16 * Mt + 4 * fq; const u32x2 og = *(const u32x2*)(C.Z + row * ZP + ZOG + h * 128 + v0); const f32x4 gn = *(const f32x4*)(C.gnw + v0);
                const float y0 = o[Mt][0] * rs * gn[0] * silu_f(bflo(og.x)), y1 = o[Mt][1] * rs * gn[1] * silu_f(bfhi(og.x)), y2 = o[Mt][2] * rs * gn[2] * silu_f(bflo(og.y)), y3 = o[Mt][3] * rs * gn[3] * silu_f(bfhi(og.y));
                u32x2 wv; wv.x = pk2(y0, y1); wv.y = pk2(y2, y3); *(u32x2*)(C.MRG + row * DM + 512 + h * 128 + v0) = wv; } }
    }
    __syncthreads();
}

DI void gla_scan(const Ctx& C, int gtid, int gthreads) {
    for (int idx = gtid; idx < 16 * 64 * 128; idx += gthreads) {
        const int v = idx & 127, k = (idx >> 7) & 63, bh = idx >> 13; float S = 0.f;
#pragma unroll 3
        for (int c = 0; c < NCH; ++c) { const size_t unit = (size_t)bh * NCH + c;
            C.SC[(unit * 64 + k) * 128 + v] = (bf16_t)(pk2(S, 0.f) & 0xffffu);
            S = __expf(C.GL[unit * 64 + k]) * S + C.DS[(unit * 64 + k) * 128 + v]; }
        const int h = bh & 3, b = bh >> 2;
        C.out[O_SP + ((size_t)((C.l * NBATCH + b) * 4 + h) * 64 + k) * 128 + v] = S;
    }
}

struct WSrc { int mat; const float* W; const float* W2; const float* gain; const float* wg2; };
DI float wsrc(const WSrc& s, int k, int n) {
    if (s.mat == 0) {
        if (n < 2304) { const int col = n < 1792 ? n : n + 16; const float sc = (n >= 768 && n < 1024) ? 0.125f : 1.0f; return s.W[(size_t)k * INW + col] * s.gain[k] * sc; }
        const int e = n - 2304; float a = 0.f;
#pragma unroll
        for (int r = 0; r < 16; ++r) a += s.W[(size_t)k * INW + 1792 + r] * s.wg2[r * 256 + e];
        return a * s.gain[k];
    } else if (s.mat == 1) { return s.W[(size_t)k * DM + n];
    } else if (s.mat == 2) { const int pn = n >> 8, j = n & 255; return (j < 128 ? s.W[(size_t)k * DFFN + 128 * pn + j] : s.W2[(size_t)k * DFFN + 128 * pn + j - 128]) * s.gain[k];
    } else { return s.W[(size_t)k * DM + n]; }
}
DI void conv_item(const WSrc& s, int K, int N, bf16_t* WT, LAS float* scr, int item, int lane) {
    const int nblk = N / 32, kb = item / nblk, nb = item % nblk, k0 = 64 * kb, n0 = 32 * nb;
#pragma unroll 8
    for (int i = 0; i < 32; ++i) { const int kk = 2 * i + (lane >> 5); scr[kk * 33 + (lane & 31)] = wsrc(s, k0 + kk, n0 + (lane & 31)); }
    asm volatile("s_waitcnt lgkmcnt(0)" ::: "memory");
    const int c = lane & 7;
#pragma unroll
    for (int j = 0; j < 4; ++j) { const int n = (lane >> 3) + 8 * j; const LAS float* sp = scr + (8 * c) * 33 + n;
        u32x4 o; o.x = pk2(sp[0 * 33], sp[1 * 33]); o.y = pk2(sp[2 * 33], sp[3 * 33]); o.z = pk2(sp[4 * 33], sp[5 * 33]); o.w = pk2(sp[6 * 33], sp[7 * 33]);
        *(u32x4*)(WT + (size_t)(n0 + n) * K + k0 + 8 * c) = o; }
    asm volatile("s_waitcnt lgkmcnt(0)" ::: "memory");
}
constexpr int NI_IN = 16 * 80, NI_O = 16 * 32, NI_GU = 16 * 176, NI_D = 44 * 32, NI_L = NI_IN + NI_O + NI_GU + NI_D;

DI void prologue(const Args& a, const RowMap& rm, LAS unsigned char* lds, int tid, int vcu, int G) {
    const int lane = tid & 63, wave = tid >> 6, gw = vcu * 8 + wave, NGW = G * 8;
    LAS float* scr = (LAS float*)(lds + wave * 16384);
    for (int it = gw; it < DEPTH * NI_L; it += NGW) {
        const int l = it / NI_L; int r = it % NI_L;
        unsigned char* wl = a.ws + WS_W + (size_t)l * SZ_WL;
        if (r < NI_IN) { WSrc s{0, a.in[7] + (size_t)l * DM * INW, nullptr, a.in[6] + l * DM, a.in[11] + l * 16 * 256}; conv_item(s, DM, NIN, (bf16_t*)wl, scr, r, lane); continue; } r -= NI_IN;
        if (r < NI_O) { WSrc s{1, a.in[14] + (size_t)l * DM * DM, nullptr, nullptr, nullptr}; conv_item(s, DM, DM, (bf16_t*)(wl + SZ_WIN), scr, r, lane); continue; } r -= NI_O;
        if (r < NI_GU) { WSrc s{2, a.in[16] + (size_t)l * DM * DFFN, a.in[17] + (size_t)l * DM * DFFN, a.in[15] + l * DM, nullptr}; conv_item(s, DM, NGU, (bf16_t*)(wl + SZ_WIN + SZ_WO), scr, r, lane); continue; } r -= NI_GU;
        { WSrc s{3, a.in[18] + (size_t)l * DFFN * DM, nullptr, nullptr, nullptr}; conv_item(s, DFFN, DM, (bf16_t*)(wl + SZ_WIN + SZ_WO + SZ_WGU), scr, r, lane); }
    }
    bf16_t* XB = (bf16_t*)(a.ws + WS_XB); bf16_t* MRG = (bf16_t*)(a.ws + WS_MRG); float* ssqA = (float*)(a.ws + WS_SSQA);
    for (int m = gw; m < MP; m += NGW) {
        const float* ip = row_in(rm, m); f32x4 v[4]; float s = 0.f;
#pragma unroll
        for (int j = 0; j < 4; ++j) { v[j] = ip ? ((const f32x4*)ip)[lane + 64 * j] : (f32x4){0.f, 0.f, 0.f, 0.f}; s += (v[j][0] * v[j][0] + v[j][1] * v[j][1]) + (v[j][2] * v[j][2] + v[j][3] * v[j][3]); }
#pragma unroll
        for (int o = 1; o < 64; o <<= 1) s += __shfl_xor(s, o);
#pragma unroll
        for (int j = 0; j < 4; ++j) { u32x2 w; w.x = pk2(v[j][0], v[j][1]); w.y = pk2(v[j][2], v[j][3]); ((u32x2*)(XB + (size_t)m * DM))[lane + 64 * j] = w; if (!ip) ((u32x2*)(MRG + (size_t)m * DM))[lane + 64 * j] = (u32x2){0u, 0u}; }
        if (lane < 16) ssqA[(size_t)m * 16 + lane] = lane == 0 ? s : 0.f;
    }
}

DI int mk_tid(int wave_s) { int lane; asm volatile("v_mbcnt_lo_u32_b32 %0, -1, 0\n\tv_mbcnt_hi_u32_b32 %0, -1, %0" : "=v"(lane)); return wave_s * 64 + lane; }
template <class T> DI T* opq(T* p) { asm volatile("" : "+s"(p)); return p; }
DI Ctx make_ctx(const Args& a, int l) {
    unsigned char* ws = opq(a.ws);
    Ctx C; C.l = l; C.Z = (const bf16_t*)(ws + WS_Z); C.LD = (float*)(ws + WS_LD); C.MRG = (bf16_t*)(ws + WS_MRG); C.DS = (float*)(ws + WS_DS); C.SC = (bf16_t*)(ws + WS_SC); C.GL = (float*)(ws + WS_GL);
    C.qnw = a.in[8] + l * 64; C.knw = a.in[9] + l * 64; C.sinks = a.in[10] + l * 8; C.gnw = a.in[13] + l * 128;
    C.cache_k = a.in[2]; C.cache_v = a.in[3]; C.state = a.in[4]; C.out = opq(a.out);
    return C;
}
DI RowMap make_rm(const Args& a) { float* out = opq(a.out); unsigned char* ws = opq(a.ws); return RowMap{a.in[0], a.in[1], a.in[5], out + O_YP, out + O_YS, (float*)(ws + WS_XMETA)}; }

__global__ void __launch_bounds__(512, 2) hymba_fwd(Args a) {
    extern __shared__ __attribute__((aligned(16))) unsigned char lds_raw[];
    LAS unsigned char* lds = (LAS unsigned char*)lds_raw;
    const int G = gridDim.x, bx = blockIdx.x; const int wave_s = __builtin_amdgcn_readfirstlane((int)threadIdx.x >> 6);
#define opaque_tid() mk_tid(wave_s)
    const int vcu = (G % 8 == 0) ? (bx % 8) * (G / 8) + bx / 8 : bx;
    const int lo = a.ph_lo, hi = a.ph_hi;
#define IN(k) (lo <= (k) && (k) < hi)
#define SEAM(k) do { if (IN(k) && IN((k) + 1)) { cg::this_grid().sync(); } } while (0)
    if (IN(0)) { const RowMap rm = make_rm(a); prologue(a, rm, lds, opaque_tid(), vcu, G); }
    SEAM(0);
#pragma unroll 1
    for (int l = 0; l < DEPTH; ++l) {
        const int pb = 1 + 7 * l;
        if (IN(pb + 0)) {
            unsigned char* ws = opq(a.ws); unsigned char* wl = ws + WS_W + (size_t)l * SZ_WL;
            pg8::Gemm g{(const bf16_t*)(ws + WS_XB), (const bf16_t*)wl, MP, NIN, DM}; pg8::StaticOrder S; S.init(MP, NIN, G, bx);
            pg8::EpiIn E{(bf16_t*)(ws + WS_Z), (float*)(ws + WS_LD), (const float*)(ws + WS_SSQA), a.in[12] + l * 256};
            pg8::gemm_phase<pg8::EpiIn, pg8::StaticOrder, true, true>(lds, g, S, E, opaque_tid());
        }
        SEAM(pb + 0);
        if (IN(pb + 1)) {
            const Ctx C = make_ctx(a, l); const int tid = opaque_tid();
            constexpr int N1 = 16 * NCH, N2 = DECB, N3 = DECB * 4;
#pragma unroll 1
            for (int u = vcu; u < N1 + N2 + N3; u += G) {
                if (u < N1) gla1_unit(C, u, lds, tid); else if (u < N1 + N2) attn_sample_unit(C, u - N1, lds, tid); else gla_sample_unit(C, u - N1 - N2, lds, tid);
            }
        }
        SEAM(pb + 1);
        if (IN(pb + 2)) { const Ctx C = make_ctx(a, l); gla_scan(C, bx * 512 + opaque_tid(), G * 512); }
        SEAM(pb + 2);
        if (IN(pb + 3)) {
            const Ctx C = make_ctx(a, l); const int tid = opaque_tid();
            constexpr int N1 = 16 * NCH, N2 = NBATCH * 2 * 65;
#pragma unroll 1
            for (int u = vcu; u < N1 + N2; u += G) { if (u < N1) gla3_unit(C, u, lds, tid); else attn_prompt_unit(C, u - N1, lds, tid); }
        }
        SEAM(pb + 3);
        if (IN(pb + 4)) {
            unsigned char* ws = opq(a.ws); unsigned char* wl = ws + WS_W + (size_t)l * SZ_WL;
            pg8::Gemm g{(const bf16_t*)(ws + WS_MRG), (const bf16_t*)(wl + SZ_WIN), MP, DM, DM}; pg8::StaticOrder S; S.init(MP, DM, G, bx);
            pg8::EpiRes E{make_rm(a), l == 0 ? 1 : 0, (bf16_t*)(ws + WS_XB), (float*)(ws + WS_SSQB)};
            pg8::gemm_phase<pg8::EpiRes, pg8::StaticOrder, true, true>(lds, g, S, E, opaque_tid());
        }
        SEAM(pb + 4);
        if (IN(pb + 5)) {
            unsigned char* ws = opq(a.ws); unsigned char* wl = ws + WS_W + (size_t)l * SZ_WL;
            pg8::Gemm g{(const bf16_t*)(ws + WS_XB), (const bf16_t*)(wl + SZ_WIN + SZ_WO), MP, NGU, DM}; pg8::StaticOrder S; S.init(MP, NGU, G, bx);
            pg8::EpiGU E{(bf16_t*)(ws + WS_U), (const float*)(ws + WS_SSQB)};
            pg8::gemm_phase<pg8::EpiGU, pg8::StaticOrder, true, true>(lds, g, S, E, opaque_tid());
        }
        SEAM(pb + 5);
        if (IN(pb + 6)) {
            unsigned char* ws = opq(a.ws); unsigned char* wl = ws + WS_W + (size_t)l * SZ_WL;
            pg8::Gemm g{(const bf16_t*)(ws + WS_U), (const bf16_t*)(wl + SZ_WIN + SZ_WO + SZ_WGU), MP, DM, DFFN}; pg8::StaticOrder S; S.init(MP, DM, G, bx);
            pg8::EpiRes E{make_rm(a), 0, (bf16_t*)(ws + WS_XB), (float*)(ws + WS_SSQA)};
            pg8::gemm_phase<pg8::EpiRes, pg8::StaticOrder, true, true>(lds, g, S, E, opaque_tid());
        }
        if (l + 1 < DEPTH) SEAM(pb + 6);
    }
#undef IN
#undef SEAM
#undef opaque_tid
}

#ifndef N_LAUNCH_MODE
#define N_LAUNCH_MODE 0
#endif
extern "C" void kernel_launch(void* const* d_in, const int* in_sizes, int n_in, void* d_out, int out_size, void* d_ws, size_t ws_size, hipStream_t stream) {
    static int grid = 0;
    if (grid == 0) {
        if (n_in != 19 || out_size != (int)O_END || ws_size < WS_END) { fprintf(stderr, "kernel_launch: unexpected shapes: n_in %d out %d ws %zu (need %zu)\n", n_in, out_size, ws_size, (size_t)WS_END); grid = -1; return; }
        int dev = 0, cus = 0, per_cu = 0;
        (void)hipGetDevice(&dev); (void)hipDeviceGetAttribute(&cus, hipDeviceAttributeMultiprocessorCount, dev);
        if (hipFuncSetAttribute((const void*)hymba_fwd, hipFuncAttributeMaxDynamicSharedMemorySize, LDS_BYTES) != hipSuccess) { fprintf(stderr, "kernel_launch: hipFuncSetAttribute failed\n"); grid = -1; return; }
        if (hipOccupancyMaxActiveBlocksPerMultiprocessor(&per_cu, (const void*)hymba_fwd, 512, LDS_BYTES) != hipSuccess || per_cu < 1) { fprintf(stderr, "kernel_launch: occupancy query says %d\n", per_cu); per_cu = 1; }
        (void)hipGetLastError();
        grid = cus > 0 ? cus : 256;
    }
    if (grid < 0) return;
    Args a{};
    for (int i = 0; i < 19; ++i) a.in[i] = (const float*)d_in[i];
    a.out = (float*)d_out; a.ws = (unsigned char*)d_ws;
#if N_LAUNCH_MODE == 1
    for (int p = 0; p < NPHASE; ++p) { a.ph_lo = p; a.ph_hi = p + 1; hipLaunchKernelGGL(hymba_fwd, dim3(grid), dim3(512), LDS_BYTES, stream, a); }
#else
    a.ph_lo = 0; a.ph_hi = NPHASE;
    void* args[] = {&a};
    hipError_t e = hipLaunchCooperativeKernel((const void*)hymba_fwd, dim3(grid), dim3(512), args, LDS_BYTES, stream);
    if (e != hipSuccess) fprintf(stderr, "cooperative launch failed: %s (grid %d)\n", hipGetErrorString(e), grid);
#endif
}
```

```cpp
#include <hip/hip_runtime.h>
#include <hip/hip_cooperative_groups.h>
#include <cstdio>
#include <cstdint>
namespace cg = cooperative_groups;

#define DI __device__ __forceinline__
#define LAS __attribute__((address_space(3)))
typedef unsigned short bf16_t;
typedef short bf16x8 __attribute__((ext_vector_type(8)));
typedef float f32x4 __attribute__((ext_vector_type(4)));
typedef float f32x2 __attribute__((ext_vector_type(2)));
typedef unsigned u32x4 __attribute__((ext_vector_type(4)));
typedef unsigned u32x2 __attribute__((ext_vector_type(2)));
typedef __bf16 bf16x2_t __attribute__((ext_vector_type(2)));

constexpr int DM = 1024, NBATCH = 4, SEQ = 4096, LP = 4112  , DEPTH = 2, DECB = 128, DECT = 8;
constexpr int MPROMPT = NBATCH * LP, MREAL = MPROMPT + DECB * DECT, MP = 17664  ;
constexpr int INW = 2320, ZP = 2304, NIN = 2560, DFFN = 2816, NGU = 5632;
constexpr int ZQ = 0, ZK = 512, ZV = 640, ZGQ = 768, ZGK = 1024, ZGV = 1280, ZOG = 1792;
constexpr int NCH = 33;
constexpr float EPS = 1e-6f, LOG2E = 1.4426950408889634f;
constexpr size_t O_YP = 0, O_YS = 16777216, O_CKP = 17825792, O_CVP = 17956864, O_SP = 18087936, O_CKS = 18350080, O_CVS = 22544384, O_SS = 26738688, O_END = 35127296;

DI unsigned pk2(float lo, float hi) { f32x2 v = {lo, hi}; bf16x2_t b = __builtin_convertvector(v, bf16x2_t); return __builtin_bit_cast(unsigned, b); }
DI float bflo(unsigned w) { return __uint_as_float(w << 16); }
DI float bfhi(unsigned w) { return __uint_as_float(w & 0xffff0000u); }
DI float bf2f(bf16_t h) { return __uint_as_float((unsigned)h << 16); }
DI void unpack8(const u32x4 w, float* f) { f[0] = bflo(w.x); f[1] = bfhi(w.x); f[2] = bflo(w.y); f[3] = bfhi(w.y); f[4] = bflo(w.z); f[5] = bfhi(w.z); f[6] = bflo(w.w); f[7] = bfhi(w.w); }
DI float silu_f(float x) { return x * __builtin_amdgcn_rcpf(1.0f + __expf(-x)); }

struct RowMap { const float* xp; const float* xs; const float* meta; float* yp; float* ys; float* xmeta; };
DI const float* row_in(const RowMap& rm, int row) {
    if (row < MPROMPT) { const int b = row / LP, p = row - b * LP; return p < 16 ? rm.meta + (size_t)p * DM : rm.xp + ((size_t)b * SEQ + (p - 16)) * DM; }
    if (row < MREAL) return rm.xs + (size_t)(row - MPROMPT) * DM;
    return nullptr;
}
DI float* row_out(const RowMap& rm, int row) {
    if (row < MPROMPT) { const int b = row / LP, p = row - b * LP; return p < 16 ? rm.xmeta + (size_t)(b * 16 + p) * DM : rm.yp + ((size_t)b * SEQ + (p - 16)) * DM; }
    if (row < MREAL) return rm.ys + (size_t)(row - MPROMPT) * DM;
    return nullptr;
}
namespace pg8 {
#define PG8_LAS __attribute__((address_space(3)))
typedef unsigned short bf16_t;
typedef short bf16x8 __attribute__((ext_vector_type(8)));
typedef float f32x4 __attribute__((ext_vector_type(4)));
typedef unsigned u32x4 __attribute__((ext_vector_type(4)));
constexpr int BM = 256, BK = 64, HALF = 128, HTB = HALF * BK * 2  , STAGE_BYTES = 8 * HTB, NXCD = 8, WGM = 8;

__host__ __device__ __forceinline__ int lds_byte(int r, int c) { const int st = (r >> 4) * 2 + (c >> 5), rr = r & 15, cc = c & 31, ob = rr * 64 + cc * 2; return st * 1024 + (ob ^ (((ob >> 9) & 1) << 5)); }
__host__ __device__ __forceinline__ void stage_rc(int b, int& R, int& C) { const int st = b / 1024, sb = b % 1024, swz = sb ^ (((sb >> 9) & 1) << 5); R = (st >> 1) * 16 + swz / 64; C = (st & 1) * 32 + (swz % 64) / 2; }
__host__ __device__ __forceinline__ int perm32(int rho) { const int n = rho >> 4, i = rho & 15; return 8 * (i >> 2) + 4 * n + (i & 3); }

struct Unit { int pm, pn; };
struct Gemm { const bf16_t* A; const bf16_t* Bt; int M, N, K; };

struct StaticOrder {
    int nM, nN, nwg, G, c;
    __host__ __device__ void init(int M, int N, int G_, int c_) { nM = M / BM; nN = N / BM; nwg = nM * nN; G = G_; c = c_; }
    __host__ __device__ bool next(int i, Unit& u) const {
        const long L = (long)i * G + c; if (L >= nwg) return false;
        int wgid = (int)L; { const int q = nwg / NXCD, r = nwg % NXCD, xcd = wgid % NXCD, off = wgid / NXCD; wgid = (xcd < r ? xcd * (q + 1) : r * (q + 1) + (xcd - r) * q) + off; }
        const int nig = WGM * nN, gid = wgid / nig, fm = gid * WGM, gsz = (nM - fm) < WGM ? (nM - fm) : WGM;
        u.pm = fm + ((wgid % nig) % gsz); u.pn = (wgid % nig) / gsz; return true;
    }
    __device__ __forceinline__ void a_ready(const Unit&) const {}
    __device__ __forceinline__ void done(const Unit&) const {}
};


DI float rstd_from_slots(const float* ssq, int row) {
    const f32x4* p = (const f32x4*)(ssq + (size_t)row * 16);
    const f32x4 a = p[0], b = p[1], c = p[2], d = p[3];
    const float s = ((a[0] + a[1]) + (a[2] + a[3])) + ((b[0] + b[1]) + (b[2] + b[3])) + ((c[0] + c[1]) + (c[2] + c[3])) + ((d[0] + d[1]) + (d[2] + d[3]));
    return rsqrtf(s * (1.0f / 1024.0f) + EPS);
}
struct EpiIn {
    static constexpr bool PERM = true, AFTER_DRAIN = false;
    bf16_t* Z; float* LD; const float* ssq; const float* bg;
    __device__ __forceinline__ void operator()(const f32x4 (&acc)[2][2][4][2], const Unit& u, int wr, int wc, int fr, int fq) const {
        const int row0 = u.pm * BM + wr * 64 + fr;
        if (u.pn < 9) {
#pragma unroll
            for (int ai = 0; ai < 2; ++ai)
#pragma unroll
                for (int m = 0; m < 4; ++m) { const int row = row0 + ai * HALF + m * 16; const float rs = rstd_from_slots(ssq, row);
                    bf16_t* rowp = Z + (size_t)row * ZP + u.pn * BM + wc * 32 + 8 * fq;
#pragma unroll
                    for (int bj = 0; bj < 2; ++bj) { const f32x4 v0 = acc[ai][bj][m][0] * rs, v1 = acc[ai][bj][m][1] * rs;
                        u32x4 w; w.x = pk2(v0[0], v0[1]); w.y = pk2(v0[2], v0[3]); w.z = pk2(v1[0], v1[1]); w.w = pk2(v1[2], v1[3]);
                        *(u32x4*)(rowp + bj * HALF) = w; }
                    asm volatile("" ::: "memory"); }
        } else {
            const int e0 = wc * 32 + 8 * fq;
#pragma unroll
            for (int bj = 0; bj < 2; ++bj) { const f32x4 b0 = *(const f32x4*)(bg + e0 + bj * HALF), b1 = *(const f32x4*)(bg + e0 + bj * HALF + 4);
#pragma unroll
                for (int ai = 0; ai < 2; ++ai)
#pragma unroll
                    for (int m = 0; m < 4; ++m) { const int row = row0 + ai * HALF + m * 16; const float rs = rstd_from_slots(ssq, row);
                        const f32x4 x0 = acc[ai][bj][m][0] * rs + b0, x1 = acc[ai][bj][m][1] * rs + b1; f32x4 o0, o1;
#pragma unroll
                        for (int i = 0; i < 4; ++i) { o0[i] = (fminf(x0[i], 0.f) - __logf(1.0f + __expf(-fabsf(x0[i])))) * 0.0625f; o1[i] = (fminf(x1[i], 0.f) - __logf(1.0f + __expf(-fabsf(x1[i])))) * 0.0625f; }
                        float* lp = LD + (size_t)row * 256 + e0 + bj * HALF; *(f32x4*)lp = o0; *(f32x4*)(lp + 4) = o1; asm volatile("" ::: "memory"); } }
        }
    }
};
struct EpiRes {
    static constexpr bool PERM = true, AFTER_DRAIN = false;
    RowMap rm; int first; bf16_t* XB; float* ssq;
    __device__ __forceinline__ void operator()(const f32x4 (&acc)[2][2][4][2], const Unit& u, int wr, int wc, int fr, int fq) const {
        const int row0 = u.pm * BM + wr * 64 + fr, col0 = u.pn * BM + wc * 32 + 8 * fq;
#pragma unroll
        for (int ai = 0; ai < 2; ++ai)
#pragma unroll
            for (int m = 0; m < 4; ++m) { const int row = row0 + ai * HALF + m * 16;
                float* op = row_out(rm, row); const float* ip = first ? row_in(rm, row) : op; float ss = 0.f;
                if (op) {
#pragma unroll
                    for (int bj = 0; bj < 2; ++bj) { const int col = col0 + bj * HALF;
                        const f32x4 v0 = acc[ai][bj][m][0] + *(const f32x4*)(ip + col), v1 = acc[ai][bj][m][1] + *(const f32x4*)(ip + col + 4);
                        *(f32x4*)(op + col) = v0; *(f32x4*)(op + col + 4) = v1;
                        u32x4 w; w.x = pk2(v0[0], v0[1]); w.y = pk2(v0[2], v0[3]); w.z = pk2(v1[0], v1[1]); w.w = pk2(v1[2], v1[3]);
                        *(u32x4*)(XB + (size_t)row * DM + col) = w;
                        ss += (v0[0] * v0[0] + v0[1] * v0[1]) + (v0[2] * v0[2] + v0[3] * v0[3]) + (v1[0] * v1[0] + v1[1] * v1[1]) + (v1[2] * v1[2] + v1[3] * v1[3]); }
                }
                ss += __shfl_xor(ss, 16); ss += __shfl_xor(ss, 32);
                if (fq == 0) ssq[(size_t)row * 16 + u.pn * 4 + wc] = ss; asm volatile("" ::: "memory"); }
    }
};
struct EpiGU {
    static constexpr bool PERM = true, AFTER_DRAIN = false;
    bf16_t* U; const float* ssq;
    __device__ __forceinline__ void operator()(const f32x4 (&acc)[2][2][4][2], const Unit& u, int wr, int wc, int fr, int fq) const {
        const int row0 = u.pm * BM + wr * 64 + fr, f0 = u.pn * HALF + wc * 32 + 8 * fq;
#pragma unroll
        for (int ai = 0; ai < 2; ++ai)
#pragma unroll
            for (int m = 0; m < 4; ++m) { const int row = row0 + ai * HALF + m * 16; const float rs = rstd_from_slots(ssq, row);
                float o[8];
#pragma unroll
                for (int n = 0; n < 2; ++n)
#pragma unroll
                    for (int i = 0; i < 4; ++i) { const float g = acc[ai][0][m][n][i] * rs, up = acc[ai][1][m][n][i] * rs; o[4 * n + i] = silu_f(g) * up; }
                u32x4 w; w.x = pk2(o[0], o[1]); w.y = pk2(o[2], o[3]); w.z = pk2(o[4], o[5]); w.w = pk2(o[6], o[7]);
                *(u32x4*)(U + (size_t)row * DFFN + f0) = w; asm volatile("" ::: "memory"); }
    }
};
template <class Epi, class Sched, bool ALIGN_EPI = false, bool SP2 = false>
__device__ __forceinline__ void gemm_phase(PG8_LAS unsigned char* lds, const Gemm g, const Sched& S, const Epi& E, const int tid_in) {
    const int tid = tid_in, wid = __builtin_amdgcn_readfirstlane(tid >> 6), lane = tid & 63, wr = wid >> 2, wc = wid & 3, fr = lane & 15, fq = lane >> 4;
    const int K = g.K, nt = K / BK;
    unsigned voffA[2], voffB[2];
#pragma unroll
    for (int i = 0; i < 2; ++i) { int R, C; stage_rc(tid * 16 + i * 8192, R, C); const int Rb = Epi::PERM ? ((R & ~31) + perm32(R & 31)) : R;
        voffA[i] = (unsigned)(R * K + C) * 2u; voffB[i] = (unsigned)(Rb * K + C) * 2u; }
    const size_t kstep = (size_t)(BK * 2);
    const size_t hstep = (size_t)HALF * K * 2;
    const size_t tstep = 2 * hstep;
    const unsigned ldsw = (unsigned)wid * 1024u;
    const int aoff = lds_byte(wr * 64 + fr, fq * 8), boff = lds_byte(wc * 32 + fr, fq * 8);
#define PG8_SA(b, h) (((b) * 2 + (h)) * HTB)
#define PG8_SB(b, h) ((4 + (b) * 2 + (h)) * HTB)
#define PG8_STAGE(bufoff, gbase, voff) do { _Pragma("unroll") for (int _i = 0; _i < 2; ++_i) \
        __builtin_amdgcn_global_load_lds((const unsigned*)((const char*)(gbase) + (voff)[_i]), (PG8_LAS unsigned*)(lds + (bufoff) + ldsw + _i * 8192), 16, 0, 0); } while (0)
#define PG8_LDA(dst, b, h) do { _Pragma("unroll") for (int m = 0; m < 4; ++m) _Pragma("unroll") for (int k = 0; k < 2; ++k) dst[m][k] = *(const PG8_LAS bf16x8*)(lds + PG8_SA(b, h) + aoff + m * 2048 + k * 1024); } while (0)
#define PG8_LDB(dst, b, h) do { _Pragma("unroll") for (int n = 0; n < 2; ++n) _Pragma("unroll") for (int k = 0; k < 2; ++k) dst[n][k] = *(const PG8_LAS bf16x8*)(lds + PG8_SB(b, h) + boff + n * 2048 + k * 1024); } while (0)
#define PG8_MMA(ai, bj, At, Bt) do { __builtin_amdgcn_s_setprio(1); _Pragma("unroll") for (int m = 0; m < 4; ++m) _Pragma("unroll") for (int n = 0; n < 2; ++n) _Pragma("unroll") for (int k = 0; k < 2; ++k) \
        acc[ai][bj][m][n] = __builtin_amdgcn_mfma_f32_16x16x32_bf16(Bt[n][k], At[m][k], acc[ai][bj][m][n], 0, 0, 0); __builtin_amdgcn_s_setprio(0); } while (0)
#define PG8_WAIT_V(n) asm volatile("s_waitcnt vmcnt(" #n ")" ::: "memory")
#define PG8_WAIT_L(n) asm volatile("s_waitcnt lgkmcnt(" #n ")" ::: "memory")
#define PG8_BAR __builtin_amdgcn_s_barrier()
#define PG8_SCHED __builtin_amdgcn_sched_barrier(0)
    Unit cur, nxt; int ui = 0;
    if (!S.next(0, cur)) return;
    f32x4 acc[2][2][4][2];
#pragma unroll
    for (int a = 0; a < 2; ++a)
#pragma unroll
        for (int b = 0; b < 2; ++b)
#pragma unroll
            for (int m = 0; m < 4; ++m)
#pragma unroll
                for (int n = 0; n < 2; ++n) acc[a][b][m][n] = (f32x4){0.f, 0.f, 0.f, 0.f};
    bf16x8 At[4][2], B0[2][2], B1[2][2];
    const char* cA = (const char*)g.A + (size_t)cur.pm * tstep; const char* cB = (const char*)g.Bt + (size_t)cur.pn * tstep;
    S.a_ready(cur);
    if constexpr (SP2) {
        PG8_STAGE(PG8_SB(0, 0), cB, voffB); PG8_STAGE(PG8_SB(0, 1), cB + hstep, voffB); PG8_STAGE(PG8_SA(0, 0), cA, voffA); PG8_STAGE(PG8_SA(0, 1), cA + hstep, voffA);
        if (wr == 1) PG8_BAR;
        PG8_WAIT_V(2); PG8_BAR;
        PG8_STAGE(PG8_SB(1, 0), cB + kstep, voffB); PG8_STAGE(PG8_SA(1, 0), cA + kstep, voffA); PG8_STAGE(PG8_SB(1, 1), cB + hstep + kstep, voffB);
        PG8_WAIT_V(6); PG8_BAR;
    } else {
        PG8_STAGE(PG8_SB(0, 0), cB, voffB); PG8_STAGE(PG8_SA(0, 0), cA, voffA); PG8_STAGE(PG8_SB(0, 1), cB + hstep, voffB); PG8_STAGE(PG8_SA(0, 1), cA + hstep, voffA);
        if (wr == 1) PG8_BAR;
        PG8_WAIT_V(4); PG8_BAR;
        PG8_STAGE(PG8_SB(1, 0), cB + kstep, voffB); PG8_STAGE(PG8_SA(1, 0), cA + kstep, voffA); PG8_STAGE(PG8_SB(1, 1), cB + hstep + kstep, voffB);
        PG8_WAIT_V(6); PG8_BAR;
    }
    for (;;) {
        const bool has_next = S.next(ui + 1, nxt);
        const char* nA = has_next ? (const char*)g.A + (size_t)nxt.pm * tstep : cA; const char* nB = has_next ? (const char*)g.Bt + (size_t)nxt.pn * tstep : cB;
        for (int t = 0; t < nt; t += 2) {
            const bool last = (t == nt - 2);
            const char* a1 = cA + (size_t)(t + 1) * kstep;
            const char* a2 = last ? nA : cA + (size_t)(t + 2) * kstep; const char* b2 = last ? nB : cB + (size_t)(t + 2) * kstep;
            const char* a3 = a2 + kstep; const char* b3 = b2 + kstep;
            if (last && has_next) S.a_ready(nxt);
            if constexpr (SP2) {
            PG8_LDB(B0, 0, 0); PG8_LDB(B1, 0, 1); PG8_SCHED; PG8_LDA(At, 0, 0); PG8_STAGE(PG8_SA(1, 1), a1 + hstep, voffA);
            PG8_WAIT_V(8); PG8_WAIT_L(0); PG8_BAR; PG8_MMA(0, 0, At, B0); PG8_MMA(0, 1, At, B1); PG8_BAR; PG8_SCHED;
            PG8_LDA(At, 0, 1); PG8_STAGE(PG8_SB(0, 0), b2, voffB); PG8_STAGE(PG8_SB(0, 1), b2 + hstep, voffB); PG8_STAGE(PG8_SA(0, 0), a2, voffA);
            PG8_WAIT_V(8); PG8_WAIT_L(0); PG8_BAR; PG8_MMA(1, 0, At, B0); PG8_MMA(1, 1, At, B1); PG8_BAR; PG8_SCHED;
            PG8_LDB(B0, 1, 0); PG8_LDB(B1, 1, 1); PG8_SCHED; PG8_LDA(At, 1, 0); PG8_STAGE(PG8_SA(0, 1), a2 + hstep, voffA);
            PG8_WAIT_V(8); PG8_WAIT_L(0); PG8_BAR; PG8_MMA(0, 0, At, B0); PG8_MMA(0, 1, At, B1); PG8_BAR; PG8_SCHED;
            PG8_LDA(At, 1, 1); PG8_STAGE(PG8_SB(1, 0), b3, voffB); PG8_STAGE(PG8_SB(1, 1), b3 + hstep, voffB); PG8_STAGE(PG8_SA(1, 0), a3, voffA);
            PG8_WAIT_V(8); PG8_WAIT_L(0); PG8_BAR; PG8_MMA(1, 0, At, B0); PG8_MMA(1, 1, At, B1); PG8_BAR; PG8_SCHED;
            } else {
            PG8_LDB(B0, 0, 0); PG8_SCHED; PG8_LDA(At, 0, 0); PG8_STAGE(PG8_SA(1, 1), a1 + hstep, voffA);
            PG8_WAIT_L(8); PG8_BAR; PG8_WAIT_L(0); PG8_MMA(0, 0, At, B0); PG8_BAR; PG8_SCHED;
            PG8_LDB(B1, 0, 1); PG8_STAGE(PG8_SB(0, 0), b2, voffB);
            PG8_BAR; PG8_WAIT_L(0); PG8_MMA(0, 1, At, B1); PG8_BAR;
            PG8_LDA(At, 0, 1); PG8_STAGE(PG8_SA(0, 0), a2, voffA);
            PG8_BAR; PG8_WAIT_L(0); PG8_MMA(1, 0, At, B0); PG8_BAR; PG8_SCHED;
            PG8_STAGE(PG8_SB(0, 1), b2 + hstep, voffB);
            PG8_WAIT_V(6); PG8_BAR; PG8_MMA(1, 1, At, B1); PG8_BAR;
            PG8_LDB(B0, 1, 0); PG8_SCHED; PG8_LDA(At, 1, 0); PG8_STAGE(PG8_SA(0, 1), a2 + hstep, voffA);
            PG8_WAIT_L(8); PG8_BAR; PG8_WAIT_L(0); PG8_MMA(0, 0, At, B0); PG8_BAR; PG8_SCHED;
            PG8_LDB(B1, 1, 1); PG8_STAGE(PG8_SB(1, 0), b3, voffB);
            PG8_BAR; PG8_WAIT_L(0); PG8_MMA(0, 1, At, B1); PG8_BAR;
            PG8_LDA(At, 1, 1); PG8_STAGE(PG8_SA(1, 0), a3, voffA);
            PG8_BAR; PG8_WAIT_L(0); PG8_MMA(1, 0, At, B0); PG8_BAR; PG8_SCHED;
            PG8_STAGE(PG8_SB(1, 1), b3 + hstep, voffB);
            PG8_WAIT_V(6); PG8_BAR; PG8_MMA(1, 1, At, B1); PG8_BAR;
            }
        }
        if constexpr (ALIGN_EPI) { if (wr == 0) PG8_BAR; }
        if constexpr (!Epi::AFTER_DRAIN) { E(acc, cur, wr, wc, fr, fq); S.done(cur); }
        if (!has_next) break;
#pragma unroll
        for (int a = 0; a < 2; ++a)
#pragma unroll
            for (int b = 0; b < 2; ++b)
#pragma unroll
                for (int m = 0; m < 4; ++m)
#pragma unroll
                    for (int n = 0; n < 2; ++n) acc[a][b][m][n] = (f32x4){0.f, 0.f, 0.f, 0.f};
        cur = nxt; cA = nA; cB = nB; ++ui;
        if constexpr (ALIGN_EPI) { if (wr == 1) PG8_BAR; }
    }
    PG8_WAIT_V(0);
    if constexpr (!ALIGN_EPI) { if (wr == 0) PG8_BAR; }
    PG8_BAR;
    if constexpr (Epi::AFTER_DRAIN) { E.fused(acc, cur, wr, wc, fr, fq, lds, wid, lane); S.done(cur); }
#undef PG8_SA
#undef PG8_SB
#undef PG8_STAGE
#undef PG8_LDA
#undef PG8_LDB
#undef PG8_MMA
#undef PG8_WAIT_V
#undef PG8_WAIT_L
#undef PG8_BAR
#undef PG8_SCHED
}
}

constexpr size_t SZ_WIN = (size_t)NIN * DM * 2, SZ_WO = (size_t)DM * DM * 2, SZ_WGU = (size_t)NGU * DM * 2, SZ_WD = (size_t)DM * DFFN * 2, SZ_WL = SZ_WIN + SZ_WO + SZ_WGU + SZ_WD;
constexpr size_t WS_CTL = 0;
constexpr size_t WS_W = 16384;
constexpr size_t WS_XB = WS_W + DEPTH * SZ_WL;
constexpr size_t WS_MRG = WS_XB + (size_t)MP * DM * 2;
constexpr size_t WS_Z = WS_MRG + (size_t)MP * DM * 2;
constexpr size_t WS_LD = WS_Z + (size_t)MP * ZP * 2;
constexpr size_t WS_U = WS_Z;
constexpr size_t WS_DS = WS_LD + (size_t)MP * 256 * 4;
constexpr size_t WS_SC = WS_DS + (size_t)16 * NCH * 64 * 128 * 4;
constexpr size_t WS_GL = WS_SC + (size_t)16 * NCH * 64 * 128 * 2;
constexpr size_t WS_SSQA = WS_GL + (size_t)16 * NCH * 64 * 4;
constexpr size_t WS_SSQB = WS_SSQA + (size_t)MP * 16 * 4;
constexpr size_t WS_XMETA = WS_SSQB + (size_t)MP * 16 * 4;
constexpr size_t WS_END = WS_XMETA + (size_t)64 * DM * 4;
static_assert((size_t)MP * DFFN * 2 <= (size_t)MP * ZP * 2 + (size_t)MP * 256 * 4, "U overlay fits Z|LD");
static_assert(WS_END <= 268435456ull, "workspace map fits 256 MiB");

#ifndef REP_PRO
#define REP_PRO 1
#endif
#ifndef REP_WIN
#define REP_WIN 1
#endif
#ifndef REP_MB
#define REP_MB 1
#endif
#ifndef REP_SCAN
#define REP_SCAN 1
#endif
#ifndef REP_GU
#define REP_GU 1
#endif
#ifndef XSYNC
#define XSYNC 0
#endif
constexpr int LDS_BYTES = 147456;
constexpr int NPHASE = 1 + 7 * DEPTH;

struct Args { const float* in[19]; float* out; unsigned char* ws; int ph_lo, ph_hi; };
typedef const __attribute__((address_space(4))) Args* KA;
DI KA ka_ptr() { KA p = (KA)__builtin_amdgcn_kernarg_segment_ptr(); asm volatile("" : "+s"(p)); return p; }

DI int mk_tid(int wave_s) { int lane; asm volatile("v_mbcnt_lo_u32_b32 %0, -1, 0\n\tv_mbcnt_hi_u32_b32 %0, -1, %0" : "=v"(lane)); return wave_s * 64 + lane; }
DI bf16x8 mk8(u32x2 lo, u32x2 hi) { u32x4 w; w.x = lo.x; w.y = lo.y; w.z = hi.x; w.w = hi.y; return __builtin_bit_cast(bf16x8, w); }
#define MFMA16(a, b, c) __builtin_amdgcn_mfma_f32_16x16x32_bf16((a), (b), (c), 0, 0, 0)

DI void attn_wave(const LAS unsigned char* Ks, const LAS unsigned char* Vt, const int VPB, const bf16_t* qrow, const float* qnw, const float sink2, const int jmin, const int c, const int fq, bf16_t* orow) {
    float qf[16];
    if (qrow) { const u32x4 a = *(const u32x4*)(qrow + 8 * fq), b = *(const u32x4*)(qrow + 32 + 8 * fq); unpack8(a, qf); unpack8(b, qf + 8); }
    else {
#pragma unroll
        for (int i = 0; i < 16; ++i) qf[i] = 0.f; }
    float ss = 0.f;
#pragma unroll
    for (int i = 0; i < 16; ++i) ss += qf[i] * qf[i];
    ss += __shfl_xor(ss, 16); ss += __shfl_xor(ss, 32);
    const float rs = rsqrtf(ss * (1.0f / 64.0f) + EPS) * (0.125f * LOG2E);
    const f32x4 w0 = *(const f32x4*)(qnw + 8 * fq), w1 = *(const f32x4*)(qnw + 8 * fq + 4), w2 = *(const f32x4*)(qnw + 32 + 8 * fq), w3 = *(const f32x4*)(qnw + 36 + 8 * fq);
#pragma unroll
    for (int i = 0; i < 4; ++i) { qf[i] *= rs * w0[i]; qf[4 + i] *= rs * w1[i]; qf[8 + i] *= rs * w2[i]; qf[12 + i] *= rs * w3[i]; }
    u32x4 q0, q1; q0.x = pk2(qf[0], qf[1]); q0.y = pk2(qf[2], qf[3]); q0.z = pk2(qf[4], qf[5]); q0.w = pk2(qf[6], qf[7]);
    q1.x = pk2(qf[8], qf[9]); q1.y = pk2(qf[10], qf[11]); q1.z = pk2(qf[12], qf[13]); q1.w = pk2(qf[14], qf[15]);
    const bf16x8 qB0 = __builtin_bit_cast(bf16x8, q0), qB1 = __builtin_bit_cast(bf16x8, q1);
    f32x4 acc[9];
    float mx = sink2;
#pragma unroll
    for (int T = 0; T < 9; ++T) {
        const LAS unsigned char* kp = Ks + (16 * T + c) * 144 + 16 * fq;
        const bf16x8 a0 = *(const LAS bf16x8*)kp, a1 = *(const LAS bf16x8*)(kp + 64);
        f32x4 s = {0.f, 0.f, 0.f, 0.f};
        s = MFMA16(a0, qB0, s); s = MFMA16(a1, qB1, s);
#pragma unroll
        for (int r = 0; r < 4; ++r) { const int jrel = 16 * T + 4 * fq + r, d = 128 + c - jrel; const bool ok = ((unsigned)d < 128u) && (jrel >= jmin); s[r] = ok ? s[r] : -1e30f; mx = fmaxf(mx, s[r]); }
        acc[T] = s;
    }
    mx = fmaxf(mx, __shfl_xor(mx, 16)); mx = fmaxf(mx, __shfl_xor(mx, 32));
    float sum = 0.f;
#pragma unroll
    for (int T = 0; T < 9; ++T)
#pragma unroll
        for (int r = 0; r < 4; ++r) { const float p = __builtin_amdgcn_exp2f(acc[T][r] - mx); acc[T][r] = p; sum += p; }
    sum += __shfl_xor(sum, 16); sum += __shfl_xor(sum, 32);
    const float inv = 1.0f / (sum + __builtin_amdgcn_exp2f(sink2 - mx));
    f32x4 o[4];
#pragma unroll
    for (int i = 0; i < 4; ++i) o[i] = (f32x4){0.f, 0.f, 0.f, 0.f};
#pragma unroll
    for (int kk = 0; kk < 5; ++kk) {
        u32x4 pw; pw.x = pk2(acc[2 * kk][0], acc[2 * kk][1]); pw.y = pk2(acc[2 * kk][2], acc[2 * kk][3]);
        if (kk < 4) { pw.z = pk2(acc[2 * kk + 1][0], acc[2 * kk + 1][1]); pw.w = pk2(acc[2 * kk + 1][2], acc[2 * kk + 1][3]); } else { pw.z = 0u; pw.w = 0u; }
        const bf16x8 pB = __builtin_bit_cast(bf16x8, pw);
#pragma unroll
        for (int Mt = 0; Mt < 4; ++Mt) {
            const LAS unsigned char* vp = Vt + (16 * Mt + c) * VPB + (32 * kk + 4 * fq) * 2;
            const u32x2 lo = *(const LAS u32x2*)vp, hi = *(const LAS u32x2*)(vp + 32);
            o[Mt] = MFMA16(mk8(lo, hi), pB, o[Mt]);
        }
    }
    if (orow) {
#pragma unroll
        for (int Mt = 0; Mt < 4; ++Mt) { u32x2 w; w.x = pk2(o[Mt][0] * inv, o[Mt][1] * inv); w.y = pk2(o[Mt][2] * inv, o[Mt][3] * inv); *(u32x2*)(orow + 16 * Mt + 4 * fq) = w; }
    }
}

struct Ctx {
    int l;
    const bf16_t* Z; float* LD; bf16_t* MRG; float* DS; bf16_t* SC; float* GL;
    const float *qnw, *knw, *sinks, *gnw;
    const float *cache_k, *cache_v, *state;
    float* out;
};

DI void attn_prompt_unit(const Ctx& C, int uidx, LAS unsigned char* lds, const int wave_s) {
    const int tid = mk_tid(wave_s);
    const int jb = uidx % 65, g = (uidx / 65) & 1, b = uidx / 130;
    const int p0 = 64 * jb, kbase = p0 - 128, rowbase = b * LP, nq = (LP - p0) < 64 ? (LP - p0) : 64;
    LAS unsigned char* Ks = lds; LAS unsigned char* Vt = lds + 208 * 144;
    const int lane = tid & 63, w = tid >> 6;
    {
        const int dc = tid & 7;
        const f32x4 kw0 = *(const f32x4*)(C.knw + dc * 8), kw1 = *(const f32x4*)(C.knw + dc * 8 + 4);
#pragma unroll
        for (int i = 0; i < 4; ++i) { const int j = (tid >> 3) + 64 * i, kp = kbase + j; const bool valid = (j < 192) && (kp >= 0) && (kp < LP);
            u32x4 raw = {0u, 0u, 0u, 0u}; if (valid) raw = *(const u32x4*)(C.Z + (size_t)(rowbase + kp) * ZP + ZK + g * 64 + dc * 8);
            float f[8]; unpack8(raw, f); float ss = 0.f;
#pragma unroll
            for (int e = 0; e < 8; ++e) ss += f[e] * f[e];
            ss += __shfl_xor(ss, 1); ss += __shfl_xor(ss, 2); ss += __shfl_xor(ss, 4);
            const float rs = rsqrtf(ss * (1.0f / 64.0f) + EPS);
#pragma unroll
            for (int e = 0; e < 4; ++e) { f[e] *= rs * kw0[e]; f[4 + e] *= rs * kw1[e]; }
            if (j < 208) { u32x4 o; o.x = pk2(f[0], f[1]); o.y = pk2(f[2], f[3]); o.z = pk2(f[4], f[5]); o.w = pk2(f[6], f[7]); *(LAS u32x4*)(Ks + j * 144 + dc * 16) = o; }
            if (valid && j >= 128 && kp >= LP - 128) { float* op = C.out + O_CKP + ((size_t)((C.l * NBATCH + b) * 128 + (kp - (LP - 128))) * 2 + g) * 64 + dc * 8;
                *(f32x4*)op = (f32x4){f[0], f[1], f[2], f[3]}; *(f32x4*)(op + 4) = (f32x4){f[4], f[5], f[6], f[7]}; } asm volatile("" ::: "memory"); }
    }
    {
        const int dc = w;
#pragma unroll
        for (int i = 0; i < 4; ++i) { const int j = lane + 64 * i, kp = kbase + j; const bool valid = (j < 192) && (kp >= 0) && (kp < LP);
            u32x4 raw = {0u, 0u, 0u, 0u}; if (valid) raw = *(const u32x4*)(C.Z + (size_t)(rowbase + kp) * ZP + ZV + g * 64 + dc * 8);
            if (j < 216) { LAS bf16_t* vp = (LAS bf16_t*)(Vt + (dc * 8) * 432 + j * 2);
                vp[0 * 216] = (bf16_t)(raw.x & 0xffffu); vp[1 * 216] = (bf16_t)(raw.x >> 16); vp[2 * 216] = (bf16_t)(raw.y & 0xffffu); vp[3 * 216] = (bf16_t)(raw.y >> 16);
                vp[4 * 216] = (bf16_t)(raw.z & 0xffffu); vp[5 * 216] = (bf16_t)(raw.z >> 16); vp[6 * 216] = (bf16_t)(raw.w & 0xffffu); vp[7 * 216] = (bf16_t)(raw.w >> 16); }
            if (valid && j >= 128 && kp >= LP - 128) { float f[8]; unpack8(raw, f); float* op = C.out + O_CVP + ((size_t)((C.l * NBATCH + b) * 128 + (kp - (LP - 128))) * 2 + g) * 64 + dc * 8;
                *(f32x4*)op = (f32x4){f[0], f[1], f[2], f[3]}; *(f32x4*)(op + 4) = (f32x4){f[4], f[5], f[6], f[7]}; } asm volatile("" ::: "memory"); }
    }
    __syncthreads();
    {
        const int tid2 = mk_tid(wave_s), lane = tid2 & 63, w = tid2 >> 6;
        const int s = w & 3, hp = w >> 2, c = lane & 15, fq = lane >> 4;
        if (16 * s < nq) {
#pragma unroll 1
            for (int hh = 0; hh < 2; ++hh) { const int h = g * 4 + hp * 2 + hh, qp = p0 + 16 * s + c; const bool qv = qp < LP;
                const bf16_t* qrow = qv ? C.Z + (size_t)(rowbase + qp) * ZP + ZQ + h * 64 : nullptr;
                bf16_t* orow = qv ? C.MRG + (size_t)(rowbase + qp) * DM + h * 64 : nullptr;
                attn_wave(Ks + 16 * s * 144, Vt + 16 * s * 2, 432, qrow, C.qnw, C.sinks[h] * LOG2E, 128 - p0 - 16 * s, c, fq, orow); }
        }
    }
    __syncthreads();
}

DI void attn_sample_unit(const Ctx& C, int b, LAS unsigned char* lds, const int wave_s) {
    const int tid = mk_tid(wave_s);
    const int lane = tid & 63, w = tid >> 6;
    constexpr int KSG = 160 * 144, VTG = 64 * 336, VT0 = 2 * KSG;
    const int row0 = MPROMPT + b * DECT;
    const size_t cbase = (size_t)(C.l * DECB + b) * 128;
#pragma unroll
    for (int i = 0; i < 4; ++i) {
        const int idx = tid + 512 * i, dc = idx & 7, j = (idx >> 3) & 127, g = idx >> 10;
        const float* sp = C.cache_k + ((cbase + j) * 2 + g) * 64 + dc * 8; const f32x4 a = *(const f32x4*)sp, bq = *(const f32x4*)(sp + 4);
        u32x4 o; o.x = pk2(a[0], a[1]); o.y = pk2(a[2], a[3]); o.z = pk2(bq[0], bq[1]); o.w = pk2(bq[2], bq[3]);
        *(LAS u32x4*)(lds + g * KSG + j * 144 + dc * 16) = o;
        if (j >= 8) { float* op = C.out + O_CKS + ((cbase + j - 8) * 2 + g) * 64 + dc * 8; *(f32x4*)op = a; *(f32x4*)(op + 4) = bq; }
        asm volatile("" ::: "memory");
    }
    if (w < 2) {
        const int dc = tid & 7, t = (tid >> 3) & 7, g = tid >> 6;
        const u32x4 raw = *(const u32x4*)(C.Z + (size_t)(row0 + t) * ZP + ZK + g * 64 + dc * 8);
        float f[8]; unpack8(raw, f); float ss = 0.f;
#pragma unroll
        for (int e = 0; e < 8; ++e) ss += f[e] * f[e];
        ss += __shfl_xor(ss, 1); ss += __shfl_xor(ss, 2); ss += __shfl_xor(ss, 4);
        const float rs = rsqrtf(ss * (1.0f / 64.0f) + EPS);
        const f32x4 kw0 = *(const f32x4*)(C.knw + dc * 8), kw1 = *(const f32x4*)(C.knw + dc * 8 + 4);
#pragma unroll
        for (int e = 0; e < 4; ++e) { f[e] *= rs * kw0[e]; f[4 + e] *= rs * kw1[e]; }
        u32x4 o; o.x = pk2(f[0], f[1]); o.y = pk2(f[2], f[3]); o.z = pk2(f[4], f[5]); o.w = pk2(f[6], f[7]);
        *(LAS u32x4*)(lds + g * KSG + (128 + t) * 144 + dc * 16) = o;
        float* op = C.out + O_CKS + ((cbase + 120 + t) * 2 + g) * 64 + dc * 8;
        *(f32x4*)op = (f32x4){f[0], f[1], f[2], f[3]}; *(f32x4*)(op + 4) = (f32x4){f[4], f[5], f[6], f[7]};
    } else if (w < 8) {
        const int idx = tid - 128, dc = idx & 7, r = (idx >> 3) % 24, g = idx / 192;
        unsigned z0 = 0u; asm volatile("" : "+v"(z0)); *(LAS u32x4*)(lds + g * KSG + (136 + r) * 144 + dc * 16) = (u32x4){z0, z0, z0, z0};
    }
#pragma unroll
    for (int i = 0; i < 4; ++i) {
        const int idx = tid + 512 * i, j = idx & 127, dc = (idx >> 7) & 7, g = idx >> 10;
        const float* sp = C.cache_v + ((cbase + j) * 2 + g) * 64 + dc * 8; const f32x4 a = *(const f32x4*)sp, bq = *(const f32x4*)(sp + 4);
        LAS bf16_t* vp = (LAS bf16_t*)(lds + VT0 + g * VTG + (dc * 8) * 336 + j * 2);
        const unsigned p0 = pk2(a[0], a[1]), p1 = pk2(a[2], a[3]), p2 = pk2(bq[0], bq[1]), p3 = pk2(bq[2], bq[3]);
        vp[0 * 168] = (bf16_t)(p0 & 0xffffu); vp[1 * 168] = (bf16_t)(p0 >> 16); vp[2 * 168] = (bf16_t)(p1 & 0xffffu); vp[3 * 168] = (bf16_t)(p1 >> 16);
        vp[4 * 168] = (bf16_t)(p2 & 0xffffu); vp[5 * 168] = (bf16_t)(p2 >> 16); vp[6 * 168] = (bf16_t)(p3 & 0xffffu); vp[7 * 168] = (bf16_t)(p3 >> 16);
        if (j >= 8) { float* op = C.out + O_CVS + ((cbase + j - 8) * 2 + g) * 64 + dc * 8; *(f32x4*)op = a; *(f32x4*)(op + 4) = bq; }
        asm volatile("" ::: "memory");
    }
    if (tid < 128) {
        const int t = tid & 7, dc = (tid >> 3) & 7, g = tid >> 6;
        const u32x4 raw = *(const u32x4*)(C.Z + (size_t)(row0 + t) * ZP + ZV + g * 64 + dc * 8);
        LAS bf16_t* vp = (LAS bf16_t*)(lds + VT0 + g * VTG + (dc * 8) * 336 + (128 + t) * 2);
        vp[0 * 168] = (bf16_t)(raw.x & 0xffffu); vp[1 * 168] = (bf16_t)(raw.x >> 16); vp[2 * 168] = (bf16_t)(raw.y & 0xffffu); vp[3 * 168] = (bf16_t)(raw.y >> 16);
        vp[4 * 168] = (bf16_t)(raw.z & 0xffffu); vp[5 * 168] = (bf16_t)(raw.z >> 16); vp[6 * 168] = (bf16_t)(raw.w & 0xffffu); vp[7 * 168] = (bf16_t)(raw.w >> 16);
        float f[8]; unpack8(raw, f); float* op = C.out + O_CVS + ((cbase + 120 + t) * 2 + g) * 64 + dc * 8;
        *(f32x4*)op = (f32x4){f[0], f[1], f[2], f[3]}; *(f32x4*)(op + 4) = (f32x4){f[4], f[5], f[6], f[7]};
    }
#pragma unroll
    for (int i = 0; i < 2; ++i) {
        const int idx = tid + 512 * i, part = idx & 7, d = (idx >> 3) & 63, g = idx >> 9;
        unsigned z0 = 0u; asm volatile("" : "+v"(z0)); *(LAS u32x2*)(lds + VT0 + g * VTG + d * 336 + 272 + part * 8) = (u32x2){z0, z0};
    }
    __syncthreads();
    {
        const int tid2 = mk_tid(wave_s), lane = tid2 & 63, w = tid2 >> 6;
        const int g = w >> 2, h = w, c = lane & 15, fq = lane >> 4;
        const bool qv = c < 8;
        const bf16_t* qrow = qv ? C.Z + (size_t)(row0 + c) * ZP + ZQ + h * 64 : nullptr;
        bf16_t* orow = qv ? C.MRG + (size_t)(row0 + c) * DM + h * 64 : nullptr;
        attn_wave(lds + g * KSG, lds + VT0 + g * VTG, 336, qrow, C.qnw, C.sinks[h] * LOG2E, 0, c, fq, orow);
    }
    __syncthreads();
}

DI void gla_sample_unit(const Ctx& C, int uidx, LAS unsigned char* lds, const int wave_s) {
    const int tid = mk_tid(wave_s);
    const int h = uidx & 3, b = uidx >> 2, row0 = MPROMPT + b * DECT;
    LAS float* qs = (LAS float*)lds; LAS float* ks = qs + 512; LAS float* dec = ks + 512; LAS float* vs = dec + 512; LAS float* red = vs + 1024;
    {
        const int t = tid >> 6, k = tid & 63; const bf16_t* zr = C.Z + (size_t)(row0 + t) * ZP;
        qs[tid] = bf2f(zr[ZGQ + h * 64 + k]); ks[tid] = bf2f(zr[ZGK + h * 64 + k]); dec[tid] = __expf(C.LD[(size_t)(row0 + t) * 256 + h * 64 + k]);
#pragma unroll
        for (int i = 0; i < 2; ++i) { const int idx = tid + 512 * i, tt = idx >> 7, v = idx & 127; vs[idx] = bf2f(C.Z[(size_t)(row0 + tt) * ZP + ZGV + h * 128 + v]); }
    }
    const int v = tid & 127, kq = tid >> 7;
    const size_t sbase = ((size_t)((C.l * DECB + b) * 4 + h) * 64 + 16 * kq) * 128 + v;
    float S[16];
#pragma unroll
    for (int i = 0; i < 16; ++i) S[i] = C.state[sbase + (size_t)i * 128];
    __syncthreads();
#pragma unroll
    for (int t = 0; t < 8; ++t) { float a = 0.f; const float vv = vs[t * 128 + v];
#pragma unroll
        for (int i = 0; i < 16; ++i) { const int k = 16 * kq + i; S[i] = dec[t * 64 + k] * S[i] + ks[t * 64 + k] * vv; a += qs[t * 64 + k] * S[i]; }
        red[(kq * 8 + t) * 128 + v] = a; }
    float* so = C.out + O_SS + sbase;
#pragma unroll
    for (int i = 0; i < 16; ++i) so[(size_t)i * 128] = S[i];
    __syncthreads();
    {
        const int t = tid >> 6, lane = tid & 63; float o[2]; float ss = 0.f;
#pragma unroll
        for (int i = 0; i < 2; ++i) { const int vv = lane + 64 * i; o[i] = (red[(0 * 8 + t) * 128 + vv] + red[(1 * 8 + t) * 128 + vv]) + (red[(2 * 8 + t) * 128 + vv] + red[(3 * 8 + t) * 128 + vv]); ss += o[i] * o[i]; }
#pragma unroll
        for (int m = 1; m < 64; m <<= 1) ss += __shfl_xor(ss, m);
        const float rs = rsqrtf(ss * (1.0f / 128.0f) + EPS);
#pragma unroll
        for (int i = 0; i < 2; ++i) { const int vv = lane + 64 * i; const float og = bf2f(C.Z[(size_t)(row0 + t) * ZP + ZOG + h * 128 + vv]);
            const float y = o[i] * rs * C.gnw[vv] * silu_f(og); C.MRG[(size_t)(row0 + t) * DM + 512 + h * 128 + vv] = (bf16_t)(pk2(y, 0.f) & 0xffffu); }
    }
    __syncthreads();
}

DI void gla1_unit(const Ctx& C, int unit, LAS unsigned char* lds, const int wave_s) {
    const int tid = mk_tid(wave_s);
    const int c = unit % NCH, bh = unit / NCH, h = bh & 3, b = bh >> 2;
    const int r0 = b * LP + 128 * c, nv = (LP - 128 * c) < 128 ? (LP - 128 * c) : 128;
    LAS float* Gs = (LAS float*)lds; LAS float* segtot = (LAS float*)(lds + 33280); LAS float* gl = (LAS float*)(lds + 35328);
    LAS unsigned char* kdT = lds + 35840; LAS unsigned char* vT = lds + 53248;
    const int lane = tid & 63, w = tid >> 6;
    {
        const int k = lane, seg = w; float g[16];
#pragma unroll
        for (int i = 0; i < 16; ++i) { const int t = 16 * seg + i; g[i] = t < nv ? C.LD[(size_t)(r0 + t) * 256 + h * 64 + k] : 0.f; }
#pragma unroll
        for (int i = 1; i < 16; ++i) g[i] += g[i - 1];
        segtot[seg * 64 + k] = g[15];
        __syncthreads();
        float off = 0.f, tot = 0.f;
#pragma unroll
        for (int s = 0; s < 8; ++s) { const float x = segtot[s * 64 + k]; off += (s < seg) ? x : 0.f; tot += x; }
#pragma unroll
        for (int i = 0; i < 16; ++i) { const int t = 16 * seg + i; const float x = g[i] + off; Gs[t * 65 + k] = x; if (t < nv) C.LD[(size_t)(r0 + t) * 256 + h * 64 + k] = x; }
        if (seg == 0) { gl[k] = tot; C.GL[(size_t)unit * 64 + k] = tot; }
    }
    __syncthreads();
    {
        const int t = tid & 127;
#pragma unroll
        for (int i = 0; i < 2; ++i) { const int kc = (tid >> 7) + 4 * i; u32x4 raw = {0u, 0u, 0u, 0u};
            if (t < nv) raw = *(const u32x4*)(C.Z + (size_t)(r0 + t) * ZP + ZGK + h * 64 + kc * 8);
            float f[8]; unpack8(raw, f);
#pragma unroll
            for (int e = 0; e < 8; ++e) { const float kd = f[e] * __expf(gl[kc * 8 + e] - Gs[t * 65 + kc * 8 + e]); *(LAS bf16_t*)(kdT + (kc * 8 + e) * 272 + t * 2) = (bf16_t)(pk2(kd, 0.f) & 0xffffu); } }
#pragma unroll
        for (int i = 0; i < 4; ++i) { const int vc = (tid >> 7) + 4 * i; u32x4 raw = {0u, 0u, 0u, 0u};
            if (t < nv) raw = *(const u32x4*)(C.Z + (size_t)(r0 + t) * ZP + ZGV + h * 128 + vc * 8);
            LAS bf16_t* vp = (LAS bf16_t*)(vT + (vc * 8) * 272 + t * 2);
            vp[0 * 136] = (bf16_t)(raw.x & 0xffffu); vp[1 * 136] = (bf16_t)(raw.x >> 16); vp[2 * 136] = (bf16_t)(raw.y & 0xffffu); vp[3 * 136] = (bf16_t)(raw.y >> 16);
            vp[4 * 136] = (bf16_t)(raw.z & 0xffffu); vp[5 * 136] = (bf16_t)(raw.z >> 16); vp[6 * 136] = (bf16_t)(raw.w & 0xffffu); vp[7 * 136] = (bf16_t)(raw.w >> 16); }
    }
    __syncthreads();
    {
        const int cc = lane & 15, fq = lane >> 4;
#pragma unroll
        for (int kt = 0; kt < 4; ++kt) { f32x4 acc = {0.f, 0.f, 0.f, 0.f};
#pragma unroll
            for (int ks = 0; ks < 4; ++ks) { const bf16x8 a = *(const LAS bf16x8*)(kdT + (16 * kt + cc) * 272 + (32 * ks + 8 * fq) * 2), bb = *(const LAS bf16x8*)(vT + (16 * w + cc) * 272 + (32 * ks + 8 * fq) * 2); acc = MFMA16(a, bb, acc); }
#pragma unroll
            for (int r = 0; r < 4; ++r) C.DS[((size_t)unit * 64 + 16 * kt + 4 * fq + r) * 128 + 16 * w + cc] = acc[r]; }
    }
    __syncthreads();
}

DI void gla3_unit(const Ctx& C, int unit, LAS unsigned char* lds, const int wave_s) {
    const int tid = mk_tid(wave_s);
    const int c = unit % NCH, bh = unit / NCH, h = bh & 3, b = bh >> 2;
    const int r0 = b * LP + 128 * c, nv = (LP - 128 * c) < 128 ? (LP - 128 * c) : 128;
    LAS unsigned char* qg = lds; LAS unsigned char* kg = lds + 18432; LAS unsigned char* vT = lds + 36864; LAS unsigned char* ScT = lds + 71680;
    const int lane = tid & 63, w = __builtin_amdgcn_readfirstlane(tid >> 6);
    {
        const int kc = tid & 7;
#pragma unroll
        for (int i = 0; i < 2; ++i) { const int t = (tid >> 3) + 64 * i; u32x4 rq = {0u, 0u, 0u, 0u}, rk = {0u, 0u, 0u, 0u}; f32x4 g0 = {0.f, 0.f, 0.f, 0.f}, g1 = g0;
            if (t < nv) { const bf16_t* zr = C.Z + (size_t)(r0 + t) * ZP + h * 64 + kc * 8; rq = *(const u32x4*)(zr + ZGQ); rk = *(const u32x4*)(zr + ZGK);
                const float* gp = C.LD + (size_t)(r0 + t) * 256 + h * 64 + kc * 8; g0 = *(const f32x4*)gp; g1 = *(const f32x4*)(gp + 4); }
            float fq_[8], fk_[8]; unpack8(rq, fq_); unpack8(rk, fk_);
#pragma unroll
            for (int e = 0; e < 4; ++e) { const float e0 = __expf(g0[e]), e1 = __expf(g1[e]); fq_[e] *= e0; fq_[4 + e] *= e1; fk_[e] *= __builtin_amdgcn_rcpf(e0); fk_[4 + e] *= __builtin_amdgcn_rcpf(e1); }
            u32x4 oq, ok; oq.x = pk2(fq_[0], fq_[1]); oq.y = pk2(fq_[2], fq_[3]); oq.z = pk2(fq_[4], fq_[5]); oq.w = pk2(fq_[6], fq_[7]);
            ok.x = pk2(fk_[0], fk_[1]); ok.y = pk2(fk_[2], fk_[3]); ok.z = pk2(fk_[4], fk_[5]); ok.w = pk2(fk_[6], fk_[7]);
            *(LAS u32x4*)(qg + t * 144 + kc * 16) = oq; *(LAS u32x4*)(kg + t * 144 + kc * 16) = ok; }
        const int t = tid & 127;
#pragma unroll
        for (int i = 0; i < 4; ++i) { const int vc = (tid >> 7) + 4 * i; u32x4 raw = {0u, 0u, 0u, 0u};
            if (t < nv) raw = *(const u32x4*)(C.Z + (size_t)(r0 + t) * ZP + ZGV + h * 128 + vc * 8);
            LAS bf16_t* vp = (LAS bf16_t*)(vT + (vc * 8) * 272 + t * 2);
            vp[0 * 136] = (bf16_t)(raw.x & 0xffffu); vp[1 * 136] = (bf16_t)(raw.x >> 16); vp[2 * 136] = (bf16_t)(raw.y & 0xffffu); vp[3 * 136] = (bf16_t)(raw.y >> 16);
            vp[4 * 136] = (bf16_t)(raw.z & 0xffffu); vp[5 * 136] = (bf16_t)(raw.z >> 16); vp[6 * 136] = (bf16_t)(raw.w & 0xffffu); vp[7 * 136] = (bf16_t)(raw.w >> 16); }
        const int k = tid & 63;
#pragma unroll
        for (int i = 0; i < 2; ++i) { const int vc = (tid >> 6) + 8 * i; const u32x4 raw = *(const u32x4*)(C.SC + ((size_t)unit * 64 + k) * 128 + vc * 8);
            LAS bf16_t* sp = (LAS bf16_t*)(ScT + (vc * 8) * 144 + k * 2);
            sp[0 * 72] = (bf16_t)(raw.x & 0xffffu); sp[1 * 72] = (bf16_t)(raw.x >> 16); sp[2 * 72] = (bf16_t)(raw.y & 0xffffu); sp[3 * 72] = (bf16_t)(raw.y >> 16);
            sp[4 * 72] = (bf16_t)(raw.z & 0xffffu); sp[5 * 72] = (bf16_t)(raw.z >> 16); sp[6 * 72] = (bf16_t)(raw.w & 0xffffu); sp[7 * 72] = (bf16_t)(raw.w >> 16); }
    }
    __syncthreads();
    {
        const int cc = lane & 15, fq = lane >> 4;
        const bf16x8 qB0 = *(const LAS bf16x8*)(qg + (16 * w + cc) * 144 + 16 * fq), qB1 = *(const LAS bf16x8*)(qg + (16 * w + cc) * 144 + 64 + 16 * fq);
        f32x4 A[8];
#pragma unroll
        for (int T = 0; T < 8; ++T) { f32x4 s = {0.f, 0.f, 0.f, 0.f};
            if (T <= w) { const LAS unsigned char* kp = kg + (16 * T + cc) * 144 + 16 * fq; const bf16x8 a0 = *(const LAS bf16x8*)kp, a1 = *(const LAS bf16x8*)(kp + 64);
                s = MFMA16(a0, qB0, s); s = MFMA16(a1, qB1, s);
                if (T == w) {
#pragma unroll
                    for (int r = 0; r < 4; ++r) s[r] = (4 * fq + r > cc) ? 0.f : s[r]; } }
            A[T] = s; }
        bf16x8 P[4];
#pragma unroll
        for (int kk = 0; kk < 4; ++kk) { u32x4 pw; pw.x = pk2(A[2 * kk][0], A[2 * kk][1]); pw.y = pk2(A[2 * kk][2], A[2 * kk][3]); pw.z = pk2(A[2 * kk + 1][0], A[2 * kk + 1][1]); pw.w = pk2(A[2 * kk + 1][2], A[2 * kk + 1][3]); P[kk] = __builtin_bit_cast(bf16x8, pw); }
        f32x4 o[8]; float ss = 0.f;
#pragma unroll
        for (int Mt = 0; Mt < 8; ++Mt) { f32x4 acc = {0.f, 0.f, 0.f, 0.f};
#pragma unroll
            for (int kk = 0; kk < 4; ++kk) if (2 * kk <= w) { const LAS unsigned char* vp = vT + (16 * Mt + cc) * 272 + (32 * kk + 4 * fq) * 2; const u32x2 lo = *(const LAS u32x2*)vp, hi = *(const LAS u32x2*)(vp + 32); acc = MFMA16(mk8(lo, hi), P[kk], acc); }
            { const LAS unsigned char* sp = ScT + (16 * Mt + cc) * 144 + 16 * fq; const bf16x8 a0 = *(const LAS bf16x8*)sp, a1 = *(const LAS bf16x8*)(sp + 64); acc = MFMA16(a0, qB0, acc); acc = MFMA16(a1, qB1, acc); }
            o[Mt] = acc; ss += (acc[0] * acc[0] + acc[1] * acc[1]) + (acc[2] * acc[2] + acc[3] * acc[3]); }
        ss += __shfl_xor(ss, 16); ss += __shfl_xor(ss, 32);
        const float rs = rsqrtf(ss * (1.0f / 128.0f) + EPS);
        const int t = 16 * w + cc;
        if (t < nv) { const size_t row = (size_t)(r0 + t);
#pragma unroll
            for (int Mt = 0; Mt < 8; ++Mt) { const int v0 = 16 * Mt + 4 * fq; const u32x2 og = *(const u32x2*)(C.Z + row * ZP + ZOG + h * 128 + v0); const f32x4 gn = *(const f32x4*)(C.gnw + v0);
                const float y0 = o[Mt][0] * rs * gn[0] * silu_f(bflo(og.x)), y1 = o[Mt][1] * rs * gn[1] * silu_f(bfhi(og.x)), y2 = o[Mt][2] * rs * gn[2] * silu_f(bflo(og.y)), y3 = o[Mt][3] * rs * gn[3] * silu_f(bfhi(og.y));
                u32x2 wv; wv.x = pk2(y0, y1); wv.y = pk2(y2, y3); *(u32x2*)(C.MRG + row * DM + 512 + h * 128 + v0) = wv; } }
    }
    __syncthreads();
}

DI void gla_scan(const Ctx& C, int gtid, int gthreads) {
    for (int idx = gtid; idx < 16 * 64 * 128; idx += gthreads) {
        const int v = idx & 127, k = (idx >> 7) & 63, bh = idx >> 13; float S = 0.f;
#pragma unroll 3
        for (int c = 0; c < NCH; ++c) { const size_t unit = (size_t)bh * NCH + c;
            C.SC[(unit * 64 + k) * 128 + v] = (bf16_t)(pk2(S, 0.f) & 0xffffu);
            S = __expf(C.GL[unit * 64 + k]) * S + C.DS[(unit * 64 + k) * 128 + v]; }
        const int h = bh & 3, b = bh >> 2;
        C.out[O_SP + ((size_t)((C.l * NBATCH + b) * 4 + h) * 64 + k) * 128 + v] = S;
    }
}

struct WSrc { int mat; const float* W; const float* W2; const float* gain; const float* wg2; };
DI float wsrc(const WSrc& s, int k, int n) {
    if (s.mat == 0) {
        if (n < 2304) { const int col = n < 1792 ? n : n + 16; const float sc = (n >= 768 && n < 1024) ? 0.125f : 1.0f; return s.W[(size_t)k * INW + col] * s.gain[k] * sc; }
        const int e = n - 2304; float a = 0.f;
#pragma unroll
        for (int r = 0; r < 16; ++r) a += s.W[(size_t)k * INW + 1792 + r] * s.wg2[r * 256 + e];
        return a * s.gain[k];
    } else if (s.mat == 1) { return s.W[(size_t)k * DM + n];
    } else if (s.mat == 2) { const int pn = n >> 8, j = n & 255; return (j < 128 ? s.W[(size_t)k * DFFN + 128 * pn + j] : s.W2[(size_t)k * DFFN + 128 * pn + j - 128]) * s.gain[k];
    } else { return s.W[(size_t)k * DM + n]; }
}
DI void conv_item(const WSrc& s, int K, int N, bf16_t* WT, LAS float* scr, int item, int lane) {
    const int nblk = N / 32, kb = item / nblk, nb = item % nblk, k0 = 64 * kb, n0 = 32 * nb;
#pragma unroll 8
    for (int i = 0; i < 32; ++i) { const int kk = 2 * i + (lane >> 5); scr[kk * 33 + (lane & 31)] = wsrc(s, k0 + kk, n0 + (lane & 31)); }
    asm volatile("s_waitcnt lgkmcnt(0)" ::: "memory");
    const int c = lane & 7;
#pragma unroll
    for (int j = 0; j < 4; ++j) { const int n = (lane >> 3) + 8 * j; const LAS float* sp = scr + (8 * c) * 33 + n;
        u32x4 o; o.x = pk2(sp[0 * 33], sp[1 * 33]); o.y = pk2(sp[2 * 33], sp[3 * 33]); o.z = pk2(sp[4 * 33], sp[5 * 33]); o.w = pk2(sp[6 * 33], sp[7 * 33]);
        *(u32x4*)(WT + (size_t)(n0 + n) * K + k0 + 8 * c) = o; }
    asm volatile("s_waitcnt lgkmcnt(0)" ::: "memory");
}
constexpr int NI_IN = 16 * 80, NI_O = 16 * 32, NI_GU = 16 * 176, NI_D = 44 * 32, NI_L = NI_IN + NI_O + NI_GU + NI_D;

DI void prologue(KA ap, const RowMap& rm, LAS unsigned char* lds, int tid, int vcu, int G) {
    const int lane = tid & 63, wave = tid >> 6, gw = vcu * 8 + wave, NGW = G * 8;
    LAS float* scr = (LAS float*)(lds + wave * 16384);
    for (int it = gw; it < DEPTH * NI_L; it += NGW) {
        const int l = it / NI_L; int r = it % NI_L;
        unsigned char* wl = ap->ws + WS_W + (size_t)l * SZ_WL;
        if (r < NI_IN) { WSrc s{0, ap->in[7] + (size_t)l * DM * INW, nullptr, ap->in[6] + l * DM, ap->in[11] + l * 16 * 256}; conv_item(s, DM, NIN, (bf16_t*)wl, scr, r, lane); continue; } r -= NI_IN;
        if (r < NI_O) { WSrc s{1, ap->in[14] + (size_t)l * DM * DM, nullptr, nullptr, nullptr}; conv_item(s, DM, DM, (bf16_t*)(wl + SZ_WIN), scr, r, lane); continue; } r -= NI_O;
        if (r < NI_GU) { WSrc s{2, ap->in[16] + (size_t)l * DM * DFFN, ap->in[17] + (size_t)l * DM * DFFN, ap->in[15] + l * DM, nullptr}; conv_item(s, DM, NGU, (bf16_t*)(wl + SZ_WIN + SZ_WO), scr, r, lane); continue; } r -= NI_GU;
        { WSrc s{3, ap->in[18] + (size_t)l * DFFN * DM, nullptr, nullptr, nullptr}; conv_item(s, DFFN, DM, (bf16_t*)(wl + SZ_WIN + SZ_WO + SZ_WGU), scr, r, lane); }
    }
    bf16_t* XB = (bf16_t*)(ap->ws + WS_XB); bf16_t* MRG = (bf16_t*)(ap->ws + WS_MRG); float* ssqA = (float*)(ap->ws + WS_SSQA);
    for (int m = gw; m < MP; m += NGW) {
        const float* ip = row_in(rm, m); f32x4 v[4]; float s = 0.f;
#pragma unroll
        for (int j = 0; j < 4; ++j) { v[j] = ip ? ((const f32x4*)ip)[lane + 64 * j] : (f32x4){0.f, 0.f, 0.f, 0.f}; s += (v[j][0] * v[j][0] + v[j][1] * v[j][1]) + (v[j][2] * v[j][2] + v[j][3] * v[j][3]); }
#pragma unroll
        for (int o = 1; o < 64; o <<= 1) s += __shfl_xor(s, o);
#pragma unroll
        for (int j = 0; j < 4; ++j) { u32x2 w; w.x = pk2(v[j][0], v[j][1]); w.y = pk2(v[j][2], v[j][3]); ((u32x2*)(XB + (size_t)m * DM))[lane + 64 * j] = w; if (!ip) ((u32x2*)(MRG + (size_t)m * DM))[lane + 64 * j] = (u32x2){0u, 0u}; }
        if (lane < 16) ssqA[(size_t)m * 16 + lane] = lane == 0 ? s : 0.f;
    }
}

#define XB_TMO      128
#define XB_XCNT(j)  (256  + 64 * (j))
#define XB_XSUB(j)  (1280 + 64 * (j))
#define XB_XGEN(j)  (2304 + 64 * (j))
#define XB_TOP      3328
#define XB_TOPGEN   3392
#define XCD_BAR_WORDS 3456
#define XB_SPIN_CAP (1u << 18)

__device__ __forceinline__ unsigned xb_ld(unsigned* p)              { return __hip_atomic_load(p, __ATOMIC_RELAXED, __HIP_MEMORY_SCOPE_AGENT); }
__device__ __forceinline__ unsigned xb_add(unsigned* p, unsigned v) { return __hip_atomic_fetch_add(p, v, __ATOMIC_RELAXED, __HIP_MEMORY_SCOPE_AGENT); }
__device__ __forceinline__ unsigned xb_xcc_id() { return (unsigned)__builtin_amdgcn_s_getreg((3 << 11) | 20) & 0xFu; }
#define XB_SPIN(cond, bar) do { unsigned _sp = 0; while (cond) { __builtin_amdgcn_s_sleep(1); \
    if ((++_sp & 255u) == 0u) { if (xb_ld(&(bar)[XB_TMO])) break; if (_sp > XB_SPIN_CAP) { atomicAdd(&(bar)[XB_TMO], 1u); break; } } } } while (0)

struct XcdBarrier {
    unsigned* bar; unsigned x;
    volatile LAS unsigned* st;
};

__device__ __forceinline__ XcdBarrier xcd_barrier_post(unsigned* bar, volatile LAS unsigned* st, const bool t0) {
    XcdBarrier b; b.bar = bar; b.x = xb_xcc_id(); b.st = st;
    if (t0) (void)xb_add(&bar[XB_XCNT(b.x)], 1u);
    return b;
}
__device__ __forceinline__ void xcd_barrier_complete(unsigned* bar, unsigned x, unsigned& nloc, unsigned& nx) {
    const unsigned G = gridDim.x * gridDim.y * gridDim.z;
    unsigned sum, cnt, mine, sp = 0u;
    for (;;) {
        sum = 0u; cnt = 0u; mine = 0u;
#pragma unroll
        for (unsigned j = 0; j < 16; ++j) { const unsigned c = xb_ld(&bar[XB_XCNT(j)]); sum += c; cnt += (c > 0u) ? 1u : 0u; mine = (j == x) ? c : mine; }
        if (sum == G) break;
        __builtin_amdgcn_s_sleep(1);
        if ((++sp & 255u) == 0u) { if (xb_ld(&bar[XB_TMO])) break; if (sp > XB_SPIN_CAP) { atomicAdd(&bar[XB_TMO], 1u); break; } }
    }
    nloc = mine > 0u ? mine : 1u; nx = cnt > 0u ? cnt : 1u;
}

__device__ __forceinline__ void xcd_barrier(const XcdBarrier& b, const bool t0) {
    asm volatile("s_waitcnt vmcnt(0)" ::: "memory");
    __syncthreads();
    if (t0) {
        unsigned* bar = b.bar;
        __builtin_amdgcn_s_waitcnt(0);
        unsigned nloc = b.st[0], nx = b.st[1];
        if (nloc == 0u) { xcd_barrier_complete(bar, b.x, nloc, nx); b.st[0] = nloc; b.st[1] = nx; }
        const unsigned old = xb_add(&bar[XB_XSUB(b.x)], 1u);
        const unsigned gen = old / nloc;
        if (old + 1u == (gen + 1u) * nloc) {
            __builtin_amdgcn_fence(__ATOMIC_RELEASE, "agent");
            asm volatile("s_waitcnt vmcnt(0)" ::: "memory");
            const unsigned og = xb_add(&bar[XB_TOP], 1u);
            const unsigned tg = og / nx;
            if (og + 1u == (tg + 1u) * nx) xb_add(&bar[XB_TOPGEN], 1u);
            else XB_SPIN(xb_ld(&bar[XB_TOPGEN]) == tg, bar);
            __builtin_amdgcn_fence(__ATOMIC_ACQUIRE, "agent");
            xb_add(&bar[XB_XGEN(b.x)], 1u);
            asm volatile("s_waitcnt vmcnt(0)" ::: "memory");
        } else {
            XB_SPIN(xb_ld(&bar[XB_XGEN(b.x)]) == gen, bar);
            __builtin_amdgcn_fence(__ATOMIC_ACQUIRE, "agent");
            asm volatile("s_waitcnt vmcnt(0)" ::: "memory");
        }
    }
    __syncthreads();
}

template <class T> DI T* opq(T* p) { asm volatile("" : "+s"(p)); return p; }
DI Ctx make_ctx(int l) {
    KA ap = ka_ptr(); unsigned char* ws = ap->ws;
    Ctx C; C.l = l; C.Z = (const bf16_t*)(ws + WS_Z); C.LD = (float*)(ws + WS_LD); C.MRG = (bf16_t*)(ws + WS_MRG); C.DS = (float*)(ws + WS_DS); C.SC = (bf16_t*)(ws + WS_SC); C.GL = (float*)(ws + WS_GL);
    C.qnw = ap->in[8] + l * 64; C.knw = ap->in[9] + l * 64; C.sinks = ap->in[10] + l * 8; C.gnw = ap->in[13] + l * 128;
    C.cache_k = ap->in[2]; C.cache_v = ap->in[3]; C.state = ap->in[4]; C.out = ap->out;
    return C;
}
DI RowMap make_rm() { KA ap = ka_ptr(); float* out = ap->out; unsigned char* ws = ap->ws; return RowMap{ap->in[0], ap->in[1], ap->in[5], out + O_YP, out + O_YS, (float*)(ws + WS_XMETA)}; }

__global__ void __launch_bounds__(512, 2) hymba_fwd(Args a) {
    extern __shared__ __attribute__((aligned(16))) unsigned char lds_raw[];
    LAS unsigned char* lds = (LAS unsigned char*)lds_raw;
    const int G = gridDim.x, bx = blockIdx.x; const int wave_s = __builtin_amdgcn_readfirstlane((int)threadIdx.x >> 6);
#define opaque_tid() mk_tid(wave_s)
    const int vcu = (G % 8 == 0) ? (bx % 8) * (G / 8) + bx / 8 : bx;
    const int lo = ka_ptr()->ph_lo, hi = ka_ptr()->ph_hi;
#define IN(k) (lo <= (k) && (k) < hi)
#ifndef FAST_BAR
#define FAST_BAR 1
#endif
    volatile LAS unsigned* MISC = (volatile LAS unsigned*)(lds + 131072 + 320);
    { const int t = opaque_tid(); if (t < 64) MISC[t] = 0u; __syncthreads(); }
    XcdBarrier bar = xcd_barrier_post((unsigned*)ka_ptr()->ws, MISC + 8, opaque_tid() == 0);
#define GSYNC() do { if (FAST_BAR) xcd_barrier(bar, opaque_tid() == 0); else cg::this_grid().sync(); } while (0)
#define SEAM(k) do { if (IN(k) && IN((k) + 1)) { if ((k) == 0) cg::this_grid().sync(); else GSYNC(); } } while (0)
    if (IN(0)) { for (int rep = 0; rep < REP_PRO; ++rep) { const RowMap rm = make_rm(); prologue(ka_ptr(), rm, lds, opaque_tid(), vcu, G); if (rep + 1 < REP_PRO) GSYNC(); }
        for (int xs = 0; xs < XSYNC; ++xs) GSYNC(); }
    SEAM(0);
#pragma unroll 1
    for (int l = 0; l < DEPTH; ++l) {
        const int pb = 1 + 7 * l;
        if (IN(pb + 0)) for (int rep = 0; rep < REP_WIN; ++rep) {
            if (rep) GSYNC();
            KA ap = ka_ptr(); unsigned char* ws = ap->ws; unsigned char* wl = ws + WS_W + (size_t)l * SZ_WL;
            pg8::Gemm g{(const bf16_t*)(ws + WS_XB), (const bf16_t*)wl, MP, NIN, DM}; pg8::StaticOrder S; S.init(MP, NIN, G, bx);
            pg8::EpiIn E{(bf16_t*)(ws + WS_Z), (float*)(ws + WS_LD), (const float*)(ws + WS_SSQA), ap->in[12] + l * 256};
            pg8::gemm_phase<pg8::EpiIn, pg8::StaticOrder, true, true>(lds, g, S, E, opaque_tid());
        }
        SEAM(pb + 0);
        if (IN(pb + 1)) {
            const Ctx C = make_ctx(l);
            constexpr int N1 = 16 * NCH, N2 = DECB, N3 = DECB * 4;
#pragma unroll 1
            for (int u = vcu; u < N1 + N2 + N3; u += G) {
                if (u < N1) gla1_unit(C, u, lds, wave_s); else if (u < N1 + N2) attn_sample_unit(C, u - N1, lds, wave_s); else gla_sample_unit(C, u - N1 - N2, lds, wave_s);
            }
        }
        SEAM(pb + 1);
        if (IN(pb + 2)) for (int rep = 0; rep < REP_SCAN; ++rep) { if (rep) GSYNC(); const Ctx C = make_ctx(l); gla_scan(C, bx * 512 + opaque_tid(), G * 512); }
        SEAM(pb + 2);
        if (IN(pb + 3)) for (int rep = 0; rep < REP_MB; ++rep) {   if (rep) GSYNC();
            const Ctx C = make_ctx(l);
            constexpr int N1 = 16 * NCH, N2 = NBATCH * 2 * 65;
#pragma unroll 1
            for (int u = vcu; u < N1 + N2; u += G) { if (u < N1) gla3_unit(C, u, lds, wave_s); else attn_prompt_unit(C, u - N1, lds, wave_s); }
        }
        SEAM(pb + 3);
        if (IN(pb + 4)) {
            KA ap = ka_ptr(); unsigned char* ws = ap->ws; unsigned char* wl = ws + WS_W + (size_t)l * SZ_WL;
            pg8::Gemm g{(const bf16_t*)(ws + WS_MRG), (const bf16_t*)(wl + SZ_WIN), MP, DM, DM}; pg8::StaticOrder S; S.init(MP, DM, G, bx);
            pg8::EpiRes E{make_rm(), l == 0 ? 1 : 0, (bf16_t*)(ws + WS_XB), (float*)(ws + WS_SSQB)};
            pg8::gemm_phase<pg8::EpiRes, pg8::StaticOrder, true, true>(lds, g, S, E, opaque_tid());
        }
        SEAM(pb + 4);
        if (IN(pb + 5)) for (int rep = 0; rep < REP_GU; ++rep) {
            if (rep) GSYNC();
            KA ap = ka_ptr(); unsigned char* ws = ap->ws; unsigned char* wl = ws + WS_W + (size_t)l * SZ_WL;
            pg8::Gemm g{(const bf16_t*)(ws + WS_XB), (const bf16_t*)(wl + SZ_WIN + SZ_WO), MP, NGU, DM}; pg8::StaticOrder S; S.init(MP, NGU, G, bx);
            pg8::EpiGU E{(bf16_t*)(ws + WS_U), (const float*)(ws + WS_SSQB)};
            pg8::gemm_phase<pg8::EpiGU, pg8::StaticOrder, true, true>(lds, g, S, E, opaque_tid());
        }
        SEAM(pb + 5);
        if (IN(pb + 6)) {
            KA ap = ka_ptr(); unsigned char* ws = ap->ws; unsigned char* wl = ws + WS_W + (size_t)l * SZ_WL;
            pg8::Gemm g{(const bf16_t*)(ws + WS_U), (const bf16_t*)(wl + SZ_WIN + SZ_WO + SZ_WGU), MP, DM, DFFN}; pg8::StaticOrder S; S.init(MP, DM, G, bx);
            pg8::EpiRes E{make_rm(), 0, (bf16_t*)(ws + WS_XB), (float*)(ws + WS_SSQA)};
            pg8::gemm_phase<pg8::EpiRes, pg8::StaticOrder, true, true>(lds, g, S, E, opaque_tid());
        }
        if (l + 1 < DEPTH) SEAM(pb + 6);
    }
#undef IN
#undef SEAM
#undef GSYNC
#undef opaque_tid
}

#ifndef N_LAUNCH_MODE
#define N_LAUNCH_MODE 0
#endif
extern "C" void kernel_launch(void* const* d_in, const int* in_sizes, int n_in, void* d_out, int out_size, void* d_ws, size_t ws_size, hipStream_t stream) {
    static int grid = 0;
    if (grid == 0) {
        if (n_in != 19 || out_size != (int)O_END || ws_size < WS_END) { fprintf(stderr, "kernel_launch: unexpected shapes: n_in %d out %d ws %zu (need %zu)\n", n_in, out_size, ws_size, (size_t)WS_END); grid = -1; return; }
        int dev = 0, cus = 0, per_cu = 0;
        (void)hipGetDevice(&dev); (void)hipDeviceGetAttribute(&cus, hipDeviceAttributeMultiprocessorCount, dev);
        if (hipFuncSetAttribute((const void*)hymba_fwd, hipFuncAttributeMaxDynamicSharedMemorySize, LDS_BYTES) != hipSuccess) { fprintf(stderr, "kernel_launch: hipFuncSetAttribute failed\n"); grid = -1; return; }
        if (hipOccupancyMaxActiveBlocksPerMultiprocessor(&per_cu, (const void*)hymba_fwd, 512, LDS_BYTES) != hipSuccess || per_cu < 1) { fprintf(stderr, "kernel_launch: occupancy query says %d\n", per_cu); per_cu = 1; }
        (void)hipGetLastError();
        grid = cus > 0 ? cus : 256;
    }
    if (grid < 0) return;
    if (hipMemsetAsync(d_ws, 0, 16384, stream) != hipSuccess) { fprintf(stderr, "kernel_launch: memset failed\n"); return; }
    Args a{};
    for (int i = 0; i < 19; ++i) a.in[i] = (const float*)d_in[i];
    a.out = (float*)d_out; a.ws = (unsigned char*)d_ws;
#if N_LAUNCH_MODE == 1
    for (int p = 0; p < NPHASE; ++p) { a.ph_lo = p; a.ph_hi = p + 1; hipLaunchKernelGGL(hymba_fwd, dim3(grid), dim3(512), LDS_BYTES, stream, a); }
#else
    a.ph_lo = 0; a.ph_hi = NPHASE;
    void* args[] = {&a};
    hipError_t e = hipLaunchCooperativeKernel((const void*)hymba_fwd, dim3(grid), dim3(512), args, LDS_BYTES, stream);
    if (e != hipSuccess) fprintf(stderr, "cooperative launch failed: %s (grid %d)\n", hipGetErrorString(e), grid);
#endif
}
```

```cpp
#include <hip/hip_runtime.h>
#include <hip/hip_cooperative_groups.h>
#include <cstdio>
#include <cstdint>
namespace cg = cooperative_groups;

#define DI __device__ __forceinline__
#define LAS __attribute__((address_space(3)))
typedef unsigned short bf16_t;
typedef short bf16x8 __attribute__((ext_vector_type(8)));
typedef float f32x4 __attribute__((ext_vector_type(4)));
typedef float f32x2 __attribute__((ext_vector_type(2)));
typedef unsigned u32x4 __attribute__((ext_vector_type(4)));
typedef unsigned u32x2 __attribute__((ext_vector_type(2)));
typedef __bf16 bf16x2_t __attribute__((ext_vector_type(2)));

constexpr int DM = 1024, NBATCH = 4, SEQ = 4096, LP = 4112  , DEPTH = 2, DECB = 128, DECT = 8;
constexpr int MPROMPT = NBATCH * LP, MREAL = MPROMPT + DECB * DECT, MP = 17664  ;
constexpr int INW = 2320, ZP = 2304, NIN = 2560, DFFN = 2816, NGU = 5632;
constexpr int ZQ = 0, ZK = 512, ZV = 640, ZGQ = 768, ZGK = 1024, ZGV = 1280, ZOG = 1792;
constexpr int NCH = 33;
constexpr float EPS = 1e-6f, LOG2E = 1.4426950408889634f;
constexpr size_t O_YP = 0, O_YS = 16777216, O_CKP = 17825792, O_CVP = 17956864, O_SP = 18087936, O_CKS = 18350080, O_CVS = 22544384, O_SS = 26738688, O_END = 35127296;

DI unsigned pk2(float lo, float hi) { f32x2 v = {lo, hi}; bf16x2_t b = __builtin_convertvector(v, bf16x2_t); return __builtin_bit_cast(unsigned, b); }
DI float bflo(unsigned w) { return __uint_as_float(w << 16); }
DI float bfhi(unsigned w) { return __uint_as_float(w & 0xffff0000u); }
DI float bf2f(bf16_t h) { return __uint_as_float((unsigned)h << 16); }
DI void unpack8(const u32x4 w, float* f) { f[0] = bflo(w.x); f[1] = bfhi(w.x); f[2] = bflo(w.y); f[3] = bfhi(w.y); f[4] = bflo(w.z); f[5] = bfhi(w.z); f[6] = bflo(w.w); f[7] = bfhi(w.w); }
DI float silu_f(float x) { return x * __builtin_amdgcn_rcpf(1.0f + __expf(-x)); }

struct RowMap { const float* xp; const float* xs; const float* meta; float* yp; float* ys; float* xmeta; };
DI const float* row_in(const RowMap& rm, int row) {
    if (row < MPROMPT) { const int b = row / LP, p = row - b * LP; return p < 16 ? rm.meta + (size_t)p * DM : rm.xp + ((size_t)b * SEQ + (p - 16)) * DM; }
    if (row < MREAL) return rm.xs + (size_t)(row - MPROMPT) * DM;
    return nullptr;
}
DI float* row_out(const RowMap& rm, int row) {
    if (row < MPROMPT) { const int b = row / LP, p = row - b * LP; return p < 16 ? rm.xmeta + (size_t)(b * 16 + p) * DM : rm.yp + ((size_t)b * SEQ + (p - 16)) * DM; }
    if (row < MREAL) return rm.ys + (size_t)(row - MPROMPT) * DM;
    return nullptr;
}
namespace pg8 {
#define PG8_LAS __attribute__((address_space(3)))
typedef unsigned short bf16_t;
typedef short bf16x8 __attribute__((ext_vector_type(8)));
typedef float f32x4 __attribute__((ext_vector_type(4)));
typedef unsigned u32x4 __attribute__((ext_vector_type(4)));
constexpr int BM = 256, BK = 64, HALF = 128, HTB = HALF * BK * 2  , STAGE_BYTES = 8 * HTB, NXCD = 8, WGM = 8;

__host__ __device__ __forceinline__ int lds_byte(int r, int c) { const int st = (r >> 4) * 2 + (c >> 5), rr = r & 15, cc = c & 31, ob = rr * 64 + cc * 2; return st * 1024 + (ob ^ (((ob >> 9) & 1) << 5)); }
__host__ __device__ __forceinline__ void stage_rc(int b, int& R, int& C) { const int st = b / 1024, sb = b % 1024, swz = sb ^ (((sb >> 9) & 1) << 5); R = (st >> 1) * 16 + swz / 64; C = (st & 1) * 32 + (swz % 64) / 2; }
__host__ __device__ __forceinline__ int perm32(int rho) { const int n = rho >> 4, i = rho & 15; return 8 * (i >> 2) + 4 * n + (i & 3); }

struct Unit { int pm, pn; };
struct Gemm { const bf16_t* A; const bf16_t* Bt; int M, N, K; };

struct StaticOrder {
    int nM, nN, nwg, G, c;
    __host__ __device__ void init(int M, int N, int G_, int c_) { nM = M / BM; nN = N / BM; nwg = nM * nN; G = G_; c = c_; }
    __host__ __device__ bool next(int i, Unit& u) const {
        const long L = (long)i * G + c; if (L >= nwg) return false;
        int wgid = (int)L; { const int q = nwg / NXCD, r = nwg % NXCD, xcd = wgid % NXCD, off = wgid / NXCD; wgid = (xcd < r ? xcd * (q + 1) : r * (q + 1) + (xcd - r) * q) + off; }
        const int nig = WGM * nN, gid = wgid / nig, fm = gid * WGM, gsz = (nM - fm) < WGM ? (nM - fm) : WGM;
        u.pm = fm + ((wgid % nig) % gsz); u.pn = (wgid % nig) / gsz; return true;
    }
    __device__ __forceinline__ void a_ready(const Unit&) const {}
    __device__ __forceinline__ void done(const Unit&) const {}
};


DI float rstd_from_slots(const float* ssq, int row) {
    const f32x4* p = (const f32x4*)(ssq + (size_t)row * 16);
    const f32x4 a = p[0], b = p[1], c = p[2], d = p[3];
    const float s = ((a[0] + a[1]) + (a[2] + a[3])) + ((b[0] + b[1]) + (b[2] + b[3])) + ((c[0] + c[1]) + (c[2] + c[3])) + ((d[0] + d[1]) + (d[2] + d[3]));
    return rsqrtf(s * (1.0f / 1024.0f) + EPS);
}
struct EpiIn {
    static constexpr bool PERM = true, AFTER_DRAIN = false;
    bf16_t* Z; float* LD; const float* ssq; const float* bg;
    __device__ __forceinline__ void operator()(const f32x4 (&acc)[2][2][4][2], const Unit& u, int wr, int wc, int fr, int fq) const {
        const int row0 = u.pm * BM + wr * 64 + fr;
        if (u.pn < 9) {
#pragma unroll
            for (int ai = 0; ai < 2; ++ai)
#pragma unroll
                for (int m = 0; m < 4; ++m) { const int row = row0 + ai * HALF + m * 16; const float rs = rstd_from_slots(ssq, row);
                    bf16_t* rowp = Z + (size_t)row * ZP + u.pn * BM + wc * 32 + 8 * fq;
#pragma unroll
                    for (int bj = 0; bj < 2; ++bj) { const f32x4 v0 = acc[ai][bj][m][0] * rs, v1 = acc[ai][bj][m][1] * rs;
                        u32x4 w; w.x = pk2(v0[0], v0[1]); w.y = pk2(v0[2], v0[3]); w.z = pk2(v1[0], v1[1]); w.w = pk2(v1[2], v1[3]);
                        *(u32x4*)(rowp + bj * HALF) = w; }
                    asm volatile("" ::: "memory"); }
        } else {
            const int e0 = wc * 32 + 8 * fq;
#pragma unroll
            for (int bj = 0; bj < 2; ++bj) { const f32x4 b0 = *(const f32x4*)(bg + e0 + bj * HALF), b1 = *(const f32x4*)(bg + e0 + bj * HALF + 4);
#pragma unroll
                for (int ai = 0; ai < 2; ++ai)
#pragma unroll
                    for (int m = 0; m < 4; ++m) { const int row = row0 + ai * HALF + m * 16; const float rs = rstd_from_slots(ssq, row);
                        const f32x4 x0 = acc[ai][bj][m][0] * rs + b0, x1 = acc[ai][bj][m][1] * rs + b1; f32x4 o0, o1;
#pragma unroll
                        for (int i = 0; i < 4; ++i) { o0[i] = (fminf(x0[i], 0.f) - __logf(1.0f + __expf(-fabsf(x0[i])))) * 0.0625f; o1[i] = (fminf(x1[i], 0.f) - __logf(1.0f + __expf(-fabsf(x1[i])))) * 0.0625f; }
                        float* lp = LD + (size_t)row * 256 + e0 + bj * HALF; *(f32x4*)lp = o0; *(f32x4*)(lp + 4) = o1; asm volatile("" ::: "memory"); } }
        }
    }
};
struct EpiRes {
    static constexpr bool PERM = true, AFTER_DRAIN = false;
    RowMap rm; int first; bf16_t* XB; float* ssq;
    __device__ __forceinline__ void operator()(const f32x4 (&acc)[2][2][4][2], const Unit& u, int wr, int wc, int fr, int fq) const {
        const int row0 = u.pm * BM + wr * 64 + fr, col0 = u.pn * BM + wc * 32 + 8 * fq;
#pragma unroll
        for (int ai = 0; ai < 2; ++ai)
#pragma unroll
            for (int m = 0; m < 4; ++m) { const int row = row0 + ai * HALF + m * 16;
                float* op = row_out(rm, row); const float* ip = first ? row_in(rm, row) : op; float ss = 0.f;
                if (op) {
#pragma unroll
                    for (int bj = 0; bj < 2; ++bj) { const int col = col0 + bj * HALF;
                        const f32x4 v0 = acc[ai][bj][m][0] + *(const f32x4*)(ip + col), v1 = acc[ai][bj][m][1] + *(const f32x4*)(ip + col + 4);
                        *(f32x4*)(op + col) = v0; *(f32x4*)(op + col + 4) = v1;
                        u32x4 w; w.x = pk2(v0[0], v0[1]); w.y = pk2(v0[2], v0[3]); w.z = pk2(v1[0], v1[1]); w.w = pk2(v1[2], v1[3]);
                        *(u32x4*)(XB + (size_t)row * DM + col) = w;
                        ss += (v0[0] * v0[0] + v0[1] * v0[1]) + (v0[2] * v0[2] + v0[3] * v0[3]) + (v1[0] * v1[0] + v1[1] * v1[1]) + (v1[2] * v1[2] + v1[3] * v1[3]); }
                }
                ss += __shfl_xor(ss, 16); ss += __shfl_xor(ss, 32);
                if (fq == 0) ssq[(size_t)row * 16 + u.pn * 4 + wc] = ss; asm volatile("" ::: "memory"); }
    }
};
struct EpiGU {
    static constexpr bool PERM = true, AFTER_DRAIN = false;
    bf16_t* U; const float* ssq;
    __device__ __forceinline__ void operator()(const f32x4 (&acc)[2][2][4][2], const Unit& u, int wr, int wc, int fr, int fq) const {
        const int row0 = u.pm * BM + wr * 64 + fr, f0 = u.pn * HALF + wc * 32 + 8 * fq;
#pragma unroll
        for (int ai = 0; ai < 2; ++ai)
#pragma unroll
            for (int m = 0; m < 4; ++m) { const int row = row0 + ai * HALF + m * 16; const float rs = rstd_from_slots(ssq, row);
                float o[8];
#pragma unroll
                for (int n = 0; n < 2; ++n)
#pragma unroll
                    for (int i = 0; i < 4; ++i) { const float g = acc[ai][0][m][n][i] * rs, up = acc[ai][1][m][n][i] * rs; o[4 * n + i] = silu_f(g) * up; }
                u32x4 w; w.x = pk2(o[0], o[1]); w.y = pk2(o[2], o[3]); w.z = pk2(o[4], o[5]); w.w = pk2(o[6], o[7]);
                *(u32x4*)(U + (size_t)row * DFFN + f0) = w; asm volatile("" ::: "memory"); }
    }
};
template <class Epi, class Sched, bool ALIGN_EPI = false, bool SP2 = false>
__device__ __forceinline__ void gemm_phase(PG8_LAS unsigned char* lds, const Gemm g, const Sched& S, const Epi& E, const int tid_in) {
    const int tid = tid_in, wid = __builtin_amdgcn_readfirstlane(tid >> 6), lane = tid & 63, wr = wid >> 2, wc = wid & 3, fr = lane & 15, fq = lane >> 4;
    const int K = g.K, nt = K / BK;
    unsigned voffA[2], voffB[2];
#pragma unroll
    for (int i = 0; i < 2; ++i) { int R, C; stage_rc(tid * 16 + i * 8192, R, C); const int Rb = Epi::PERM ? ((R & ~31) + perm32(R & 31)) : R;
        voffA[i] = (unsigned)(R * K + C) * 2u; voffB[i] = (unsigned)(Rb * K + C) * 2u; }
    const size_t kstep = (size_t)(BK * 2);
    const size_t hstep = (size_t)HALF * K * 2;
    const size_t tstep = 2 * hstep;
    const unsigned ldsw = (unsigned)wid * 1024u;
    const int aoff = lds_byte(wr * 64 + fr, fq * 8), boff = lds_byte(wc * 32 + fr, fq * 8);
#define PG8_SA(b, h) (((b) * 2 + (h)) * HTB)
#define PG8_SB(b, h) ((4 + (b) * 2 + (h)) * HTB)
#define PG8_STAGE(bufoff, gbase, voff) do { _Pragma("unroll") for (int _i = 0; _i < 2; ++_i) \
        __builtin_amdgcn_global_load_lds((const unsigned*)((const char*)(gbase) + (voff)[_i]), (PG8_LAS unsigned*)(lds + (bufoff) + ldsw + _i * 8192), 16, 0, 0); } while (0)
#define PG8_LDA(dst, b, h) do { _Pragma("unroll") for (int m = 0; m < 4; ++m) _Pragma("unroll") for (int k = 0; k < 2; ++k) dst[m][k] = *(const PG8_LAS bf16x8*)(lds + PG8_SA(b, h) + aoff + m * 2048 + k * 1024); } while (0)
#define PG8_LDB(dst, b, h) do { _Pragma("unroll") for (int n = 0; n < 2; ++n) _Pragma("unroll") for (int k = 0; k < 2; ++k) dst[n][k] = *(const PG8_LAS bf16x8*)(lds + PG8_SB(b, h) + boff + n * 2048 + k * 1024); } while (0)
#define PG8_MMA(ai, bj, At, Bt) do { __builtin_amdgcn_s_setprio(1); _Pragma("unroll") for (int m = 0; m < 4; ++m) _Pragma("unroll") for (int n = 0; n < 2; ++n) _Pragma("unroll") for (int k = 0; k < 2; ++k) \
        acc[ai][bj][m][n] = __builtin_amdgcn_mfma_f32_16x16x32_bf16(Bt[n][k], At[m][k], acc[ai][bj][m][n], 0, 0, 0); __builtin_amdgcn_s_setprio(0); } while (0)
#define PG8_WAIT_V(n) asm volatile("s_waitcnt vmcnt(" #n ")" ::: "memory")
#define PG8_WAIT_L(n) asm volatile("s_waitcnt lgkmcnt(" #n ")" ::: "memory")
#define PG8_BAR __builtin_amdgcn_s_barrier()
#define PG8_SCHED __builtin_amdgcn_sched_barrier(0)
    Unit cur, nxt; int ui = 0;
    if (!S.next(0, cur)) return;
    f32x4 acc[2][2][4][2];
#pragma unroll
    for (int a = 0; a < 2; ++a)
#pragma unroll
        for (int b = 0; b < 2; ++b)
#pragma unroll
            for (int m = 0; m < 4; ++m)
#pragma unroll
                for (int n = 0; n < 2; ++n) acc[a][b][m][n] = (f32x4){0.f, 0.f, 0.f, 0.f};
    bf16x8 At[4][2], B0[2][2], B1[2][2];
    const char* cA = (const char*)g.A + (size_t)cur.pm * tstep; const char* cB = (const char*)g.Bt + (size_t)cur.pn * tstep;
    S.a_ready(cur);
    if constexpr (SP2) {
        PG8_STAGE(PG8_SB(0, 0), cB, voffB); PG8_STAGE(PG8_SB(0, 1), cB + hstep, voffB); PG8_STAGE(PG8_SA(0, 0), cA, voffA); PG8_STAGE(PG8_SA(0, 1), cA + hstep, voffA);
        if (wr == 1) PG8_BAR;
        PG8_WAIT_V(2); PG8_BAR;
        PG8_STAGE(PG8_SB(1, 0), cB + kstep, voffB); PG8_STAGE(PG8_SA(1, 0), cA + kstep, voffA); PG8_STAGE(PG8_SB(1, 1), cB + hstep + kstep, voffB);
        PG8_WAIT_V(6); PG8_BAR;
    } else {
        PG8_STAGE(PG8_SB(0, 0), cB, voffB); PG8_STAGE(PG8_SA(0, 0), cA, voffA); PG8_STAGE(PG8_SB(0, 1), cB + hstep, voffB); PG8_STAGE(PG8_SA(0, 1), cA + hstep, voffA);
        if (wr == 1) PG8_BAR;
        PG8_WAIT_V(4); PG8_BAR;
        PG8_STAGE(PG8_SB(1, 0), cB + kstep, voffB); PG8_STAGE(PG8_SA(1, 0), cA + kstep, voffA); PG8_STAGE(PG8_SB(1, 1), cB + hstep + kstep, voffB);
        PG8_WAIT_V(6); PG8_BAR;
    }
    for (;;) {
        const bool has_next = S.next(ui + 1, nxt);
        const char* nA = has_next ? (const char*)g.A + (size_t)nxt.pm * tstep : cA; const char* nB = has_next ? (const char*)g.Bt + (size_t)nxt.pn * tstep : cB;
        for (int t = 0; t < nt; t += 2) {
            const bool last = (t == nt - 2);
            const char* a1 = cA + (size_t)(t + 1) * kstep;
            const char* a2 = last ? nA : cA + (size_t)(t + 2) * kstep; const char* b2 = last ? nB : cB + (size_t)(t + 2) * kstep;
            const char* a3 = a2 + kstep; const char* b3 = b2 + kstep;
            if (last && has_next) S.a_ready(nxt);
            if constexpr (SP2) {
            PG8_LDB(B0, 0, 0); PG8_LDB(B1, 0, 1); PG8_SCHED; PG8_LDA(At, 0, 0); PG8_STAGE(PG8_SA(1, 1), a1 + hstep, voffA);
            PG8_WAIT_V(8); PG8_WAIT_L(0); PG8_BAR; PG8_MMA(0, 0, At, B0); PG8_MMA(0, 1, At, B1); PG8_BAR; PG8_SCHED;
            PG8_LDA(At, 0, 1); PG8_STAGE(PG8_SB(0, 0), b2, voffB); PG8_STAGE(PG8_SB(0, 1), b2 + hstep, voffB); PG8_STAGE(PG8_SA(0, 0), a2, voffA);
            PG8_WAIT_V(8); PG8_WAIT_L(0); PG8_BAR; PG8_MMA(1, 0, At, B0); PG8_MMA(1, 1, At, B1); PG8_BAR; PG8_SCHED;
            PG8_LDB(B0, 1, 0); PG8_LDB(B1, 1, 1); PG8_SCHED; PG8_LDA(At, 1, 0); PG8_STAGE(PG8_SA(0, 1), a2 + hstep, voffA);
            PG8_WAIT_V(8); PG8_WAIT_L(0); PG8_BAR; PG8_MMA(0, 0, At, B0); PG8_MMA(0, 1, At, B1); PG8_BAR; PG8_SCHED;
            PG8_LDA(At, 1, 1); PG8_STAGE(PG8_SB(1, 0), b3, voffB); PG8_STAGE(PG8_SB(1, 1), b3 + hstep, voffB); PG8_STAGE(PG8_SA(1, 0), a3, voffA);
            PG8_WAIT_V(8); PG8_WAIT_L(0); PG8_BAR; PG8_MMA(1, 0, At, B0); PG8_MMA(1, 1, At, B1); PG8_BAR; PG8_SCHED;
            } else {
            PG8_LDB(B0, 0, 0); PG8_SCHED; PG8_LDA(At, 0, 0); PG8_STAGE(PG8_SA(1, 1), a1 + hstep, voffA);
            PG8_WAIT_L(8); PG8_BAR; PG8_WAIT_L(0); PG8_MMA(0, 0, At, B0); PG8_BAR; PG8_SCHED;
            PG8_LDB(B1, 0, 1); PG8_STAGE(PG8_SB(0, 0), b2, voffB);
            PG8_BAR; PG8_WAIT_L(0); PG8_MMA(0, 1, At, B1); PG8_BAR;
            PG8_LDA(At, 0, 1); PG8_STAGE(PG8_SA(0, 0), a2, voffA);
            PG8_BAR; PG8_WAIT_L(0); PG8_MMA(1, 0, At, B0); PG8_BAR; PG8_SCHED;
            PG8_STAGE(PG8_SB(0, 1), b2 + hstep, voffB);
            PG8_WAIT_V(6); PG8_BAR; PG8_MMA(1, 1, At, B1); PG8_BAR;
            PG8_LDB(B0, 1, 0); PG8_SCHED; PG8_LDA(At, 1, 0); PG8_STAGE(PG8_SA(0, 1), a2 + hstep, voffA);
            PG8_WAIT_L(8); PG8_BAR; PG8_WAIT_L(0); PG8_MMA(0, 0, At, B0); PG8_BAR; PG8_SCHED;
            PG8_LDB(B1, 1, 1); PG8_STAGE(PG8_SB(1, 0), b3, voffB);
            PG8_BAR; PG8_WAIT_L(0); PG8_MMA(0, 1, At, B1); PG8_BAR;
            PG8_LDA(At, 1, 1); PG8_STAGE(PG8_SA(1, 0), a3, voffA);
            PG8_BAR; PG8_WAIT_L(0); PG8_MMA(1, 0, At, B0); PG8_BAR; PG8_SCHED;
            PG8_STAGE(PG8_SB(1, 1), b3 + hstep, voffB);
            PG8_WAIT_V(6); PG8_BAR; PG8_MMA(1, 1, At, B1); PG8_BAR;
            }
        }
        if constexpr (ALIGN_EPI) { if (wr == 0) PG8_BAR; }
        if constexpr (!Epi::AFTER_DRAIN) { E(acc, cur, wr, wc, fr, fq); S.done(cur); }
        if (!has_next) break;
#pragma unroll
        for (int a = 0; a < 2; ++a)
#pragma unroll
            for (int b = 0; b < 2; ++b)
#pragma unroll
                for (int m = 0; m < 4; ++m)
#pragma unroll
                    for (int n = 0; n < 2; ++n) acc[a][b][m][n] = (f32x4){0.f, 0.f, 0.f, 0.f};
        cur = nxt; cA = nA; cB = nB; ++ui;
        if constexpr (ALIGN_EPI) { if (wr == 1) PG8_BAR; }
    }
    PG8_WAIT_V(0);
    if constexpr (!ALIGN_EPI) { if (wr == 0) PG8_BAR; }
    PG8_BAR;
    if constexpr (Epi::AFTER_DRAIN) { E.fused(acc, cur, wr, wc, fr, fq, lds, wid, lane); S.done(cur); }
#undef PG8_SA
#undef PG8_SB
#undef PG8_STAGE
#undef PG8_LDA
#undef PG8_LDB
#undef PG8_MMA
#undef PG8_WAIT_V
#undef PG8_WAIT_L
#undef PG8_BAR
#undef PG8_SCHED
}
}

constexpr size_t SZ_WIN = (size_t)NIN * DM * 2, SZ_WO = (size_t)DM * DM * 2, SZ_WGU = (size_t)NGU * DM * 2, SZ_WD = (size_t)DM * DFFN * 2, SZ_WL = SZ_WIN + SZ_WO + SZ_WGU + SZ_WD;
constexpr size_t WS_CTL = 0;
constexpr size_t WS_W = 16384;
constexpr size_t WS_XB = WS_W + DEPTH * SZ_WL;
constexpr size_t WS_MRG = WS_XB + (size_t)MP * DM * 2;
constexpr size_t WS_Z = WS_MRG + (size_t)MP * DM * 2;
constexpr size_t WS_LD = WS_Z + (size_t)MP * ZP * 2;
constexpr size_t WS_U = WS_Z;
constexpr size_t WS_DS = WS_LD + (size_t)MP * 256 * 4;
constexpr size_t WS_SC = WS_DS + (size_t)16 * NCH * 64 * 128 * 4;
constexpr size_t WS_GL = WS_SC + (size_t)16 * NCH * 64 * 128 * 2;
constexpr size_t WS_SSQA = WS_GL + (size_t)16 * NCH * 64 * 4;
constexpr size_t WS_SSQB = WS_SSQA + (size_t)MP * 16 * 4;
constexpr size_t WS_XMETA = WS_SSQB + (size_t)MP * 16 * 4;
constexpr size_t WS_END = WS_XMETA + (size_t)64 * DM * 4;
static_assert((size_t)MP * DFFN * 2 <= (size_t)MP * ZP * 2 + (size_t)MP * 256 * 4, "U overlay fits Z|LD");
static_assert(WS_END <= 268435456ull, "workspace map fits 256 MiB");

#ifndef REP_PRO
#define REP_PRO 1
#endif
#ifndef REP_WIN
#define REP_WIN 1
#endif
#ifndef REP_MB
#define REP_MB 1
#endif
#ifndef REP_SCAN
#define REP_SCAN 1
#endif
#ifndef REP_GU
#define REP_GU 1
#endif
#ifndef REP_G1
#define REP_G1 1
#endif
#ifndef REP_AS
#define REP_AS 1
#endif
#ifndef REP_GS
#define REP_GS 1
#endif
#ifndef REP_G3
#define REP_G3 1
#endif
#ifndef REP_AP
#define REP_AP 1
#endif
#ifndef REP_WO0
#define REP_WO0 1
#endif
#ifndef XSYNC
#define XSYNC 0
#endif
constexpr int LDS_BYTES = 147456;
constexpr int NPHASE = 1 + 7 * DEPTH;

struct Args { const float* in[19]; float* out; unsigned char* ws; int ph_lo, ph_hi; };
typedef const __attribute__((address_space(4))) Args* KA;
DI KA ka_ptr() { KA p = (KA)__builtin_amdgcn_kernarg_segment_ptr(); asm volatile("" : "+s"(p)); return p; }

DI int mk_tid(int wave_s) { int lane; asm volatile("v_mbcnt_lo_u32_b32 %0, -1, 0\n\tv_mbcnt_hi_u32_b32 %0, -1, %0" : "=v"(lane)); return wave_s * 64 + lane; }
DI bf16x8 mk8(u32x2 lo, u32x2 hi) { u32x4 w; w.x = lo.x; w.y = lo.y; w.z = hi.x; w.w = hi.y; return __builtin_bit_cast(bf16x8, w); }
#define MFMA16(a, b, c) __builtin_amdgcn_mfma_f32_16x16x32_bf16((a), (b), (c), 0, 0, 0)

DI void attn_wave(const LAS unsigned char* Ks, const LAS unsigned char* Vt, const int VPB, const bf16_t* qrow, const float* qnw, const float sink2, const int jmin, const int c, const int fq, bf16_t* orow) {
    float qf[16];
    if (qrow) { const u32x4 a = *(const u32x4*)(qrow + 8 * fq), b = *(const u32x4*)(qrow + 32 + 8 * fq); unpack8(a, qf); unpack8(b, qf + 8); }
    else {
#pragma unroll
        for (int i = 0; i < 16; ++i) qf[i] = 0.f; }
    float ss = 0.f;
#pragma unroll
    for (int i = 0; i < 16; ++i) ss += qf[i] * qf[i];
    ss += __shfl_xor(ss, 16); ss += __shfl_xor(ss, 32);
    const float rs = rsqrtf(ss * (1.0f / 64.0f) + EPS) * (0.125f * LOG2E);
    const f32x4 w0 = *(const f32x4*)(qnw + 8 * fq), w1 = *(const f32x4*)(qnw + 8 * fq + 4), w2 = *(const f32x4*)(qnw + 32 + 8 * fq), w3 = *(const f32x4*)(qnw + 36 + 8 * fq);
#pragma unroll
    for (int i = 0; i < 4; ++i) { qf[i] *= rs * w0[i]; qf[4 + i] *= rs * w1[i]; qf[8 + i] *= rs * w2[i]; qf[12 + i] *= rs * w3[i]; }
    u32x4 q0, q1; q0.x = pk2(qf[0], qf[1]); q0.y = pk2(qf[2], qf[3]); q0.z = pk2(qf[4], qf[5]); q0.w = pk2(qf[6], qf[7]);
    q1.x = pk2(qf[8], qf[9]); q1.y = pk2(qf[10], qf[11]); q1.z = pk2(qf[12], qf[13]); q1.w = pk2(qf[14], qf[15]);
    const bf16x8 qB0 = __builtin_bit_cast(bf16x8, q0), qB1 = __builtin_bit_cast(bf16x8, q1);
    f32x4 acc[9];
    float mx = sink2;
#pragma unroll
    for (int T = 0; T < 9; ++T) {
        const LAS unsigned char* kp = Ks + (16 * T + c) * 144 + 16 * fq;
        const bf16x8 a0 = *(const LAS bf16x8*)kp, a1 = *(const LAS bf16x8*)(kp + 64);
        f32x4 s = {0.f, 0.f, 0.f, 0.f};
        s = MFMA16(a0, qB0, s); s = MFMA16(a1, qB1, s);
#pragma unroll
        for (int r = 0; r < 4; ++r) { const int jrel = 16 * T + 4 * fq + r, d = 128 + c - jrel; const bool ok = ((unsigned)d < 128u) && (jrel >= jmin); s[r] = ok ? s[r] : -1e30f; mx = fmaxf(mx, s[r]); }
        acc[T] = s;
    }
    mx = fmaxf(mx, __shfl_xor(mx, 16)); mx = fmaxf(mx, __shfl_xor(mx, 32));
    float sum = 0.f;
#pragma unroll
    for (int T = 0; T < 9; ++T)
#pragma unroll
        for (int r = 0; r < 4; ++r) { const float p = __builtin_amdgcn_exp2f(acc[T][r] - mx); acc[T][r] = p; sum += p; }
    sum += __shfl_xor(sum, 16); sum += __shfl_xor(sum, 32);
    const float inv = 1.0f / (sum + __builtin_amdgcn_exp2f(sink2 - mx));
    f32x4 o[4];
#pragma unroll
    for (int i = 0; i < 4; ++i) o[i] = (f32x4){0.f, 0.f, 0.f, 0.f};
#pragma unroll
    for (int kk = 0; kk < 5; ++kk) {
        u32x4 pw; pw.x = pk2(acc[2 * kk][0], acc[2 * kk][1]); pw.y = pk2(acc[2 * kk][2], acc[2 * kk][3]);
        if (kk < 4) { pw.z = pk2(acc[2 * kk + 1][0], acc[2 * kk + 1][1]); pw.w = pk2(acc[2 * kk + 1][2], acc[2 * kk + 1][3]); } else { pw.z = 0u; pw.w = 0u; }
        const bf16x8 pB = __builtin_bit_cast(bf16x8, pw);
#pragma unroll
        for (int Mt = 0; Mt < 4; ++Mt) {
            const LAS unsigned char* vp = Vt + (16 * Mt + c) * VPB + (32 * kk + 4 * fq) * 2;
            const u32x2 lo = *(const LAS u32x2*)vp, hi = *(const LAS u32x2*)(vp + 32);
            o[Mt] = MFMA16(mk8(lo, hi), pB, o[Mt]);
        }
    }
    if (orow) {
#pragma unroll
        for (int Mt = 0; Mt < 4; ++Mt) { u32x2 w; w.x = pk2(o[Mt][0] * inv, o[Mt][1] * inv); w.y = pk2(o[Mt][2] * inv, o[Mt][3] * inv); *(u32x2*)(orow + 16 * Mt + 4 * fq) = w; }
    }
}

struct Ctx {
    int l;
    const bf16_t* Z; float* LD; bf16_t* MRG; float* DS; bf16_t* SC; float* GL;
    const float *qnw, *knw, *sinks, *gnw;
    const float *cache_k, *cache_v, *state;
    float* out;
};

DI void attn_prompt_unit(const Ctx& C, int uidx, LAS unsigned char* lds, const int wave_s) {
    const int tid = mk_tid(wave_s);
    const int jb = uidx % 65, g = (uidx / 65) & 1, b = uidx / 130;
    const int p0 = 64 * jb, kbase = p0 - 128, rowbase = b * LP, nq = (LP - p0) < 64 ? (LP - p0) : 64;
    LAS unsigned char* Ks = lds; LAS unsigned char* Vt = lds + 208 * 144;
    const int lane = tid & 63, w = tid >> 6;
    {
        const int dc = tid & 7;
        const f32x4 kw0 = *(const f32x4*)(C.knw + dc * 8), kw1 = *(const f32x4*)(C.knw + dc * 8 + 4);
#pragma unroll
        for (int i = 0; i < 4; ++i) { const int j = (tid >> 3) + 64 * i, kp = kbase + j; const bool valid = (j < 192) && (kp >= 0) && (kp < LP);
            u32x4 raw = {0u, 0u, 0u, 0u}; if (valid) raw = *(const u32x4*)(C.Z + (size_t)(rowbase + kp) * ZP + ZK + g * 64 + dc * 8);
            float f[8]; unpack8(raw, f); float ss = 0.f;
#pragma unroll
            for (int e = 0; e < 8; ++e) ss += f[e] * f[e];
            ss += __shfl_xor(ss, 1); ss += __shfl_xor(ss, 2); ss += __shfl_xor(ss, 4);
            const float rs = rsqrtf(ss * (1.0f / 64.0f) + EPS);
#pragma unroll
            for (int e = 0; e < 4; ++e) { f[e] *= rs * kw0[e]; f[4 + e] *= rs * kw1[e]; }
            if (j < 208) { u32x4 o; o.x = pk2(f[0], f[1]); o.y = pk2(f[2], f[3]); o.z = pk2(f[4], f[5]); o.w = pk2(f[6], f[7]); *(LAS u32x4*)(Ks + j * 144 + dc * 16) = o; }
            if (valid && j >= 128 && kp >= LP - 128) { float* op = C.out + O_CKP + ((size_t)((C.l * NBATCH + b) * 128 + (kp - (LP - 128))) * 2 + g) * 64 + dc * 8;
                *(f32x4*)op = (f32x4){f[0], f[1], f[2], f[3]}; *(f32x4*)(op + 4) = (f32x4){f[4], f[5], f[6], f[7]}; } asm volatile("" ::: "memory"); }
    }
    {
        const int dc = w;
#pragma unroll
        for (int i = 0; i < 4; ++i) { const int j = lane + 64 * i, kp = kbase + j; const bool valid = (j < 192) && (kp >= 0) && (kp < LP);
            u32x4 raw = {0u, 0u, 0u, 0u}; if (valid) raw = *(const u32x4*)(C.Z + (size_t)(rowbase + kp) * ZP + ZV + g * 64 + dc * 8);
            if (j < 216) { LAS bf16_t* vp = (LAS bf16_t*)(Vt + (dc * 8) * 432 + j * 2);
                vp[0 * 216] = (bf16_t)(raw.x & 0xffffu); vp[1 * 216] = (bf16_t)(raw.x >> 16); vp[2 * 216] = (bf16_t)(raw.y & 0xffffu); vp[3 * 216] = (bf16_t)(raw.y >> 16);
                vp[4 * 216] = (bf16_t)(raw.z & 0xffffu); vp[5 * 216] = (bf16_t)(raw.z >> 16); vp[6 * 216] = (bf16_t)(raw.w & 0xffffu); vp[7 * 216] = (bf16_t)(raw.w >> 16); }
            if (valid && j >= 128 && kp >= LP - 128) { float f[8]; unpack8(raw, f); float* op = C.out + O_CVP + ((size_t)((C.l * NBATCH + b) * 128 + (kp - (LP - 128))) * 2 + g) * 64 + dc * 8;
                *(f32x4*)op = (f32x4){f[0], f[1], f[2], f[3]}; *(f32x4*)(op + 4) = (f32x4){f[4], f[5], f[6], f[7]}; } asm volatile("" ::: "memory"); }
    }
    __syncthreads();
    {
        const int tid2 = mk_tid(wave_s), lane = tid2 & 63, w = tid2 >> 6;
        const int s = w & 3, hp = w >> 2, c = lane & 15, fq = lane >> 4;
        if (16 * s < nq) {
#pragma unroll 1
            for (int hh = 0; hh < 2; ++hh) { const int h = g * 4 + hp * 2 + hh, qp = p0 + 16 * s + c; const bool qv = qp < LP;
                const bf16_t* qrow = qv ? C.Z + (size_t)(rowbase + qp) * ZP + ZQ + h * 64 : nullptr;
                bf16_t* orow = qv ? C.MRG + (size_t)(rowbase + qp) * DM + h * 64 : nullptr;
                attn_wave(Ks + 16 * s * 144, Vt + 16 * s * 2, 432, qrow, C.qnw, C.sinks[h] * LOG2E, 128 - p0 - 16 * s, c, fq, orow); }
        }
    }
    __syncthreads();
}

DI void attn_sample_unit(const Ctx& C, int b, LAS unsigned char* lds, const int wave_s) {
    const int tid = mk_tid(wave_s);
    const int lane = tid & 63, w = tid >> 6;
    constexpr int KSG = 160 * 144, VTG = 64 * 336, VT0 = 2 * KSG;
    const int row0 = MPROMPT + b * DECT;
    const size_t cbase = (size_t)(C.l * DECB + b) * 128;
#pragma unroll
    for (int i = 0; i < 4; ++i) {
        const int idx = tid + 512 * i, dc = idx & 7, j = (idx >> 3) & 127, g = idx >> 10;
        const float* sp = C.cache_k + ((cbase + j) * 2 + g) * 64 + dc * 8; const f32x4 a = *(const f32x4*)sp, bq = *(const f32x4*)(sp + 4);
        u32x4 o; o.x = pk2(a[0], a[1]); o.y = pk2(a[2], a[3]); o.z = pk2(bq[0], bq[1]); o.w = pk2(bq[2], bq[3]);
        *(LAS u32x4*)(lds + g * KSG + j * 144 + dc * 16) = o;
        if (j >= 8) { float* op = C.out + O_CKS + ((cbase + j - 8) * 2 + g) * 64 + dc * 8; *(f32x4*)op = a; *(f32x4*)(op + 4) = bq; }
        asm volatile("" ::: "memory");
    }
    if (w < 2) {
        const int dc = tid & 7, t = (tid >> 3) & 7, g = tid >> 6;
        const u32x4 raw = *(const u32x4*)(C.Z + (size_t)(row0 + t) * ZP + ZK + g * 64 + dc * 8);
        float f[8]; unpack8(raw, f); float ss = 0.f;
#pragma unroll
        for (int e = 0; e < 8; ++e) ss += f[e] * f[e];
        ss += __shfl_xor(ss, 1); ss += __shfl_xor(ss, 2); ss += __shfl_xor(ss, 4);
        const float rs = rsqrtf(ss * (1.0f / 64.0f) + EPS);
        const f32x4 kw0 = *(const f32x4*)(C.knw + dc * 8), kw1 = *(const f32x4*)(C.knw + dc * 8 + 4);
#pragma unroll
        for (int e = 0; e < 4; ++e) { f[e] *= rs * kw0[e]; f[4 + e] *= rs * kw1[e]; }
        u32x4 o; o.x = pk2(f[0], f[1]); o.y = pk2(f[2], f[3]); o.z = pk2(f[4], f[5]); o.w = pk2(f[6], f[7]);
        *(LAS u32x4*)(lds + g * KSG + (128 + t) * 144 + dc * 16) = o;
        float* op = C.out + O_CKS + ((cbase + 120 + t) * 2 + g) * 64 + dc * 8;
        *(f32x4*)op = (f32x4){f[0], f[1], f[2], f[3]}; *(f32x4*)(op + 4) = (f32x4){f[4], f[5], f[6], f[7]};
    } else if (w < 8) {
        const int idx = tid - 128, dc = idx & 7, r = (idx >> 3) % 24, g = idx / 192;
        unsigned z0 = 0u; asm volatile("" : "+v"(z0)); *(LAS u32x4*)(lds + g * KSG + (136 + r) * 144 + dc * 16) = (u32x4){z0, z0, z0, z0};
    }
#pragma unroll
    for (int i = 0; i < 4; ++i) {
        const int idx = tid + 512 * i, j = idx & 127, dc = (idx >> 7) & 7, g = idx >> 10;
        const float* sp = C.cache_v + ((cbase + j) * 2 + g) * 64 + dc * 8; const f32x4 a = *(const f32x4*)sp, bq = *(const f32x4*)(sp + 4);
        LAS bf16_t* vp = (LAS bf16_t*)(lds + VT0 + g * VTG + (dc * 8) * 336 + j * 2);
        const unsigned p0 = pk2(a[0], a[1]), p1 = pk2(a[2], a[3]), p2 = pk2(bq[0], bq[1]), p3 = pk2(bq[2], bq[3]);
        vp[0 * 168] = (bf16_t)(p0 & 0xffffu); vp[1 * 168] = (bf16_t)(p0 >> 16); vp[2 * 168] = (bf16_t)(p1 & 0xffffu); vp[3 * 168] = (bf16_t)(p1 >> 16);
        vp[4 * 168] = (bf16_t)(p2 & 0xffffu); vp[5 * 168] = (bf16_t)(p2 >> 16); vp[6 * 168] = (bf16_t)(p3 & 0xffffu); vp[7 * 168] = (bf16_t)(p3 >> 16);
        if (j >= 8) { float* op = C.out + O_CVS + ((cbase + j - 8) * 2 + g) * 64 + dc * 8; *(f32x4*)op = a; *(f32x4*)(op + 4) = bq; }
        asm volatile("" ::: "memory");
    }
    if (tid < 128) {
        const int t = tid & 7, dc = (tid >> 3) & 7, g = tid >> 6;
        const u32x4 raw = *(const u32x4*)(C.Z + (size_t)(row0 + t) * ZP + ZV + g * 64 + dc * 8);
        LAS bf16_t* vp = (LAS bf16_t*)(lds + VT0 + g * VTG + (dc * 8) * 336 + (128 + t) * 2);
        vp[0 * 168] = (bf16_t)(raw.x & 0xffffu); vp[1 * 168] = (bf16_t)(raw.x >> 16); vp[2 * 168] = (bf16_t)(raw.y & 0xffffu); vp[3 * 168] = (bf16_t)(raw.y >> 16);
        vp[4 * 168] = (bf16_t)(raw.z & 0xffffu); vp[5 * 168] = (bf16_t)(raw.z >> 16); vp[6 * 168] = (bf16_t)(raw.w & 0xffffu); vp[7 * 168] = (bf16_t)(raw.w >> 16);
        float f[8]; unpack8(raw, f); float* op = C.out + O_CVS + ((cbase + 120 + t) * 2 + g) * 64 + dc * 8;
        *(f32x4*)op = (f32x4){f[0], f[1], f[2], f[3]}; *(f32x4*)(op + 4) = (f32x4){f[4], f[5], f[6], f[7]};
    }
#pragma unroll
    for (int i = 0; i < 2; ++i) {
        const int idx = tid + 512 * i, part = idx & 7, d = (idx >> 3) & 63, g = idx >> 9;
        unsigned z0 = 0u; asm volatile("" : "+v"(z0)); *(LAS u32x2*)(lds + VT0 + g * VTG + d * 336 + 272 + part * 8) = (u32x2){z0, z0};
    }
    __syncthreads();
    {
        const int tid2 = mk_tid(wave_s), lane = tid2 & 63, w = tid2 >> 6;
        const int g = w >> 2, h = w, c = lane & 15, fq = lane >> 4;
        const bool qv = c < 8;
        const bf16_t* qrow = qv ? C.Z + (size_t)(row0 + c) * ZP + ZQ + h * 64 : nullptr;
        bf16_t* orow = qv ? C.MRG + (size_t)(row0 + c) * DM + h * 64 : nullptr;
        attn_wave(lds + g * KSG, lds + VT0 + g * VTG, 336, qrow, C.qnw, C.sinks[h] * LOG2E, 0, c, fq, orow);
    }
    __syncthreads();
}

DI void gla_sample_unit(const Ctx& C, int uidx, LAS unsigned char* lds, const int wave_s) {
    const int tid = mk_tid(wave_s);
    const int h = uidx & 3, b = uidx >> 2, row0 = MPROMPT + b * DECT;
    LAS float* qs = (LAS float*)lds; LAS float* ks = qs + 512; LAS float* dec = ks + 512; LAS float* vs = dec + 512; LAS float* red = vs + 1024;
    {
        const int t = tid >> 6, k = tid & 63; const bf16_t* zr = C.Z + (size_t)(row0 + t) * ZP;
        qs[tid] = bf2f(zr[ZGQ + h * 64 + k]); ks[tid] = bf2f(zr[ZGK + h * 64 + k]); dec[tid] = __expf(C.LD[(size_t)(row0 + t) * 256 + h * 64 + k]);
#pragma unroll
        for (int i = 0; i < 2; ++i) { const int idx = tid + 512 * i, tt = idx >> 7, v = idx & 127; vs[idx] = bf2f(C.Z[(size_t)(row0 + tt) * ZP + ZGV + h * 128 + v]); }
    }
    const int v = tid & 127, kq = tid >> 7;
    const size_t sbase = ((size_t)((C.l * DECB + b) * 4 + h) * 64 + 16 * kq) * 128 + v;
    float S[16];
#pragma unroll
    for (int i = 0; i < 16; ++i) S[i] = C.state[sbase + (size_t)i * 128];
    __syncthreads();
#pragma unroll
    for (int t = 0; t < 8; ++t) { float a = 0.f; const float vv = vs[t * 128 + v];
#pragma unroll
        for (int i = 0; i < 16; ++i) { const int k = 16 * kq + i; S[i] = dec[t * 64 + k] * S[i] + ks[t * 64 + k] * vv; a += qs[t * 64 + k] * S[i]; }
        red[(kq * 8 + t) * 128 + v] = a; }
    float* so = C.out + O_SS + sbase;
#pragma unroll
    for (int i = 0; i < 16; ++i) so[(size_t)i * 128] = S[i];
    __syncthreads();
    {
        const int t = tid >> 6, lane = tid & 63; float o[2]; float ss = 0.f;
#pragma unroll
        for (int i = 0; i < 2; ++i) { const int vv = lane + 64 * i; o[i] = (red[(0 * 8 + t) * 128 + vv] + red[(1 * 8 + t) * 128 + vv]) + (red[(2 * 8 + t) * 128 + vv] + red[(3 * 8 + t) * 128 + vv]); ss += o[i] * o[i]; }
#pragma unroll
        for (int m = 1; m < 64; m <<= 1) ss += __shfl_xor(ss, m);
        const float rs = rsqrtf(ss * (1.0f / 128.0f) + EPS);
#pragma unroll
        for (int i = 0; i < 2; ++i) { const int vv = lane + 64 * i; const float og = bf2f(C.Z[(size_t)(row0 + t) * ZP + ZOG + h * 128 + vv]);
            const float y = o[i] * rs * C.gnw[vv] * silu_f(og); C.MRG[(size_t)(row0 + t) * DM + 512 + h * 128 + vv] = (bf16_t)(pk2(y, 0.f) & 0xffffu); }
    }
    __syncthreads();
}

DI float gla_prefix(const float* LD, int r0, int nv, int h, LAS float* Gs, LAS float* segtot, int lane, int w) {
    const int k = lane, seg = w; float g[16];
#pragma unroll
    for (int i = 0; i < 16; ++i) { const int t = 16 * seg + i; g[i] = t < nv ? LD[(size_t)(r0 + t) * 256 + h * 64 + k] : 0.f; }
#pragma unroll
    for (int i = 1; i < 16; ++i) g[i] += g[i - 1];
    segtot[seg * 64 + k] = g[15];
    __syncthreads();
    float off = 0.f, tot = 0.f;
#pragma unroll
    for (int s = 0; s < 8; ++s) { const float x = segtot[s * 64 + k]; off += (s < seg) ? x : 0.f; tot += x; }
#pragma unroll
    for (int i = 0; i < 16; ++i) { const int t = 16 * seg + i; Gs[t * 65 + k] = g[i] + off; }
    return tot;
}

DI void gla1_unit(const Ctx& C, int unit, LAS unsigned char* lds, const int wave_s) {
    const int tid = mk_tid(wave_s);
    const int c = unit % NCH, bh = unit / NCH, h = bh & 3, b = bh >> 2;
    const int r0 = b * LP + 128 * c, nv = (LP - 128 * c) < 128 ? (LP - 128 * c) : 128;
    LAS float* Gs = (LAS float*)lds; LAS float* segtot = (LAS float*)(lds + 33280); LAS float* gl = (LAS float*)(lds + 35328);
    LAS unsigned char* kdT = lds + 35840; LAS unsigned char* vT = lds + 53248;
    const int lane = tid & 63, w = tid >> 6;
    { const float tot = gla_prefix(C.LD, r0, nv, h, Gs, segtot, lane, w); if (w == 0) { gl[lane] = tot; C.GL[(size_t)unit * 64 + lane] = tot; } }
    __syncthreads();
    {
        const int t = tid & 127;
#pragma unroll
        for (int i = 0; i < 2; ++i) { const int kc = (tid >> 7) + 4 * i; u32x4 raw = {0u, 0u, 0u, 0u};
            if (t < nv) raw = *(const u32x4*)(C.Z + (size_t)(r0 + t) * ZP + ZGK + h * 64 + kc * 8);
            float f[8]; unpack8(raw, f);
#pragma unroll
            for (int e = 0; e < 8; ++e) { const float kd = f[e] * __expf(gl[kc * 8 + e] - Gs[t * 65 + kc * 8 + e]); *(LAS bf16_t*)(kdT + (kc * 8 + e) * 272 + t * 2) = (bf16_t)(pk2(kd, 0.f) & 0xffffu); } }
#pragma unroll
        for (int i = 0; i < 4; ++i) { const int vc = (tid >> 7) + 4 * i; u32x4 raw = {0u, 0u, 0u, 0u};
            if (t < nv) raw = *(const u32x4*)(C.Z + (size_t)(r0 + t) * ZP + ZGV + h * 128 + vc * 8);
            LAS bf16_t* vp = (LAS bf16_t*)(vT + (vc * 8) * 272 + t * 2);
            vp[0 * 136] = (bf16_t)(raw.x & 0xffffu); vp[1 * 136] = (bf16_t)(raw.x >> 16); vp[2 * 136] = (bf16_t)(raw.y & 0xffffu); vp[3 * 136] = (bf16_t)(raw.y >> 16);
            vp[4 * 136] = (bf16_t)(raw.z & 0xffffu); vp[5 * 136] = (bf16_t)(raw.z >> 16); vp[6 * 136] = (bf16_t)(raw.w & 0xffffu); vp[7 * 136] = (bf16_t)(raw.w >> 16); }
    }
    __syncthreads();
    {
        const int cc = lane & 15, fq = lane >> 4;
#pragma unroll
        for (int kt = 0; kt < 4; ++kt) { f32x4 acc = {0.f, 0.f, 0.f, 0.f};
#pragma unroll
            for (int ks = 0; ks < 4; ++ks) { const bf16x8 a = *(const LAS bf16x8*)(kdT + (16 * kt + cc) * 272 + (32 * ks + 8 * fq) * 2), bb = *(const LAS bf16x8*)(vT + (16 * w + cc) * 272 + (32 * ks + 8 * fq) * 2); acc = MFMA16(a, bb, acc); }
#pragma unroll
            for (int r = 0; r < 4; ++r) C.DS[((size_t)unit * 64 + 16 * kt + 4 * fq + r) * 128 + 16 * w + cc] = acc[r]; }
    }
    __syncthreads();
}

DI void gla3_unit(const Ctx& C, int unit, LAS unsigned char* lds, const int wave_s) {
    const int tid = mk_tid(wave_s);
    const int c = unit % NCH, bh = unit / NCH, h = bh & 3, b = bh >> 2;
    const int r0 = b * LP + 128 * c, nv = (LP - 128 * c) < 128 ? (LP - 128 * c) : 128;
    LAS unsigned char* qg = lds; LAS unsigned char* kg = lds + 18432; LAS unsigned char* vT = lds + 36864; LAS unsigned char* ScT = lds + 71680;
    LAS float* Gs = (LAS float*)(lds + 90112); LAS float* segtot = (LAS float*)(lds + 123392);
    const int lane = tid & 63, w = __builtin_amdgcn_readfirstlane(tid >> 6);
    (void)gla_prefix(C.LD, r0, nv, h, Gs, segtot, lane, w);
    __syncthreads();
    {
        const int kc = tid & 7;
#pragma unroll
        for (int i = 0; i < 2; ++i) { const int t = (tid >> 3) + 64 * i; u32x4 rq = {0u, 0u, 0u, 0u}, rk = {0u, 0u, 0u, 0u}; f32x4 g0 = {0.f, 0.f, 0.f, 0.f}, g1 = g0;
            if (t < nv) { const bf16_t* zr = C.Z + (size_t)(r0 + t) * ZP + h * 64 + kc * 8; rq = *(const u32x4*)(zr + ZGQ); rk = *(const u32x4*)(zr + ZGK);
                const LAS float* gp = Gs + t * 65 + kc * 8; g0 = (f32x4){gp[0], gp[1], gp[2], gp[3]}; g1 = (f32x4){gp[4], gp[5], gp[6], gp[7]}; }
            float fq_[8], fk_[8]; unpack8(rq, fq_); unpack8(rk, fk_);
#pragma unroll
            for (int e = 0; e < 4; ++e) { const float e0 = __expf(g0[e]), e1 = __expf(g1[e]); fq_[e] *= e0; fq_[4 + e] *= e1; fk_[e] *= __builtin_amdgcn_rcpf(e0); fk_[4 + e] *= __builtin_amdgcn_rcpf(e1); }
            u32x4 oq, ok; oq.x = pk2(fq_[0], fq_[1]); oq.y = pk2(fq_[2], fq_[3]); oq.z = pk2(fq_[4], fq_[5]); oq.w = pk2(fq_[6], fq_[7]);
            ok.x = pk2(fk_[0], fk_[1]); ok.y = pk2(fk_[2], fk_[3]); ok.z = pk2(fk_[4], fk_[5]); ok.w = pk2(fk_[6], fk_[7]);
            *(LAS u32x4*)(qg + t * 144 + kc * 16) = oq; *(LAS u32x4*)(kg + t * 144 + kc * 16) = ok; }
        const int t = tid & 127;
#pragma unroll
        for (int i = 0; i < 4; ++i) { const int vc = (tid >> 7) + 4 * i; u32x4 raw = {0u, 0u, 0u, 0u};
            if (t < nv) raw = *(const u32x4*)(C.Z + (size_t)(r0 + t) * ZP + ZGV + h * 128 + vc * 8);
            LAS bf16_t* vp = (LAS bf16_t*)(vT + (vc * 8) * 272 + t * 2);
            vp[0 * 136] = (bf16_t)(raw.x & 0xffffu); vp[1 * 136] = (bf16_t)(raw.x >> 16); vp[2 * 136] = (bf16_t)(raw.y & 0xffffu); vp[3 * 136] = (bf16_t)(raw.y >> 16);
            vp[4 * 136] = (bf16_t)(raw.z & 0xffffu); vp[5 * 136] = (bf16_t)(raw.z >> 16); vp[6 * 136] = (bf16_t)(raw.w & 0xffffu); vp[7 * 136] = (bf16_t)(raw.w >> 16); }
        const int k = tid & 63;
#pragma unroll
        for (int i = 0; i < 2; ++i) { const int vc = (tid >> 6) + 8 * i; const u32x4 raw = *(const u32x4*)(C.SC + ((size_t)unit * 64 + k) * 128 + vc * 8);
            LAS bf16_t* sp = (LAS bf16_t*)(ScT + (vc * 8) * 144 + k * 2);
            sp[0 * 72] = (bf16_t)(raw.x & 0xffffu); sp[1 * 72] = (bf16_t)(raw.x >> 16); sp[2 * 72] = (bf16_t)(raw.y & 0xffffu); sp[3 * 72] = (bf16_t)(raw.y >> 16);
            sp[4 * 72] = (bf16_t)(raw.z & 0xffffu); sp[5 * 72] = (bf16_t)(raw.z >> 16); sp[6 * 72] = (bf16_t)(raw.w & 0xffffu); sp[7 * 72] = (bf16_t)(raw.w >> 16); }
    }
    __syncthreads();
    {
        const int cc = lane & 15, fq = lane >> 4;
        const bf16x8 qB0 = *(const LAS bf16x8*)(qg + (16 * w + cc) * 144 + 16 * fq), qB1 = *(const LAS bf16x8*)(qg + (16 * w + cc) * 144 + 64 + 16 * fq);
        f32x4 A[8];
#pragma unroll
        for (int T = 0; T < 8; ++T) { f32x4 s = {0.f, 0.f, 0.f, 0.f};
            if (T <= w) { const LAS unsigned char* kp = kg + (16 * T + cc) * 144 + 16 * fq; const bf16x8 a0 = *(const LAS bf16x8*)kp, a1 = *(const LAS bf16x8*)(kp + 64);
                s = MFMA16(a0, qB0, s); s = MFMA16(a1, qB1, s);
                if (T == w) {
#pragma unroll
                    for (int r = 0; r < 4; ++r) s[r] = (4 * fq + r > cc) ? 0.f : s[r]; } }
            A[T] = s; }
        bf16x8 P[4];
#pragma unroll
        for (int kk = 0; kk < 4; ++kk) { u32x4 pw; pw.x = pk2(A[2 * kk][0], A[2 * kk][1]); pw.y = pk2(A[2 * kk][2], A[2 * kk][3]); pw.z = pk2(A[2 * kk + 1][0], A[2 * kk + 1][1]); pw.w = pk2(A[2 * kk + 1][2], A[2 * kk + 1][3]); P[kk] = __builtin_bit_cast(bf16x8, pw); }
        f32x4 o[8]; float ss = 0.f;
#pragma unroll
        for (int Mt = 0; Mt < 8; ++Mt) { f32x4 acc = {0.f, 0.f, 0.f, 0.f};
#pragma unroll
            for (int kk = 0; kk < 4; ++kk) if (2 * kk <= w) { const LAS unsigned char* vp = vT + (16 * Mt + cc) * 272 + (32 * kk + 4 * fq) * 2; const u32x2 lo = *(const LAS u32x2*)vp, hi = *(const LAS u32x2*)(vp + 32); acc = MFMA16(mk8(lo, hi), P[kk], acc); }
            { const LAS unsigned char* sp = ScT + (16 * Mt + cc) * 144 + 16 * fq; const bf16x8 a0 = *(const LAS bf16x8*)sp, a1 = *(const LAS bf16x8*)(sp + 64); acc = MFMA16(a0, qB0, acc); acc = MFMA16(a1, qB1, acc); }
            o[Mt] = acc; ss += (acc[0] * acc[0] + acc[1] * acc[1]) + (acc[2] * acc[2] + acc[3] * acc[3]); }
        ss += __shfl_xor(ss, 16); ss += __shfl_xor(ss, 32);
        const float rs = rsqrtf(ss * (1.0f / 128.0f) + EPS);
        const int t = 16 * w + cc;
        if (t < nv) { const size_t row = (size_t)(r0 + t);
#pragma unroll
            for (int Mt = 0; Mt < 8; ++Mt) { const int v0 = 16 * Mt + 4 * fq; const u32x2 og = *(const u32x2*)(C.Z + row * ZP + ZOG + h * 128 + v0); const f32x4 gn = *(const f32x4*)(C.gnw + v0);
                const float y0 = o[Mt][0] * rs * gn[0] * silu_f(bflo(og.x)), y1 = o[Mt][1] * rs * gn[1] * silu_f(bfhi(og.x)), y2 = o[Mt][2] * rs * gn[2] * silu_f(bflo(og.y)), y3 = o[Mt][3] * rs * gn[3] * silu_f(bfhi(og.y));
                u32x2 wv; wv.x = pk2(y0, y1); wv.y = pk2(y2, y3); *(u32x2*)(C.MRG + row * DM + 512 + h * 128 + v0) = wv; } }
    }
    __syncthreads();
}

DI void gla_scan(const Ctx& C, int gtid, int gthreads) {
    for (int idx = gtid; idx < 16 * 64 * 128; idx += gthreads) {
        const int v = idx & 127, k = (idx >> 7) & 63, bh = idx >> 13; float S = 0.f;
#pragma unroll 3
        for (int c = 0; c < NCH; ++c) { const size_t unit = (size_t)bh * NCH + c;
            C.SC[(unit * 64 + k) * 128 + v] = (bf16_t)(pk2(S, 0.f) & 0xffffu);
            S = __expf(C.GL[unit * 64 + k]) * S + C.DS[(unit * 64 + k) * 128 + v]; }
        const int h = bh & 3, b = bh >> 2;
        C.out[O_SP + ((size_t)((C.l * NBATCH + b) * 4 + h) * 64 + k) * 128 + v] = S;
    }
}

struct WSrc { int mat; const float* W; const float* W2; const float* gain; const float* wg2; };
DI float wsrc(const WSrc& s, int k, int n) {
    if (s.mat == 0) {
        if (n < 2304) { const int col = n < 1792 ? n : n + 16; const float sc = (n >= 768 && n < 1024) ? 0.125f : 1.0f; return s.W[(size_t)k * INW + col] * s.gain[k] * sc; }
        const int e = n - 2304; float a = 0.f;
#pragma unroll
        for (int r = 0; r < 16; ++r) a += s.W[(size_t)k * INW + 1792 + r] * s.wg2[r * 256 + e];
        return a * s.gain[k];
    } else if (s.mat == 1) { return s.W[(size_t)k * DM + n];
    } else if (s.mat == 2) { const int pn = n >> 8, j = n & 255; return (j < 128 ? s.W[(size_t)k * DFFN + 128 * pn + j] : s.W2[(size_t)k * DFFN + 128 * pn + j - 128]) * s.gain[k];
    } else { return s.W[(size_t)k * DM + n]; }
}
DI void conv_item(const WSrc& s, int K, int N, bf16_t* WT, LAS float* scr, int item, int lane) {
    const int nblk = N / 32, kb = item / nblk, nb = item % nblk, k0 = 64 * kb, n0 = 32 * nb;
#pragma unroll 8
    for (int i = 0; i < 32; ++i) { const int kk = 2 * i + (lane >> 5); scr[kk * 33 + (lane & 31)] = wsrc(s, k0 + kk, n0 + (lane & 31)); }
    asm volatile("s_waitcnt lgkmcnt(0)" ::: "memory");
    const int c = lane & 7;
#pragma unroll
    for (int j = 0; j < 4; ++j) { const int n = (lane >> 3) + 8 * j; const LAS float* sp = scr + (8 * c) * 33 + n;
        u32x4 o; o.x = pk2(sp[0 * 33], sp[1 * 33]); o.y = pk2(sp[2 * 33], sp[3 * 33]); o.z = pk2(sp[4 * 33], sp[5 * 33]); o.w = pk2(sp[6 * 33], sp[7 * 33]);
        *(u32x4*)(WT + (size_t)(n0 + n) * K + k0 + 8 * c) = o; }
    asm volatile("s_waitcnt lgkmcnt(0)" ::: "memory");
}
constexpr int NI_IN = 16 * 80, NI_O = 16 * 32, NI_GU = 16 * 176, NI_D = 44 * 32, NI_L = NI_IN + NI_O + NI_GU + NI_D;

DI void prologue(KA ap, const RowMap& rm, LAS unsigned char* lds, int tid, int vcu, int G) {
    const int lane = tid & 63, wave = tid >> 6, gw = vcu * 8 + wave, NGW = G * 8;
    LAS float* scr = (LAS float*)(lds + wave * 16384);
    for (int it = gw; it < DEPTH * NI_L; it += NGW) {
        const int l = it / NI_L; int r = it % NI_L;
        unsigned char* wl = ap->ws + WS_W + (size_t)l * SZ_WL;
        if (r < NI_IN) { WSrc s{0, ap->in[7] + (size_t)l * DM * INW, nullptr, ap->in[6] + l * DM, ap->in[11] + l * 16 * 256}; conv_item(s, DM, NIN, (bf16_t*)wl, scr, r, lane); continue; } r -= NI_IN;
        if (r < NI_O) { WSrc s{1, ap->in[14] + (size_t)l * DM * DM, nullptr, nullptr, nullptr}; conv_item(s, DM, DM, (bf16_t*)(wl + SZ_WIN), scr, r, lane); continue; } r -= NI_O;
        if (r < NI_GU) { WSrc s{2, ap->in[16] + (size_t)l * DM * DFFN, ap->in[17] + (size_t)l * DM * DFFN, ap->in[15] + l * DM, nullptr}; conv_item(s, DM, NGU, (bf16_t*)(wl + SZ_WIN + SZ_WO), scr, r, lane); continue; } r -= NI_GU;
        { WSrc s{3, ap->in[18] + (size_t)l * DFFN * DM, nullptr, nullptr, nullptr}; conv_item(s, DFFN, DM, (bf16_t*)(wl + SZ_WIN + SZ_WO + SZ_WGU), scr, r, lane); }
    }
    bf16_t* XB = (bf16_t*)(ap->ws + WS_XB); bf16_t* MRG = (bf16_t*)(ap->ws + WS_MRG); float* ssqA = (float*)(ap->ws + WS_SSQA);
    for (int m = gw; m < MP; m += NGW) {
        const float* ip = row_in(rm, m); f32x4 v[4]; float s = 0.f;
#pragma unroll
        for (int j = 0; j < 4; ++j) { v[j] = ip ? ((const f32x4*)ip)[lane + 64 * j] : (f32x4){0.f, 0.f, 0.f, 0.f}; s += (v[j][0] * v[j][0] + v[j][1] * v[j][1]) + (v[j][2] * v[j][2] + v[j][3] * v[j][3]); }
#pragma unroll
        for (int o = 1; o < 64; o <<= 1) s += __shfl_xor(s, o);
#pragma unroll
        for (int j = 0; j < 4; ++j) { u32x2 w; w.x = pk2(v[j][0], v[j][1]); w.y = pk2(v[j][2], v[j][3]); ((u32x2*)(XB + (size_t)m * DM))[lane + 64 * j] = w; if (!ip) ((u32x2*)(MRG + (size_t)m * DM))[lane + 64 * j] = (u32x2){0u, 0u}; }
        if (lane < 16) ssqA[(size_t)m * 16 + lane] = lane == 0 ? s : 0.f;
    }
}

#define XB_TMO      128
#define XB_XCNT(j)  (256  + 64 * (j))
#define XB_XSUB(j)  (1280 + 64 * (j))
#define XB_XGEN(j)  (2304 + 64 * (j))
#define XB_TOP      3328
#define XB_TOPGEN   3392
#define XCD_BAR_WORDS 3456
#define XB_SPIN_CAP (1u << 18)

__device__ __forceinline__ unsigned xb_ld(unsigned* p)              { return __hip_atomic_load(p, __ATOMIC_RELAXED, __HIP_MEMORY_SCOPE_AGENT); }
__device__ __forceinline__ unsigned xb_add(unsigned* p, unsigned v) { return __hip_atomic_fetch_add(p, v, __ATOMIC_RELAXED, __HIP_MEMORY_SCOPE_AGENT); }
__device__ __forceinline__ unsigned xb_xcc_id() { return (unsigned)__builtin_amdgcn_s_getreg((3 << 11) | 20) & 0xFu; }
#define XB_SPIN(cond, bar) do { unsigned _sp = 0; while (cond) { __builtin_amdgcn_s_sleep(1); \
    if ((++_sp & 255u) == 0u) { if (xb_ld(&(bar)[XB_TMO])) break; if (_sp > XB_SPIN_CAP) { atomicAdd(&(bar)[XB_TMO], 1u); break; } } } } while (0)

struct XcdBarrier {
    unsigned* bar; unsigned x;
    volatile LAS unsigned* st;
};

__device__ __forceinline__ XcdBarrier xcd_barrier_post(unsigned* bar, volatile LAS unsigned* st, const bool t0) {
    XcdBarrier b; b.bar = bar; b.x = xb_xcc_id(); b.st = st;
    if (t0) (void)xb_add(&bar[XB_XCNT(b.x)], 1u);
    return b;
}
__device__ __forceinline__ void xcd_barrier_complete(unsigned* bar, unsigned x, unsigned& nloc, unsigned& nx) {
    const unsigned G = gridDim.x * gridDim.y * gridDim.z;
    unsigned sum, cnt, mine, sp = 0u;
    for (;;) {
        sum = 0u; cnt = 0u; mine = 0u;
#pragma unroll
        for (unsigned j = 0; j < 16; ++j) { const unsigned c = xb_ld(&bar[XB_XCNT(j)]); sum += c; cnt += (c > 0u) ? 1u : 0u; mine = (j == x) ? c : mine; }
        if (sum == G) break;
        __builtin_amdgcn_s_sleep(1);
        if ((++sp & 255u) == 0u) { if (xb_ld(&bar[XB_TMO])) break; if (sp > XB_SPIN_CAP) { atomicAdd(&bar[XB_TMO], 1u); break; } }
    }
    nloc = mine > 0u ? mine : 1u; nx = cnt > 0u ? cnt : 1u;
}

__device__ __forceinline__ void xcd_barrier(const XcdBarrier& b, const bool t0) {
    asm volatile("s_waitcnt vmcnt(0)" ::: "memory");
    __syncthreads();
    if (t0) {
        unsigned* bar = b.bar;
        __builtin_amdgcn_s_waitcnt(0);
        unsigned nloc = b.st[0], nx = b.st[1];
        if (nloc == 0u) { xcd_barrier_complete(bar, b.x, nloc, nx); b.st[0] = nloc; b.st[1] = nx; }
        const unsigned old = xb_add(&bar[XB_XSUB(b.x)], 1u);
        const unsigned gen = old / nloc;
        if (old + 1u == (gen + 1u) * nloc) {
            __builtin_amdgcn_fence(__ATOMIC_RELEASE, "agent");
            asm volatile("s_waitcnt vmcnt(0)" ::: "memory");
            const unsigned og = xb_add(&bar[XB_TOP], 1u);
            const unsigned tg = og / nx;
            if (og + 1u == (tg + 1u) * nx) xb_add(&bar[XB_TOPGEN], 1u);
            else XB_SPIN(xb_ld(&bar[XB_TOPGEN]) == tg, bar);
            __builtin_amdgcn_fence(__ATOMIC_ACQUIRE, "agent");
            xb_add(&bar[XB_XGEN(b.x)], 1u);
            asm volatile("s_waitcnt vmcnt(0)" ::: "memory");
        } else {
            XB_SPIN(xb_ld(&bar[XB_XGEN(b.x)]) == gen, bar);
            __builtin_amdgcn_fence(__ATOMIC_ACQUIRE, "agent");
            asm volatile("s_waitcnt vmcnt(0)" ::: "memory");
        }
    }
    __syncthreads();
}

template <class T> DI T* opq(T* p) { asm volatile("" : "+s"(p)); return p; }
DI Ctx make_ctx(int l) {
    KA ap = ka_ptr(); unsigned char* ws = ap->ws;
    Ctx C; C.l = l; C.Z = (const bf16_t*)(ws + WS_Z); C.LD = (float*)(ws + WS_LD); C.MRG = (bf16_t*)(ws + WS_MRG); C.DS = (float*)(ws + WS_DS); C.SC = (bf16_t*)(ws + WS_SC); C.GL = (float*)(ws + WS_GL);
    C.qnw = ap->in[8] + l * 64; C.knw = ap->in[9] + l * 64; C.sinks = ap->in[10] + l * 8; C.gnw = ap->in[13] + l * 128;
    C.cache_k = ap->in[2]; C.cache_v = ap->in[3]; C.state = ap->in[4]; C.out = ap->out;
    return C;
}
DI RowMap make_rm() { KA ap = ka_ptr(); float* out = ap->out; unsigned char* ws = ap->ws; return RowMap{ap->in[0], ap->in[1], ap->in[5], out + O_YP, out + O_YS, (float*)(ws + WS_XMETA)}; }

__global__ void __launch_bounds__(512, 2) hymba_fwd(Args a) {
    extern __shared__ __attribute__((aligned(16))) unsigned char lds_raw[];
    LAS unsigned char* lds = (LAS unsigned char*)lds_raw;
    const int G = gridDim.x, bx = blockIdx.x; const int wave_s = __builtin_amdgcn_readfirstlane((int)threadIdx.x >> 6);
#define opaque_tid() mk_tid(wave_s)
    const int vcu = (G % 8 == 0) ? (bx % 8) * (G / 8) + bx / 8 : bx;
    const int lo = ka_ptr()->ph_lo, hi = ka_ptr()->ph_hi;
#define IN(k) (lo <= (k) && (k) < hi)
#ifndef FAST_BAR
#define FAST_BAR 1
#endif
    volatile LAS unsigned* MISC = (volatile LAS unsigned*)(lds + 131072 + 320);
    { const int t = opaque_tid(); if (t < 64) MISC[t] = 0u; __syncthreads(); }
    XcdBarrier bar = xcd_barrier_post((unsigned*)ka_ptr()->ws, MISC + 8, opaque_tid() == 0);
#define GSYNC() do { if (FAST_BAR) xcd_barrier(bar, opaque_tid() == 0); else cg::this_grid().sync(); } while (0)
#define SEAM(k) do { if (IN(k) && IN((k) + 1)) { if ((k) == 0) cg::this_grid().sync(); else GSYNC(); } } while (0)
    if (IN(0)) { for (int rep = 0; rep < REP_PRO; ++rep) { const RowMap rm = make_rm(); prologue(ka_ptr(), rm, lds, opaque_tid(), vcu, G); if (rep + 1 < REP_PRO) GSYNC(); }
        for (int xs = 0; xs < XSYNC; ++xs) GSYNC(); }
    SEAM(0);
#pragma unroll 1
    for (int l = 0; l < DEPTH; ++l) {
        const int pb = 1 + 7 * l;
        if (IN(pb + 0)) for (int rep = 0; rep < REP_WIN; ++rep) {
            if (rep) GSYNC();
            KA ap = ka_ptr(); unsigned char* ws = ap->ws; unsigned char* wl = ws + WS_W + (size_t)l * SZ_WL;
            pg8::Gemm g{(const bf16_t*)(ws + WS_XB), (const bf16_t*)wl, MP, NIN, DM}; pg8::StaticOrder S; S.init(MP, NIN, G, bx);
            pg8::EpiIn E{(bf16_t*)(ws + WS_Z), (float*)(ws + WS_LD), (const float*)(ws + WS_SSQA), ap->in[12] + l * 256};
            pg8::gemm_phase<pg8::EpiIn, pg8::StaticOrder, true, true>(lds, g, S, E, opaque_tid());
        }
        SEAM(pb + 0);
        if (IN(pb + 1)) {
            const Ctx C = make_ctx(l);
            constexpr int N1 = 16 * NCH, N2 = DECB, N3 = DECB * 4;
#pragma unroll 1
            for (int u = vcu; u < N1 + N2 + N3; u += G) {
                if (u < N1) { for (int r = 0; r < REP_G1; ++r) gla1_unit(C, u, lds, wave_s); } else if (u < N1 + N2) { for (int r = 0; r < REP_AS; ++r) attn_sample_unit(C, u - N1, lds, wave_s); } else { for (int r = 0; r < REP_GS; ++r) gla_sample_unit(C, u - N1 - N2, lds, wave_s); }
            }
        }
        SEAM(pb + 1);
        if (IN(pb + 2)) for (int rep = 0; rep < REP_SCAN; ++rep) { if (rep) GSYNC(); const Ctx C = make_ctx(l); gla_scan(C, bx * 512 + opaque_tid(), G * 512); }
        SEAM(pb + 2);
        if (IN(pb + 3)) for (int rep = 0; rep < REP_MB; ++rep) {   if (rep) GSYNC();
            const Ctx C = make_ctx(l);
            constexpr int N1 = 16 * NCH, N2 = NBATCH * 2 * 65;
#pragma unroll 1
            for (int u = vcu; u < N1 + N2; u += G) { if (u < N1) { for (int r = 0; r < REP_G3; ++r) gla3_unit(C, u, lds, wave_s); } else { for (int r = 0; r < REP_AP; ++r) attn_prompt_unit(C, u - N1, lds, wave_s); } }
        }
        SEAM(pb + 3);
        if (IN(pb + 4)) for (int rep = 0; rep < (l == 0 ? REP_WO0 : 1); ++rep) {
            if (rep) GSYNC();
            KA ap = ka_ptr(); unsigned char* ws = ap->ws; unsigned char* wl = ws + WS_W + (size_t)l * SZ_WL;
            pg8::Gemm g{(const bf16_t*)(ws + WS_MRG), (const bf16_t*)(wl + SZ_WIN), MP, DM, DM}; pg8::StaticOrder S; S.init(MP, DM, G, bx);
            pg8::EpiRes E{make_rm(), l == 0 ? 1 : 0, (bf16_t*)(ws + WS_XB), (float*)(ws + WS_SSQB)};
            pg8::gemm_phase<pg8::EpiRes, pg8::StaticOrder, true, true>(lds, g, S, E, opaque_tid());
        }
        SEAM(pb + 4);
        if (IN(pb + 5)) for (int rep = 0; rep < REP_GU; ++rep) {
            if (rep) GSYNC();
            KA ap = ka_ptr(); unsigned char* ws = ap->ws; unsigned char* wl = ws + WS_W + (size_t)l * SZ_WL;
            pg8::Gemm g{(const bf16_t*)(ws + WS_XB), (const bf16_t*)(wl + SZ_WIN + SZ_WO), MP, NGU, DM}; pg8::StaticOrder S; S.init(MP, NGU, G, bx);
            pg8::EpiGU E{(bf16_t*)(ws + WS_U), (const float*)(ws + WS_SSQB)};
            pg8::gemm_phase<pg8::EpiGU, pg8::StaticOrder, true, true>(lds, g, S, E, opaque_tid());
        }
        SEAM(pb + 5);
        if (IN(pb + 6)) {
            KA ap = ka_ptr(); unsigned char* ws = ap->ws; unsigned char* wl = ws + WS_W + (size_t)l * SZ_WL;
            pg8::Gemm g{(const bf16_t*)(ws + WS_U), (const bf16_t*)(wl + SZ_WIN + SZ_WO + SZ_WGU), MP, DM, DFFN}; pg8::StaticOrder S; S.init(MP, DM, G, bx);
            pg8::EpiRes E{make_rm(), 0, (bf16_t*)(ws + WS_XB), (float*)(ws + WS_SSQA)};
            pg8::gemm_phase<pg8::EpiRes, pg8::StaticOrder, true, true>(lds, g, S, E, opaque_tid());
        }
        if (l + 1 < DEPTH) SEAM(pb + 6);
    }
#undef IN
#undef SEAM
#undef GSYNC
#undef opaque_tid
}

#ifndef N_LAUNCH_MODE
#define N_LAUNCH_MODE 0
#endif
extern "C" void kernel_launch(void* const* d_in, const int* in_sizes, int n_in, void* d_out, int out_size, void* d_ws, size_t ws_size, hipStream_t stream) {
    static int grid = 0;
    if (grid == 0) {
        if (n_in != 19 || out_size != (int)O_END || ws_size < WS_END) { fprintf(stderr, "kernel_launch: unexpected shapes: n_in %d out %d ws %zu (need %zu)\n", n_in, out_size, ws_size, (size_t)WS_END); grid = -1; return; }
        int dev = 0, cus = 0, per_cu = 0;
        (void)hipGetDevice(&dev); (void)hipDeviceGetAttribute(&cus, hipDeviceAttributeMultiprocessorCount, dev);
        if (hipFuncSetAttribute((const void*)hymba_fwd, hipFuncAttributeMaxDynamicSharedMemorySize, LDS_BYTES) != hipSuccess) { fprintf(stderr, "kernel_launch: hipFuncSetAttribute failed\n"); grid = -1; return; }
        if (hipOccupancyMaxActiveBlocksPerMultiprocessor(&per_cu, (const void*)hymba_fwd, 512, LDS_BYTES) != hipSuccess || per_cu < 1) { fprintf(stderr, "kernel_launch: occupancy query says %d\n", per_cu); per_cu = 1; }
        (void)hipGetLastError();
        grid = cus > 0 ? cus : 256;
    }
    if (grid < 0) return;
    if (hipMemsetAsync(d_ws, 0, 16384, stream) != hipSuccess) { fprintf(stderr, "kernel_launch: memset failed\n"); return; }
    Args a{};
    for (int i = 0; i < 19; ++i) a.in[i] = (const float*)d_in[i];
    a.out = (float*)d_out; a.ws = (unsigned char*)d_ws;
#if N_LAUNCH_MODE == 1
    for (int p = 0; p < NPHASE; ++p) { a.ph_lo = p; a.ph_hi = p + 1; hipLaunchKernelGGL(hymba_fwd, dim3(grid), dim3(512), LDS_BYTES, stream, a); }
#else
    a.ph_lo = 0; a.ph_hi = NPHASE;
    void* args[] = {&a};
    hipError_t e = hipLaunchCooperativeKernel((const void*)hymba_fwd, dim3(grid), dim3(512), args, LDS_BYTES, stream);
    if (e != hipSuccess) fprintf(stderr, "cooperative launch failed: %s (grid %d)\n", hipGetErrorString(e), grid);
#endif
}
```

```cpp
#include <hip/hip_runtime.h>
#include <hip/hip_cooperative_groups.h>
#include <cstdio>
#include <cstdint>
namespace cg = cooperative_groups;

#define DI __device__ __forceinline__
#define LAS __attribute__((address_space(3)))
typedef unsigned short bf16_t;
typedef short bf16x8 __attribute__((ext_vector_type(8)));
typedef float f32x4 __attribute__((ext_vector_type(4)));
typedef float f32x2 __attribute__((ext_vector_type(2)));
typedef unsigned u32x4 __attribute__((ext_vector_type(4)));
typedef unsigned u32x2 __attribute__((ext_vector_type(2)));
typedef __bf16 bf16x2_t __attribute__((ext_vector_type(2)));

constexpr int DM = 1024, NBATCH = 4, SEQ = 4096, LP = 4112  , DEPTH = 2, DECB = 128, DECT = 8;
constexpr int MPROMPT = NBATCH * LP, MREAL = MPROMPT + DECB * DECT, MP = 17664  ;
constexpr int INW = 2320, ZP = 2304, NIN = 2560, DFFN = 2816, NGU = 5632;
constexpr int ZQ = 0, ZK = 512, ZV = 640, ZGQ = 768, ZGK = 1024, ZGV = 1280, ZOG = 1792;
constexpr int NCH = 33;
constexpr float EPS = 1e-6f, LOG2E = 1.4426950408889634f;
constexpr size_t O_YP = 0, O_YS = 16777216, O_CKP = 17825792, O_CVP = 17956864, O_SP = 18087936, O_CKS = 18350080, O_CVS = 22544384, O_SS = 26738688, O_END = 35127296;

DI unsigned pk2(float lo, float hi) { f32x2 v = {lo, hi}; bf16x2_t b = __builtin_convertvector(v, bf16x2_t); return __builtin_bit_cast(unsigned, b); }
DI float bflo(unsigned w) { return __uint_as_float(w << 16); }
DI float bfhi(unsigned w) { return __uint_as_float(w & 0xffff0000u); }
DI float bf2f(bf16_t h) { return __uint_as_float((unsigned)h << 16); }
DI void unpack8(const u32x4 w, float* f) { f[0] = bflo(w.x); f[1] = bfhi(w.x); f[2] = bflo(w.y); f[3] = bfhi(w.y); f[4] = bflo(w.z); f[5] = bfhi(w.z); f[6] = bflo(w.w); f[7] = bfhi(w.w); }
DI float silu_f(float x) { return x * __builtin_amdgcn_rcpf(1.0f + __expf(-x)); }

struct RowMap { const float* xp; const float* xs; const float* meta; float* yp; float* ys; float* xmeta; };
DI const float* row_in(const RowMap& rm, int row) {
    if (row < MPROMPT) { const int b = row / LP, p = row - b * LP; return p < 16 ? rm.meta + (size_t)p * DM : rm.xp + ((size_t)b * SEQ + (p - 16)) * DM; }
    if (row < MREAL) return rm.xs + (size_t)(row - MPROMPT) * DM;
    return nullptr;
}
DI float* row_out(const RowMap& rm, int row) {
    if (row < MPROMPT) { const int b = row / LP, p = row - b * LP; return p < 16 ? nullptr : rm.yp + ((size_t)b * SEQ + (p - 16)) * DM; }
    if (row < MREAL) return rm.ys + (size_t)(row - MPROMPT) * DM;
    return nullptr;
}
namespace pg8 {
#define PG8_LAS __attribute__((address_space(3)))
typedef unsigned short bf16_t;
typedef short bf16x8 __attribute__((ext_vector_type(8)));
typedef float f32x4 __attribute__((ext_vector_type(4)));
typedef unsigned u32x4 __attribute__((ext_vector_type(4)));
constexpr int BM = 256, BK = 64, HALF = 128, HTB = HALF * BK * 2  , STAGE_BYTES = 8 * HTB, NXCD = 8, WGM = 8;

__host__ __device__ __forceinline__ int lds_byte(int r, int c) { const int st = (r >> 4) * 2 + (c >> 5), rr = r & 15, cc = c & 31, ob = rr * 64 + cc * 2; return st * 1024 + (ob ^ (((ob >> 9) & 1) << 5)); }
__host__ __device__ __forceinline__ void stage_rc(int b, int& R, int& C) { const int st = b / 1024, sb = b % 1024, swz = sb ^ (((sb >> 9) & 1) << 5); R = (st >> 1) * 16 + swz / 64; C = (st & 1) * 32 + (swz % 64) / 2; }
__host__ __device__ __forceinline__ int perm32(int rho) { const int n = rho >> 4, i = rho & 15; return 8 * (i >> 2) + 4 * n + (i & 3); }

struct Unit { int pm, pn; };
struct Gemm { const bf16_t* A; const bf16_t* Bt; int M, N, K; };

struct StaticOrder {
    int nM, nN, nwg, G, c;
    __host__ __device__ void init(int M, int N, int G_, int c_) { nM = M / BM; nN = N / BM; nwg = nM * nN; G = G_; c = c_; }
    __host__ __device__ bool next(int i, Unit& u) const {
        const long L = (long)i * G + c; if (L >= nwg) return false;
        int wgid = (int)L; { const int q = nwg / NXCD, r = nwg % NXCD, xcd = wgid % NXCD, off = wgid / NXCD; wgid = (xcd < r ? xcd * (q + 1) : r * (q + 1) + (xcd - r) * q) + off; }
        const int nig = WGM * nN, gid = wgid / nig, fm = gid * WGM, gsz = (nM - fm) < WGM ? (nM - fm) : WGM;
        u.pm = fm + ((wgid % nig) % gsz); u.pn = (wgid % nig) / gsz; return true;
    }
    __device__ __forceinline__ void a_ready(const Unit&) const {}
    __device__ __forceinline__ void done(const Unit&) const {}
};


DI float rstd_from_slots(const float* ssq, int row) {
    const f32x4* p = (const f32x4*)(ssq + (size_t)row * 16);
    const f32x4 a = p[0], b = p[1], c = p[2], d = p[3];
    const float s = ((a[0] + a[1]) + (a[2] + a[3])) + ((b[0] + b[1]) + (b[2] + b[3])) + ((c[0] + c[1]) + (c[2] + c[3])) + ((d[0] + d[1]) + (d[2] + d[3]));
    return rsqrtf(s * (1.0f / 1024.0f) + EPS);
}
DI void rstd8(const float* ssq, int row0, float (&rs)[2][4]) {
#pragma unroll
    for (int ai = 0; ai < 2; ++ai) {
        f32x4 t[4][4];
#pragma unroll
        for (int m = 0; m < 4; ++m) { const f32x4* p = (const f32x4*)(ssq + (size_t)(row0 + ai * HALF + m * 16) * 16); t[m][0] = p[0]; t[m][1] = p[1]; t[m][2] = p[2]; t[m][3] = p[3]; }
#pragma unroll
        for (int m = 0; m < 4; ++m) { const f32x4 q = (t[m][0] + t[m][1]) + (t[m][2] + t[m][3]); rs[ai][m] = rsqrtf(((q[0] + q[1]) + (q[2] + q[3])) * (1.0f / 1024.0f) + EPS); }
        asm volatile("" ::: "memory");
    }
}
struct EpiIn {
    static constexpr bool PERM = true, AFTER_DRAIN = false;
    bf16_t* Z; float* LD; const float* ssq; const float* bg;
    __device__ __forceinline__ void operator()(const f32x4 (&acc)[2][2][4][2], const Unit& u, int wr, int wc, int fr, int fq) const {
        const int row0 = u.pm * BM + wr * 64 + fr;
        float rs[2][4]; rstd8(ssq, row0, rs);
        if (u.pn < 9) {
#pragma unroll
            for (int ai = 0; ai < 2; ++ai)
#pragma unroll
                for (int m = 0; m < 4; ++m) { const int row = row0 + ai * HALF + m * 16; const float r = rs[ai][m];
                    bf16_t* rowp = Z + (size_t)row * ZP + u.pn * BM + wc * 32 + 8 * fq;
#pragma unroll
                    for (int bj = 0; bj < 2; ++bj) { const f32x4 v0 = acc[ai][bj][m][0] * r, v1 = acc[ai][bj][m][1] * r;
                        u32x4 w; w.x = pk2(v0[0], v0[1]); w.y = pk2(v0[2], v0[3]); w.z = pk2(v1[0], v1[1]); w.w = pk2(v1[2], v1[3]);
                        *(u32x4*)(rowp + bj * HALF) = w; } }
        } else {
            const int e0 = wc * 32 + 8 * fq;
#pragma unroll
            for (int bj = 0; bj < 2; ++bj) { const f32x4 b0 = *(const f32x4*)(bg + e0 + bj * HALF), b1 = *(const f32x4*)(bg + e0 + bj * HALF + 4);
#pragma unroll
                for (int ai = 0; ai < 2; ++ai)
#pragma unroll
                    for (int m = 0; m < 4; ++m) { const int row = row0 + ai * HALF + m * 16; const float r = rs[ai][m];
                        const f32x4 x0 = acc[ai][bj][m][0] * r + b0, x1 = acc[ai][bj][m][1] * r + b1; f32x4 o0, o1;
#pragma unroll
                        for (int i = 0; i < 4; ++i) { o0[i] = (fminf(x0[i], 0.f) - __logf(1.0f + __expf(-fabsf(x0[i])))) * 0.0625f; o1[i] = (fminf(x1[i], 0.f) - __logf(1.0f + __expf(-fabsf(x1[i])))) * 0.0625f; }
                        float* lp = LD + (size_t)row * 256 + e0 + bj * HALF; *(f32x4*)lp = o0; *(f32x4*)(lp + 4) = o1; } }
        }
    }
};
struct EpiRes {
    static constexpr bool PERM = true, AFTER_DRAIN = false;
    RowMap rm; int final_; bf16_t* XB; float* ssq;
    __device__ __forceinline__ void operator()(const f32x4 (&acc)[2][2][4][2], const Unit& u, int wr, int wc, int fr, int fq) const {
        const int row0 = u.pm * BM + wr * 64 + fr, col0 = u.pn * BM + wc * 32 + 8 * fq;
#pragma unroll
        for (int ai = 0; ai < 2; ++ai) {
            u32x4 res[4][2];
#pragma unroll
            for (int m = 0; m < 4; ++m) { const int row = row0 + ai * HALF + m * 16;
#pragma unroll
                for (int bj = 0; bj < 2; ++bj) res[m][bj] = *(const u32x4*)(XB + (size_t)row * DM + col0 + bj * HALF); }
#pragma unroll
            for (int m = 0; m < 4; ++m) { const int row = row0 + ai * HALF + m * 16; float ss = 0.f; float* op = final_ ? row_out(rm, row) : nullptr;
#pragma unroll
                for (int bj = 0; bj < 2; ++bj) { const int col = col0 + bj * HALF; float r[8]; unpack8(res[m][bj], r);
                    const f32x4 v0 = acc[ai][bj][m][0] + (f32x4){r[0], r[1], r[2], r[3]}, v1 = acc[ai][bj][m][1] + (f32x4){r[4], r[5], r[6], r[7]};
                    if (final_) { if (op) { *(f32x4*)(op + col) = v0; *(f32x4*)(op + col + 4) = v1; } }
                    else { u32x4 w; w.x = pk2(v0[0], v0[1]); w.y = pk2(v0[2], v0[3]); w.z = pk2(v1[0], v1[1]); w.w = pk2(v1[2], v1[3]);
                        *(u32x4*)(XB + (size_t)row * DM + col) = w;
                        const f32x4 q0 = {bflo(w.x), bfhi(w.x), bflo(w.y), bfhi(w.y)}, q1 = {bflo(w.z), bfhi(w.z), bflo(w.w), bfhi(w.w)};
                        ss += (q0[0] * q0[0] + q0[1] * q0[1]) + (q0[2] * q0[2] + q0[3] * q0[3]) + (q1[0] * q1[0] + q1[1] * q1[1]) + (q1[2] * q1[2] + q1[3] * q1[3]); } }
                if (!final_) { ss += __shfl_xor(ss, 16); ss += __shfl_xor(ss, 32); if (fq == 0) ssq[(size_t)row * 16 + u.pn * 4 + wc] = ss; } }
            asm volatile("" ::: "memory");
        }
    }
};
struct EpiGU {
    static constexpr bool PERM = true, AFTER_DRAIN = false;
    bf16_t* U; const float* ssq;
    __device__ __forceinline__ void operator()(const f32x4 (&acc)[2][2][4][2], const Unit& u, int wr, int wc, int fr, int fq) const {
        const int row0 = u.pm * BM + wr * 64 + fr, f0 = u.pn * HALF + wc * 32 + 8 * fq;
        float rs[2][4]; rstd8(ssq, row0, rs);
#pragma unroll
        for (int ai = 0; ai < 2; ++ai)
#pragma unroll
            for (int m = 0; m < 4; ++m) { const int row = row0 + ai * HALF + m * 16; const float r = rs[ai][m];
                float o[8];
#pragma unroll
                for (int n = 0; n < 2; ++n)
#pragma unroll
                    for (int i = 0; i < 4; ++i) { const float g = acc[ai][0][m][n][i] * r, up = acc[ai][1][m][n][i] * r; o[4 * n + i] = silu_f(g) * up; }
                u32x4 w; w.x = pk2(o[0], o[1]); w.y = pk2(o[2], o[3]); w.z = pk2(o[4], o[5]); w.w = pk2(o[6], o[7]);
                *(u32x4*)(U + (size_t)row * DFFN + f0) = w; }
    }
};
template <class Epi, class Sched, bool ALIGN_EPI = false, bool SP2 = false>
__device__ __forceinline__ void gemm_phase(PG8_LAS unsigned char* lds, const Gemm g, const Sched& S, const Epi& E, const int tid_in) {
    const int tid = tid_in, wid = __builtin_amdgcn_readfirstlane(tid >> 6), lane = tid & 63, wr = wid >> 2, wc = wid & 3, fr = lane & 15, fq = lane >> 4;
    const int K = g.K, nt = K / BK;
    unsigned voffA[2], voffB[2];
#pragma unroll
    for (int i = 0; i < 2; ++i) { int R, C; stage_rc(tid * 16 + i * 8192, R, C); const int Rb = Epi::PERM ? ((R & ~31) + perm32(R & 31)) : R;
        voffA[i] = (unsigned)(R * K + C) * 2u; voffB[i] = (unsigned)(Rb * K + C) * 2u; }
    const size_t kstep = (size_t)(BK * 2);
    const size_t hstep = (size_t)HALF * K * 2;
    const size_t tstep = 2 * hstep;
    const unsigned ldsw = (unsigned)wid * 1024u;
    const int aoff = lds_byte(wr * 64 + fr, fq * 8), boff = lds_byte(wc * 32 + fr, fq * 8);
#define PG8_SA(b, h) (((b) * 2 + (h)) * HTB)
#define PG8_SB(b, h) ((4 + (b) * 2 + (h)) * HTB)
#define PG8_STAGE(bufoff, gbase, voff) do { _Pragma("unroll") for (int _i = 0; _i < 2; ++_i) \
        __builtin_amdgcn_global_load_lds((const unsigned*)((const char*)(gbase) + (voff)[_i]), (PG8_LAS unsigned*)(lds + (bufoff) + ldsw + _i * 8192), 16, 0, 0); } while (0)
#define PG8_LDA(dst, b, h) do { _Pragma("unroll") for (int m = 0; m < 4; ++m) _Pragma("unroll") for (int k = 0; k < 2; ++k) dst[m][k] = *(const PG8_LAS bf16x8*)(lds + PG8_SA(b, h) + aoff + m * 2048 + k * 1024); } while (0)
#define PG8_LDB(dst, b, h) do { _Pragma("unroll") for (int n = 0; n < 2; ++n) _Pragma("unroll") for (int k = 0; k < 2; ++k) dst[n][k] = *(const PG8_LAS bf16x8*)(lds + PG8_SB(b, h) + boff + n * 2048 + k * 1024); } while (0)
#define PG8_MMA(ai, bj, At, Bt) do { __builtin_amdgcn_s_setprio(1); _Pragma("unroll") for (int m = 0; m < 4; ++m) _Pragma("unroll") for (int n = 0; n < 2; ++n) _Pragma("unroll") for (int k = 0; k < 2; ++k) \
        acc[ai][bj][m][n] = __builtin_amdgcn_mfma_f32_16x16x32_bf16(Bt[n][k], At[m][k], acc[ai][bj][m][n], 0, 0, 0); __builtin_amdgcn_s_setprio(0); } while (0)
#define PG8_WAIT_V(n) asm volatile("s_waitcnt vmcnt(" #n ")" ::: "memory")
#define PG8_WAIT_L(n) asm volatile("s_waitcnt lgkmcnt(" #n ")" ::: "memory")
#define PG8_BAR __builtin_amdgcn_s_barrier()
#define PG8_SCHED __builtin_amdgcn_sched_barrier(0)
    Unit cur, nxt; int ui = 0;
    if (!S.next(0, cur)) return;
    f32x4 acc[2][2][4][2];
#pragma unroll
    for (int a = 0; a < 2; ++a)
#pragma unroll
        for (int b = 0; b < 2; ++b)
#pragma unroll
            for (int m = 0; m < 4; ++m)
#pragma unroll
                for (int n = 0; n < 2; ++n) acc[a][b][m][n] = (f32x4){0.f, 0.f, 0.f, 0.f};
    bf16x8 At[4][2], B0[2][2], B1[2][2];
    const char* cA = (const char*)g.A + (size_t)cur.pm * tstep; const char* cB = (const char*)g.Bt + (size_t)cur.pn * tstep;
    S.a_ready(cur);
    if constexpr (SP2) {
        PG8_STAGE(PG8_SB(0, 0), cB, voffB); PG8_STAGE(PG8_SB(0, 1), cB + hstep, voffB); PG8_STAGE(PG8_SA(0, 0), cA, voffA); PG8_STAGE(PG8_SA(0, 1), cA + hstep, voffA);
        if (wr == 1) PG8_BAR;
        PG8_WAIT_V(2); PG8_BAR;
        PG8_STAGE(PG8_SB(1, 0), cB + kstep, voffB); PG8_STAGE(PG8_SA(1, 0), cA + kstep, voffA); PG8_STAGE(PG8_SB(1, 1), cB + hstep + kstep, voffB);
        PG8_WAIT_V(6); PG8_BAR;
    } else {
        PG8_STAGE(PG8_SB(0, 0), cB, voffB); PG8_STAGE(PG8_SA(0, 0), cA, voffA); PG8_STAGE(PG8_SB(0, 1), cB + hstep, voffB); PG8_STAGE(PG8_SA(0, 1), cA + hstep, voffA);
        if (wr == 1) PG8_BAR;
        PG8_WAIT_V(4); PG8_BAR;
        PG8_STAGE(PG8_SB(1, 0), cB + kstep, voffB); PG8_STAGE(PG8_SA(1, 0), cA + kstep, voffA); PG8_STAGE(PG8_SB(1, 1), cB + hstep + kstep, voffB);
        PG8_WAIT_V(6); PG8_BAR;
    }
    for (;;) {
        const bool has_next = S.next(ui + 1, nxt);
        const char* nA = has_next ? (const char*)g.A + (size_t)nxt.pm * tstep : cA; const char* nB = has_next ? (const char*)g.Bt + (size_t)nxt.pn * tstep : cB;
        for (int t = 0; t < nt; t += 2) {
            const bool last = (t == nt - 2);
            const char* a1 = cA + (size_t)(t + 1) * kstep;
            const char* a2 = last ? nA : cA + (size_t)(t + 2) * kstep; const char* b2 = last ? nB : cB + (size_t)(t + 2) * kstep;
            const char* a3 = a2 + kstep; const char* b3 = b2 + kstep;
            if (last && has_next) S.a_ready(nxt);
            if constexpr (SP2) {
            PG8_LDB(B0, 0, 0); PG8_LDB(B1, 0, 1); PG8_SCHED; PG8_LDA(At, 0, 0); PG8_STAGE(PG8_SA(1, 1), a1 + hstep, voffA);
            PG8_WAIT_V(8); PG8_WAIT_L(0); PG8_BAR; PG8_MMA(0, 0, At, B0); PG8_MMA(0, 1, At, B1); PG8_BAR; PG8_SCHED;
            PG8_LDA(At, 0, 1); PG8_STAGE(PG8_SB(0, 0), b2, voffB); PG8_STAGE(PG8_SB(0, 1), b2 + hstep, voffB); PG8_STAGE(PG8_SA(0, 0), a2, voffA);
            PG8_WAIT_V(8); PG8_WAIT_L(0); PG8_BAR; PG8_MMA(1, 0, At, B0); PG8_MMA(1, 1, At, B1); PG8_BAR; PG8_SCHED;
            PG8_LDB(B0, 1, 0); PG8_LDB(B1, 1, 1); PG8_SCHED; PG8_LDA(At, 1, 0); PG8_STAGE(PG8_SA(0, 1), a2 + hstep, voffA);
            PG8_WAIT_V(8); PG8_WAIT_L(0); PG8_BAR; PG8_MMA(0, 0, At, B0); PG8_MMA(0, 1, At, B1); PG8_BAR; PG8_SCHED;
            PG8_LDA(At, 1, 1); PG8_STAGE(PG8_SB(1, 0), b3, voffB); PG8_STAGE(PG8_SB(1, 1), b3 + hstep, voffB); PG8_STAGE(PG8_SA(1, 0), a3, voffA);
            PG8_WAIT_V(8); PG8_WAIT_L(0); PG8_BAR; PG8_MMA(1, 0, At, B0); PG8_MMA(1, 1, At, B1); PG8_BAR; PG8_SCHED;
            } else {
            PG8_LDB(B0, 0, 0); PG8_SCHED; PG8_LDA(At, 0, 0); PG8_STAGE(PG8_SA(1, 1), a1 + hstep, voffA);
            PG8_WAIT_L(8); PG8_BAR; PG8_WAIT_L(0); PG8_MMA(0, 0, At, B0); PG8_BAR; PG8_SCHED;
            PG8_LDB(B1, 0, 1); PG8_STAGE(PG8_SB(0, 0), b2, voffB);
            PG8_BAR; PG8_WAIT_L(0); PG8_MMA(0, 1, At, B1); PG8_BAR;
            PG8_LDA(At, 0, 1); PG8_STAGE(PG8_SA(0, 0), a2, voffA);
            PG8_BAR; PG8_WAIT_L(0); PG8_MMA(1, 0, At, B0); PG8_BAR; PG8_SCHED;
            PG8_STAGE(PG8_SB(0, 1), b2 + hstep, voffB);
            PG8_WAIT_V(6); PG8_BAR; PG8_MMA(1, 1, At, B1); PG8_BAR;
            PG8_LDB(B0, 1, 0); PG8_SCHED; PG8_LDA(At, 1, 0); PG8_STAGE(PG8_SA(0, 1), a2 + hstep, voffA);
            PG8_WAIT_L(8); PG8_BAR; PG8_WAIT_L(0); PG8_MMA(0, 0, At, B0); PG8_BAR; PG8_SCHED;
            PG8_LDB(B1, 1, 1); PG8_STAGE(PG8_SB(1, 0), b3, voffB);
            PG8_BAR; PG8_WAIT_L(0); PG8_MMA(0, 1, At, B1); PG8_BAR;
            PG8_LDA(At, 1, 1); PG8_STAGE(PG8_SA(1, 0), a3, voffA);
            PG8_BAR; PG8_WAIT_L(0); PG8_MMA(1, 0, At, B0); PG8_BAR; PG8_SCHED;
            PG8_STAGE(PG8_SB(1, 1), b3 + hstep, voffB);
            PG8_WAIT_V(6); PG8_BAR; PG8_MMA(1, 1, At, B1); PG8_BAR;
            }
        }
        if constexpr (ALIGN_EPI) { if (wr == 0) PG8_BAR; }
        if constexpr (!Epi::AFTER_DRAIN) { E(acc, cur, wr, wc, fr, fq); S.done(cur); }
        if (!has_next) break;
#pragma unroll
        for (int a = 0; a < 2; ++a)
#pragma unroll
            for (int b = 0; b < 2; ++b)
#pragma unroll
                for (int m = 0; m < 4; ++m)
#pragma unroll
                    for (int n = 0; n < 2; ++n) acc[a][b][m][n] = (f32x4){0.f, 0.f, 0.f, 0.f};
        cur = nxt; cA = nA; cB = nB; ++ui;
        if constexpr (ALIGN_EPI) { if (wr == 1) PG8_BAR; }
    }
    PG8_WAIT_V(0);
    if constexpr (!ALIGN_EPI) { if (wr == 0) PG8_BAR; }
    PG8_BAR;
    if constexpr (Epi::AFTER_DRAIN) { E.fused(acc, cur, wr, wc, fr, fq, lds, wid, lane); S.done(cur); }
#undef PG8_SA
#undef PG8_SB
#undef PG8_STAGE
#undef PG8_LDA
#undef PG8_LDB
#undef PG8_MMA
#undef PG8_WAIT_V
#undef PG8_WAIT_L
#undef PG8_BAR
#undef PG8_SCHED
}
}

constexpr size_t SZ_WIN = (size_t)NIN * DM * 2, SZ_WO = (size_t)DM * DM * 2, SZ_WGU = (size_t)NGU * DM * 2, SZ_WD = (size_t)DM * DFFN * 2, SZ_WL = SZ_WIN + SZ_WO + SZ_WGU + SZ_WD;
constexpr size_t WS_CTL = 0;
constexpr size_t WS_W = 16384;
constexpr size_t WS_XB = WS_W + DEPTH * SZ_WL;
constexpr size_t WS_MRG = WS_XB + (size_t)MP * DM * 2;
constexpr size_t WS_Z = WS_MRG + (size_t)MP * DM * 2;
constexpr size_t WS_LD = WS_Z + (size_t)MP * ZP * 2;
constexpr size_t WS_U = WS_Z;
constexpr size_t WS_DS = WS_LD + (size_t)MP * 256 * 4;
constexpr size_t WS_SC = WS_DS + (size_t)16 * NCH * 64 * 128 * 4;
constexpr size_t WS_GL = WS_SC + (size_t)16 * NCH * 64 * 128 * 2;
constexpr size_t WS_SSQA = WS_GL + (size_t)16 * NCH * 64 * 4;
constexpr size_t WS_SSQB = WS_SSQA + (size_t)MP * 16 * 4;
constexpr size_t WS_XMETA = WS_SSQB + (size_t)MP * 16 * 4;
constexpr size_t WS_END = WS_XMETA + (size_t)64 * DM * 4;
static_assert((size_t)MP * DFFN * 2 <= (size_t)MP * ZP * 2 + (size_t)MP * 256 * 4, "U overlay fits Z|LD");
static_assert(WS_END <= 268435456ull, "workspace map fits 256 MiB");

#ifndef REP_PRO
#define REP_PRO 1
#endif
#ifndef REP_WIN
#define REP_WIN 1
#endif
#ifndef REP_MB
#define REP_MB 1
#endif
#ifndef REP_SCAN
#define REP_SCAN 1
#endif
#ifndef REP_GU
#define REP_GU 1
#endif
#ifndef REP_G1
#define REP_G1 1
#endif
#ifndef REP_AS
#define REP_AS 1
#endif
#ifndef REP_GS
#define REP_GS 1
#endif
#ifndef REP_G3
#define REP_G3 1
#endif
#ifndef REP_AP
#define REP_AP 1
#endif
#ifndef REP_WO0
#define REP_WO0 1
#endif
#ifndef XSYNC
#define XSYNC 0
#endif
constexpr int LDS_BYTES = 147456;
constexpr int NPHASE = 1 + 7 * DEPTH;

struct Args { const float* in[19]; float* out; unsigned char* ws; int ph_lo, ph_hi; };
typedef const __attribute__((address_space(4))) Args* KA;
DI KA ka_ptr() { KA p = (KA)__builtin_amdgcn_kernarg_segment_ptr(); asm volatile("" : "+s"(p)); return p; }

DI int mk_tid(int wave_s) { int lane; asm volatile("v_mbcnt_lo_u32_b32 %0, -1, 0\n\tv_mbcnt_hi_u32_b32 %0, -1, %0" : "=v"(lane)); return wave_s * 64 + lane; }
DI bf16x8 mk8(u32x2 lo, u32x2 hi) { u32x4 w; w.x = lo.x; w.y = lo.y; w.z = hi.x; w.w = hi.y; return __builtin_bit_cast(bf16x8, w); }
#define MFMA16(a, b, c) __builtin_amdgcn_mfma_f32_16x16x32_bf16((a), (b), (c), 0, 0, 0)

DI void attn_wave(const LAS unsigned char* Ks, const LAS unsigned char* Vt, const int VPB, const bf16_t* qrow, const float* qnw, const float sink2, const int jmin, const int c, const int fq, bf16_t* orow) {
    float qf[16];
    if (qrow) { const u32x4 a = *(const u32x4*)(qrow + 8 * fq), b = *(const u32x4*)(qrow + 32 + 8 * fq); unpack8(a, qf); unpack8(b, qf + 8); }
    else {
#pragma unroll
        for (int i = 0; i < 16; ++i) qf[i] = 0.f; }
    float ss = 0.f;
#pragma unroll
    for (int i = 0; i < 16; ++i) ss += qf[i] * qf[i];
    ss += __shfl_xor(ss, 16); ss += __shfl_xor(ss, 32);
    const float rs = rsqrtf(ss * (1.0f / 64.0f) + EPS) * (0.125f * LOG2E);
    const f32x4 w0 = *(const f32x4*)(qnw + 8 * fq), w1 = *(const f32x4*)(qnw + 8 * fq + 4), w2 = *(const f32x4*)(qnw + 32 + 8 * fq), w3 = *(const f32x4*)(qnw + 36 + 8 * fq);
#pragma unroll
    for (int i = 0; i < 4; ++i) { qf[i] *= rs * w0[i]; qf[4 + i] *= rs * w1[i]; qf[8 + i] *= rs * w2[i]; qf[12 + i] *= rs * w3[i]; }
    u32x4 q0, q1; q0.x = pk2(qf[0], qf[1]); q0.y = pk2(qf[2], qf[3]); q0.z = pk2(qf[4], qf[5]); q0.w = pk2(qf[6], qf[7]);
    q1.x = pk2(qf[8], qf[9]); q1.y = pk2(qf[10], qf[11]); q1.z = pk2(qf[12], qf[13]); q1.w = pk2(qf[14], qf[15]);
    const bf16x8 qB0 = __builtin_bit_cast(bf16x8, q0), qB1 = __builtin_bit_cast(bf16x8, q1);
    f32x4 acc[9];
    float mx = sink2;
#pragma unroll
    for (int T = 0; T < 9; ++T) {
        const LAS unsigned char* kp = Ks + (16 * T + c) * 144 + 16 * fq;
        const bf16x8 a0 = *(const LAS bf16x8*)kp, a1 = *(const LAS bf16x8*)(kp + 64);
        f32x4 s = {0.f, 0.f, 0.f, 0.f};
        s = MFMA16(a0, qB0, s); s = MFMA16(a1, qB1, s);
#pragma unroll
        for (int r = 0; r < 4; ++r) { const int jrel = 16 * T + 4 * fq + r, d = 128 + c - jrel; const bool ok = ((unsigned)d < 128u) && (jrel >= jmin); s[r] = ok ? s[r] : -1e30f; mx = fmaxf(mx, s[r]); }
        acc[T] = s;
    }
    mx = fmaxf(mx, __shfl_xor(mx, 16)); mx = fmaxf(mx, __shfl_xor(mx, 32));
    float sum = 0.f;
#pragma unroll
    for (int T = 0; T < 9; ++T)
#pragma unroll
        for (int r = 0; r < 4; ++r) { const float p = __builtin_amdgcn_exp2f(acc[T][r] - mx); acc[T][r] = p; sum += p; }
    sum += __shfl_xor(sum, 16); sum += __shfl_xor(sum, 32);
    const float inv = 1.0f / (sum + __builtin_amdgcn_exp2f(sink2 - mx));
    f32x4 o[4];
#pragma unroll
    for (int i = 0; i < 4; ++i) o[i] = (f32x4){0.f, 0.f, 0.f, 0.f};
#pragma unroll
    for (int kk = 0; kk < 5; ++kk) {
        u32x4 pw; pw.x = pk2(acc[2 * kk][0], acc[2 * kk][1]); pw.y = pk2(acc[2 * kk][2], acc[2 * kk][3]);
        if (kk < 4) { pw.z = pk2(acc[2 * kk + 1][0], acc[2 * kk + 1][1]); pw.w = pk2(acc[2 * kk + 1][2], acc[2 * kk + 1][3]); } else { pw.z = 0u; pw.w = 0u; }
        const bf16x8 pB = __builtin_bit_cast(bf16x8, pw);
#pragma unroll
        for (int Mt = 0; Mt < 4; ++Mt) {
            const LAS unsigned char* vp = Vt + (16 * Mt + c) * VPB + (32 * kk + 4 * fq) * 2;
            const u32x2 lo = *(const LAS u32x2*)vp, hi = *(const LAS u32x2*)(vp + 32);
            o[Mt] = MFMA16(mk8(lo, hi), pB, o[Mt]);
        }
    }
    if (orow) {
#pragma unroll
        for (int Mt = 0; Mt < 4; ++Mt) { u32x2 w; w.x = pk2(o[Mt][0] * inv, o[Mt][1] * inv); w.y = pk2(o[Mt][2] * inv, o[Mt][3] * inv); *(u32x2*)(orow + 16 * Mt + 4 * fq) = w; }
    }
}

struct Ctx {
    int l;
    const bf16_t* Z; float* LD; bf16_t* MRG; float* DS; bf16_t* SC; float* GL;
    const float *qnw, *knw, *sinks, *gnw;
    const float *cache_k, *cache_v, *state;
    float* out;
};

DI void attn_prompt_unit(const Ctx& C, int uidx, LAS unsigned char* lds, const int wave_s) {
    const int tid = mk_tid(wave_s);
    const int jb = uidx % 65, g = (uidx / 65) & 1, b = uidx / 130;
    const int p0 = 64 * jb, kbase = p0 - 128, rowbase = b * LP, nq = (LP - p0) < 64 ? (LP - p0) : 64;
    LAS unsigned char* Ks = lds; LAS unsigned char* Vt = lds + 208 * 144;
    const int lane = tid & 63, w = tid >> 6;
    {
        const int dc = tid & 7;
        const f32x4 kw0 = *(const f32x4*)(C.knw + dc * 8), kw1 = *(const f32x4*)(C.knw + dc * 8 + 4);
#pragma unroll
        for (int i = 0; i < 4; ++i) { const int j = (tid >> 3) + 64 * i, kp = kbase + j; const bool valid = (j < 192) && (kp >= 0) && (kp < LP);
            u32x4 raw = {0u, 0u, 0u, 0u}; if (valid) raw = *(const u32x4*)(C.Z + (size_t)(rowbase + kp) * ZP + ZK + g * 64 + dc * 8);
            float f[8]; unpack8(raw, f); float ss = 0.f;
#pragma unroll
            for (int e = 0; e < 8; ++e) ss += f[e] * f[e];
            ss += __shfl_xor(ss, 1); ss += __shfl_xor(ss, 2); ss += __shfl_xor(ss, 4);
            const float rs = rsqrtf(ss * (1.0f / 64.0f) + EPS);
#pragma unroll
            for (int e = 0; e < 4; ++e) { f[e] *= rs * kw0[e]; f[4 + e] *= rs * kw1[e]; }
            if (j < 208) { u32x4 o; o.x = pk2(f[0], f[1]); o.y = pk2(f[2], f[3]); o.z = pk2(f[4], f[5]); o.w = pk2(f[6], f[7]); *(LAS u32x4*)(Ks + j * 144 + dc * 16) = o; }
            if (valid && j >= 128 && kp >= LP - 128) { float* op = C.out + O_CKP + ((size_t)((C.l * NBATCH + b) * 128 + (kp - (LP - 128))) * 2 + g) * 64 + dc * 8;
                *(f32x4*)op = (f32x4){f[0], f[1], f[2], f[3]}; *(f32x4*)(op + 4) = (f32x4){f[4], f[5], f[6], f[7]}; } asm volatile("" ::: "memory"); }
    }
    {
        const int dc = w;
#pragma unroll
        for (int i = 0; i < 4; ++i) { const int j = lane + 64 * i, kp = kbase + j; const bool valid = (j < 192) && (kp >= 0) && (kp < LP);
            u32x4 raw = {0u, 0u, 0u, 0u}; if (valid) raw = *(const u32x4*)(C.Z + (size_t)(rowbase + kp) * ZP + ZV + g * 64 + dc * 8);
            if (j < 216) { LAS bf16_t* vp = (LAS bf16_t*)(Vt + (dc * 8) * 432 + j * 2);
                vp[0 * 216] = (bf16_t)(raw.x & 0xffffu); vp[1 * 216] = (bf16_t)(raw.x >> 16); vp[2 * 216] = (bf16_t)(raw.y & 0xffffu); vp[3 * 216] = (bf16_t)(raw.y >> 16);
                vp[4 * 216] = (bf16_t)(raw.z & 0xffffu); vp[5 * 216] = (bf16_t)(raw.z >> 16); vp[6 * 216] = (bf16_t)(raw.w & 0xffffu); vp[7 * 216] = (bf16_t)(raw.w >> 16); }
            if (valid && j >= 128 && kp >= LP - 128) { float f[8]; unpack8(raw, f); float* op = C.out + O_CVP + ((size_t)((C.l * NBATCH + b) * 128 + (kp - (LP - 128))) * 2 + g) * 64 + dc * 8;
                *(f32x4*)op = (f32x4){f[0], f[1], f[2], f[3]}; *(f32x4*)(op + 4) = (f32x4){f[4], f[5], f[6], f[7]}; } asm volatile("" ::: "memory"); }
    }
    __syncthreads();
    {
        const int tid2 = mk_tid(wave_s), lane = tid2 & 63, w = tid2 >> 6;
        const int s = w & 3, hp = w >> 2, c = lane & 15, fq = lane >> 4;
        if (16 * s < nq) {
#pragma unroll 1
            for (int hh = 0; hh < 2; ++hh) { const int h = g * 4 + hp * 2 + hh, qp = p0 + 16 * s + c; const bool qv = qp < LP;
                const bf16_t* qrow = qv ? C.Z + (size_t)(rowbase + qp) * ZP + ZQ + h * 64 : nullptr;
                bf16_t* orow = qv ? C.MRG + (size_t)(rowbase + qp) * DM + h * 64 : nullptr;
                attn_wave(Ks + 16 * s * 144, Vt + 16 * s * 2, 432, qrow, C.qnw, C.sinks[h] * LOG2E, 128 - p0 - 16 * s, c, fq, orow); }
        }
    }
    __syncthreads();
}

DI void attn_sample_unit(const Ctx& C, int b, LAS unsigned char* lds, const int wave_s) {
    const int tid = mk_tid(wave_s);
    const int lane = tid & 63, w = tid >> 6;
    constexpr int KSG = 160 * 144, VTG = 64 * 336, VT0 = 2 * KSG;
    const int row0 = MPROMPT + b * DECT;
    const size_t cbase = (size_t)(C.l * DECB + b) * 128;
#pragma unroll
    for (int i = 0; i < 4; ++i) {
        const int idx = tid + 512 * i, dc = idx & 7, j = (idx >> 3) & 127, g = idx >> 10;
        const float* sp = C.cache_k + ((cbase + j) * 2 + g) * 64 + dc * 8; const f32x4 a = *(const f32x4*)sp, bq = *(const f32x4*)(sp + 4);
        u32x4 o; o.x = pk2(a[0], a[1]); o.y = pk2(a[2], a[3]); o.z = pk2(bq[0], bq[1]); o.w = pk2(bq[2], bq[3]);
        *(LAS u32x4*)(lds + g * KSG + j * 144 + dc * 16) = o;
        if (j >= 8) { float* op = C.out + O_CKS + ((cbase + j - 8) * 2 + g) * 64 + dc * 8; *(f32x4*)op = a; *(f32x4*)(op + 4) = bq; }
        asm volatile("" ::: "memory");
    }
    if (w < 2) {
        const int dc = tid & 7, t = (tid >> 3) & 7, g = tid >> 6;
        const u32x4 raw = *(const u32x4*)(C.Z + (size_t)(row0 + t) * ZP + ZK + g * 64 + dc * 8);
        float f[8]; unpack8(raw, f); float ss = 0.f;
#pragma unroll
        for (int e = 0; e < 8; ++e) ss += f[e] * f[e];
        ss += __shfl_xor(ss, 1); ss += __shfl_xor(ss, 2); ss += __shfl_xor(ss, 4);
        const float rs = rsqrtf(ss * (1.0f / 64.0f) + EPS);
        const f32x4 kw0 = *(const f32x4*)(C.knw + dc * 8), kw1 = *(const f32x4*)(C.knw + dc * 8 + 4);
#pragma unroll
        for (int e = 0; e < 4; ++e) { f[e] *= rs * kw0[e]; f[4 + e] *= rs * kw1[e]; }
        u32x4 o; o.x = pk2(f[0], f[1]); o.y = pk2(f[2], f[3]); o.z = pk2(f[4], f[5]); o.w = pk2(f[6], f[7]);
        *(LAS u32x4*)(lds + g * KSG + (128 + t) * 144 + dc * 16) = o;
        float* op = C.out + O_CKS + ((cbase + 120 + t) * 2 + g) * 64 + dc * 8;
        *(f32x4*)op = (f32x4){f[0], f[1], f[2], f[3]}; *(f32x4*)(op + 4) = (f32x4){f[4], f[5], f[6], f[7]};
    } else if (w < 8) {
        const int idx = tid - 128, dc = idx & 7, r = (idx >> 3) % 24, g = idx / 192;
        unsigned z0 = 0u; asm volatile("" : "+v"(z0)); *(LAS u32x4*)(lds + g * KSG + (136 + r) * 144 + dc * 16) = (u32x4){z0, z0, z0, z0};
    }
#pragma unroll
    for (int i = 0; i < 4; ++i) {
        const int idx = tid + 512 * i, j = idx & 127, dc = (idx >> 7) & 7, g = idx >> 10;
        const float* sp = C.cache_v + ((cbase + j) * 2 + g) * 64 + dc * 8; const f32x4 a = *(const f32x4*)sp, bq = *(const f32x4*)(sp + 4);
        LAS bf16_t* vp = (LAS bf16_t*)(lds + VT0 + g * VTG + (dc * 8) * 336 + j * 2);
        const unsigned p0 = pk2(a[0], a[1]), p1 = pk2(a[2], a[3]), p2 = pk2(bq[0], bq[1]), p3 = pk2(bq[2], bq[3]);
        vp[0 * 168] = (bf16_t)(p0 & 0xffffu); vp[1 * 168] = (bf16_t)(p0 >> 16); vp[2 * 168] = (bf16_t)(p1 & 0xffffu); vp[3 * 168] = (bf16_t)(p1 >> 16);
        vp[4 * 168] = (bf16_t)(p2 & 0xffffu); vp[5 * 168] = (bf16_t)(p2 >> 16); vp[6 * 168] = (bf16_t)(p3 & 0xffffu); vp[7 * 168] = (bf16_t)(p3 >> 16);
        if (j >= 8) { float* op = C.out + O_CVS + ((cbase + j - 8) * 2 + g) * 64 + dc * 8; *(f32x4*)op = a; *(f32x4*)(op + 4) = bq; }
        asm volatile("" ::: "memory");
    }
    if (tid < 128) {
        const int t = tid & 7, dc = (tid >> 3) & 7, g = tid >> 6;
        const u32x4 raw = *(const u32x4*)(C.Z + (size_t)(row0 + t) * ZP + ZV + g * 64 + dc * 8);
        LAS bf16_t* vp = (LAS bf16_t*)(lds + VT0 + g * VTG + (dc * 8) * 336 + (128 + t) * 2);
        vp[0 * 168] = (bf16_t)(raw.x & 0xffffu); vp[1 * 168] = (bf16_t)(raw.x >> 16); vp[2 * 168] = (bf16_t)(raw.y & 0xffffu); vp[3 * 168] = (bf16_t)(raw.y >> 16);
        vp[4 * 168] = (bf16_t)(raw.z & 0xffffu); vp[5 * 168] = (bf16_t)(raw.z >> 16); vp[6 * 168] = (bf16_t)(raw.w & 0xffffu); vp[7 * 168] = (bf16_t)(raw.w >> 16);
        float f[8]; unpack8(raw, f); float* op = C.out + O_CVS + ((cbase + 120 + t) * 2 + g) * 64 + dc * 8;
        *(f32x4*)op = (f32x4){f[0], f[1], f[2], f[3]}; *(f32x4*)(op + 4) = (f32x4){f[4], f[5], f[6], f[7]};
    }
#pragma unroll
    for (int i = 0; i < 2; ++i) {
        const int idx = tid + 512 * i, part = idx & 7, d = (idx >> 3) & 63, g = idx >> 9;
        unsigned z0 = 0u; asm volatile("" : "+v"(z0)); *(LAS u32x2*)(lds + VT0 + g * VTG + d * 336 + 272 + part * 8) = (u32x2){z0, z0};
    }
    __syncthreads();
    {
        const int tid2 = mk_tid(wave_s), lane = tid2 & 63, w = tid2 >> 6;
        const int g = w >> 2, h = w, c = lane & 15, fq = lane >> 4;
        const bool qv = c < 8;
        const bf16_t* qrow = qv ? C.Z + (size_t)(row0 + c) * ZP + ZQ + h * 64 : nullptr;
        bf16_t* orow = qv ? C.MRG + (size_t)(row0 + c) * DM + h * 64 : nullptr;
        attn_wave(lds + g * KSG, lds + VT0 + g * VTG, 336, qrow, C.qnw, C.sinks[h] * LOG2E, 0, c, fq, orow);
    }
    __syncthreads();
}

DI void gla_sample_unit(const Ctx& C, int uidx, LAS unsigned char* lds, const int wave_s) {
    const int tid = mk_tid(wave_s);
    const int h = uidx & 3, b = uidx >> 2, row0 = MPROMPT + b * DECT;
    LAS float* qs = (LAS float*)lds; LAS float* ks = qs + 512; LAS float* dec = ks + 512; LAS float* vs = dec + 512; LAS float* red = vs + 1024;
    {
        const int t = tid >> 6, k = tid & 63; const bf16_t* zr = C.Z + (size_t)(row0 + t) * ZP;
        qs[tid] = bf2f(zr[ZGQ + h * 64 + k]); ks[tid] = bf2f(zr[ZGK + h * 64 + k]); dec[tid] = __expf(C.LD[(size_t)(row0 + t) * 256 + h * 64 + k]);
#pragma unroll
        for (int i = 0; i < 2; ++i) { const int idx = tid + 512 * i, tt = idx >> 7, v = idx & 127; vs[idx] = bf2f(C.Z[(size_t)(row0 + tt) * ZP + ZGV + h * 128 + v]); }
    }
    const int v = tid & 127, kq = tid >> 7;
    const size_t sbase = ((size_t)((C.l * DECB + b) * 4 + h) * 64 + 16 * kq) * 128 + v;
    float S[16];
#pragma unroll
    for (int i = 0; i < 16; ++i) S[i] = C.state[sbase + (size_t)i * 128];
    __syncthreads();
#pragma unroll
    for (int t = 0; t < 8; ++t) { float a = 0.f; const float vv = vs[t * 128 + v];
#pragma unroll
        for (int i = 0; i < 16; ++i) { const int k = 16 * kq + i; S[i] = dec[t * 64 + k] * S[i] + ks[t * 64 + k] * vv; a += qs[t * 64 + k] * S[i]; }
        red[(kq * 8 + t) * 128 + v] = a; }
    float* so = C.out + O_SS + sbase;
#pragma unroll
    for (int i = 0; i < 16; ++i) so[(size_t)i * 128] = S[i];
    __syncthreads();
    {
        const int t = tid >> 6, lane = tid & 63; float o[2]; float ss = 0.f;
#pragma unroll
        for (int i = 0; i < 2; ++i) { const int vv = lane + 64 * i; o[i] = (red[(0 * 8 + t) * 128 + vv] + red[(1 * 8 + t) * 128 + vv]) + (red[(2 * 8 + t) * 128 + vv] + red[(3 * 8 + t) * 128 + vv]); ss += o[i] * o[i]; }
#pragma unroll
        for (int m = 1; m < 64; m <<= 1) ss += __shfl_xor(ss, m);
        const float rs = rsqrtf(ss * (1.0f / 128.0f) + EPS);
#pragma unroll
        for (int i = 0; i < 2; ++i) { const int vv = lane + 64 * i; const float og = bf2f(C.Z[(size_t)(row0 + t) * ZP + ZOG + h * 128 + vv]);
            const float y = o[i] * rs * C.gnw[vv] * silu_f(og); C.MRG[(size_t)(row0 + t) * DM + 512 + h * 128 + vv] = (bf16_t)(pk2(y, 0.f) & 0xffffu); }
    }
    __syncthreads();
}

DI float gla_prefix(const float* LD, int r0, int nv, int h, LAS float* Gs, LAS float* segtot, int lane, int w) {
    const int k = lane, seg = w; float g[16];
#pragma unroll
    for (int i = 0; i < 16; ++i) { const int t = 16 * seg + i; g[i] = t < nv ? LD[(size_t)(r0 + t) * 256 + h * 64 + k] : 0.f; }
#pragma unroll
    for (int i = 1; i < 16; ++i) g[i] += g[i - 1];
    segtot[seg * 64 + k] = g[15];
    __syncthreads();
    float off = 0.f, tot = 0.f;
#pragma unroll
    for (int s = 0; s < 8; ++s) { const float x = segtot[s * 64 + k]; off += (s < seg) ? x : 0.f; tot += x; }
#pragma unroll
    for (int i = 0; i < 16; ++i) { const int t = 16 * seg + i; Gs[t * 65 + k] = g[i] + off; }
    return tot;
}

DI void gla1_unit(const Ctx& C, int unit, LAS unsigned char* lds, const int wave_s) {
    const int tid = mk_tid(wave_s);
    const int c = unit % NCH, bh = unit / NCH, h = bh & 3, b = bh >> 2;
    const int r0 = b * LP + 128 * c, nv = (LP - 128 * c) < 128 ? (LP - 128 * c) : 128;
    LAS float* Gs = (LAS float*)lds; LAS float* segtot = (LAS float*)(lds + 33280); LAS float* gl = (LAS float*)(lds + 35328);
    LAS unsigned char* kdT = lds + 35840; LAS unsigned char* vT = lds + 53248;
    const int lane = tid & 63, w = tid >> 6;
    { const float tot = gla_prefix(C.LD, r0, nv, h, Gs, segtot, lane, w); if (w == 0) { gl[lane] = tot; C.GL[(size_t)unit * 64 + lane] = tot; } }
    __syncthreads();
    {
        const int t = tid & 127;
#pragma unroll
        for (int i = 0; i < 2; ++i) { const int kc = (tid >> 7) + 4 * i; u32x4 raw = {0u, 0u, 0u, 0u};
            if (t < nv) raw = *(const u32x4*)(C.Z + (size_t)(r0 + t) * ZP + ZGK + h * 64 + kc * 8);
            float f[8]; unpack8(raw, f);
#pragma unroll
            for (int e = 0; e < 8; ++e) { const float kd = f[e] * __expf(gl[kc * 8 + e] - Gs[t * 65 + kc * 8 + e]); *(LAS bf16_t*)(kdT + (kc * 8 + e) * 272 + t * 2) = (bf16_t)(pk2(kd, 0.f) & 0xffffu); } }
#pragma unroll
        for (int i = 0; i < 4; ++i) { const int vc = (tid >> 7) + 4 * i; u32x4 raw = {0u, 0u, 0u, 0u};
            if (t < nv) raw = *(const u32x4*)(C.Z + (size_t)(r0 + t) * ZP + ZGV + h * 128 + vc * 8);
            LAS bf16_t* vp = (LAS bf16_t*)(vT + (vc * 8) * 272 + t * 2);
            vp[0 * 136] = (bf16_t)(raw.x & 0xffffu); vp[1 * 136] = (bf16_t)(raw.x >> 16); vp[2 * 136] = (bf16_t)(raw.y & 0xffffu); vp[3 * 136] = (bf16_t)(raw.y >> 16);
            vp[4 * 136] = (bf16_t)(raw.z & 0xffffu); vp[5 * 136] = (bf16_t)(raw.z >> 16); vp[6 * 136] = (bf16_t)(raw.w & 0xffffu); vp[7 * 136] = (bf16_t)(raw.w >> 16); }
    }
    __syncthreads();
    {
        const int cc = lane & 15, fq = lane >> 4;
#pragma unroll
        for (int kt = 0; kt < 4; ++kt) { f32x4 acc = {0.f, 0.f, 0.f, 0.f};
#pragma unroll
            for (int ks = 0; ks < 4; ++ks) { const bf16x8 a = *(const LAS bf16x8*)(kdT + (16 * kt + cc) * 272 + (32 * ks + 8 * fq) * 2), bb = *(const LAS bf16x8*)(vT + (16 * w + cc) * 272 + (32 * ks + 8 * fq) * 2); acc = MFMA16(a, bb, acc); }
#pragma unroll
            for (int r = 0; r < 4; ++r) C.DS[((size_t)unit * 64 + 16 * kt + 4 * fq + r) * 128 + 16 * w + cc] = acc[r]; }
    }
    __syncthreads();
}

DI void gla3_unit(const Ctx& C, int unit, LAS unsigned char* lds, const int wave_s) {
    const int tid = mk_tid(wave_s);
    const int c = unit % NCH, bh = unit / NCH, h = bh & 3, b = bh >> 2;
    const int r0 = b * LP + 128 * c, nv = (LP - 128 * c) < 128 ? (LP - 128 * c) : 128;
    LAS unsigned char* qg = lds; LAS unsigned char* kg = lds + 18432; LAS unsigned char* vT = lds + 36864; LAS unsigned char* ScT = lds + 71680;
    LAS float* Gs = (LAS float*)(lds + 90112); LAS float* segtot = (LAS float*)(lds + 123392);
    const int lane = tid & 63, w = __builtin_amdgcn_readfirstlane(tid >> 6);
    (void)gla_prefix(C.LD, r0, nv, h, Gs, segtot, lane, w);
    __syncthreads();
    {
        const int kc = tid & 7;
#pragma unroll
        for (int i = 0; i < 2; ++i) { const int t = (tid >> 3) + 64 * i; u32x4 rq = {0u, 0u, 0u, 0u}, rk = {0u, 0u, 0u, 0u}; f32x4 g0 = {0.f, 0.f, 0.f, 0.f}, g1 = g0;
            if (t < nv) { const bf16_t* zr = C.Z + (size_t)(r0 + t) * ZP + h * 64 + kc * 8; rq = *(const u32x4*)(zr + ZGQ); rk = *(const u32x4*)(zr + ZGK);
                const LAS float* gp = Gs + t * 65 + kc * 8; g0 = (f32x4){gp[0], gp[1], gp[2], gp[3]}; g1 = (f32x4){gp[4], gp[5], gp[6], gp[7]}; }
            float fq_[8], fk_[8]; unpack8(rq, fq_); unpack8(rk, fk_);
#pragma unroll
            for (int e = 0; e < 4; ++e) { const float e0 = __expf(g0[e]), e1 = __expf(g1[e]); fq_[e] *= e0; fq_[4 + e] *= e1; fk_[e] *= __builtin_amdgcn_rcpf(e0); fk_[4 + e] *= __builtin_amdgcn_rcpf(e1); }
            u32x4 oq, ok; oq.x = pk2(fq_[0], fq_[1]); oq.y = pk2(fq_[2], fq_[3]); oq.z = pk2(fq_[4], fq_[5]); oq.w = pk2(fq_[6], fq_[7]);
            ok.x = pk2(fk_[0], fk_[1]); ok.y = pk2(fk_[2], fk_[3]); ok.z = pk2(fk_[4], fk_[5]); ok.w = pk2(fk_[6], fk_[7]);
            *(LAS u32x4*)(qg + t * 144 + kc * 16) = oq; *(LAS u32x4*)(kg + t * 144 + kc * 16) = ok; }
        const int t = tid & 127;
#pragma unroll
        for (int i = 0; i < 4; ++i) { const int vc = (tid >> 7) + 4 * i; u32x4 raw = {0u, 0u, 0u, 0u};
            if (t < nv) raw = *(const u32x4*)(C.Z + (size_t)(r0 + t) * ZP + ZGV + h * 128 + vc * 8);
            LAS bf16_t* vp = (LAS bf16_t*)(vT + (vc * 8) * 272 + t * 2);
            vp[0 * 136] = (bf16_t)(raw.x & 0xffffu); vp[1 * 136] = (bf16_t)(raw.x >> 16); vp[2 * 136] = (bf16_t)(raw.y & 0xffffu); vp[3 * 136] = (bf16_t)(raw.y >> 16);
            vp[4 * 136] = (bf16_t)(raw.z & 0xffffu); vp[5 * 136] = (bf16_t)(raw.z >> 16); vp[6 * 136] = (bf16_t)(raw.w & 0xffffu); vp[7 * 136] = (bf16_t)(raw.w >> 16); }
        const int k = tid & 63;
#pragma unroll
        for (int i = 0; i < 2; ++i) { const int vc = (tid >> 6) + 8 * i; const u32x4 raw = *(const u32x4*)(C.SC + ((size_t)unit * 64 + k) * 128 + vc * 8);
            LAS bf16_t* sp = (LAS bf16_t*)(ScT + (vc * 8) * 144 + k * 2);
            sp[0 * 72] = (bf16_t)(raw.x & 0xffffu); sp[1 * 72] = (bf16_t)(raw.x >> 16); sp[2 * 72] = (bf16_t)(raw.y & 0xffffu); sp[3 * 72] = (bf16_t)(raw.y >> 16);
            sp[4 * 72] = (bf16_t)(raw.z & 0xffffu); sp[5 * 72] = (bf16_t)(raw.z >> 16); sp[6 * 72] = (bf16_t)(raw.w & 0xffffu); sp[7 * 72] = (bf16_t)(raw.w >> 16); }
    }
    __syncthreads();
    {
        const int cc = lane & 15, fq = lane >> 4;
        const bf16x8 qB0 = *(const LAS bf16x8*)(qg + (16 * w + cc) * 144 + 16 * fq), qB1 = *(const LAS bf16x8*)(qg + (16 * w + cc) * 144 + 64 + 16 * fq);
        f32x4 A[8];
#pragma unroll
        for (int T = 0; T < 8; ++T) { f32x4 s = {0.f, 0.f, 0.f, 0.f};
            if (T <= w) { const LAS unsigned char* kp = kg + (16 * T + cc) * 144 + 16 * fq; const bf16x8 a0 = *(const LAS bf16x8*)kp, a1 = *(const LAS bf16x8*)(kp + 64);
                s = MFMA16(a0, qB0, s); s = MFMA16(a1, qB1, s);
                if (T == w) {
#pragma unroll
                    for (int r = 0; r < 4; ++r) s[r] = (4 * fq + r > cc) ? 0.f : s[r]; } }
            A[T] = s; }
        bf16x8 P[4];
#pragma unroll
        for (int kk = 0; kk < 4; ++kk) { u32x4 pw; pw.x = pk2(A[2 * kk][0], A[2 * kk][1]); pw.y = pk2(A[2 * kk][2], A[2 * kk][3]); pw.z = pk2(A[2 * kk + 1][0], A[2 * kk + 1][1]); pw.w = pk2(A[2 * kk + 1][2], A[2 * kk + 1][3]); P[kk] = __builtin_bit_cast(bf16x8, pw); }
        f32x4 o[8]; float ss = 0.f;
#pragma unroll
        for (int Mt = 0; Mt < 8; ++Mt) { f32x4 acc = {0.f, 0.f, 0.f, 0.f};
#pragma unroll
            for (int kk = 0; kk < 4; ++kk) if (2 * kk <= w) { const LAS unsigned char* vp = vT + (16 * Mt + cc) * 272 + (32 * kk + 4 * fq) * 2; const u32x2 lo = *(const LAS u32x2*)vp, hi = *(const LAS u32x2*)(vp + 32); acc = MFMA16(mk8(lo, hi), P[kk], acc); }
            { const LAS unsigned char* sp = ScT + (16 * Mt + cc) * 144 + 16 * fq; const bf16x8 a0 = *(const LAS bf16x8*)sp, a1 = *(const LAS bf16x8*)(sp + 64); acc = MFMA16(a0, qB0, acc); acc = MFMA16(a1, qB1, acc); }
            o[Mt] = acc; ss += (acc[0] * acc[0] + acc[1] * acc[1]) + (acc[2] * acc[2] + acc[3] * acc[3]); }
        ss += __shfl_xor(ss, 16); ss += __shfl_xor(ss, 32);
        const float rs = rsqrtf(ss * (1.0f / 128.0f) + EPS);
        const int t = 16 * w + cc;
        if (t < nv) { const size_t row = (size_t)(r0 + t);
#pragma unroll
            for (int Mt = 0; Mt < 8; ++Mt) { const int v0 = 16 * Mt + 4 * fq; const u32x2 og = *(const u32x2*)(C.Z + row * ZP + ZOG + h * 128 + v0); const f32x4 gn = *(const f32x4*)(C.gnw + v0);
                const float y0 = o[Mt][0] * rs * gn[0] * silu_f(bflo(og.x)), y1 = o[Mt][1] * rs * gn[1] * silu_f(bfhi(og.x)), y2 = o[Mt][2] * rs * gn[2] * silu_f(bflo(og.y)), y3 = o[Mt][3] * rs * gn[3] * silu_f(bfhi(og.y));
                u32x2 wv; wv.x = pk2(y0, y1); wv.y = pk2(y2, y3); *(u32x2*)(C.MRG + row * DM + 512 + h * 128 + v0) = wv; } }
    }
    __syncthreads();
}

DI void gla_scan(const Ctx& C, int gtid, int gthreads) {
    for (int idx = gtid; idx < 16 * 64 * 128; idx += gthreads) {
        const int v = idx & 127, k = (idx >> 7) & 63, bh = idx >> 13;
        const size_t u0 = (size_t)bh * NCH;
        float ds[NCH], dg[NCH];
#pragma unroll
        for (int c = 0; c < NCH; ++c) { ds[c] = C.DS[((u0 + c) * 64 + k) * 128 + v]; dg[c] = C.GL[(u0 + c) * 64 + k]; }
        float S = 0.f;
#pragma unroll
        for (int c = 0; c < NCH; ++c) { C.SC[((u0 + c) * 64 + k) * 128 + v] = (bf16_t)(pk2(S, 0.f) & 0xffffu); S = __expf(dg[c]) * S + ds[c]; }
        const int h = bh & 3, b = bh >> 2;
        C.out[O_SP + ((size_t)((C.l * NBATCH + b) * 4 + h) * 64 + k) * 128 + v] = S;
    }
}

struct WSrc { int mat; const float* W; const float* W2; const float* gain; const float* wg2; };
DI float wsrc(const WSrc& s, int k, int n) {
    if (s.mat == 0) {
        if (n < 2304) { const int col = n < 1792 ? n : n + 16; const float sc = (n >= 768 && n < 1024) ? 0.125f : 1.0f; return s.W[(size_t)k * INW + col] * s.gain[k] * sc; }
        const int e = n - 2304; float a = 0.f;
#pragma unroll
        for (int r = 0; r < 16; ++r) a += s.W[(size_t)k * INW + 1792 + r] * s.wg2[r * 256 + e];
        return a * s.gain[k];
    } else if (s.mat == 1) { return s.W[(size_t)k * DM + n];
    } else if (s.mat == 2) { const int pn = n >> 8, j = n & 255; return (j < 128 ? s.W[(size_t)k * DFFN + 128 * pn + j] : s.W2[(size_t)k * DFFN + 128 * pn + j - 128]) * s.gain[k];
    } else { return s.W[(size_t)k * DM + n]; }
}
DI void conv_item(const WSrc& s, int K, int N, bf16_t* WT, LAS float* scr, int item, int lane) {
    const int nblk = N / 32, kb = item / nblk, nb = item % nblk, k0 = 64 * kb, n0 = 32 * nb;
#pragma unroll 8
    for (int i = 0; i < 32; ++i) { const int kk = 2 * i + (lane >> 5); scr[kk * 33 + (lane & 31)] = wsrc(s, k0 + kk, n0 + (lane & 31)); }
    asm volatile("s_waitcnt lgkmcnt(0)" ::: "memory");
    const int c = lane & 7;
#pragma unroll
    for (int j = 0; j < 4; ++j) { const int n = (lane >> 3) + 8 * j; const LAS float* sp = scr + (8 * c) * 33 + n;
        u32x4 o; o.x = pk2(sp[0 * 33], sp[1 * 33]); o.y = pk2(sp[2 * 33], sp[3 * 33]); o.z = pk2(sp[4 * 33], sp[5 * 33]); o.w = pk2(sp[6 * 33], sp[7 * 33]);
        *(u32x4*)(WT + (size_t)(n0 + n) * K + k0 + 8 * c) = o; }
    asm volatile("s_waitcnt lgkmcnt(0)" ::: "memory");
}
constexpr int NI_IN = 16 * 80, NI_O = 16 * 32, NI_GU = 16 * 176, NI_D = 44 * 32, NI_L = NI_IN + NI_O + NI_GU + NI_D;

DI void prologue(KA ap, const RowMap& rm, LAS unsigned char* lds, int tid, int vcu, int G) {
    const int lane = tid & 63, wave = tid >> 6, gw = vcu * 8 + wave, NGW = G * 8;
    LAS float* scr = (LAS float*)(lds + wave * 16384);
    for (int it = gw; it < DEPTH * NI_L; it += NGW) {
        const int l = it / NI_L; int r = it % NI_L;
        unsigned char* wl = ap->ws + WS_W + (size_t)l * SZ_WL;
        if (r < NI_IN) { WSrc s{0, ap->in[7] + (size_t)l * DM * INW, nullptr, ap->in[6] + l * DM, ap->in[11] + l * 16 * 256}; conv_item(s, DM, NIN, (bf16_t*)wl, scr, r, lane); continue; } r -= NI_IN;
        if (r < NI_O) { WSrc s{1, ap->in[14] + (size_t)l * DM * DM, nullptr, nullptr, nullptr}; conv_item(s, DM, DM, (bf16_t*)(wl + SZ_WIN), scr, r, lane); continue; } r -= NI_O;
        if (r < NI_GU) { WSrc s{2, ap->in[16] + (size_t)l * DM * DFFN, ap->in[17] + (size_t)l * DM * DFFN, ap->in[15] + l * DM, nullptr}; conv_item(s, DM, NGU, (bf16_t*)(wl + SZ_WIN + SZ_WO), scr, r, lane); continue; } r -= NI_GU;
        { WSrc s{3, ap->in[18] + (size_t)l * DFFN * DM, nullptr, nullptr, nullptr}; conv_item(s, DFFN, DM, (bf16_t*)(wl + SZ_WIN + SZ_WO + SZ_WGU), scr, r, lane); }
    }
    bf16_t* XB = (bf16_t*)(ap->ws + WS_XB); bf16_t* MRG = (bf16_t*)(ap->ws + WS_MRG); float* ssqA = (float*)(ap->ws + WS_SSQA);
    for (int m = gw; m < MP; m += NGW) {
        const float* ip = row_in(rm, m); f32x4 v[4]; float s = 0.f;
#pragma unroll
        for (int j = 0; j < 4; ++j) { v[j] = ip ? ((const f32x4*)ip)[lane + 64 * j] : (f32x4){0.f, 0.f, 0.f, 0.f}; s += (v[j][0] * v[j][0] + v[j][1] * v[j][1]) + (v[j][2] * v[j][2] + v[j][3] * v[j][3]); }
#pragma unroll
        for (int o = 1; o < 64; o <<= 1) s += __shfl_xor(s, o);
#pragma unroll
        for (int j = 0; j < 4; ++j) { u32x2 w; w.x = pk2(v[j][0], v[j][1]); w.y = pk2(v[j][2], v[j][3]); ((u32x2*)(XB + (size_t)m * DM))[lane + 64 * j] = w; if (!ip) ((u32x2*)(MRG + (size_t)m * DM))[lane + 64 * j] = (u32x2){0u, 0u}; }
        if (lane < 16) ssqA[(size_t)m * 16 + lane] = lane == 0 ? s : 0.f;
    }
}

#define XB_TMO      128
#define XB_XCNT(j)  (256  + 64 * (j))
#define XB_XSUB(j)  (1280 + 64 * (j))
#define XB_XGEN(j)  (2304 + 64 * (j))
#define XB_TOP      3328
#define XB_TOPGEN   3392
#define XCD_BAR_WORDS 3456
#define XB_SPIN_CAP (1u << 18)

__device__ __forceinline__ unsigned xb_ld(unsigned* p)              { return __hip_atomic_load(p, __ATOMIC_RELAXED, __HIP_MEMORY_SCOPE_AGENT); }
__device__ __forceinline__ unsigned xb_add(unsigned* p, unsigned v) { return __hip_atomic_fetch_add(p, v, __ATOMIC_RELAXED, __HIP_MEMORY_SCOPE_AGENT); }
__device__ __forceinline__ unsigned xb_xcc_id() { return (unsigned)__builtin_amdgcn_s_getreg((3 << 11) | 20) & 0xFu; }
#define XB_SPIN(cond, bar) do { unsigned _sp = 0; while (cond) { __builtin_amdgcn_s_sleep(1); \
    if ((++_sp & 255u) == 0u) { if (xb_ld(&(bar)[XB_TMO])) break; if (_sp > XB_SPIN_CAP) { atomicAdd(&(bar)[XB_TMO], 1u); break; } } } } while (0)

struct XcdBarrier {
    unsigned* bar; unsigned x;
    volatile LAS unsigned* st;
};

__device__ __forceinline__ XcdBarrier xcd_barrier_post(unsigned* bar, volatile LAS unsigned* st, const bool t0) {
    XcdBarrier b; b.bar = bar; b.x = xb_xcc_id(); b.st = st;
    if (t0) (void)xb_add(&bar[XB_XCNT(b.x)], 1u);
    return b;
}
__device__ __forceinline__ void xcd_barrier_complete(unsigned* bar, unsigned x, unsigned& nloc, unsigned& nx) {
    const unsigned G = gridDim.x * gridDim.y * gridDim.z;
    unsigned sum, cnt, mine, sp = 0u;
    for (;;) {
        sum = 0u; cnt = 0u; mine = 0u;
#pragma unroll
        for (unsigned j = 0; j < 16; ++j) { const unsigned c = xb_ld(&bar[XB_XCNT(j)]); sum += c; cnt += (c > 0u) ? 1u : 0u; mine = (j == x) ? c : mine; }
        if (sum == G) break;
        __builtin_amdgcn_s_sleep(1);
        if ((++sp & 255u) == 0u) { if (xb_ld(&bar[XB_TMO])) break; if (sp > XB_SPIN_CAP) { atomicAdd(&bar[XB_TMO], 1u); break; } }
    }
    nloc = mine > 0u ? mine : 1u; nx = cnt > 0u ? cnt : 1u;
}

__device__ __forceinline__ void xcd_barrier(const XcdBarrier& b, const bool t0) {
    asm volatile("s_waitcnt vmcnt(0)" ::: "memory");
    __syncthreads();
    if (t0) {
        unsigned* bar = b.bar;
        __builtin_amdgcn_s_waitcnt(0);
        unsigned nloc = b.st[0], nx = b.st[1];
        if (nloc == 0u) { xcd_barrier_complete(bar, b.x, nloc, nx); b.st[0] = nloc; b.st[1] = nx; }
        const unsigned old = xb_add(&bar[XB_XSUB(b.x)], 1u);
        const unsigned gen = old / nloc;
        if (old + 1u == (gen + 1u) * nloc) {
            __builtin_amdgcn_fence(__ATOMIC_RELEASE, "agent");
            asm volatile("s_waitcnt vmcnt(0)" ::: "memory");
            const unsigned og = xb_add(&bar[XB_TOP], 1u);
            const unsigned tg = og / nx;
            if (og + 1u == (tg + 1u) * nx) xb_add(&bar[XB_TOPGEN], 1u);
            else XB_SPIN(xb_ld(&bar[XB_TOPGEN]) == tg, bar);
            __builtin_amdgcn_fence(__ATOMIC_ACQUIRE, "agent");
            xb_add(&bar[XB_XGEN(b.x)], 1u);
            asm volatile("s_waitcnt vmcnt(0)" ::: "memory");
        } else {
            XB_SPIN(xb_ld(&bar[XB_XGEN(b.x)]) == gen, bar);
            __builtin_amdgcn_fence(__ATOMIC_ACQUIRE, "agent");
            asm volatile("s_waitcnt vmcnt(0)" ::: "memory");
        }
    }
    __syncthreads();
}

template <class T> DI T* opq(T* p) { asm volatile("" : "+s"(p)); return p; }
DI Ctx make_ctx(int l) {
    KA ap = ka_ptr(); unsigned char* ws = ap->ws;
    Ctx C; C.l = l; C.Z = (const bf16_t*)(ws + WS_Z); C.LD = (float*)(ws + WS_LD); C.MRG = (bf16_t*)(ws + WS_MRG); C.DS = (float*)(ws + WS_DS); C.SC = (bf16_t*)(ws + WS_SC); C.GL = (float*)(ws + WS_GL);
    C.qnw = ap->in[8] + l * 64; C.knw = ap->in[9] + l * 64; C.sinks = ap->in[10] + l * 8; C.gnw = ap->in[13] + l * 128;
    C.cache_k = ap->in[2]; C.cache_v = ap->in[3]; C.state = ap->in[4]; C.out = ap->out;
    return C;
}
DI RowMap make_rm() { KA ap = ka_ptr(); float* out = ap->out; unsigned char* ws = ap->ws; return RowMap{ap->in[0], ap->in[1], ap->in[5], out + O_YP, out + O_YS, (float*)(ws + WS_XMETA)}; }

__global__ void __launch_bounds__(512, 2) hymba_fwd(Args a) {
    extern __shared__ __attribute__((aligned(16))) unsigned char lds_raw[];
    LAS unsigned char* lds = (LAS unsigned char*)lds_raw;
    const int G = gridDim.x, bx = blockIdx.x; const int wave_s = __builtin_amdgcn_readfirstlane((int)threadIdx.x >> 6);
#define opaque_tid() mk_tid(wave_s)
    const int vcu = (G % 8 == 0) ? (bx % 8) * (G / 8) + bx / 8 : bx;
    const int lo = ka_ptr()->ph_lo, hi = ka_ptr()->ph_hi;
#define IN(k) (lo <= (k) && (k) < hi)
#ifndef FAST_BAR
#define FAST_BAR 1
#endif
    volatile LAS unsigned* MISC = (volatile LAS unsigned*)(lds + 131072 + 320);
    { const int t = opaque_tid(); if (t < 64) MISC[t] = 0u; __syncthreads(); }
    XcdBarrier bar = xcd_barrier_post((unsigned*)ka_ptr()->ws, MISC + 8, opaque_tid() == 0);
#define GSYNC() do { if (FAST_BAR) xcd_barrier(bar, opaque_tid() == 0); else cg::this_grid().sync(); } while (0)
#define SEAM(k) do { if (IN(k) && IN((k) + 1)) { if ((k) == 0) cg::this_grid().sync(); else GSYNC(); } } while (0)
    if (IN(0)) { for (int rep = 0; rep < REP_PRO; ++rep) { const RowMap rm = make_rm(); prologue(ka_ptr(), rm, lds, opaque_tid(), vcu, G); if (rep + 1 < REP_PRO) GSYNC(); }
        for (int xs = 0; xs < XSYNC; ++xs) GSYNC(); }
    SEAM(0);
#pragma unroll 1
    for (int l = 0; l < DEPTH; ++l) {
        const int pb = 1 + 7 * l;
        if (IN(pb + 0)) for (int rep = 0; rep < REP_WIN; ++rep) {
            if (rep) GSYNC();
            KA ap = ka_ptr(); unsigned char* ws = ap->ws; unsigned char* wl = ws + WS_W + (size_t)l * SZ_WL;
            pg8::Gemm g{(const bf16_t*)(ws + WS_XB), (const bf16_t*)wl, MP, NIN, DM}; pg8::StaticOrder S; S.init(MP, NIN, G, bx);
            pg8::EpiIn E{(bf16_t*)(ws + WS_Z), (float*)(ws + WS_LD), (const float*)(ws + WS_SSQA), ap->in[12] + l * 256};
            pg8::gemm_phase<pg8::EpiIn, pg8::StaticOrder, true, true>(lds, g, S, E, opaque_tid());
        }
        SEAM(pb + 0);
        if (IN(pb + 1)) {
            const Ctx C = make_ctx(l);
            constexpr int N1 = 16 * NCH, N2 = DECB, N3 = DECB * 4;
#pragma unroll 1
            for (int u = vcu; u < N1 + N2 + N3; u += G) {
                if (u < N1) { for (int r = 0; r < REP_G1; ++r) gla1_unit(C, u, lds, wave_s); } else if (u < N1 + N2) { for (int r = 0; r < REP_AS; ++r) attn_sample_unit(C, u - N1, lds, wave_s); } else { for (int r = 0; r < REP_GS; ++r) gla_sample_unit(C, u - N1 - N2, lds, wave_s); }
            }
        }
        SEAM(pb + 1);
        if (IN(pb + 2)) for (int rep = 0; rep < REP_SCAN; ++rep) { if (rep) GSYNC(); const Ctx C = make_ctx(l); gla_scan(C, bx * 512 + opaque_tid(), G * 512); }
        SEAM(pb + 2);
        if (IN(pb + 3)) for (int rep = 0; rep < REP_MB; ++rep) {   if (rep) GSYNC();
            const Ctx C = make_ctx(l);
            constexpr int N1 = 16 * NCH, N2 = NBATCH * 2 * 65;
#pragma unroll 1
            for (int u = vcu; u < N1 + N2; u += G) { if (u < N1) { for (int r = 0; r < REP_G3; ++r) gla3_unit(C, u, lds, wave_s); } else { for (int r = 0; r < REP_AP; ++r) attn_prompt_unit(C, u - N1, lds, wave_s); } }
        }
        SEAM(pb + 3);
        if (IN(pb + 4)) for (int rep = 0; rep < (l == 0 ? REP_WO0 : 1); ++rep) {
            if (rep) GSYNC();
            KA ap = ka_ptr(); unsigned char* ws = ap->ws; unsigned char* wl = ws + WS_W + (size_t)l * SZ_WL;
            pg8::Gemm g{(const bf16_t*)(ws + WS_MRG), (const bf16_t*)(wl + SZ_WIN), MP, DM, DM}; pg8::StaticOrder S; S.init(MP, DM, G, bx);
            pg8::EpiRes E{make_rm(), 0, (bf16_t*)(ws + WS_XB), (float*)(ws + WS_SSQB)};
            pg8::gemm_phase<pg8::EpiRes, pg8::StaticOrder, true, true>(lds, g, S, E, opaque_tid());
        }
        SEAM(pb + 4);
        if (IN(pb + 5)) for (int rep = 0; rep < REP_GU; ++rep) {
            if (rep) GSYNC();
            KA ap = ka_ptr(); unsigned char* ws = ap->ws; unsigned char* wl = ws + WS_W + (size_t)l * SZ_WL;
            pg8::Gemm g{(const bf16_t*)(ws + WS_XB), (const bf16_t*)(wl + SZ_WIN + SZ_WO), MP, NGU, DM}; pg8::StaticOrder S; S.init(MP, NGU, G, bx);
            pg8::EpiGU E{(bf16_t*)(ws + WS_U), (const float*)(ws + WS_SSQB)};
            pg8::gemm_phase<pg8::EpiGU, pg8::StaticOrder, true, true>(lds, g, S, E, opaque_tid());
        }
        SEAM(pb + 5);
        if (IN(pb + 6)) {
            KA ap = ka_ptr(); unsigned char* ws = ap->ws; unsigned char* wl = ws + WS_W + (size_t)l * SZ_WL;
            pg8::Gemm g{(const bf16_t*)(ws + WS_U), (const bf16_t*)(wl + SZ_WIN + SZ_WO + SZ_WGU), MP, DM, DFFN}; pg8::StaticOrder S; S.init(MP, DM, G, bx);
            pg8::EpiRes E{make_rm(), l == DEPTH - 1 ? 1 : 0, (bf16_t*)(ws + WS_XB), (float*)(ws + WS_SSQA)};
            pg8::gemm_phase<pg8::EpiRes, pg8::StaticOrder, true, true>(lds, g, S, E, opaque_tid());
        }
        if (l + 1 < DEPTH) SEAM(pb + 6);
    }
#undef IN
#undef SEAM
#undef GSYNC
#undef opaque_tid
}

#ifndef N_LAUNCH_MODE
#define N_LAUNCH_MODE 0
#endif
extern "C" void kernel_launch(void* const* d_in, const int* in_sizes, int n_in, void* d_out, int out_size, void* d_ws, size_t ws_size, hipStream_t stream) {
    static int grid = 0;
    if (grid == 0) {
        if (n_in != 19 || out_size != (int)O_END || ws_size < WS_END) { fprintf(stderr, "kernel_launch: unexpected shapes: n_in %d out %d ws %zu (need %zu)\n", n_in, out_size, ws_size, (size_t)WS_END); grid = -1; return; }
        int dev = 0, cus = 0, per_cu = 0;
        (void)hipGetDevice(&dev); (void)hipDeviceGetAttribute(&cus, hipDeviceAttributeMultiprocessorCount, dev);
        if (hipFuncSetAttribute((const void*)hymba_fwd, hipFuncAttributeMaxDynamicSharedMemorySize, LDS_BYTES) != hipSuccess) { fprintf(stderr, "kernel_launch: hipFuncSetAttribute failed\n"); grid = -1; return; }
        if (hipOccupancyMaxActiveBlocksPerMultiprocessor(&per_cu, (const void*)hymba_fwd, 512, LDS_BYTES) != hipSuccess || per_cu < 1) { fprintf(stderr, "kernel_launch: occupancy query says %d\n", per_cu); per_cu = 1; }
        (void)hipGetLastError();
        grid = cus > 0 ? cus : 256;
    }
    if (grid < 0) return;
    if (hipMemsetAsync(d_ws, 0, 16384, stream) != hipSuccess) { fprintf(stderr, "kernel_launch: memset failed\n"); return; }
    Args a{};
    for (int i = 0; i < 19; ++i) a.in[i] = (const float*)d_in[i];
    a.out = (float*)d_out; a.ws = (unsigned char*)d_ws;
#if N_LAUNCH_MODE == 1
    for (int p = 0; p < NPHASE; ++p) { a.ph_lo = p; a.ph_hi = p + 1; hipLaunchKernelGGL(hymba_fwd, dim3(grid), dim3(512), LDS_BYTES, stream, a); }
#else
    a.ph_lo = 0; a.ph_hi = NPHASE;
    void* args[] = {&a};
    hipError_t e = hipLaunchCooperativeKernel((const void*)hymba_fwd, dim3(grid), dim3(512), args, LDS_BYTES, stream);
    if (e != hipSuccess) fprintf(stderr, "cooperative launch failed: %s (grid %d)\n", hipGetErrorString(e), grid);
#endif
}
```

```cpp
#include <hip/hip_runtime.h>
#include <hip/hip_cooperative_groups.h>
#include <cstdio>
#include <cstdint>
namespace cg = cooperative_groups;

#define DI __device__ __forceinline__
#define LAS __attribute__((address_space(3)))
typedef unsigned short bf16_t;
typedef short bf16x8 __attribute__((ext_vector_type(8)));
typedef float f32x4 __attribute__((ext_vector_type(4)));
typedef float f32x2 __attribute__((ext_vector_type(2)));
typedef unsigned u32x4 __attribute__((ext_vector_type(4)));
typedef unsigned u32x2 __attribute__((ext_vector_type(2)));
typedef __bf16 bf16x2_t __attribute__((ext_vector_type(2)));

constexpr int DM = 1024, NBATCH = 4, SEQ = 4096, LP = 4112  , DEPTH = 2, DECB = 128, DECT = 8;
constexpr int MPROMPT = NBATCH * LP, MREAL = MPROMPT + DECB * DECT, MP = 17664  ;
constexpr int INW = 2320, ZP = 2304, NIN = 2560, DFFN = 2816, NGU = 5632;
constexpr int ZQ = 0, ZK = 512, ZV = 640, ZGQ = 768, ZGK = 1024, ZGV = 1280, ZOG = 1792;
constexpr int NCH = 33;
constexpr float EPS = 1e-6f, LOG2E = 1.4426950408889634f;
constexpr size_t O_YP = 0, O_YS = 16777216, O_CKP = 17825792, O_CVP = 17956864, O_SP = 18087936, O_CKS = 18350080, O_CVS = 22544384, O_SS = 26738688, O_END = 35127296;

DI unsigned pk2(float lo, float hi) { f32x2 v = {lo, hi}; bf16x2_t b = __builtin_convertvector(v, bf16x2_t); return __builtin_bit_cast(unsigned, b); }
DI float bflo(unsigned w) { return __uint_as_float(w << 16); }
DI float bfhi(unsigned w) { return __uint_as_float(w & 0xffff0000u); }
DI float bf2f(bf16_t h) { return __uint_as_float((unsigned)h << 16); }
DI void unpack8(const u32x4 w, float* f) { f[0] = bflo(w.x); f[1] = bfhi(w.x); f[2] = bflo(w.y); f[3] = bfhi(w.y); f[4] = bflo(w.z); f[5] = bfhi(w.z); f[6] = bflo(w.w); f[7] = bfhi(w.w); }
DI float red4rows(float v) {
    auto r = __builtin_amdgcn_permlane16_swap(__float_as_uint(v), __float_as_uint(v), false, false); v = __uint_as_float(r[0]) + __uint_as_float(r[1]);
    auto q = __builtin_amdgcn_permlane32_swap(__float_as_uint(v), __float_as_uint(v), false, false); return __uint_as_float(q[0]) + __uint_as_float(q[1]);
}
DI float max4rows(float v) {
    auto r = __builtin_amdgcn_permlane16_swap(__float_as_uint(v), __float_as_uint(v), false, false); v = fmaxf(__uint_as_float(r[0]), __uint_as_float(r[1]));
    auto q = __builtin_amdgcn_permlane32_swap(__float_as_uint(v), __float_as_uint(v), false, false); return fmaxf(__uint_as_float(q[0]), __uint_as_float(q[1]));
}
template <int M> DI float shx(float v) { return __int_as_float(__builtin_amdgcn_ds_swizzle(__float_as_int(v), 0x1f | (M << 10))); }
DI float sum8(float v) { v += shx<1>(v); v += shx<2>(v); v += shx<4>(v); return v; }
DI float sum64(float v) { v += shx<1>(v); v += shx<2>(v); v += shx<4>(v); v += shx<8>(v); v += shx<16>(v);
    auto q = __builtin_amdgcn_permlane32_swap(__float_as_uint(v), __float_as_uint(v), false, false); return __uint_as_float(q[0]) + __uint_as_float(q[1]); }
DI float silu_f(float x) { return x * __builtin_amdgcn_rcpf(1.0f + __expf(-x)); }

struct RowMap { const float* xp; const float* xs; const float* meta; float* yp; float* ys; float* xmeta; };
DI const float* row_in(const RowMap& rm, int row) {
    if (row < MPROMPT) { const int b = row / LP, p = row - b * LP; return p < 16 ? rm.meta + (size_t)p * DM : rm.xp + ((size_t)b * SEQ + (p - 16)) * DM; }
    if (row < MREAL) return rm.xs + (size_t)(row - MPROMPT) * DM;
    return nullptr;
}
DI float* row_out(const RowMap& rm, int row) {
    if (row < MPROMPT) { const int b = row / LP, p = row - b * LP; return p < 16 ? nullptr : rm.yp + ((size_t)b * SEQ + (p - 16)) * DM; }
    if (row < MREAL) return rm.ys + (size_t)(row - MPROMPT) * DM;
    return nullptr;
}
namespace pg8 {
#define PG8_LAS __attribute__((address_space(3)))
typedef unsigned short bf16_t;
typedef short bf16x8 __attribute__((ext_vector_type(8)));
typedef float f32x4 __attribute__((ext_vector_type(4)));
typedef unsigned u32x4 __attribute__((ext_vector_type(4)));
constexpr int BM = 256, BK = 64, HALF = 128, HTB = HALF * BK * 2  , STAGE_BYTES = 8 * HTB, NXCD = 8, WGM = 8;

__host__ __device__ __forceinline__ int lds_byte(int r, int c) { const int st = (r >> 4) * 2 + (c >> 5), rr = r & 15, cc = c & 31, ob = rr * 64 + cc * 2; return st * 1024 + (ob ^ (((ob >> 9) & 1) << 5)); }
__host__ __device__ __forceinline__ void stage_rc(int b, int& R, int& C) { const int st = b / 1024, sb = b % 1024, swz = sb ^ (((sb >> 9) & 1) << 5); R = (st >> 1) * 16 + swz / 64; C = (st & 1) * 32 + (swz % 64) / 2; }
__host__ __device__ __forceinline__ int perm32(int rho) { const int n = rho >> 4, i = rho & 15; return 8 * (i >> 2) + 4 * n + (i & 3); }

struct Unit { int pm, pn, k0, nk, mode; };
struct Gemm { const bf16_t* A; const bf16_t* Bt; int M, N, K; };

struct StaticOrder {
    static constexpr bool STREAMK = false;
    int nM, nN, nwg, G, c;
    __host__ __device__ void init(int M, int N, int G_, int c_) { nM = M / BM; nN = N / BM; nwg = nM * nN; G = G_; c = c_; }
    __host__ __device__ bool next(int i, Unit& u) const {
        const long L = (long)i * G + c; if (L >= nwg) return false;
        int wgid = (int)L; { const int q = nwg / NXCD, r = nwg % NXCD, xcd = wgid % NXCD, off = wgid / NXCD; wgid = (xcd < r ? xcd * (q + 1) : r * (q + 1) + (xcd - r) * q) + off; }
        const int nig = WGM * nN, gid = wgid / nig, fm = gid * WGM, gsz = (nM - fm) < WGM ? (nM - fm) : WGM;
        u.pm = fm + ((wgid % nig) % gsz); u.pn = (wgid % nig) / gsz; u.k0 = 0; u.nk = 0; u.mode = 0; return true;
    }
    __device__ __forceinline__ void a_ready(const Unit&) const {}
    __device__ __forceinline__ void done(const Unit&) const {}
};


struct StreamK {
    static constexpr bool STREAMK = true;
    int P, r, s, e, nseg; unsigned* flags; unsigned char* part; const unsigned char* zero;
    __device__ __forceinline__ void init(int ntiles, int P_, int G, int r_, unsigned* flags_, unsigned char* part_, const unsigned char* zero_) {
        P = P_; r = r_; flags = flags_; part = part_; zero = zero_; const long TP = (long)ntiles * P; s = (int)(TP * r / G); e = (int)(TP * (r + 1) / G);
        nseg = 0; int cur = s; while (cur < e) { const int kb = cur % P; int ke = kb + (e - cur); ke = ke < P ? ke : P; cur += ke - kb; ++nseg; }
    }
    __device__ __forceinline__ bool next(int i, Unit& u) const {
        if (i >= nseg) return false;
        const int want = nseg - 1 - i; int cur = s, idx = 0;
        for (;;) { const int t = cur / P, kb = cur % P; int ke = kb + (e - cur); ke = ke < P ? ke : P;
            if (idx == want) { u.pm = t >> 2; u.pn = t & 3; u.k0 = 2 * kb; u.nk = 2 * (ke - kb); u.mode = (kb == 0 && ke == P) ? 0 : (kb == 0 ? 1 : 2); return true; }
            cur += ke - kb; ++idx; }
    }
    __device__ __forceinline__ void a_ready(const Unit&) const {}
    __device__ __forceinline__ void done(const Unit&) const {}
};

DI float rstd_from_slots(const float* ssq, int row) {
    const f32x4* p = (const f32x4*)(ssq + (size_t)row * 16);
    const f32x4 a = p[0], b = p[1], c = p[2], d = p[3];
    const float s = ((a[0] + a[1]) + (a[2] + a[3])) + ((b[0] + b[1]) + (b[2] + b[3])) + ((c[0] + c[1]) + (c[2] + c[3])) + ((d[0] + d[1]) + (d[2] + d[3]));
    return rsqrtf(s * (1.0f / 1024.0f) + EPS);
}
DI void rstd8(const float* ssq, int row0, float (&rs)[2][4]) {
#pragma unroll
    for (int ai = 0; ai < 2; ++ai) {
        f32x4 t[4][4];
#pragma unroll
        for (int m = 0; m < 4; ++m) { const f32x4* p = (const f32x4*)(ssq + (size_t)(row0 + ai * HALF + m * 16) * 16); t[m][0] = p[0]; t[m][1] = p[1]; t[m][2] = p[2]; t[m][3] = p[3]; }
#pragma unroll
        for (int m = 0; m < 4; ++m) { const f32x4 q = (t[m][0] + t[m][1]) + (t[m][2] + t[m][3]); rs[ai][m] = rsqrtf(((q[0] + q[1]) + (q[2] + q[3])) * (1.0f / 1024.0f) + EPS); }
        asm volatile("" ::: "memory");
    }
}
struct EpiIn {
    static constexpr bool PERM = true, AFTER_DRAIN = false;
    bf16_t* Z; float* LD; const float* ssq; const float* bg;
    __device__ __forceinline__ void operator()(const f32x4 (&acc)[2][2][4][2], const Unit& u, int wr, int wc, int fr, int fq) const {
        const int row0 = u.pm * BM + wr * 64 + fr;
        float rs[2][4]; rstd8(ssq, row0, rs);
        if (u.pn < 9) {
#pragma unroll
            for (int ai = 0; ai < 2; ++ai)
#pragma unroll
                for (int m = 0; m < 4; ++m) { const int row = row0 + ai * HALF + m * 16; const float r = rs[ai][m];
                    bf16_t* rowp = Z + (size_t)row * ZP + u.pn * BM + wc * 32 + 8 * fq;
#pragma unroll
                    for (int bj = 0; bj < 2; ++bj) { const f32x4 v0 = acc[ai][bj][m][0] * r, v1 = acc[ai][bj][m][1] * r;
                        u32x4 w; w.x = pk2(v0[0], v0[1]); w.y = pk2(v0[2], v0[3]); w.z = pk2(v1[0], v1[1]); w.w = pk2(v1[2], v1[3]);
                        *(u32x4*)(rowp + bj * HALF) = w; } }
        } else {
            const int e0 = wc * 32 + 8 * fq;
#pragma unroll
            for (int bj = 0; bj < 2; ++bj) { const f32x4 b0 = *(const f32x4*)(bg + e0 + bj * HALF), b1 = *(const f32x4*)(bg + e0 + bj * HALF + 4);
#pragma unroll
                for (int ai = 0; ai < 2; ++ai)
#pragma unroll
                    for (int m = 0; m < 4; ++m) { const int row = row0 + ai * HALF + m * 16; const float r = rs[ai][m];
                        const f32x4 x0 = acc[ai][bj][m][0] * r + b0, x1 = acc[ai][bj][m][1] * r + b1; f32x4 o0, o1;
#pragma unroll
                        for (int i = 0; i < 4; ++i) { o0[i] = (fminf(x0[i], 0.f) - __logf(1.0f + __expf(-fabsf(x0[i])))) * 0.0625f; o1[i] = (fminf(x1[i], 0.f) - __logf(1.0f + __expf(-fabsf(x1[i])))) * 0.0625f; }
                        float* lp = LD + (size_t)row * 256 + e0 + bj * HALF; *(f32x4*)lp = o0; *(f32x4*)(lp + 4) = o1; } }
        }
    }
};
struct EpiRes {
    static constexpr bool PERM = true, AFTER_DRAIN = false;
    RowMap rm; int final_; bf16_t* XB; float* ssq; int dry;
    __device__ __forceinline__ void operator()(const f32x4 (&acc)[2][2][4][2], const Unit& u, int wr, int wc, int fr, int fq, const unsigned char* pp) const {
        if (dry) return;
        const int row0 = u.pm * BM + wr * 64 + fr, col0 = u.pn * BM + wc * 32 + 8 * fq;
#pragma unroll
        for (int ai = 0; ai < 2; ++ai)
#pragma unroll
        for (int mh = 0; mh < 2; ++mh) {
            u32x4 res[2][2], par[2][2];
#pragma unroll
            for (int mm = 0; mm < 2; ++mm) { const int row = row0 + ai * HALF + (2 * mh + mm) * 16;
#pragma unroll
                for (int bj = 0; bj < 2; ++bj) { res[mm][bj] = *(const u32x4*)(XB + (size_t)row * DM + col0 + bj * HALF); par[mm][bj] = (u32x4){0u, 0u, 0u, 0u}; } }
            if (pp) {
#pragma unroll
                for (int mm = 0; mm < 2; ++mm)
#pragma unroll
                    for (int bj = 0; bj < 2; ++bj) asm volatile("global_load_dwordx4 %0, %1, off sc0 sc1" : "=v"(par[mm][bj]) : "v"(pp + ((ai * 2 + bj) * 4 + 2 * mh + mm) * 8192) : "memory");
                asm volatile("s_waitcnt vmcnt(0)" : "+v"(par[0][0]), "+v"(par[0][1]), "+v"(par[1][0]), "+v"(par[1][1]) :: "memory");
            }
#pragma unroll
            for (int mm = 0; mm < 2; ++mm) { const int m = 2 * mh + mm; const int row = row0 + ai * HALF + m * 16; float ss = 0.f; float* op = final_ ? row_out(rm, row) : nullptr;
#pragma unroll
                for (int bj = 0; bj < 2; ++bj) { const int col = col0 + bj * HALF; float r[8], q[8]; unpack8(res[mm][bj], r); unpack8(par[mm][bj], q);
                    const f32x4 v0 = (acc[ai][bj][m][0] + (f32x4){q[0], q[1], q[2], q[3]}) + (f32x4){r[0], r[1], r[2], r[3]}, v1 = (acc[ai][bj][m][1] + (f32x4){q[4], q[5], q[6], q[7]}) + (f32x4){r[4], r[5], r[6], r[7]};
                    if (final_) { if (op) { *(f32x4*)(op + col) = v0; *(f32x4*)(op + col + 4) = v1; } }
                    else { u32x4 w; w.x = pk2(v0[0], v0[1]); w.y = pk2(v0[2], v0[3]); w.z = pk2(v1[0], v1[1]); w.w = pk2(v1[2], v1[3]);
                        *(u32x4*)(XB + (size_t)row * DM + col) = w;
                        const f32x4 q0 = {bflo(w.x), bfhi(w.x), bflo(w.y), bfhi(w.y)}, q1 = {bflo(w.z), bfhi(w.z), bflo(w.w), bfhi(w.w)};
                        ss += (q0[0] * q0[0] + q0[1] * q0[1]) + (q0[2] * q0[2] + q0[3] * q0[3]) + (q1[0] * q1[0] + q1[1] * q1[1]) + (q1[2] * q1[2] + q1[3] * q1[3]); } }
                if (!final_) { ss = red4rows(ss); if (fq == 0) ssq[(size_t)row * 16 + u.pn * 4 + wc] = ss; } }
            asm volatile("" ::: "memory");
        }
    }
};
struct EpiGU {
    static constexpr bool PERM = true, AFTER_DRAIN = false;
    bf16_t* U; const float* ssq;
    __device__ __forceinline__ void operator()(const f32x4 (&acc)[2][2][4][2], const Unit& u, int wr, int wc, int fr, int fq) const {
        const int row0 = u.pm * BM + wr * 64 + fr, f0 = u.pn * HALF + wc * 32 + 8 * fq;
        float rs[2][4]; rstd8(ssq, row0, rs);
#pragma unroll
        for (int ai = 0; ai < 2; ++ai)
#pragma unroll
            for (int m = 0; m < 4; ++m) { const int row = row0 + ai * HALF + m * 16; const float r = rs[ai][m];
                float o[8];
#pragma unroll
                for (int n = 0; n < 2; ++n)
#pragma unroll
                    for (int i = 0; i < 4; ++i) { const float g = acc[ai][0][m][n][i] * r, up = acc[ai][1][m][n][i] * r; o[4 * n + i] = silu_f(g) * up; }
                u32x4 w; w.x = pk2(o[0], o[1]); w.y = pk2(o[2], o[3]); w.z = pk2(o[4], o[5]); w.w = pk2(o[6], o[7]);
                *(u32x4*)(U + (size_t)row * DFFN + f0) = w; }
    }
};
template <class Epi, class Sched, bool ALIGN_EPI = false, bool SP2 = false>
__device__ __forceinline__ void gemm_phase(PG8_LAS unsigned char* lds, const Gemm g, const Sched& S, const Epi& E, const int tid_in) {
    const int tid = tid_in, wid = __builtin_amdgcn_readfirstlane(tid >> 6), lane = tid & 63, wr = wid >> 2, wc = wid & 3, fr = lane & 15, fq = lane >> 4;
    const int K = g.K;
    unsigned voffA[2], voffB[2];
#pragma unroll
    for (int i = 0; i < 2; ++i) { int R, C; stage_rc(tid * 16 + i * 8192, R, C); const int Rb = Epi::PERM ? ((R & ~31) + perm32(R & 31)) : R;
        voffA[i] = (unsigned)(R * K + C) * 2u; voffB[i] = (unsigned)(Rb * K + C) * 2u; }
    const size_t kstep = (size_t)(BK * 2);
    const size_t hstep = (size_t)HALF * K * 2;
    const size_t tstep = 2 * hstep;
    const unsigned ldsw = (unsigned)wid * 1024u;
    const int aoff = lds_byte(wr * 64 + fr, fq * 8), boff = lds_byte(wc * 32 + fr, fq * 8);
#define PG8_SA(b, h) (((b) * 2 + (h)) * HTB)
#define PG8_SB(b, h) ((4 + (b) * 2 + (h)) * HTB)
#define PG8_STAGE(bufoff, gbase, voff) do { _Pragma("unroll") for (int _i = 0; _i < 2; ++_i) \
        __builtin_amdgcn_global_load_lds((const unsigned*)((const char*)(gbase) + (voff)[_i]), (PG8_LAS unsigned*)(lds + (bufoff) + ldsw + _i * 8192), 16, 0, 0); } while (0)
#define PG8_LDA(dst, b, h) do { _Pragma("unroll") for (int m = 0; m < 4; ++m) _Pragma("unroll") for (int k = 0; k < 2; ++k) dst[m][k] = *(const PG8_LAS bf16x8*)(lds + PG8_SA(b, h) + aoff + m * 2048 + k * 1024); } while (0)
#define PG8_LDB(dst, b, h) do { _Pragma("unroll") for (int n = 0; n < 2; ++n) _Pragma("unroll") for (int k = 0; k < 2; ++k) dst[n][k] = *(const PG8_LAS bf16x8*)(lds + PG8_SB(b, h) + boff + n * 2048 + k * 1024); } while (0)
#define PG8_MMA(ai, bj, At, Bt) do { __builtin_amdgcn_s_setprio(1); _Pragma("unroll") for (int m = 0; m < 4; ++m) _Pragma("unroll") for (int n = 0; n < 2; ++n) _Pragma("unroll") for (int k = 0; k < 2; ++k) \
        acc[ai][bj][m][n] = __builtin_amdgcn_mfma_f32_16x16x32_bf16(Bt[n][k], At[m][k], acc[ai][bj][m][n], 0, 0, 0); __builtin_amdgcn_s_setprio(0); } while (0)
#define PG8_WAIT_V(n) asm volatile("s_waitcnt vmcnt(" #n ")" ::: "memory")
#define PG8_WAIT_L(n) asm volatile("s_waitcnt lgkmcnt(" #n ")" ::: "memory")
#define PG8_BAR __builtin_amdgcn_s_barrier()
#define PG8_SCHED __builtin_amdgcn_sched_barrier(0)
    Unit cur, nxt; int ui = 0;
    if (!S.next(0, cur)) return;
    f32x4 acc[2][2][4][2];
#pragma unroll
    for (int a = 0; a < 2; ++a)
#pragma unroll
        for (int b = 0; b < 2; ++b)
#pragma unroll
            for (int m = 0; m < 4; ++m)
#pragma unroll
                for (int n = 0; n < 2; ++n) acc[a][b][m][n] = (f32x4){0.f, 0.f, 0.f, 0.f};
    bf16x8 At[4][2], B0[2][2], B1[2][2];
    const char* cA = (const char*)g.A + (size_t)cur.pm * tstep + (size_t)cur.k0 * kstep; const char* cB = (const char*)g.Bt + (size_t)cur.pn * tstep + (size_t)cur.k0 * kstep;
    S.a_ready(cur);
    if constexpr (SP2) {
        PG8_STAGE(PG8_SB(0, 0), cB, voffB); PG8_STAGE(PG8_SB(0, 1), cB + hstep, voffB); PG8_STAGE(PG8_SA(0, 0), cA, voffA); PG8_STAGE(PG8_SA(0, 1), cA + hstep, voffA);
        if (wr == 1) PG8_BAR;
        PG8_WAIT_V(2); PG8_BAR;
        PG8_STAGE(PG8_SB(1, 0), cB + kstep, voffB); PG8_STAGE(PG8_SA(1, 0), cA + kstep, voffA); PG8_STAGE(PG8_SB(1, 1), cB + hstep + kstep, voffB);
        PG8_WAIT_V(6); PG8_BAR;
    } else {
        PG8_STAGE(PG8_SB(0, 0), cB, voffB); PG8_STAGE(PG8_SA(0, 0), cA, voffA); PG8_STAGE(PG8_SB(0, 1), cB + hstep, voffB); PG8_STAGE(PG8_SA(0, 1), cA + hstep, voffA);
        if (wr == 1) PG8_BAR;
        PG8_WAIT_V(4); PG8_BAR;
        PG8_STAGE(PG8_SB(1, 0), cB + kstep, voffB); PG8_STAGE(PG8_SA(1, 0), cA + kstep, voffA); PG8_STAGE(PG8_SB(1, 1), cB + hstep + kstep, voffB);
        PG8_WAIT_V(6); PG8_BAR;
    }
    for (;;) {
        const bool has_next = S.next(ui + 1, nxt);
        const char* nA = has_next ? (const char*)g.A + (size_t)nxt.pm * tstep + (size_t)nxt.k0 * kstep : cA; const char* nB = has_next ? (const char*)g.Bt + (size_t)nxt.pn * tstep + (size_t)nxt.k0 * kstep : cB;
        const int nt = cur.nk ? cur.nk : K / BK;
        for (int t = 0; t < nt; t += 2) {
            const bool last = (t == nt - 2);
            const char* a1 = cA + (size_t)(t + 1) * kstep;
            const char* a2 = last ? nA : cA + (size_t)(t + 2) * kstep; const char* b2 = last ? nB : cB + (size_t)(t + 2) * kstep;
            const char* a3 = a2 + kstep; const char* b3 = b2 + kstep;
            if (last && has_next) S.a_ready(nxt);
            if constexpr (SP2) {
            PG8_LDB(B0, 0, 0); PG8_LDB(B1, 0, 1); PG8_SCHED; PG8_LDA(At, 0, 0); PG8_STAGE(PG8_SA(1, 1), a1 + hstep, voffA);
            PG8_WAIT_V(8); PG8_WAIT_L(0); PG8_BAR; PG8_MMA(0, 0, At, B0); PG8_MMA(0, 1, At, B1); PG8_BAR; PG8_SCHED;
            PG8_LDA(At, 0, 1); PG8_STAGE(PG8_SB(0, 0), b2, voffB); PG8_STAGE(PG8_SB(0, 1), b2 + hstep, voffB); PG8_STAGE(PG8_SA(0, 0), a2, voffA);
            PG8_WAIT_V(8); PG8_WAIT_L(0); PG8_BAR; PG8_MMA(1, 0, At, B0); PG8_MMA(1, 1, At, B1); PG8_BAR; PG8_SCHED;
            PG8_LDB(B0, 1, 0); PG8_LDB(B1, 1, 1); PG8_SCHED; PG8_LDA(At, 1, 0); PG8_STAGE(PG8_SA(0, 1), a2 + hstep, voffA);
            PG8_WAIT_V(8); PG8_WAIT_L(0); PG8_BAR; PG8_MMA(0, 0, At, B0); PG8_MMA(0, 1, At, B1); PG8_BAR; PG8_SCHED;
            PG8_LDA(At, 1, 1); PG8_STAGE(PG8_SB(1, 0), b3, voffB); PG8_STAGE(PG8_SB(1, 1), b3 + hstep, voffB); PG8_STAGE(PG8_SA(1, 0), a3, voffA);
            PG8_WAIT_V(8); PG8_WAIT_L(0); PG8_BAR; PG8_MMA(1, 0, At, B0); PG8_MMA(1, 1, At, B1); PG8_BAR; PG8_SCHED;
            } else {
            PG8_LDB(B0, 0, 0); PG8_SCHED; PG8_LDA(At, 0, 0); PG8_STAGE(PG8_SA(1, 1), a1 + hstep, voffA);
            PG8_WAIT_L(8); PG8_BAR; PG8_WAIT_L(0); PG8_MMA(0, 0, At, B0); PG8_BAR; PG8_SCHED;
            PG8_LDB(B1, 0, 1); PG8_STAGE(PG8_SB(0, 0), b2, voffB);
            PG8_BAR; PG8_WAIT_L(0); PG8_MMA(0, 1, At, B1); PG8_BAR;
            PG8_LDA(At, 0, 1); PG8_STAGE(PG8_SA(0, 0), a2, voffA);
            PG8_BAR; PG8_WAIT_L(0); PG8_MMA(1, 0, At, B0); PG8_BAR; PG8_SCHED;
            PG8_STAGE(PG8_SB(0, 1), b2 + hstep, voffB);
            PG8_WAIT_V(6); PG8_BAR; PG8_MMA(1, 1, At, B1); PG8_BAR;
            PG8_LDB(B0, 1, 0); PG8_SCHED; PG8_LDA(At, 1, 0); PG8_STAGE(PG8_SA(0, 1), a2 + hstep, voffA);
            PG8_WAIT_L(8); PG8_BAR; PG8_WAIT_L(0); PG8_MMA(0, 0, At, B0); PG8_BAR; PG8_SCHED;
            PG8_LDB(B1, 1, 1); PG8_STAGE(PG8_SB(1, 0), b3, voffB);
            PG8_BAR; PG8_WAIT_L(0); PG8_MMA(0, 1, At, B1); PG8_BAR;
            PG8_LDA(At, 1, 1); PG8_STAGE(PG8_SA(1, 0), a3, voffA);
            PG8_BAR; PG8_WAIT_L(0); PG8_MMA(1, 0, At, B0); PG8_BAR; PG8_SCHED;
            PG8_STAGE(PG8_SB(1, 1), b3 + hstep, voffB);
            PG8_WAIT_V(6); PG8_BAR; PG8_MMA(1, 1, At, B1); PG8_BAR;
            }
        }
        if constexpr (ALIGN_EPI) { if (wr == 0) PG8_BAR; }
        int fr2 = fr, fq2 = fq, tid2 = tid; asm volatile("" : "+v"(fr2), "+v"(fq2), "+v"(tid2));
        if constexpr (Sched::STREAMK) {
            if (cur.mode == 1) {
                unsigned char* pp = S.part + (size_t)S.r * 131072 + (size_t)tid2 * 16;
#pragma unroll
                for (int a = 0; a < 2; ++a)
#pragma unroll
                    for (int b = 0; b < 2; ++b)
#pragma unroll
                        for (int m = 0; m < 4; ++m) { u32x4 w; w.x = pk2(acc[a][b][m][0][0], acc[a][b][m][0][1]); w.y = pk2(acc[a][b][m][0][2], acc[a][b][m][0][3]); w.z = pk2(acc[a][b][m][1][0], acc[a][b][m][1][1]); w.w = pk2(acc[a][b][m][1][2], acc[a][b][m][1][3]);
                            asm volatile("global_store_dwordx4 %0, %1, off sc0 sc1" :: "v"(pp + ((a * 2 + b) * 4 + m) * 8192), "v"(w) : "memory"); }
                asm volatile("s_waitcnt vmcnt(0)" ::: "memory");
                if (lane == 0) __hip_atomic_fetch_add(S.flags + 16 * S.r, 1u, __ATOMIC_RELAXED, __HIP_MEMORY_SCOPE_AGENT);
            } else {
                const bool tail = cur.mode == 2;
                if (tail) {
                    unsigned sp = 0;
                    while ((unsigned)__builtin_amdgcn_readfirstlane(__hip_atomic_load(S.flags + 16 * (S.r - 1), __ATOMIC_RELAXED, __HIP_MEMORY_SCOPE_AGENT)) < 8u) { __builtin_amdgcn_s_sleep(2); if (++sp > (1u << 22)) break; }
                }
                const unsigned char* pp = tail ? S.part + (size_t)(S.r - 1) * 131072 + (size_t)tid2 * 16 : nullptr;
                E(acc, cur, wr, wc, fr2, fq2, pp);
            }
        } else
        if constexpr (!Epi::AFTER_DRAIN) { E(acc, cur, wr, wc, fr2, fq2); S.done(cur); }
        if (!has_next) break;
#pragma unroll
        for (int a = 0; a < 2; ++a)
#pragma unroll
            for (int b = 0; b < 2; ++b)
#pragma unroll
                for (int m = 0; m < 4; ++m)
#pragma unroll
                    for (int n = 0; n < 2; ++n) acc[a][b][m][n] = (f32x4){0.f, 0.f, 0.f, 0.f};
        cur = nxt; cA = nA; cB = nB; ++ui;
        if constexpr (ALIGN_EPI) { if (wr == 1) PG8_BAR; }
    }
    PG8_WAIT_V(0);
    if constexpr (!ALIGN_EPI) { if (wr == 0) PG8_BAR; }
    PG8_BAR;
    if constexpr (Epi::AFTER_DRAIN) { E.fused(acc, cur, wr, wc, fr, fq, lds, wid, lane); S.done(cur); }
#undef PG8_SA
#undef PG8_SB
#undef PG8_STAGE
#undef PG8_LDA
#undef PG8_LDB
#undef PG8_MMA
#undef PG8_WAIT_V
#undef PG8_WAIT_L
#undef PG8_BAR
#undef PG8_SCHED
}
}

constexpr size_t SZ_WIN = (size_t)NIN * DM * 2, SZ_WO = (size_t)DM * DM * 2, SZ_WGU = (size_t)NGU * DM * 2, SZ_WD = (size_t)DM * DFFN * 2, SZ_WL = SZ_WIN + SZ_WO + SZ_WGU + SZ_WD;
constexpr size_t WS_CTL = 0;
constexpr size_t WS_FLAGS = 16384;
constexpr size_t WS_ZERO = 16384 + 4 * 256 * 64;
constexpr size_t WS_W = WS_ZERO + 256;
constexpr size_t WS_XB = WS_W + DEPTH * SZ_WL;
constexpr size_t WS_MRG = WS_XB + (size_t)MP * DM * 2;
constexpr size_t WS_Z = WS_MRG + (size_t)MP * DM * 2;
constexpr size_t WS_LD = WS_Z + (size_t)MP * ZP * 2;
constexpr size_t WS_U = WS_Z;
constexpr size_t WS_DS = WS_LD + (size_t)MP * 256 * 4;
constexpr size_t WS_SC = WS_DS + (size_t)16 * NCH * 64 * 128 * 4;
constexpr size_t WS_GL = WS_SC + (size_t)16 * NCH * 64 * 128 * 2;
constexpr size_t WS_SSQA = WS_GL + (size_t)16 * NCH * 64 * 4;
constexpr size_t WS_SSQB = WS_SSQA + (size_t)MP * 16 * 4;
constexpr size_t WS_XMETA = WS_SSQB + (size_t)MP * 16 * 4;
constexpr size_t WS_END = WS_XMETA + (size_t)64 * DM * 4;
static_assert((size_t)MP * DFFN * 2 <= (size_t)MP * ZP * 2 + (size_t)MP * 256 * 4, "U overlay fits Z|LD");
static_assert(WS_END <= 268435456ull, "workspace map fits 256 MiB");

#ifndef REP_PRO
#define REP_PRO 1
#endif
#ifndef REP_WIN
#define REP_WIN 1
#endif
#ifndef REP_MB
#define REP_MB 1
#endif
#ifndef REP_SCAN
#define REP_SCAN 1
#endif
#ifndef REP_GU
#define REP_GU 1
#endif
#ifndef REP_G1
#define REP_G1 1
#endif
#ifndef REP_AS
#define REP_AS 1
#endif
#ifndef REP_GS
#define REP_GS 1
#endif
#ifndef REP_G3
#define REP_G3 1
#endif
#ifndef REP_AP
#define REP_AP 1
#endif
#ifndef REP_WO0
#define REP_WO0 1
#endif
#ifndef DRY_WO
#define DRY_WO 0
#endif
#ifndef DRY_DN
#define DRY_DN 0
#endif
#ifndef XSYNC
#define XSYNC 0
#endif
constexpr int LDS_BYTES = 147456;
constexpr int NPHASE = 1 + 7 * DEPTH;

struct Args { const float* in[19]; float* out; unsigned char* ws; int ph_lo, ph_hi; };
typedef const __attribute__((address_space(4))) Args* KA;
DI KA ka_ptr() { KA p = (KA)__builtin_amdgcn_kernarg_segment_ptr(); asm volatile("" : "+s"(p)); return p; }

DI int mk_tid(int wave_s) { int lane; asm volatile("v_mbcnt_lo_u32_b32 %0, -1, 0\n\tv_mbcnt_hi_u32_b32 %0, -1, %0" : "=v"(lane)); return wave_s * 64 + lane; }
DI bf16x8 mk8(u32x2 lo, u32x2 hi) { u32x4 w; w.x = lo.x; w.y = lo.y; w.z = hi.x; w.w = hi.y; return __builtin_bit_cast(bf16x8, w); }
#define MFMA16(a, b, c) __builtin_amdgcn_mfma_f32_16x16x32_bf16((a), (b), (c), 0, 0, 0)

DI void attn_wave(const LAS unsigned char* Ks, const LAS unsigned char* Vt, const int VPB, const bf16_t* qrow, const float* qnw, const float sink2, const int jmin, const int c, const int fq, bf16_t* orow) {
    float qf[16];
    if (qrow) { const u32x4 a = *(const u32x4*)(qrow + 8 * fq), b = *(const u32x4*)(qrow + 32 + 8 * fq); unpack8(a, qf); unpack8(b, qf + 8); }
    else {
#pragma unroll
        for (int i = 0; i < 16; ++i) qf[i] = 0.f; }
    float ss = 0.f;
#pragma unroll
    for (int i = 0; i < 16; ++i) ss += qf[i] * qf[i];
    ss = red4rows(ss);
    const float rs = rsqrtf(ss * (1.0f / 64.0f) + EPS) * (0.125f * LOG2E);
    const f32x4 w0 = *(const f32x4*)(qnw + 8 * fq), w1 = *(const f32x4*)(qnw + 8 * fq + 4), w2 = *(const f32x4*)(qnw + 32 + 8 * fq), w3 = *(const f32x4*)(qnw + 36 + 8 * fq);
#pragma unroll
    for (int i = 0; i < 4; ++i) { qf[i] *= rs * w0[i]; qf[4 + i] *= rs * w1[i]; qf[8 + i] *= rs * w2[i]; qf[12 + i] *= rs * w3[i]; }
    u32x4 q0, q1; q0.x = pk2(qf[0], qf[1]); q0.y = pk2(qf[2], qf[3]); q0.z = pk2(qf[4], qf[5]); q0.w = pk2(qf[6], qf[7]);
    q1.x = pk2(qf[8], qf[9]); q1.y = pk2(qf[10], qf[11]); q1.z = pk2(qf[12], qf[13]); q1.w = pk2(qf[14], qf[15]);
    const bf16x8 qB0 = __builtin_bit_cast(bf16x8, q0), qB1 = __builtin_bit_cast(bf16x8, q1);
    f32x4 acc[9];
    float mx = sink2;
#pragma unroll
    for (int T = 0; T < 9; ++T) {
        const LAS unsigned char* kp = Ks + (16 * T + c) * 144 + 16 * fq;
        const bf16x8 a0 = *(const LAS bf16x8*)kp, a1 = *(const LAS bf16x8*)(kp + 64);
        f32x4 s = {0.f, 0.f, 0.f, 0.f};
        s = MFMA16(a0, qB0, s); s = MFMA16(a1, qB1, s);
#pragma unroll
        for (int r = 0; r < 4; ++r) { const int jrel = 16 * T + 4 * fq + r, d = 128 + c - jrel; const bool ok = ((unsigned)d < 128u) && (jrel >= jmin); s[r] = ok ? s[r] : -1e30f; mx = fmaxf(mx, s[r]); }
        acc[T] = s;
    }
    mx = max4rows(mx);
    float sum = 0.f;
#pragma unroll
    for (int T = 0; T < 9; ++T)
#pragma unroll
        for (int r = 0; r < 4; ++r) { const float p = __builtin_amdgcn_exp2f(acc[T][r] - mx); acc[T][r] = p; sum += p; }
    sum = red4rows(sum);
    const float inv = 1.0f / (sum + __builtin_amdgcn_exp2f(sink2 - mx));
    f32x4 o[4];
#pragma unroll
    for (int i = 0; i < 4; ++i) o[i] = (f32x4){0.f, 0.f, 0.f, 0.f};
#pragma unroll
    for (int kk = 0; kk < 5; ++kk) {
        u32x4 pw; pw.x = pk2(acc[2 * kk][0], acc[2 * kk][1]); pw.y = pk2(acc[2 * kk][2], acc[2 * kk][3]);
        if (kk < 4) { pw.z = pk2(acc[2 * kk + 1][0], acc[2 * kk + 1][1]); pw.w = pk2(acc[2 * kk + 1][2], acc[2 * kk + 1][3]); } else { pw.z = 0u; pw.w = 0u; }
        const bf16x8 pB = __builtin_bit_cast(bf16x8, pw);
#pragma unroll
        for (int Mt = 0; Mt < 4; ++Mt) {
            const LAS unsigned char* vp = Vt + (16 * Mt + c) * VPB + (32 * kk + 4 * fq) * 2;
            const u32x2 lo = *(const LAS u32x2*)vp, hi = *(const LAS u32x2*)(vp + 32);
            o[Mt] = MFMA16(mk8(lo, hi), pB, o[Mt]);
        }
    }
    if (orow) {
#pragma unroll
        for (int Mt = 0; Mt < 4; ++Mt) { u32x2 w; w.x = pk2(o[Mt][0] * inv, o[Mt][1] * inv); w.y = pk2(o[Mt][2] * inv, o[Mt][3] * inv); *(u32x2*)(orow + 16 * Mt + 4 * fq) = w; }
    }
}

struct Ctx {
    int l;
    const bf16_t* Z; float* LD; bf16_t* MRG; float* DS; bf16_t* SC; float* GL;
    const float *qnw, *knw, *sinks, *gnw;
    const float *cache_k, *cache_v, *state;
    float* out;
};

DI void attn_prompt_unit(const Ctx& C, int uidx, LAS unsigned char* lds, const int wave_s) {
    const int tid = mk_tid(wave_s);
    const int jb = uidx % 65, g = (uidx / 65) & 1, b = uidx / 130;
    const int p0 = 64 * jb, kbase = p0 - 128, rowbase = b * LP, nq = (LP - p0) < 64 ? (LP - p0) : 64;
    LAS unsigned char* Ks = lds; LAS unsigned char* Vt = lds + 208 * 144;
    const int lane = tid & 63, w = tid >> 6;
    {
        const int dc = tid & 7;
        const f32x4 kw0 = *(const f32x4*)(C.knw + dc * 8), kw1 = *(const f32x4*)(C.knw + dc * 8 + 4);
#pragma unroll
        for (int i = 0; i < 4; ++i) { const int j = (tid >> 3) + 64 * i, kp = kbase + j; const bool valid = (j < 192) && (kp >= 0) && (kp < LP);
            u32x4 raw = {0u, 0u, 0u, 0u}; if (valid) raw = *(const u32x4*)(C.Z + (size_t)(rowbase + kp) * ZP + ZK + g * 64 + dc * 8);
            float f[8]; unpack8(raw, f); float ss = 0.f;
#pragma unroll
            for (int e = 0; e < 8; ++e) ss += f[e] * f[e];
            ss = sum8(ss);
            const float rs = rsqrtf(ss * (1.0f / 64.0f) + EPS);
#pragma unroll
            for (int e = 0; e < 4; ++e) { f[e] *= rs * kw0[e]; f[4 + e] *= rs * kw1[e]; }
            if (j < 208) { u32x4 o; o.x = pk2(f[0], f[1]); o.y = pk2(f[2], f[3]); o.z = pk2(f[4], f[5]); o.w = pk2(f[6], f[7]); *(LAS u32x4*)(Ks + j * 144 + dc * 16) = o; }
            if (valid && j >= 128 && kp >= LP - 128) { float* op = C.out + O_CKP + ((size_t)((C.l * NBATCH + b) * 128 + (kp - (LP - 128))) * 2 + g) * 64 + dc * 8;
                *(f32x4*)op = (f32x4){f[0], f[1], f[2], f[3]}; *(f32x4*)(op + 4) = (f32x4){f[4], f[5], f[6], f[7]}; } asm volatile("" ::: "memory"); }
    }
    {
        const int dc = w;
#pragma unroll
        for (int i = 0; i < 4; ++i) { const int j = lane + 64 * i, kp = kbase + j; const bool valid = (j < 192) && (kp >= 0) && (kp < LP);
            u32x4 raw = {0u, 0u, 0u, 0u}; if (valid) raw = *(const u32x4*)(C.Z + (size_t)(rowbase + kp) * ZP + ZV + g * 64 + dc * 8);
            if (j < 216) { LAS bf16_t* vp = (LAS bf16_t*)(Vt + (dc * 8) * 432 + j * 2);
                vp[0 * 216] = (bf16_t)(raw.x & 0xffffu); vp[1 * 216] = (bf16_t)(raw.x >> 16); vp[2 * 216] = (bf16_t)(raw.y & 0xffffu); vp[3 * 216] = (bf16_t)(raw.y >> 16);
                vp[4 * 216] = (bf16_t)(raw.z & 0xffffu); vp[5 * 216] = (bf16_t)(raw.z >> 16); vp[6 * 216] = (bf16_t)(raw.w & 0xffffu); vp[7 * 216] = (bf16_t)(raw.w >> 16); }
            if (valid && j >= 128 && kp >= LP - 128) { float f[8]; unpack8(raw, f); float* op = C.out + O_CVP + ((size_t)((C.l * NBATCH + b) * 128 + (kp - (LP - 128))) * 2 + g) * 64 + dc * 8;
                *(f32x4*)op = (f32x4){f[0], f[1], f[2], f[3]}; *(f32x4*)(op + 4) = (f32x4){f[4], f[5], f[6], f[7]}; } asm volatile("" ::: "memory"); }
    }
    __syncthreads();
    {
        const int tid2 = mk_tid(wave_s), lane = tid2 & 63, w = tid2 >> 6;
        const int s = w & 3, hp = w >> 2, c = lane & 15, fq = lane >> 4;
        if (16 * s < nq) {
#pragma unroll 1
            for (int hh = 0; hh < 2; ++hh) { const int h = g * 4 + hp * 2 + hh, qp = p0 + 16 * s + c; const bool qv = qp < LP;
                const bf16_t* qrow = qv ? C.Z + (size_t)(rowbase + qp) * ZP + ZQ + h * 64 : nullptr;
                bf16_t* orow = qv ? C.MRG + (size_t)(rowbase + qp) * DM + h * 64 : nullptr;
                attn_wave(Ks + 16 * s * 144, Vt + 16 * s * 2, 432, qrow, C.qnw, C.sinks[h] * LOG2E, 128 - p0 - 16 * s, c, fq, orow); }
        }
    }
    __syncthreads();
}

DI void attn_sample_unit(const Ctx& C, int b, LAS unsigned char* lds, const int wave_s) {
    const int tid = mk_tid(wave_s);
    const int lane = tid & 63, w = tid >> 6;
    constexpr int KSG = 160 * 144, VTG = 64 * 336, VT0 = 2 * KSG;
    const int row0 = MPROMPT + b * DECT;
    const size_t cbase = (size_t)(C.l * DECB + b) * 128;
#pragma unroll
    for (int i = 0; i < 4; ++i) {
        const int idx = tid + 512 * i, dc = idx & 7, j = (idx >> 3) & 127, g = idx >> 10;
        const float* sp = C.cache_k + ((cbase + j) * 2 + g) * 64 + dc * 8; const f32x4 a = *(const f32x4*)sp, bq = *(const f32x4*)(sp + 4);
        u32x4 o; o.x = pk2(a[0], a[1]); o.y = pk2(a[2], a[3]); o.z = pk2(bq[0], bq[1]); o.w = pk2(bq[2], bq[3]);
        *(LAS u32x4*)(lds + g * KSG + j * 144 + dc * 16) = o;
        if (j >= 8) { float* op = C.out + O_CKS + ((cbase + j - 8) * 2 + g) * 64 + dc * 8; *(f32x4*)op = a; *(f32x4*)(op + 4) = bq; }
        asm volatile("" ::: "memory");
    }
    if (w < 2) {
        const int dc = tid & 7, t = (tid >> 3) & 7, g = tid >> 6;
        const u32x4 raw = *(const u32x4*)(C.Z + (size_t)(row0 + t) * ZP + ZK + g * 64 + dc * 8);
        float f[8]; unpack8(raw, f); float ss = 0.f;
#pragma unroll
        for (int e = 0; e < 8; ++e) ss += f[e] * f[e];
        ss = sum8(ss);
        const float rs = rsqrtf(ss * (1.0f / 64.0f) + EPS);
        const f32x4 kw0 = *(const f32x4*)(C.knw + dc * 8), kw1 = *(const f32x4*)(C.knw + dc * 8 + 4);
#pragma unroll
        for (int e = 0; e < 4; ++e) { f[e] *= rs * kw0[e]; f[4 + e] *= rs * kw1[e]; }
        u32x4 o; o.x = pk2(f[0], f[1]); o.y = pk2(f[2], f[3]); o.z = pk2(f[4], f[5]); o.w = pk2(f[6], f[7]);
        *(LAS u32x4*)(lds + g * KSG + (128 + t) * 144 + dc * 16) = o;
        float* op = C.out + O_CKS + ((cbase + 120 + t) * 2 + g) * 64 + dc * 8;
        *(f32x4*)op = (f32x4){f[0], f[1], f[2], f[3]}; *(f32x4*)(op + 4) = (f32x4){f[4], f[5], f[6], f[7]};
    } else if (w < 8) {
        const int idx = tid - 128, dc = idx & 7, r = (idx >> 3) % 24, g = idx / 192;
        unsigned z0 = 0u; asm volatile("" : "+v"(z0)); *(LAS u32x4*)(lds + g * KSG + (136 + r) * 144 + dc * 16) = (u32x4){z0, z0, z0, z0};
    }
#pragma unroll
    for (int i = 0; i < 4; ++i) {
        const int idx = tid + 512 * i, j = idx & 127, dc = (idx >> 7) & 7, g = idx >> 10;
        const float* sp = C.cache_v + ((cbase + j) * 2 + g) * 64 + dc * 8; const f32x4 a = *(const f32x4*)sp, bq = *(const f32x4*)(sp + 4);
        LAS bf16_t* vp = (LAS bf16_t*)(lds + VT0 + g * VTG + (dc * 8) * 336 + j * 2);
        const unsigned p0 = pk2(a[0], a[1]), p1 = pk2(a[2], a[3]), p2 = pk2(bq[0], bq[1]), p3 = pk2(bq[2], bq[3]);
        vp[0 * 168] = (bf16_t)(p0 & 0xffffu); vp[1 * 168] = (bf16_t)(p0 >> 16); vp[2 * 168] = (bf16_t)(p1 & 0xffffu); vp[3 * 168] = (bf16_t)(p1 >> 16);
        vp[4 * 168] = (bf16_t)(p2 & 0xffffu); vp[5 * 168] = (bf16_t)(p2 >> 16); vp[6 * 168] = (bf16_t)(p3 & 0xffffu); vp[7 * 168] = (bf16_t)(p3 >> 16);
        if (j >= 8) { float* op = C.out + O_CVS + ((cbase + j - 8) * 2 + g) * 64 + dc * 8; *(f32x4*)op = a; *(f32x4*)(op + 4) = bq; }
        asm volatile("" ::: "memory");
    }
    if (tid < 128) {
        const int t = tid & 7, dc = (tid >> 3) & 7, g = tid >> 6;
        const u32x4 raw = *(const u32x4*)(C.Z + (size_t)(row0 + t) * ZP + ZV + g * 64 + dc * 8);
        LAS bf16_t* vp = (LAS bf16_t*)(lds + VT0 + g * VTG + (dc * 8) * 336 + (128 + t) * 2);
        vp[0 * 168] = (bf16_t)(raw.x & 0xffffu); vp[1 * 168] = (bf16_t)(raw.x >> 16); vp[2 * 168] = (bf16_t)(raw.y & 0xffffu); vp[3 * 168] = (bf16_t)(raw.y >> 16);
        vp[4 * 168] = (bf16_t)(raw.z & 0xffffu); vp[5 * 168] = (bf16_t)(raw.z >> 16); vp[6 * 168] = (bf16_t)(raw.w & 0xffffu); vp[7 * 168] = (bf16_t)(raw.w >> 16);
        float f[8]; unpack8(raw, f); float* op = C.out + O_CVS + ((cbase + 120 + t) * 2 + g) * 64 + dc * 8;
        *(f32x4*)op = (f32x4){f[0], f[1], f[2], f[3]}; *(f32x4*)(op + 4) = (f32x4){f[4], f[5], f[6], f[7]};
    }
#pragma unroll
    for (int i = 0; i < 2; ++i) {
        const int idx = tid + 512 * i, part = idx & 7, d = (idx >> 3) & 63, g = idx >> 9;
        unsigned z0 = 0u; asm volatile("" : "+v"(z0)); *(LAS u32x2*)(lds + VT0 + g * VTG + d * 336 + 272 + part * 8) = (u32x2){z0, z0};
    }
    __syncthreads();
    {
        const int tid2 = mk_tid(wave_s), lane = tid2 & 63, w = tid2 >> 6;
        const int g = w >> 2, h = w, c = lane & 15, fq = lane >> 4;
        const bool qv = c < 8;
        const bf16_t* qrow = qv ? C.Z + (size_t)(row0 + c) * ZP + ZQ + h * 64 : nullptr;
        bf16_t* orow = qv ? C.MRG + (size_t)(row0 + c) * DM + h * 64 : nullptr;
        attn_wave(lds + g * KSG, lds + VT0 + g * VTG, 336, qrow, C.qnw, C.sinks[h] * LOG2E, 0, c, fq, orow);
    }
    __syncthreads();
}

DI void gla_sample_unit(const Ctx& C, int uidx, LAS unsigned char* lds, const int wave_s) {
    const int tid = mk_tid(wave_s);
    const int h = uidx & 3, b = uidx >> 2, row0 = MPROMPT + b * DECT;
    LAS float* qs = (LAS float*)lds; LAS float* ks = qs + 512; LAS float* dec = ks + 512; LAS float* vs = dec + 512; LAS float* red = vs + 1024;
    {
        const int t = tid >> 6, k = tid & 63; const bf16_t* zr = C.Z + (size_t)(row0 + t) * ZP;
        qs[tid] = bf2f(zr[ZGQ + h * 64 + k]); ks[tid] = bf2f(zr[ZGK + h * 64 + k]); dec[tid] = __expf(C.LD[(size_t)(row0 + t) * 256 + h * 64 + k]);
#pragma unroll
        for (int i = 0; i < 2; ++i) { const int idx = tid + 512 * i, tt = idx >> 7, v = idx & 127; vs[idx] = bf2f(C.Z[(size_t)(row0 + tt) * ZP + ZGV + h * 128 + v]); }
    }
    const int v = tid & 127, kq = tid >> 7;
    const size_t sbase = ((size_t)((C.l * DECB + b) * 4 + h) * 64 + 16 * kq) * 128 + v;
    float S[16];
#pragma unroll
    for (int i = 0; i < 16; ++i) S[i] = C.state[sbase + (size_t)i * 128];
    __syncthreads();
#pragma unroll
    for (int t = 0; t < 8; ++t) { float a = 0.f; const float vv = vs[t * 128 + v];
#pragma unroll
        for (int i = 0; i < 16; ++i) { const int k = 16 * kq + i; S[i] = dec[t * 64 + k] * S[i] + ks[t * 64 + k] * vv; a += qs[t * 64 + k] * S[i]; }
        red[(kq * 8 + t) * 128 + v] = a; }
    float* so = C.out + O_SS + sbase;
#pragma unroll
    for (int i = 0; i < 16; ++i) so[(size_t)i * 128] = S[i];
    __syncthreads();
    {
        const int t = tid >> 6, lane = tid & 63; float o[2]; float ss = 0.f;
#pragma unroll
        for (int i = 0; i < 2; ++i) { const int vv = lane + 64 * i; o[i] = (red[(0 * 8 + t) * 128 + vv] + red[(1 * 8 + t) * 128 + vv]) + (red[(2 * 8 + t) * 128 + vv] + red[(3 * 8 + t) * 128 + vv]); ss += o[i] * o[i]; }
        ss = sum64(ss);
        const float rs = rsqrtf(ss * (1.0f / 128.0f) + EPS);
#pragma unroll
        for (int i = 0; i < 2; ++i) { const int vv = lane + 64 * i; const float og = bf2f(C.Z[(size_t)(row0 + t) * ZP + ZOG + h * 128 + vv]);
            const float y = o[i] * rs * C.gnw[vv] * silu_f(og); C.MRG[(size_t)(row0 + t) * DM + 512 + h * 128 + vv] = (bf16_t)(pk2(y, 0.f) & 0xffffu); }
    }
    __syncthreads();
}

DI float gla_prefix(const float* LD, int r0, int nv, int h, LAS float* Gs, LAS float* segtot, int lane, int w) {
    const int k = lane, seg = w; float g[16];
#pragma unroll
    for (int i = 0; i < 16; ++i) { const int t = 16 * seg + i; g[i] = t < nv ? LD[(size_t)(r0 + t) * 256 + h * 64 + k] : 0.f; }
#pragma unroll
    for (int i = 1; i < 16; ++i) g[i] += g[i - 1];
    segtot[seg * 64 + k] = g[15];
    __syncthreads();
    float off = 0.f, tot = 0.f;
#pragma unroll
    for (int s = 0; s < 8; ++s) { const float x = segtot[s * 64 + k]; off += (s < seg) ? x : 0.f; tot += x; }
#pragma unroll
    for (int i = 0; i < 16; ++i) { const int t = 16 * seg + i; Gs[t * 65 + k] = g[i] + off; }
    return tot;
}

DI void gla1_unit(const Ctx& C, int unit, LAS unsigned char* lds, const int wave_s) {
    const int tid = mk_tid(wave_s);
    const int c = unit % NCH, bh = unit / NCH, h = bh & 3, b = bh >> 2;
    const int r0 = b * LP + 128 * c, nv = (LP - 128 * c) < 128 ? (LP - 128 * c) : 128;
    LAS float* Gs = (LAS float*)lds; LAS float* segtot = (LAS float*)(lds + 33280); LAS float* gl = (LAS float*)(lds + 35328);
    LAS unsigned char* kdT = lds + 35840; LAS unsigned char* vT = lds + 53248;
    const int lane = tid & 63, w = tid >> 6;
    { const float tot = gla_prefix(C.LD, r0, nv, h, Gs, segtot, lane, w); if (w == 0) { gl[lane] = tot; C.GL[(size_t)unit * 64 + lane] = tot; } }
    __syncthreads();
    {
        const int t = tid & 127;
#pragma unroll
        for (int i = 0; i < 2; ++i) { const int kc = (tid >> 7) + 4 * i; u32x4 raw = {0u, 0u, 0u, 0u};
            if (t < nv) raw = *(const u32x4*)(C.Z + (size_t)(r0 + t) * ZP + ZGK + h * 64 + kc * 8);
            float f[8]; unpack8(raw, f);
#pragma unroll
            for (int e = 0; e < 8; ++e) { const float kd = f[e] * __expf(gl[kc * 8 + e] - Gs[t * 65 + kc * 8 + e]); *(LAS bf16_t*)(kdT + (kc * 8 + e) * 272 + t * 2) = (bf16_t)(pk2(kd, 0.f) & 0xffffu); } }
#pragma unroll
        for (int i = 0; i < 4; ++i) { const int vc = (tid >> 7) + 4 * i; u32x4 raw = {0u, 0u, 0u, 0u};
            if (t < nv) raw = *(const u32x4*)(C.Z + (size_t)(r0 + t) * ZP + ZGV + h * 128 + vc * 8);
            LAS bf16_t* vp = (LAS bf16_t*)(vT + (vc * 8) * 272 + t * 2);
            vp[0 * 136] = (bf16_t)(raw.x & 0xffffu); vp[1 * 136] = (bf16_t)(raw.x >> 16); vp[2 * 136] = (bf16_t)(raw.y & 0xffffu); vp[3 * 136] = (bf16_t)(raw.y >> 16);
            vp[4 * 136] = (bf16_t)(raw.z & 0xffffu); vp[5 * 136] = (bf16_t)(raw.z >> 16); vp[6 * 136] = (bf16_t)(raw.w & 0xffffu); vp[7 * 136] = (bf16_t)(raw.w >> 16); }
    }
    __syncthreads();
    {
        const int cc = lane & 15, fq = lane >> 4;
#pragma unroll
        for (int kt = 0; kt < 4; ++kt) { f32x4 acc = {0.f, 0.f, 0.f, 0.f};
#pragma unroll
            for (int ks = 0; ks < 4; ++ks) { const bf16x8 a = *(const LAS bf16x8*)(kdT + (16 * kt + cc) * 272 + (32 * ks + 8 * fq) * 2), bb = *(const LAS bf16x8*)(vT + (16 * w + cc) * 272 + (32 * ks + 8 * fq) * 2); acc = MFMA16(a, bb, acc); }
#pragma unroll
            for (int r = 0; r < 4; ++r) C.DS[((size_t)unit * 64 + 16 * kt + 4 * fq + r) * 128 + 16 * w + cc] = acc[r]; }
    }
    __syncthreads();
}

DI void gla3_unit(const Ctx& C, int unit, LAS unsigned char* lds, const int wave_s) {
    const int tid = mk_tid(wave_s);
    const int c = unit % NCH, bh = unit / NCH, h = bh & 3, b = bh >> 2;
    const int r0 = b * LP + 128 * c, nv = (LP - 128 * c) < 128 ? (LP - 128 * c) : 128;
    LAS unsigned char* qg = lds; LAS unsigned char* kg = lds + 18432; LAS unsigned char* vT = lds + 36864; LAS unsigned char* ScT = lds + 71680;
    LAS float* Gs = (LAS float*)(lds + 90112); LAS float* segtot = (LAS float*)(lds + 123392);
    const int lane = tid & 63, w = __builtin_amdgcn_readfirstlane(tid >> 6);
    (void)gla_prefix(C.LD, r0, nv, h, Gs, segtot, lane, w);
    __syncthreads();
    {
        const int kc = tid & 7;
#pragma unroll
        for (int i = 0; i < 2; ++i) { const int t = (tid >> 3) + 64 * i; u32x4 rq = {0u, 0u, 0u, 0u}, rk = {0u, 0u, 0u, 0u}; f32x4 g0 = {0.f, 0.f, 0.f, 0.f}, g1 = g0;
            if (t < nv) { const bf16_t* zr = C.Z + (size_t)(r0 + t) * ZP + h * 64 + kc * 8; rq = *(const u32x4*)(zr + ZGQ); rk = *(const u32x4*)(zr + ZGK);
                const LAS float* gp = Gs + t * 65 + kc * 8; g0 = (f32x4){gp[0], gp[1], gp[2], gp[3]}; g1 = (f32x4){gp[4], gp[5], gp[6], gp[7]}; }
            float fq_[8], fk_[8]; unpack8(rq, fq_); unpack8(rk, fk_);
#pragma unroll
            for (int e = 0; e < 4; ++e) { const float e0 = __expf(g0[e]), e1 = __expf(g1[e]); fq_[e] *= e0; fq_[4 + e] *= e1; fk_[e] *= __builtin_amdgcn_rcpf(e0); fk_[4 + e] *= __builtin_amdgcn_rcpf(e1); }
            u32x4 oq, ok; oq.x = pk2(fq_[0], fq_[1]); oq.y = pk2(fq_[2], fq_[3]); oq.z = pk2(fq_[4], fq_[5]); oq.w = pk2(fq_[6], fq_[7]);
            ok.x = pk2(fk_[0], fk_[1]); ok.y = pk2(fk_[2], fk_[3]); ok.z = pk2(fk_[4], fk_[5]); ok.w = pk2(fk_[6], fk_[7]);
            *(LAS u32x4*)(qg + t * 144 + kc * 16) = oq; *(LAS u32x4*)(kg + t * 144 + kc * 16) = ok; }
        const int t = tid & 127;
#pragma unroll
        for (int i = 0; i < 4; ++i) { const int vc = (tid >> 7) + 4 * i; u32x4 raw = {0u, 0u, 0u, 0u};
            if (t < nv) raw = *(const u32x4*)(C.Z + (size_t)(r0 + t) * ZP + ZGV + h * 128 + vc * 8);
            LAS bf16_t* vp = (LAS bf16_t*)(vT + (vc * 8) * 272 + t * 2);
            vp[0 * 136] = (bf16_t)(raw.x & 0xffffu); vp[1 * 136] = (bf16_t)(raw.x >> 16); vp[2 * 136] = (bf16_t)(raw.y & 0xffffu); vp[3 * 136] = (bf16_t)(raw.y >> 16);
            vp[4 * 136] = (bf16_t)(raw.z & 0xffffu); vp[5 * 136] = (bf16_t)(raw.z >> 16); vp[6 * 136] = (bf16_t)(raw.w & 0xffffu); vp[7 * 136] = (bf16_t)(raw.w >> 16); }
        const int k = tid & 63;
#pragma unroll
        for (int i = 0; i < 2; ++i) { const int vc = (tid >> 6) + 8 * i; const u32x4 raw = *(const u32x4*)(C.SC + ((size_t)unit * 64 + k) * 128 + vc * 8);
            LAS bf16_t* sp = (LAS bf16_t*)(ScT + (vc * 8) * 144 + k * 2);
            sp[0 * 72] = (bf16_t)(raw.x & 0xffffu); sp[1 * 72] = (bf16_t)(raw.x >> 16); sp[2 * 72] = (bf16_t)(raw.y & 0xffffu); sp[3 * 72] = (bf16_t)(raw.y >> 16);
            sp[4 * 72] = (bf16_t)(raw.z & 0xffffu); sp[5 * 72] = (bf16_t)(raw.z >> 16); sp[6 * 72] = (bf16_t)(raw.w & 0xffffu); sp[7 * 72] = (bf16_t)(raw.w >> 16); }
    }
    __syncthreads();
    {
        const int cc = lane & 15, fq = lane >> 4;
        const bf16x8 qB0 = *(const LAS bf16x8*)(qg + (16 * w + cc) * 144 + 16 * fq), qB1 = *(const LAS bf16x8*)(qg + (16 * w + cc) * 144 + 64 + 16 * fq);
        f32x4 A[8];
#pragma unroll
        for (int T = 0; T < 8; ++T) { f32x4 s = {0.f, 0.f, 0.f, 0.f};
            if (T <= w) { const LAS unsigned char* kp = kg + (16 * T + cc) * 144 + 16 * fq; const bf16x8 a0 = *(const LAS bf16x8*)kp, a1 = *(const LAS bf16x8*)(kp + 64);
                s = MFMA16(a0, qB0, s); s = MFMA16(a1, qB1, s);
                if (T == w) {
#pragma unroll
                    for (int r = 0; r < 4; ++r) s[r] = (4 * fq + r > cc) ? 0.f : s[r]; } }
            A[T] = s; }
        bf16x8 P[4];
#pragma unroll
        for (int kk = 0; kk < 4; ++kk) { u32x4 pw; pw.x = pk2(A[2 * kk][0], A[2 * kk][1]); pw.y = pk2(A[2 * kk][2], A[2 * kk][3]); pw.z = pk2(A[2 * kk + 1][0], A[2 * kk + 1][1]); pw.w = pk2(A[2 * kk + 1][2], A[2 * kk + 1][3]); P[kk] = __builtin_bit_cast(bf16x8, pw); }
        f32x4 o[8]; float ss = 0.f;
#pragma unroll
        for (int Mt = 0; Mt < 8; ++Mt) { f32x4 acc = {0.f, 0.f, 0.f, 0.f};
#pragma unroll
            for (int kk = 0; kk < 4; ++kk) if (2 * kk <= w) { const LAS unsigned char* vp = vT + (16 * Mt + cc) * 272 + (32 * kk + 4 * fq) * 2; const u32x2 lo = *(const LAS u32x2*)vp, hi = *(const LAS u32x2*)(vp + 32); acc = MFMA16(mk8(lo, hi), P[kk], acc); }
            { const LAS unsigned char* sp = ScT + (16 * Mt + cc) * 144 + 16 * fq; const bf16x8 a0 = *(const LAS bf16x8*)sp, a1 = *(const LAS bf16x8*)(sp + 64); acc = MFMA16(a0, qB0, acc); acc = MFMA16(a1, qB1, acc); }
            o[Mt] = acc; ss += (acc[0] * acc[0] + acc[1] * acc[1]) + (acc[2] * acc[2] + acc[3] * acc[3]); }
        ss = red4rows(ss);
        const float rs = rsqrtf(ss * (1.0f / 128.0f) + EPS);
        const int t = 16 * w + cc;
        if (t < nv) { const size_t row = (size_t)(r0 + t);
#pragma unroll
            for (int Mt = 0; Mt < 8; ++Mt) { const int v0 = 16 * Mt + 4 * fq; const u32x2 og = *(const u32x2*)(C.Z + row * ZP + ZOG + h * 128 + v0); const f32x4 gn = *(const f32x4*)(C.gnw + v0);
                const float y0 = o[Mt][0] * rs * gn[0] * silu_f(bflo(og.x)), y1 = o[Mt][1] * rs * gn[1] * silu_f(bfhi(og.x)), y2 = o[Mt][2] * rs * gn[2] * silu_f(bflo(og.y)), y3 = o[Mt][3] * rs * gn[3] * silu_f(bfhi(og.y));
                u32x2 wv; wv.x = pk2(y0, y1); wv.y = pk2(y2, y3); *(u32x2*)(C.MRG + row * DM + 512 + h * 128 + v0) = wv; } }
    }
    __syncthreads();
}

DI void gla_scan(const Ctx& C, int gtid, int gthreads) {
    for (int idx = gtid; idx < 16 * 64 * 128; idx += gthreads) {
        const int v = idx & 127, k = (idx >> 7) & 63, bh = idx >> 13;
        const size_t u0 = (size_t)bh * NCH;
        float ds[NCH], dg[NCH];
#pragma unroll
        for (int c = 0; c < NCH; ++c) { ds[c] = C.DS[((u0 + c) * 64 + k) * 128 + v]; dg[c] = C.GL[(u0 + c) * 64 + k]; }
        float S = 0.f;
#pragma unroll
        for (int c = 0; c < NCH; ++c) { C.SC[((u0 + c) * 64 + k) * 128 + v] = (bf16_t)(pk2(S, 0.f) & 0xffffu); S = __expf(dg[c]) * S + ds[c]; }
        const int h = bh & 3, b = bh >> 2;
        C.out[O_SP + ((size_t)((C.l * NBATCH + b) * 4 + h) * 64 + k) * 128 + v] = S;
    }
}

struct WSrc { int mat; const float* W; const float* W2; const float* gain; const float* wg2; };
DI float wsrc(const WSrc& s, int k, int n) {
    if (s.mat == 0) {
        if (n < 2304) { const int col = n < 1792 ? n : n + 16; const float sc = (n >= 768 && n < 1024) ? 0.125f : 1.0f; return s.W[(size_t)k * INW + col] * s.gain[k] * sc; }
        const int e = n - 2304; float a = 0.f;
#pragma unroll
        for (int r = 0; r < 16; ++r) a += s.W[(size_t)k * INW + 1792 + r] * s.wg2[r * 256 + e];
        return a * s.gain[k];
    } else if (s.mat == 1) { return s.W[(size_t)k * DM + n];
    } else if (s.mat == 2) { const int pn = n >> 8, j = n & 255; return (j < 128 ? s.W[(size_t)k * DFFN + 128 * pn + j] : s.W2[(size_t)k * DFFN + 128 * pn + j - 128]) * s.gain[k];
    } else { return s.W[(size_t)k * DM + n]; }
}
DI void conv_item(const WSrc& s, int K, int N, bf16_t* WT, LAS float* scr, int item, int lane) {
    const int nblk = N / 32, kb = item / nblk, nb = item % nblk, k0 = 64 * kb, n0 = 32 * nb;
#pragma unroll 8
    for (int i = 0; i < 32; ++i) { const int kk = 2 * i + (lane >> 5); scr[kk * 33 + (lane & 31)] = wsrc(s, k0 + kk, n0 + (lane & 31)); }
    asm volatile("s_waitcnt lgkmcnt(0)" ::: "memory");
    const int c = lane & 7;
#pragma unroll
    for (int j = 0; j < 4; ++j) { const int n = (lane >> 3) + 8 * j; const LAS float* sp = scr + (8 * c) * 33 + n;
        u32x4 o; o.x = pk2(sp[0 * 33], sp[1 * 33]); o.y = pk2(sp[2 * 33], sp[3 * 33]); o.z = pk2(sp[4 * 33], sp[5 * 33]); o.w = pk2(sp[6 * 33], sp[7 * 33]);
        *(u32x4*)(WT + (size_t)(n0 + n) * K + k0 + 8 * c) = o; }
    asm volatile("s_waitcnt lgkmcnt(0)" ::: "memory");
}
constexpr int NI_IN = 16 * 80, NI_O = 16 * 32, NI_GU = 16 * 176, NI_D = 44 * 32, NI_L = NI_IN + NI_O + NI_GU + NI_D;

DI void prologue(KA ap, const RowMap& rm, LAS unsigned char* lds, int tid, int vcu, int G) {
    const int lane = tid & 63, wave = tid >> 6, gw = vcu * 8 + wave, NGW = G * 8;
    LAS float* scr = (LAS float*)(lds + wave * 16384);
    for (int it = gw; it < DEPTH * NI_L; it += NGW) {
        const int l = it / NI_L; int r = it % NI_L;
        unsigned char* wl = ap->ws + WS_W + (size_t)l * SZ_WL;
        if (r < NI_IN) { WSrc s{0, ap->in[7] + (size_t)l * DM * INW, nullptr, ap->in[6] + l * DM, ap->in[11] + l * 16 * 256}; conv_item(s, DM, NIN, (bf16_t*)wl, scr, r, lane); continue; } r -= NI_IN;
        if (r < NI_O) { WSrc s{1, ap->in[14] + (size_t)l * DM * DM, nullptr, nullptr, nullptr}; conv_item(s, DM, DM, (bf16_t*)(wl + SZ_WIN), scr, r, lane); continue; } r -= NI_O;
        if (r < NI_GU) { WSrc s{2, ap->in[16] + (size_t)l * DM * DFFN, ap->in[17] + (size_t)l * DM * DFFN, ap->in[15] + l * DM, nullptr}; conv_item(s, DM, NGU, (bf16_t*)(wl + SZ_WIN + SZ_WO), scr, r, lane); continue; } r -= NI_GU;
        { WSrc s{3, ap->in[18] + (size_t)l * DFFN * DM, nullptr, nullptr, nullptr}; conv_item(s, DFFN, DM, (bf16_t*)(wl + SZ_WIN + SZ_WO + SZ_WGU), scr, r, lane); }
    }
    bf16_t* XB = (bf16_t*)(ap->ws + WS_XB); bf16_t* MRG = (bf16_t*)(ap->ws + WS_MRG); float* ssqA = (float*)(ap->ws + WS_SSQA);
    for (int m = gw; m < MP; m += NGW) {
        const float* ip = row_in(rm, m); f32x4 v[4]; float s = 0.f;
#pragma unroll
        for (int j = 0; j < 4; ++j) { v[j] = ip ? ((const f32x4*)ip)[lane + 64 * j] : (f32x4){0.f, 0.f, 0.f, 0.f}; s += (v[j][0] * v[j][0] + v[j][1] * v[j][1]) + (v[j][2] * v[j][2] + v[j][3] * v[j][3]); }
        s = sum64(s);
#pragma unroll
        for (int j = 0; j < 4; ++j) { u32x2 w; w.x = pk2(v[j][0], v[j][1]); w.y = pk2(v[j][2], v[j][3]); ((u32x2*)(XB + (size_t)m * DM))[lane + 64 * j] = w; if (!ip) ((u32x2*)(MRG + (size_t)m * DM))[lane + 64 * j] = (u32x2){0u, 0u}; }
        if (lane < 16) ssqA[(size_t)m * 16 + lane] = lane == 0 ? s : 0.f;
    }
}

#define XB_TMO      128
#define XB_XCNT(j)  (256  + 64 * (j))
#define XB_XSUB(j)  (1280 + 64 * (j))
#define XB_XGEN(j)  (2304 + 64 * (j))
#define XB_TOP      3328
#define XB_TOPGEN   3392
#define XCD_BAR_WORDS 3456
#define XB_SPIN_CAP (1u << 18)

__device__ __forceinline__ unsigned xb_ld(unsigned* p)              { return __hip_atomic_load(p, __ATOMIC_RELAXED, __HIP_MEMORY_SCOPE_AGENT); }
__device__ __forceinline__ unsigned xb_add(unsigned* p, unsigned v) { return __hip_atomic_fetch_add(p, v, __ATOMIC_RELAXED, __HIP_MEMORY_SCOPE_AGENT); }
__device__ __forceinline__ unsigned xb_xcc_id() { return (unsigned)__builtin_amdgcn_s_getreg((3 << 11) | 20) & 0xFu; }
#define XB_SPIN(cond, bar) do { unsigned _sp = 0; while (cond) { __builtin_amdgcn_s_sleep(1); \
    if ((++_sp & 255u) == 0u) { if (xb_ld(&(bar)[XB_TMO])) break; if (_sp > XB_SPIN_CAP) { atomicAdd(&(bar)[XB_TMO], 1u); break; } } } } while (0)

struct XcdBarrier {
    unsigned* bar; unsigned x;
    volatile LAS unsigned* st;
};

__device__ __forceinline__ XcdBarrier xcd_barrier_post(unsigned* bar, volatile LAS unsigned* st, const bool t0) {
    XcdBarrier b; b.bar = bar; b.x = xb_xcc_id(); b.st = st;
    if (t0) (void)xb_add(&bar[XB_XCNT(b.x)], 1u);
    return b;
}
__device__ __forceinline__ void xcd_barrier_complete(unsigned* bar, unsigned x, unsigned& nloc, unsigned& nx) {
    const unsigned G = gridDim.x * gridDim.y * gridDim.z;
    unsigned sum, cnt, mine, sp = 0u;
    for (;;) {
        sum = 0u; cnt = 0u; mine = 0u;
#pragma unroll
        for (unsigned j = 0; j < 16; ++j) { const unsigned c = xb_ld(&bar[XB_XCNT(j)]); sum += c; cnt += (c > 0u) ? 1u : 0u; mine = (j == x) ? c : mine; }
        if (sum == G) break;
        __builtin_amdgcn_s_sleep(1);
        if ((++sp & 255u) == 0u) { if (xb_ld(&bar[XB_TMO])) break; if (sp > XB_SPIN_CAP) { atomicAdd(&bar[XB_TMO], 1u); break; } }
    }
    nloc = mine > 0u ? mine : 1u; nx = cnt > 0u ? cnt : 1u;
}

__device__ __forceinline__ void xcd_barrier(const XcdBarrier& b, const bool t0) {
    asm volatile("s_waitcnt vmcnt(0)" ::: "memory");
    __syncthreads();
    if (t0) {
        unsigned* bar = b.bar;
        __builtin_amdgcn_s_waitcnt(0);
        unsigned nloc = b.st[0], nx = b.st[1];
        if (nloc == 0u) { xcd_barrier_complete(bar, b.x, nloc, nx); b.st[0] = nloc; b.st[1] = nx; }
        const unsigned old = xb_add(&bar[XB_XSUB(b.x)], 1u);
        const unsigned gen = old / nloc;
        if (old + 1u == (gen + 1u) * nloc) {
            __builtin_amdgcn_fence(__ATOMIC_RELEASE, "agent");
            asm volatile("s_waitcnt vmcnt(0)" ::: "memory");
            const unsigned og = xb_add(&bar[XB_TOP], 1u);
            const unsigned tg = og / nx;
            if (og + 1u == (tg + 1u) * nx) xb_add(&bar[XB_TOPGEN], 1u);
            else XB_SPIN(xb_ld(&bar[XB_TOPGEN]) == tg, bar);
            __builtin_amdgcn_fence(__ATOMIC_ACQUIRE, "agent");
            xb_add(&bar[XB_XGEN(b.x)], 1u);
            asm volatile("s_waitcnt vmcnt(0)" ::: "memory");
        } else {
            XB_SPIN(xb_ld(&bar[XB_XGEN(b.x)]) == gen, bar);
            __builtin_amdgcn_fence(__ATOMIC_ACQUIRE, "agent");
            asm volatile("s_waitcnt vmcnt(0)" ::: "memory");
        }
    }
    __syncthreads();
}

template <class T> DI T* opq(T* p) { asm volatile("" : "+s"(p)); return p; }
DI Ctx make_ctx(int l) {
    KA ap = ka_ptr(); unsigned char* ws = ap->ws;
    Ctx C; C.l = l; C.Z = (const bf16_t*)(ws + WS_Z); C.LD = (float*)(ws + WS_LD); C.MRG = (bf16_t*)(ws + WS_MRG); C.DS = (float*)(ws + WS_DS); C.SC = (bf16_t*)(ws + WS_SC); C.GL = (float*)(ws + WS_GL);
    C.qnw = ap->in[8] + l * 64; C.knw = ap->in[9] + l * 64; C.sinks = ap->in[10] + l * 8; C.gnw = ap->in[13] + l * 128;
    C.cache_k = ap->in[2]; C.cache_v = ap->in[3]; C.state = ap->in[4]; C.out = ap->out;
    return C;
}
DI RowMap make_rm() { KA ap = ka_ptr(); float* out = ap->out; unsigned char* ws = ap->ws; return RowMap{ap->in[0], ap->in[1], ap->in[5], out + O_YP, out + O_YS, (float*)(ws + WS_XMETA)}; }

__global__ void __launch_bounds__(512, 2) hymba_fwd(Args a) {
    extern __shared__ __attribute__((aligned(16))) unsigned char lds_raw[];
    LAS unsigned char* lds = (LAS unsigned char*)lds_raw;
    const int G = gridDim.x, bx = blockIdx.x; const int wave_s = __builtin_amdgcn_readfirstlane((int)threadIdx.x >> 6);
#define opaque_tid() mk_tid(wave_s)
    const int vcu = (G % 8 == 0) ? (bx % 8) * (G / 8) + bx / 8 : bx;
    const int lo = ka_ptr()->ph_lo, hi = ka_ptr()->ph_hi;
#define IN(k) (lo <= (k) && (k) < hi)
#ifndef FAST_BAR
#define FAST_BAR 1
#endif
    volatile LAS unsigned* MISC = (volatile LAS unsigned*)(lds + 131072 + 320);
    { const int t = opaque_tid(); if (t < 64) MISC[t] = 0u; __syncthreads(); }
    XcdBarrier bar = xcd_barrier_post((unsigned*)ka_ptr()->ws, MISC + 8, opaque_tid() == 0);
#define GSYNC() do { if (FAST_BAR) xcd_barrier(bar, opaque_tid() == 0); else cg::this_grid().sync(); } while (0)
#define SEAM(k) do { if (IN(k) && IN((k) + 1)) { if ((k) == 0) cg::this_grid().sync(); else GSYNC(); } } while (0)
    if (IN(0)) { for (int rep = 0; rep < REP_PRO; ++rep) { const RowMap rm = make_rm(); prologue(ka_ptr(), rm, lds, opaque_tid(), vcu, G); if (rep + 1 < REP_PRO) GSYNC(); }
        for (int xs = 0; xs < XSYNC; ++xs) GSYNC(); }
    SEAM(0);
#pragma unroll 1
    for (int l = 0; l < DEPTH; ++l) {
        const int pb = 1 + 7 * l;
        if (IN(pb + 0)) for (int rep = 0; rep < REP_WIN; ++rep) {
            if (rep) GSYNC();
            KA ap = ka_ptr(); unsigned char* ws = ap->ws; unsigned char* wl = ws + WS_W + (size_t)l * SZ_WL;
            pg8::Gemm g{(const bf16_t*)(ws + WS_XB), (const bf16_t*)wl, MP, NIN, DM}; pg8::StaticOrder S; S.init(MP, NIN, G, bx);
            pg8::EpiIn E{(bf16_t*)(ws + WS_Z), (float*)(ws + WS_LD), (const float*)(ws + WS_SSQA), ap->in[12] + l * 256};
            pg8::gemm_phase<pg8::EpiIn, pg8::StaticOrder, true, true>(lds, g, S, E, opaque_tid());
        }
        SEAM(pb + 0);
        if (IN(pb + 1)) {
            const Ctx C = make_ctx(l);
            constexpr int N1 = 16 * NCH, N2 = DECB, N3 = DECB * 4;
#pragma unroll 1
            for (int u = vcu; u < N1 + N2 + N3; u += G) {
                if (u < N1) { for (int r = 0; r < REP_G1; ++r) gla1_unit(C, u, lds, wave_s); } else if (u < N1 + N2) { for (int r = 0; r < REP_AS; ++r) attn_sample_unit(C, u - N1, lds, wave_s); } else { for (int r = 0; r < REP_GS; ++r) gla_sample_unit(C, u - N1 - N2, lds, wave_s); }
            }
        }
        SEAM(pb + 1);
        if (IN(pb + 2)) for (int rep = 0; rep < REP_SCAN; ++rep) { if (rep) GSYNC(); const Ctx C = make_ctx(l); gla_scan(C, bx * 512 + opaque_tid(), G * 512); }
        SEAM(pb + 2);
        if (IN(pb + 3)) for (int rep = 0; rep < REP_MB; ++rep) {   if (rep) GSYNC();
            const Ctx C = make_ctx(l);
            constexpr int N1 = 16 * NCH, N2 = NBATCH * 2 * 65;
#pragma unroll 1
            for (int u = vcu; u < N1 + N2; u += G) { if (u < N1) { for (int r = 0; r < REP_G3; ++r) gla3_unit(C, u, lds, wave_s); } else { for (int r = 0; r < REP_AP; ++r) attn_prompt_unit(C, u - N1, lds, wave_s); } }
        }
        SEAM(pb + 3);
        if (IN(pb + 4)) for (int rep = 0; rep < 1 + DRY_WO; ++rep) {
            if (rep) GSYNC();
            KA ap = ka_ptr(); unsigned char* ws = ap->ws; unsigned char* wl = ws + WS_W + (size_t)l * SZ_WL;
            pg8::Gemm g{(const bf16_t*)(ws + WS_MRG), (const bf16_t*)(wl + SZ_WIN), MP, DM, DM}; pg8::StreamK S; S.init((MP / 256) * 4, DM / 128, G, vcu, (unsigned*)(ws + WS_FLAGS) + (2 * l) * 256 * 16, ws + WS_Z, ws + WS_ZERO);
            pg8::EpiRes E{make_rm(), 0, (bf16_t*)(ws + WS_XB), (float*)(ws + WS_SSQB), rep};
            pg8::gemm_phase<pg8::EpiRes, pg8::StreamK, true, true>(lds, g, S, E, opaque_tid());
        }
        SEAM(pb + 4);
        if (IN(pb + 5)) for (int rep = 0; rep < REP_GU; ++rep) {
            if (rep) GSYNC();
            KA ap = ka_ptr(); unsigned char* ws = ap->ws; unsigned char* wl = ws + WS_W + (size_t)l * SZ_WL;
            pg8::Gemm g{(const bf16_t*)(ws + WS_XB), (const bf16_t*)(wl + SZ_WIN + SZ_WO), MP, NGU, DM}; pg8::StaticOrder S; S.init(MP, NGU, G, bx);
            pg8::EpiGU E{(bf16_t*)(ws + WS_U), (const float*)(ws + WS_SSQB)};
            pg8::gemm_phase<pg8::EpiGU, pg8::StaticOrder, true, true>(lds, g, S, E, opaque_tid());
        }
        SEAM(pb + 5);
        if (IN(pb + 6)) for (int rep = 0; rep < 1 + DRY_DN; ++rep) {
            if (rep) GSYNC();
            KA ap = ka_ptr(); unsigned char* ws = ap->ws; unsigned char* wl = ws + WS_W + (size_t)l * SZ_WL;
            pg8::Gemm g{(const bf16_t*)(ws + WS_U), (const bf16_t*)(wl + SZ_WIN + SZ_WO + SZ_WGU), MP, DM, DFFN}; pg8::StreamK S; S.init((MP / 256) * 4, DFFN / 128, G, vcu, (unsigned*)(ws + WS_FLAGS) + (2 * l + 1) * 256 * 16, ws + WS_MRG, ws + WS_ZERO);
            pg8::EpiRes E{make_rm(), l == DEPTH - 1 ? 1 : 0, (bf16_t*)(ws + WS_XB), (float*)(ws + WS_SSQA), rep};
            pg8::gemm_phase<pg8::EpiRes, pg8::StreamK, true, true>(lds, g, S, E, opaque_tid());
        }
        if (l + 1 < DEPTH) SEAM(pb + 6);
    }
#undef IN
#undef SEAM
#undef GSYNC
#undef opaque_tid
}

#ifndef N_LAUNCH_MODE
#define N_LAUNCH_MODE 0
#endif
extern "C" void kernel_launch(void* const* d_in, const int* in_sizes, int n_in, void* d_out, int out_size, void* d_ws, size_t ws_size, hipStream_t stream) {
    static int grid = 0;
    if (grid == 0) {
        if (n_in != 19 || out_size != (int)O_END || ws_size < WS_END) { fprintf(stderr, "kernel_launch: unexpected shapes: n_in %d out %d ws %zu (need %zu)\n", n_in, out_size, ws_size, (size_t)WS_END); grid = -1; return; }
        int dev = 0, cus = 0, per_cu = 0;
        (void)hipGetDevice(&dev); (void)hipDeviceGetAttribute(&cus, hipDeviceAttributeMultiprocessorCount, dev);
        if (hipFuncSetAttribute((const void*)hymba_fwd, hipFuncAttributeMaxDynamicSharedMemorySize, LDS_BYTES) != hipSuccess) { fprintf(stderr, "kernel_launch: hipFuncSetAttribute failed\n"); grid = -1; return; }
        if (hipOccupancyMaxActiveBlocksPerMultiprocessor(&per_cu, (const void*)hymba_fwd, 512, LDS_BYTES) != hipSuccess || per_cu < 1) { fprintf(stderr, "kernel_launch: occupancy query says %d\n", per_cu); per_cu = 1; }
        (void)hipGetLastError();
        grid = cus > 0 ? cus : 256;
    }
    if (grid < 0) return;
    if (hipMemsetAsync(d_ws, 0, WS_W, stream) != hipSuccess) { fprintf(stderr, "kernel_launch: memset failed\n"); return; }
    Args a{};
    for (int i = 0; i < 19; ++i) a.in[i] = (const float*)d_in[i];
    a.out = (float*)d_out; a.ws = (unsigned char*)d_ws;
#if N_LAUNCH_MODE == 1
    for (int p = 0; p < NPHASE; ++p) { a.ph_lo = p; a.ph_hi = p + 1; hipLaunchKernelGGL(hymba_fwd, dim3(grid), dim3(512), LDS_BYTES, stream, a); }
#else
    a.ph_lo = 0; a.ph_hi = NPHASE;
    void* args[] = {&a};
    hipError_t e = hipLaunchCooperativeKernel((const void*)hymba_fwd, dim3(grid), dim3(512), args, LDS_BYTES, stream);
    if (e != hipSuccess) fprintf(stderr, "cooperative launch failed: %s (grid %d)\n", hipGetErrorString(e), grid);
#endif
}
```

```cpp
#include <hip/hip_runtime.h>
#include <hip/hip_cooperative_groups.h>
#include <cstdio>
#include <cstdint>
namespace cg = cooperative_groups;

#define DI __device__ __forceinline__
#define LAS __attribute__((address_space(3)))
typedef unsigned short bf16_t;
typedef short bf16x8 __attribute__((ext_vector_type(8)));
typedef float f32x4 __attribute__((ext_vector_type(4)));
typedef float f32x2 __attribute__((ext_vector_type(2)));
typedef unsigned u32x4 __attribute__((ext_vector_type(4)));
typedef unsigned u32x2 __attribute__((ext_vector_type(2)));
typedef __bf16 bf16x2_t __attribute__((ext_vector_type(2)));

constexpr int DM = 1024, NBATCH = 4, SEQ = 4096, LP = 4112  , DEPTH = 2, DECB = 128, DECT = 8;
constexpr int MPROMPT = NBATCH * LP, MREAL = MPROMPT + DECB * DECT, MP = 17664  ;
constexpr int INW = 2320, ZP = 2304, NIN = 2560, DFFN = 2816, NGU = 5632;
constexpr int ZQ = 0, ZK = 512, ZV = 640, ZGQ = 768, ZGK = 1024, ZGV = 1280, ZOG = 1792;
constexpr int NCH = 33;
constexpr float EPS = 1e-6f, LOG2E = 1.4426950408889634f;
constexpr size_t O_YP = 0, O_YS = 16777216, O_CKP = 17825792, O_CVP = 17956864, O_SP = 18087936, O_CKS = 18350080, O_CVS = 22544384, O_SS = 26738688, O_END = 35127296;

DI unsigned pk2(float lo, float hi) { f32x2 v = {lo, hi}; bf16x2_t b = __builtin_convertvector(v, bf16x2_t); return __builtin_bit_cast(unsigned, b); }
DI float bflo(unsigned w) { return __uint_as_float(w << 16); }
DI float bfhi(unsigned w) { return __uint_as_float(w & 0xffff0000u); }
DI float bf2f(bf16_t h) { return __uint_as_float((unsigned)h << 16); }
DI void unpack8(const u32x4 w, float* f) { f[0] = bflo(w.x); f[1] = bfhi(w.x); f[2] = bflo(w.y); f[3] = bfhi(w.y); f[4] = bflo(w.z); f[5] = bfhi(w.z); f[6] = bflo(w.w); f[7] = bfhi(w.w); }
DI float red4rows(float v) {
    auto r = __builtin_amdgcn_permlane16_swap(__float_as_uint(v), __float_as_uint(v), false, false); v = __uint_as_float(r[0]) + __uint_as_float(r[1]);
    auto q = __builtin_amdgcn_permlane32_swap(__float_as_uint(v), __float_as_uint(v), false, false); return __uint_as_float(q[0]) + __uint_as_float(q[1]);
}
DI float max4rows(float v) {
    auto r = __builtin_amdgcn_permlane16_swap(__float_as_uint(v), __float_as_uint(v), false, false); v = fmaxf(__uint_as_float(r[0]), __uint_as_float(r[1]));
    auto q = __builtin_amdgcn_permlane32_swap(__float_as_uint(v), __float_as_uint(v), false, false); return fmaxf(__uint_as_float(q[0]), __uint_as_float(q[1]));
}
template <int M> DI float shx(float v) { return __int_as_float(__builtin_amdgcn_ds_swizzle(__float_as_int(v), 0x1f | (M << 10))); }
DI float sum8(float v) { v += shx<1>(v); v += shx<2>(v); v += shx<4>(v); return v; }
DI float sum64(float v) { v += shx<1>(v); v += shx<2>(v); v += shx<4>(v); v += shx<8>(v); v += shx<16>(v);
    auto q = __builtin_amdgcn_permlane32_swap(__float_as_uint(v), __float_as_uint(v), false, false); return __uint_as_float(q[0]) + __uint_as_float(q[1]); }
DI float silu_f(float x) { return x * __builtin_amdgcn_rcpf(1.0f + __expf(-x)); }

struct RowMap { const float* xp; const float* xs; const float* meta; float* yp; float* ys; float* xmeta; };
DI const float* row_in(const RowMap& rm, int row) {
    if (row < MPROMPT) { const int b = row / LP, p = row - b * LP; return p < 16 ? rm.meta + (size_t)p * DM : rm.xp + ((size_t)b * SEQ + (p - 16)) * DM; }
    if (row < MREAL) return rm.xs + (size_t)(row - MPROMPT) * DM;
    return nullptr;
}
DI float* row_out(const RowMap& rm, int row) {
    if (row < MPROMPT) { const int b = row / LP, p = row - b * LP; return p < 16 ? nullptr : rm.yp + ((size_t)b * SEQ + (p - 16)) * DM; }
    if (row < MREAL) return rm.ys + (size_t)(row - MPROMPT) * DM;
    return nullptr;
}
namespace pg8 {
#define PG8_LAS __attribute__((address_space(3)))
typedef unsigned short bf16_t;
typedef short bf16x8 __attribute__((ext_vector_type(8)));
typedef float f32x4 __attribute__((ext_vector_type(4)));
typedef unsigned u32x4 __attribute__((ext_vector_type(4)));
constexpr int BM = 256, BK = 64, HALF = 128, HTB = HALF * BK * 2  , STAGE_BYTES = 8 * HTB, NXCD = 8, WGM = 8;

__host__ __device__ __forceinline__ int lds_byte(int r, int c) { const int st = (r >> 4) * 2 + (c >> 5), rr = r & 15, cc = c & 31, ob = rr * 64 + cc * 2; return st * 1024 + (ob ^ (((ob >> 9) & 1) << 5)); }
__host__ __device__ __forceinline__ void stage_rc(int b, int& R, int& C) { const int st = b / 1024, sb = b % 1024, swz = sb ^ (((sb >> 9) & 1) << 5); R = (st >> 1) * 16 + swz / 64; C = (st & 1) * 32 + (swz % 64) / 2; }
__host__ __device__ __forceinline__ int perm32(int rho) { const int n = rho >> 4, i = rho & 15; return 8 * (i >> 2) + 4 * n + (i & 3); }

struct Unit { int pm, pn, k0, nk, mode; };
struct Gemm { const bf16_t* A; const bf16_t* Bt; int M, N, K; };

struct StaticOrder {
    static constexpr bool STREAMK = false;
    int nM, nN, nwg, G, c;
    __host__ __device__ void init(int M, int N, int G_, int c_) { nM = M / BM; nN = N / BM; nwg = nM * nN; G = G_; c = c_; }
    __host__ __device__ bool next(int i, Unit& u) const {
        const long L = (long)i * G + c; if (L >= nwg) return false;
        int wgid = (int)L; { const int q = nwg / NXCD, r = nwg % NXCD, xcd = wgid % NXCD, off = wgid / NXCD; wgid = (xcd < r ? xcd * (q + 1) : r * (q + 1) + (xcd - r) * q) + off; }
        const int nig = WGM * nN, gid = wgid / nig, fm = gid * WGM, gsz = (nM - fm) < WGM ? (nM - fm) : WGM;
        u.pm = fm + ((wgid % nig) % gsz); u.pn = (wgid % nig) / gsz; u.k0 = 0; u.nk = 0; u.mode = 0; return true;
    }
    __device__ __forceinline__ void a_ready(const Unit&) const {}
    __device__ __forceinline__ void done(const Unit&) const {}
};


struct StreamK {
    static constexpr bool STREAMK = true;
    int P, r, s, e, nseg; unsigned* flags; unsigned char* part; const unsigned char* zero;
    __device__ __forceinline__ void init(int ntiles, int P_, int G, int r_, unsigned* flags_, unsigned char* part_, const unsigned char* zero_) {
        P = P_; r = r_; flags = flags_; part = part_; zero = zero_; const long TP = (long)ntiles * P; s = (int)(TP * r / G); e = (int)(TP * (r + 1) / G);
        nseg = 0; int cur = s; while (cur < e) { const int kb = cur % P; int ke = kb + (e - cur); ke = ke < P ? ke : P; cur += ke - kb; ++nseg; }
    }
    __device__ __forceinline__ bool next(int i, Unit& u) const {
        if (i >= nseg) return false;
        const int want = nseg - 1 - i; int cur = s, idx = 0;
        for (;;) { const int t = cur / P, kb = cur % P; int ke = kb + (e - cur); ke = ke < P ? ke : P;
            if (idx == want) { u.pm = t >> 2; u.pn = t & 3; u.k0 = 2 * kb; u.nk = 2 * (ke - kb); u.mode = (kb == 0 && ke == P) ? 0 : (kb == 0 ? 1 : 2); return true; }
            cur += ke - kb; ++idx; }
    }
    __device__ __forceinline__ void a_ready(const Unit&) const {}
    __device__ __forceinline__ void done(const Unit&) const {}
};

DI float rstd_from_slots(const float* ssq, int row) {
    const f32x4* p = (const f32x4*)(ssq + (size_t)row * 16);
    const f32x4 a = p[0], b = p[1], c = p[2], d = p[3];
    const float s = ((a[0] + a[1]) + (a[2] + a[3])) + ((b[0] + b[1]) + (b[2] + b[3])) + ((c[0] + c[1]) + (c[2] + c[3])) + ((d[0] + d[1]) + (d[2] + d[3]));
    return rsqrtf(s * (1.0f / 1024.0f) + EPS);
}
DI void rstd8(const float* ssq, int row0, float (&rs)[2][4]) {
#pragma unroll
    for (int ai = 0; ai < 2; ++ai) {
        f32x4 t[4][4];
#pragma unroll
        for (int m = 0; m < 4; ++m) { const f32x4* p = (const f32x4*)(ssq + (size_t)(row0 + ai * HALF + m * 16) * 16); t[m][0] = p[0]; t[m][1] = p[1]; t[m][2] = p[2]; t[m][3] = p[3]; }
#pragma unroll
        for (int m = 0; m < 4; ++m) { const f32x4 q = (t[m][0] + t[m][1]) + (t[m][2] + t[m][3]); rs[ai][m] = rsqrtf(((q[0] + q[1]) + (q[2] + q[3])) * (1.0f / 1024.0f) + EPS); }
        asm volatile("" ::: "memory");
    }
}
DI void rstd_tab_fill(const float* ssq, int pm, PG8_LAS float* tab, int tid) {
    if (tid < 256) { const f32x4* p = (const f32x4*)(ssq + (size_t)(pm * BM + tid) * 16); const f32x4 q = (p[0] + p[1]) + (p[2] + p[3]); tab[tid] = rsqrtf(((q[0] + q[1]) + (q[2] + q[3])) * (1.0f / 1024.0f) + EPS); }
}
DI void rstd8_tab(const PG8_LAS float* tab, int wr, int fr, float (&rs)[2][4]) {
#pragma unroll
    for (int ai = 0; ai < 2; ++ai)
#pragma unroll
        for (int m = 0; m < 4; ++m) rs[ai][m] = tab[ai * HALF + wr * 64 + m * 16 + fr];
}
struct EpiIn {
    static constexpr bool PERM = true, AFTER_DRAIN = false, RSTAB = true;
    bf16_t* Z; float* LD; const float* ssq; const float* bg;
    __device__ __forceinline__ void prefetch(const Unit& u, PG8_LAS float* tab, int tid) const { rstd_tab_fill(ssq, u.pm, tab, tid); }
    __device__ __forceinline__ void operator()(const f32x4 (&acc)[2][2][4][2], const Unit& u, int wr, int wc, int fr, int fq, const PG8_LAS float* tab) const {
        const int row0 = u.pm * BM + wr * 64 + fr;
        float rs[2][4]; rstd8_tab(tab, wr, fr, rs);
        if (u.pn < 9) {
#pragma unroll
            for (int ai = 0; ai < 2; ++ai)
#pragma unroll
                for (int m = 0; m < 4; ++m) { const int row = row0 + ai * HALF + m * 16; const float r = rs[ai][m];
                    bf16_t* rowp = Z + (size_t)row * ZP + u.pn * BM + wc * 32 + 8 * fq;
#pragma unroll
                    for (int bj = 0; bj < 2; ++bj) { const f32x4 v0 = acc[ai][bj][m][0] * r, v1 = acc[ai][bj][m][1] * r;
                        u32x4 w; w.x = pk2(v0[0], v0[1]); w.y = pk2(v0[2], v0[3]); w.z = pk2(v1[0], v1[1]); w.w = pk2(v1[2], v1[3]);
                        *(u32x4*)(rowp + bj * HALF) = w; } }
        } else {
            const int e0 = wc * 32 + 8 * fq;
#pragma unroll
            for (int bj = 0; bj < 2; ++bj) { const f32x4 b0 = *(const f32x4*)(bg + e0 + bj * HALF), b1 = *(const f32x4*)(bg + e0 + bj * HALF + 4);
#pragma unroll
                for (int ai = 0; ai < 2; ++ai)
#pragma unroll
                    for (int m = 0; m < 4; ++m) { const int row = row0 + ai * HALF + m * 16; const float r = rs[ai][m];
                        const f32x4 x0 = acc[ai][bj][m][0] * r + b0, x1 = acc[ai][bj][m][1] * r + b1; f32x4 o0, o1;
#pragma unroll
                        for (int i = 0; i < 4; ++i) { o0[i] = (fminf(x0[i], 0.f) - __logf(1.0f + __expf(-fabsf(x0[i])))) * 0.0625f; o1[i] = (fminf(x1[i], 0.f) - __logf(1.0f + __expf(-fabsf(x1[i])))) * 0.0625f; }
                        float* lp = LD + (size_t)row * 256 + e0 + bj * HALF; *(f32x4*)lp = o0; *(f32x4*)(lp + 4) = o1; } }
        }
    }
};
#ifndef EPIRES_BATCH4
#define EPIRES_BATCH4 1
#endif
#if EPIRES_BATCH4
struct EpiRes {
    static constexpr bool PERM = true, AFTER_DRAIN = false, RSTAB = false;
    RowMap rm; int final_; bf16_t* XB; float* ssq; int dry;
    __device__ __forceinline__ void operator()(const f32x4 (&acc)[2][2][4][2], const Unit& u, int wr, int wc, int fr, int fq, const unsigned char* pp) const {
        if (dry) return;
        const int row0 = u.pm * BM + wr * 64 + fr, col0 = u.pn * BM + wc * 32 + 8 * fq;
#pragma unroll
        for (int ai = 0; ai < 2; ++ai) {
            u32x4 res[4][2], par[4][2];
#pragma unroll
            for (int m = 0; m < 4; ++m) { const int row = row0 + ai * HALF + m * 16;
#pragma unroll
                for (int bj = 0; bj < 2; ++bj) { res[m][bj] = *(const u32x4*)(XB + (size_t)row * DM + col0 + bj * HALF); par[m][bj] = (u32x4){0u, 0u, 0u, 0u}; } }
            if (pp) {
#pragma unroll
                for (int m = 0; m < 4; ++m)
#pragma unroll
                    for (int bj = 0; bj < 2; ++bj) asm volatile("global_load_dwordx4 %0, %1, off sc0 sc1" : "=v"(par[m][bj]) : "v"(pp + ((ai * 2 + bj) * 4 + m) * 8192) : "memory");
                asm volatile("s_waitcnt vmcnt(0)" : "+v"(par[0][0]), "+v"(par[0][1]), "+v"(par[1][0]), "+v"(par[1][1]), "+v"(par[2][0]), "+v"(par[2][1]), "+v"(par[3][0]), "+v"(par[3][1]) :: "memory");
            }
#pragma unroll
            for (int m = 0; m < 4; ++m) { const int row = row0 + ai * HALF + m * 16; float ss = 0.f; float* op = final_ ? row_out(rm, row) : nullptr;
#pragma unroll
                for (int bj = 0; bj < 2; ++bj) { const int col = col0 + bj * HALF; float r[8], q[8]; unpack8(res[m][bj], r); unpack8(par[m][bj], q);
                    const f32x4 v0 = (acc[ai][bj][m][0] + (f32x4){q[0], q[1], q[2], q[3]}) + (f32x4){r[0], r[1], r[2], r[3]}, v1 = (acc[ai][bj][m][1] + (f32x4){q[4], q[5], q[6], q[7]}) + (f32x4){r[4], r[5], r[6], r[7]};
                    if (final_) { if (op) { *(f32x4*)(op + col) = v0; *(f32x4*)(op + col + 4) = v1; } }
                    else { u32x4 w; w.x = pk2(v0[0], v0[1]); w.y = pk2(v0[2], v0[3]); w.z = pk2(v1[0], v1[1]); w.w = pk2(v1[2], v1[3]);
                        *(u32x4*)(XB + (size_t)row * DM + col) = w;
                        const f32x4 q0 = {bflo(w.x), bfhi(w.x), bflo(w.y), bfhi(w.y)}, q1 = {bflo(w.z), bfhi(w.z), bflo(w.w), bfhi(w.w)};
                        ss += (q0[0] * q0[0] + q0[1] * q0[1]) + (q0[2] * q0[2] + q0[3] * q0[3]) + (q1[0] * q1[0] + q1[1] * q1[1]) + (q1[2] * q1[2] + q1[3] * q1[3]); } }
                if (!final_) { ss = red4rows(ss); if (fq == 0) ssq[(size_t)row * 16 + u.pn * 4 + wc] = ss; } }
            asm volatile("" ::: "memory");
        }
    }
};
#else
struct EpiRes {
    static constexpr bool PERM = true, AFTER_DRAIN = false, RSTAB = false;
    RowMap rm; int final_; bf16_t* XB; float* ssq; int dry;
    __device__ __forceinline__ void operator()(const f32x4 (&acc)[2][2][4][2], const Unit& u, int wr, int wc, int fr, int fq, const unsigned char* pp) const {
        if (dry) return;
        const int row0 = u.pm * BM + wr * 64 + fr, col0 = u.pn * BM + wc * 32 + 8 * fq;
#pragma unroll
        for (int ai = 0; ai < 2; ++ai)
#pragma unroll
        for (int mh = 0; mh < 2; ++mh) {
            u32x4 res[2][2], par[2][2];
#pragma unroll
            for (int mm = 0; mm < 2; ++mm) { const int row = row0 + ai * HALF + (2 * mh + mm) * 16;
#pragma unroll
                for (int bj = 0; bj < 2; ++bj) { res[mm][bj] = *(const u32x4*)(XB + (size_t)row * DM + col0 + bj * HALF); par[mm][bj] = (u32x4){0u, 0u, 0u, 0u}; } }
            if (pp) {
#pragma unroll
                for (int mm = 0; mm < 2; ++mm)
#pragma unroll
                    for (int bj = 0; bj < 2; ++bj) asm volatile("global_load_dwordx4 %0, %1, off sc0 sc1" : "=v"(par[mm][bj]) : "v"(pp + ((ai * 2 + bj) * 4 + 2 * mh + mm) * 8192) : "memory");
                asm volatile("s_waitcnt vmcnt(0)" : "+v"(par[0][0]), "+v"(par[0][1]), "+v"(par[1][0]), "+v"(par[1][1]) :: "memory");
            }
#pragma unroll
            for (int mm = 0; mm < 2; ++mm) { const int m = 2 * mh + mm; const int row = row0 + ai * HALF + m * 16; float ss = 0.f; float* op = final_ ? row_out(rm, row) : nullptr;
#pragma unroll
                for (int bj = 0; bj < 2; ++bj) { const int col = col0 + bj * HALF; float r[8], q[8]; unpack8(res[mm][bj], r); unpack8(par[mm][bj], q);
                    const f32x4 v0 = (acc[ai][bj][m][0] + (f32x4){q[0], q[1], q[2], q[3]}) + (f32x4){r[0], r[1], r[2], r[3]}, v1 = (acc[ai][bj][m][1] + (f32x4){q[4], q[5], q[6], q[7]}) + (f32x4){r[4], r[5], r[6], r[7]};
                    if (final_) { if (op) { *(f32x4*)(op + col) = v0; *(f32x4*)(op + col + 4) = v1; } }
                    else { u32x4 w; w.x = pk2(v0[0], v0[1]); w.y = pk2(v0[2], v0[3]); w.z = pk2(v1[0], v1[1]); w.w = pk2(v1[2], v1[3]);
                        *(u32x4*)(XB + (size_t)row * DM + col) = w;
                        const f32x4 q0 = {bflo(w.x), bfhi(w.x), bflo(w.y), bfhi(w.y)}, q1 = {bflo(w.z), bfhi(w.z), bflo(w.w), bfhi(w.w)};
                        ss += (q0[0] * q0[0] + q0[1] * q0[1]) + (q0[2] * q0[2] + q0[3] * q0[3]) + (q1[0] * q1[0] + q1[1] * q1[1]) + (q1[2] * q1[2] + q1[3] * q1[3]); } }
                if (!final_) { ss = red4rows(ss); if (fq == 0) ssq[(size_t)row * 16 + u.pn * 4 + wc] = ss; } }
            asm volatile("" ::: "memory");
        }
    }
};
#endif
struct EpiGU {
    static constexpr bool PERM = true, AFTER_DRAIN = false, RSTAB = true;
    bf16_t* U; const float* ssq;
    __device__ __forceinline__ void prefetch(const Unit& u, PG8_LAS float* tab, int tid) const { rstd_tab_fill(ssq, u.pm, tab, tid); }
    __device__ __forceinline__ void operator()(const f32x4 (&acc)[2][2][4][2], const Unit& u, int wr, int wc, int fr, int fq, const PG8_LAS float* tab) const {
        const int row0 = u.pm * BM + wr * 64 + fr, f0 = u.pn * HALF + wc * 32 + 8 * fq;
        float rs[2][4]; rstd8_tab(tab, wr, fr, rs);
#pragma unroll
        for (int ai = 0; ai < 2; ++ai)
#pragma unroll
            for (int m = 0; m < 4; ++m) { const int row = row0 + ai * HALF + m * 16; const float r = rs[ai][m];
                float o[8];
#pragma unroll
                for (int n = 0; n < 2; ++n)
#pragma unroll
                    for (int i = 0; i < 4; ++i) { const float g = acc[ai][0][m][n][i] * r, up = acc[ai][1][m][n][i] * r; o[4 * n + i] = silu_f(g) * up; }
                u32x4 w; w.x = pk2(o[0], o[1]); w.y = pk2(o[2], o[3]); w.z = pk2(o[4], o[5]); w.w = pk2(o[6], o[7]);
                *(u32x4*)(U + (size_t)row * DFFN + f0) = w; }
    }
};
template <class Epi, class Sched, bool ALIGN_EPI = false, bool SP2 = false>
__device__ __forceinline__ void gemm_phase(PG8_LAS unsigned char* lds, const Gemm g, const Sched& S, const Epi& E, const int tid_in) {
    const int tid = tid_in, wid = __builtin_amdgcn_readfirstlane(tid >> 6), lane = tid & 63, wr = wid >> 2, wc = wid & 3, fr = lane & 15, fq = lane >> 4;
    const int K = g.K;
    unsigned voffA[2], voffB[2];
#pragma unroll
    for (int i = 0; i < 2; ++i) { int R, C; stage_rc(tid * 16 + i * 8192, R, C); const int Rb = Epi::PERM ? ((R & ~31) + perm32(R & 31)) : R;
        voffA[i] = (unsigned)(R * K + C) * 2u; voffB[i] = (unsigned)(Rb * K + C) * 2u; }
    const size_t kstep = (size_t)(BK * 2);
    const size_t hstep = (size_t)HALF * K * 2;
    const size_t tstep = 2 * hstep;
    const unsigned ldsw = (unsigned)wid * 1024u;
    const int aoff = lds_byte(wr * 64 + fr, fq * 8), boff = lds_byte(wc * 32 + fr, fq * 8);
#define PG8_SA(b, h) (((b) * 2 + (h)) * HTB)
#define PG8_SB(b, h) ((4 + (b) * 2 + (h)) * HTB)
#define PG8_STAGE(bufoff, gbase, voff) do { _Pragma("unroll") for (int _i = 0; _i < 2; ++_i) \
        __builtin_amdgcn_global_load_lds((const unsigned*)((const char*)(gbase) + (voff)[_i]), (PG8_LAS unsigned*)(lds + (bufoff) + ldsw + _i * 8192), 16, 0, 0); } while (0)
#define PG8_LDA(dst, b, h) do { _Pragma("unroll") for (int m = 0; m < 4; ++m) _Pragma("unroll") for (int k = 0; k < 2; ++k) dst[m][k] = *(const PG8_LAS bf16x8*)(lds + PG8_SA(b, h) + aoff + m * 2048 + k * 1024); } while (0)
#define PG8_LDB(dst, b, h) do { _Pragma("unroll") for (int n = 0; n < 2; ++n) _Pragma("unroll") for (int k = 0; k < 2; ++k) dst[n][k] = *(const PG8_LAS bf16x8*)(lds + PG8_SB(b, h) + boff + n * 2048 + k * 1024); } while (0)
#define PG8_MMA(ai, bj, At, Bt) do { __builtin_amdgcn_s_setprio(1); _Pragma("unroll") for (int m = 0; m < 4; ++m) _Pragma("unroll") for (int n = 0; n < 2; ++n) _Pragma("unroll") for (int k = 0; k < 2; ++k) \
        acc[ai][bj][m][n] = __builtin_amdgcn_mfma_f32_16x16x32_bf16(Bt[n][k], At[m][k], acc[ai][bj][m][n], 0, 0, 0); __builtin_amdgcn_s_setprio(0); } while (0)
#define PG8_WAIT_V(n) asm volatile("s_waitcnt vmcnt(" #n ")" ::: "memory")
#define PG8_WAIT_L(n) asm volatile("s_waitcnt lgkmcnt(" #n ")" ::: "memory")
#define PG8_BAR __builtin_amdgcn_s_barrier()
#define PG8_SCHED __builtin_amdgcn_sched_barrier(0)
    Unit cur, nxt; int ui = 0;
    if (!S.next(0, cur)) return;
    f32x4 acc[2][2][4][2];
#pragma unroll
    for (int a = 0; a < 2; ++a)
#pragma unroll
        for (int b = 0; b < 2; ++b)
#pragma unroll
            for (int m = 0; m < 4; ++m)
#pragma unroll
                for (int n = 0; n < 2; ++n) acc[a][b][m][n] = (f32x4){0.f, 0.f, 0.f, 0.f};
    bf16x8 At[4][2], B0[2][2], B1[2][2];
    const char* cA = (const char*)g.A + (size_t)cur.pm * tstep + (size_t)cur.k0 * kstep; const char* cB = (const char*)g.Bt + (size_t)cur.pn * tstep + (size_t)cur.k0 * kstep;
    S.a_ready(cur);
    if constexpr (Epi::RSTAB) E.prefetch(cur, (PG8_LAS float*)(lds + STAGE_BYTES + 1024), tid);
    if constexpr (SP2) {
        PG8_STAGE(PG8_SB(0, 0), cB, voffB); PG8_STAGE(PG8_SB(0, 1), cB + hstep, voffB); PG8_STAGE(PG8_SA(0, 0), cA, voffA); PG8_STAGE(PG8_SA(0, 1), cA + hstep, voffA);
        if (wr == 1) PG8_BAR;
        PG8_WAIT_V(2); PG8_BAR;
        PG8_STAGE(PG8_SB(1, 0), cB + kstep, voffB); PG8_STAGE(PG8_SA(1, 0), cA + kstep, voffA); PG8_STAGE(PG8_SB(1, 1), cB + hstep + kstep, voffB);
        PG8_WAIT_V(6); PG8_BAR;
    } else {
        PG8_STAGE(PG8_SB(0, 0), cB, voffB); PG8_STAGE(PG8_SA(0, 0), cA, voffA); PG8_STAGE(PG8_SB(0, 1), cB + hstep, voffB); PG8_STAGE(PG8_SA(0, 1), cA + hstep, voffA);
        if (wr == 1) PG8_BAR;
        PG8_WAIT_V(4); PG8_BAR;
        PG8_STAGE(PG8_SB(1, 0), cB + kstep, voffB); PG8_STAGE(PG8_SA(1, 0), cA + kstep, voffA); PG8_STAGE(PG8_SB(1, 1), cB + hstep + kstep, voffB);
        PG8_WAIT_V(6); PG8_BAR;
    }
    for (;;) {
        const bool has_next = S.next(ui + 1, nxt);
        const char* nA = has_next ? (const char*)g.A + (size_t)nxt.pm * tstep + (size_t)nxt.k0 * kstep : cA; const char* nB = has_next ? (const char*)g.Bt + (size_t)nxt.pn * tstep + (size_t)nxt.k0 * kstep : cB;
        const int nt = cur.nk ? cur.nk : K / BK;
        for (int t = 0; t < nt; t += 2) {
            const bool last = (t == nt - 2);
            const char* a1 = cA + (size_t)(t + 1) * kstep;
            const char* a2 = last ? nA : cA + (size_t)(t + 2) * kstep; const char* b2 = last ? nB : cB + (size_t)(t + 2) * kstep;
            const char* a3 = a2 + kstep; const char* b3 = b2 + kstep;
            if (last && has_next) S.a_ready(nxt);
            if constexpr (SP2) {
            PG8_LDB(B0, 0, 0); PG8_LDB(B1, 0, 1); PG8_SCHED; PG8_LDA(At, 0, 0); PG8_STAGE(PG8_SA(1, 1), a1 + hstep, voffA);
            PG8_WAIT_V(8); PG8_WAIT_L(0); PG8_BAR; PG8_MMA(0, 0, At, B0); PG8_MMA(0, 1, At, B1); PG8_BAR; PG8_SCHED;
            PG8_LDA(At, 0, 1); PG8_STAGE(PG8_SB(0, 0), b2, voffB); PG8_STAGE(PG8_SB(0, 1), b2 + hstep, voffB); PG8_STAGE(PG8_SA(0, 0), a2, voffA);
            PG8_WAIT_V(8); PG8_WAIT_L(0); PG8_BAR; PG8_MMA(1, 0, At, B0); PG8_MMA(1, 1, At, B1); PG8_BAR; PG8_SCHED;
            PG8_LDB(B0, 1, 0); PG8_LDB(B1, 1, 1); PG8_SCHED; PG8_LDA(At, 1, 0); PG8_STAGE(PG8_SA(0, 1), a2 + hstep, voffA);
            PG8_WAIT_V(8); PG8_WAIT_L(0); PG8_BAR; PG8_MMA(0, 0, At, B0); PG8_MMA(0, 1, At, B1); PG8_BAR; PG8_SCHED;
            PG8_LDA(At, 1, 1); PG8_STAGE(PG8_SB(1, 0), b3, voffB); PG8_STAGE(PG8_SB(1, 1), b3 + hstep, voffB); PG8_STAGE(PG8_SA(1, 0), a3, voffA);
            PG8_WAIT_V(8); PG8_WAIT_L(0); PG8_BAR; PG8_MMA(1, 0, At, B0); PG8_MMA(1, 1, At, B1); PG8_BAR; PG8_SCHED;
            } else {
            PG8_LDB(B0, 0, 0); PG8_SCHED; PG8_LDA(At, 0, 0); PG8_STAGE(PG8_SA(1, 1), a1 + hstep, voffA);
            PG8_WAIT_L(8); PG8_BAR; PG8_WAIT_L(0); PG8_MMA(0, 0, At, B0); PG8_BAR; PG8_SCHED;
            PG8_LDB(B1, 0, 1); PG8_STAGE(PG8_SB(0, 0), b2, voffB);
            PG8_BAR; PG8_WAIT_L(0); PG8_MMA(0, 1, At, B1); PG8_BAR;
            PG8_LDA(At, 0, 1); PG8_STAGE(PG8_SA(0, 0), a2, voffA);
            PG8_BAR; PG8_WAIT_L(0); PG8_MMA(1, 0, At, B0); PG8_BAR; PG8_SCHED;
            PG8_STAGE(PG8_SB(0, 1), b2 + hstep, voffB);
            PG8_WAIT_V(6); PG8_BAR; PG8_MMA(1, 1, At, B1); PG8_BAR;
            PG8_LDB(B0, 1, 0); PG8_SCHED; PG8_LDA(At, 1, 0); PG8_STAGE(PG8_SA(0, 1), a2 + hstep, voffA);
            PG8_WAIT_L(8); PG8_BAR; PG8_WAIT_L(0); PG8_MMA(0, 0, At, B0); PG8_BAR; PG8_SCHED;
            PG8_LDB(B1, 1, 1); PG8_STAGE(PG8_SB(1, 0), b3, voffB);
            PG8_BAR; PG8_WAIT_L(0); PG8_MMA(0, 1, At, B1); PG8_BAR;
            PG8_LDA(At, 1, 1); PG8_STAGE(PG8_SA(1, 0), a3, voffA);
            PG8_BAR; PG8_WAIT_L(0); PG8_MMA(1, 0, At, B0); PG8_BAR; PG8_SCHED;
            PG8_STAGE(PG8_SB(1, 1), b3 + hstep, voffB);
            PG8_WAIT_V(6); PG8_BAR; PG8_MMA(1, 1, At, B1); PG8_BAR;
            }
        }
        if constexpr (ALIGN_EPI) { if (wr == 0) PG8_BAR; }
        int fr2 = fr, fq2 = fq, tid2 = tid; asm volatile("" : "+v"(fr2), "+v"(fq2), "+v"(tid2));
        if constexpr (Sched::STREAMK) {
            if (cur.mode == 1) {
                unsigned char* pp = S.part + (size_t)S.r * 131072 + (size_t)tid2 * 16;
#pragma unroll
                for (int a = 0; a < 2; ++a)
#pragma unroll
                    for (int b = 0; b < 2; ++b)
#pragma unroll
                        for (int m = 0; m < 4; ++m) { u32x4 w; w.x = pk2(acc[a][b][m][0][0], acc[a][b][m][0][1]); w.y = pk2(acc[a][b][m][0][2], acc[a][b][m][0][3]); w.z = pk2(acc[a][b][m][1][0], acc[a][b][m][1][1]); w.w = pk2(acc[a][b][m][1][2], acc[a][b][m][1][3]);
                            asm volatile("global_store_dwordx4 %0, %1, off sc0 sc1" :: "v"(pp + ((a * 2 + b) * 4 + m) * 8192), "v"(w) : "memory"); }
                asm volatile("s_waitcnt vmcnt(0)" ::: "memory");
                if (lane == 0) __hip_atomic_fetch_add(S.flags + 16 * S.r, 1u, __ATOMIC_RELAXED, __HIP_MEMORY_SCOPE_AGENT);
            } else {
                const bool tail = cur.mode == 2;
                if (tail) {
                    unsigned sp = 0;
                    while ((unsigned)__builtin_amdgcn_readfirstlane(__hip_atomic_load(S.flags + 16 * (S.r - 1), __ATOMIC_RELAXED, __HIP_MEMORY_SCOPE_AGENT)) < 8u) { __builtin_amdgcn_s_sleep(2); if (++sp > (1u << 22)) break; }
                }
                const unsigned char* pp = tail ? S.part + (size_t)(S.r - 1) * 131072 + (size_t)tid2 * 16 : nullptr;
                E(acc, cur, wr, wc, fr2, fq2, pp);
            }
        } else
        if constexpr (Epi::RSTAB) { E(acc, cur, wr, wc, fr2, fq2, (const PG8_LAS float*)(lds + STAGE_BYTES + 1024) + (ui & 1) * 256); } else
        if constexpr (!Epi::AFTER_DRAIN) { E(acc, cur, wr, wc, fr2, fq2); S.done(cur); }
        if (!has_next) break;
#pragma unroll
        for (int a = 0; a < 2; ++a)
#pragma unroll
            for (int b = 0; b < 2; ++b)
#pragma unroll
                for (int m = 0; m < 4; ++m)
#pragma unroll
                    for (int n = 0; n < 2; ++n) acc[a][b][m][n] = (f32x4){0.f, 0.f, 0.f, 0.f};
        cur = nxt; cA = nA; cB = nB; ++ui;
        if constexpr (Epi::RSTAB) E.prefetch(cur, (PG8_LAS float*)(lds + STAGE_BYTES + 1024) + (ui & 1) * 256, tid2);
        if constexpr (ALIGN_EPI) { if (wr == 1) PG8_BAR; }
    }
    PG8_WAIT_V(0);
    if constexpr (!ALIGN_EPI) { if (wr == 0) PG8_BAR; }
    PG8_BAR;
    if constexpr (Epi::AFTER_DRAIN) { E.fused(acc, cur, wr, wc, fr, fq, lds, wid, lane); S.done(cur); }
#undef PG8_SA
#undef PG8_SB
#undef PG8_STAGE
#undef PG8_LDA
#undef PG8_LDB
#undef PG8_MMA
#undef PG8_WAIT_V
#undef PG8_WAIT_L
#undef PG8_BAR
#undef PG8_SCHED
}
}

constexpr size_t SZ_WIN = (size_t)NIN * DM * 2, SZ_WO = (size_t)DM * DM * 2, SZ_WGU = (size_t)NGU * DM * 2, SZ_WD = (size_t)DM * DFFN * 2, SZ_WL = SZ_WIN + SZ_WO + SZ_WGU + SZ_WD;
constexpr size_t WS_CTL = 0;
constexpr size_t WS_FLAGS = 16384;
constexpr size_t WS_ZERO = 16384 + 4 * 256 * 64;
constexpr size_t WS_CTR = WS_ZERO + 256;
constexpr size_t WS_W = WS_CTR + 4 * 64;
constexpr size_t WS_XB = WS_W + DEPTH * SZ_WL;
constexpr size_t WS_MRG = WS_XB + (size_t)MP * DM * 2;
constexpr size_t WS_Z = WS_MRG + (size_t)MP * DM * 2;
constexpr size_t WS_LD = WS_Z + (size_t)MP * ZP * 2;
constexpr size_t WS_U = WS_Z;
constexpr size_t WS_DS = WS_LD + (size_t)MP * 256 * 4;
constexpr size_t WS_SC = WS_DS + (size_t)16 * NCH * 64 * 128 * 4;
constexpr size_t WS_GL = WS_SC + (size_t)16 * NCH * 64 * 128 * 2;
constexpr size_t WS_SSQA = WS_GL + (size_t)16 * NCH * 64 * 4;
constexpr size_t WS_SSQB = WS_SSQA + (size_t)MP * 16 * 4;
constexpr size_t WS_XMETA = WS_SSQB + (size_t)MP * 16 * 4;
constexpr size_t WS_END = WS_XMETA + (size_t)64 * DM * 4;
static_assert((size_t)MP * DFFN * 2 <= (size_t)MP * ZP * 2 + (size_t)MP * 256 * 4, "U overlay fits Z|LD");
static_assert(WS_END <= 268435456ull, "workspace map fits 256 MiB");

#ifndef REP_PRO
#define REP_PRO 1
#endif
#ifndef REP_WIN
#define REP_WIN 1
#endif
#ifndef REP_MB
#define REP_MB 1
#endif
#ifndef REP_SCAN
#define REP_SCAN 1
#endif
#ifndef REP_GU
#define REP_GU 1
#endif
#ifndef REP_G1
#define REP_G1 1
#endif
#ifndef REP_AS
#define REP_AS 1
#endif
#ifndef REP_GS
#define REP_GS 1
#endif
#ifndef REP_G3
#define REP_G3 1
#endif
#ifndef REP_AP
#define REP_AP 1
#endif
#ifndef REP_WO0
#define REP_WO0 1
#endif
#ifndef DRY_WO
#define DRY_WO 0
#endif
#ifndef DRY_DN
#define DRY_DN 0
#endif
#ifndef TIME_PH
#define TIME_PH -1
#endif
#ifndef TIME_MULT
#define TIME_MULT 4
#endif
#ifndef TIME_BUSY
#define TIME_BUSY 0
#endif
#ifndef TIME_SUB
#define TIME_SUB -1
#endif
#ifndef XSYNC
#define XSYNC 0
#endif
constexpr int LDS_BYTES = 147456;
constexpr int NPHASE = 1 + 7 * DEPTH;

struct Args { const float* in[19]; float* out; unsigned char* ws; int ph_lo, ph_hi; };
typedef const __attribute__((address_space(4))) Args* KA;
DI KA ka_ptr() { KA p = (KA)__builtin_amdgcn_kernarg_segment_ptr(); asm volatile("" : "+s"(p)); return p; }

DI int mk_tid(int wave_s) { int lane; asm volatile("v_mbcnt_lo_u32_b32 %0, -1, 0\n\tv_mbcnt_hi_u32_b32 %0, -1, %0" : "=v"(lane)); return wave_s * 64 + lane; }
typedef short v4i16_t __attribute__((ext_vector_type(4)));
DI u32x2 tr4(const LAS unsigned char* p) { return __builtin_bit_cast(u32x2, __builtin_amdgcn_ds_read_tr16_b64_v4i16((LAS v4i16_t*)p)); }
#if TIME_SUB >= 0
#define TICK(id) do { if (blockIdx.x == 0 && tid == 0) { volatile LAS unsigned* M_ = (volatile LAS unsigned*)(lds + 131072 + 320); const unsigned now_ = (unsigned)__builtin_amdgcn_s_memrealtime(); M_[100 + (id)] += now_ - M_[99]; M_[99] = now_; } } while (0)
#else
#define TICK(id) do {} while (0)
#endif
DI bf16x8 mk8(u32x2 lo, u32x2 hi) { u32x4 w; w.x = lo.x; w.y = lo.y; w.z = hi.x; w.w = hi.y; return __builtin_bit_cast(bf16x8, w); }
#define MFMA16(a, b, c) __builtin_amdgcn_mfma_f32_16x16x32_bf16((a), (b), (c), 0, 0, 0)

DI void attn_wave(const LAS unsigned char* Ks, const LAS unsigned char* Vt, const int VPB, const u32x4 qa, const u32x4 qb, const float* qnw, const float sink2, const int jmin, const int c, const int fq, bf16_t* orow) {
    float qf[16]; unpack8(qa, qf); unpack8(qb, qf + 8);
    float ss = 0.f;
#pragma unroll
    for (int i = 0; i < 16; ++i) ss += qf[i] * qf[i];
    ss = red4rows(ss);
    const float rs = rsqrtf(ss * (1.0f / 64.0f) + EPS) * (0.125f * LOG2E);
    const f32x4 w0 = *(const f32x4*)(qnw + 8 * fq), w1 = *(const f32x4*)(qnw + 8 * fq + 4), w2 = *(const f32x4*)(qnw + 32 + 8 * fq), w3 = *(const f32x4*)(qnw + 36 + 8 * fq);
#pragma unroll
    for (int i = 0; i < 4; ++i) { qf[i] *= rs * w0[i]; qf[4 + i] *= rs * w1[i]; qf[8 + i] *= rs * w2[i]; qf[12 + i] *= rs * w3[i]; }
    u32x4 q0, q1; q0.x = pk2(qf[0], qf[1]); q0.y = pk2(qf[2], qf[3]); q0.z = pk2(qf[4], qf[5]); q0.w = pk2(qf[6], qf[7]);
    q1.x = pk2(qf[8], qf[9]); q1.y = pk2(qf[10], qf[11]); q1.z = pk2(qf[12], qf[13]); q1.w = pk2(qf[14], qf[15]);
    const bf16x8 qB0 = __builtin_bit_cast(bf16x8, q0), qB1 = __builtin_bit_cast(bf16x8, q1);
    f32x4 acc[9];
    float mx = sink2;
#pragma unroll
    for (int T = 0; T < 9; ++T) {
        const LAS unsigned char* kp = Ks + (16 * T + c) * 144 + 16 * fq;
        const bf16x8 a0 = *(const LAS bf16x8*)kp, a1 = *(const LAS bf16x8*)(kp + 64);
        f32x4 s = {0.f, 0.f, 0.f, 0.f};
        s = MFMA16(a0, qB0, s); s = MFMA16(a1, qB1, s);
#pragma unroll
        for (int r = 0; r < 4; ++r) { const int jrel = 16 * T + 4 * fq + r, d = 128 + c - jrel; const bool ok = ((unsigned)d < 128u) && (jrel >= jmin); s[r] = ok ? s[r] : -1e30f; mx = fmaxf(mx, s[r]); }
        acc[T] = s;
    }
    mx = max4rows(mx);
    float sum = 0.f;
#pragma unroll
    for (int T = 0; T < 9; ++T)
#pragma unroll
        for (int r = 0; r < 4; ++r) { const float p = __builtin_amdgcn_exp2f(acc[T][r] - mx); acc[T][r] = p; sum += p; }
    sum = red4rows(sum);
    const float inv = 1.0f / (sum + __builtin_amdgcn_exp2f(sink2 - mx));
    f32x4 o[4];
#pragma unroll
    for (int i = 0; i < 4; ++i) o[i] = (f32x4){0.f, 0.f, 0.f, 0.f};
#pragma unroll
    for (int kk = 0; kk < 5; ++kk) {
        u32x4 pw; pw.x = pk2(acc[2 * kk][0], acc[2 * kk][1]); pw.y = pk2(acc[2 * kk][2], acc[2 * kk][3]);
        if (kk < 4) { pw.z = pk2(acc[2 * kk + 1][0], acc[2 * kk + 1][1]); pw.w = pk2(acc[2 * kk + 1][2], acc[2 * kk + 1][3]); } else { pw.z = 0u; pw.w = 0u; }
        const bf16x8 pB = __builtin_bit_cast(bf16x8, pw);
#pragma unroll
        for (int Mt = 0; Mt < 4; ++Mt) {
            const LAS unsigned char* vp = Vt + (32 * kk + 4 * fq + (c >> 2)) * VPB + (16 * Mt + 4 * (c & 3)) * 2;
            const u32x2 lo = tr4(vp), hi = tr4(vp + 16 * VPB);
            o[Mt] = MFMA16(mk8(lo, hi), pB, o[Mt]);
        }
    }
    if (orow) {
#pragma unroll
        for (int Mt = 0; Mt < 4; ++Mt) { u32x2 w; w.x = pk2(o[Mt][0] * inv, o[Mt][1] * inv); w.y = pk2(o[Mt][2] * inv, o[Mt][3] * inv); *(u32x2*)(orow + 16 * Mt + 4 * fq) = w; }
    }
}

struct Ctx {
    int l;
    const bf16_t* Z; float* LD; bf16_t* MRG; float* DS; bf16_t* SC; float* GL;
    const float *qnw, *knw, *sinks, *gnw;
    const float *cache_k, *cache_v, *state;
    float* out;
};

DI void attn_prompt_unit(const Ctx& C, int uidx, LAS unsigned char* lds, const int wave_s) {
    const int tid = mk_tid(wave_s);
    const int jb = uidx % 65, g = (uidx / 65) & 1, b = uidx / 130;
    const int p0 = 64 * jb, kbase = p0 - 128, rowbase = b * LP, nq = (LP - p0) < 64 ? (LP - p0) : 64;
    LAS unsigned char* Ks = lds; LAS unsigned char* Vs = lds + 208 * 144;
    TICK(0);
    {
        const int dc = tid & 7;
        u32x4 rk[4], rv[4];
#pragma unroll
        for (int i = 0; i < 4; ++i) { const int j = (tid >> 3) + 64 * i, kp = kbase + j; const bool valid = (j < 192) && (kp >= 0) && (kp < LP);
            rk[i] = (u32x4){0u, 0u, 0u, 0u}; rv[i] = rk[i];
            if (valid) { const bf16_t* zr = C.Z + (size_t)(rowbase + kp) * ZP + g * 64 + dc * 8; rk[i] = *(const u32x4*)(zr + ZK); rv[i] = *(const u32x4*)(zr + ZV); } }
        const f32x4 kw0 = *(const f32x4*)(C.knw + dc * 8), kw1 = *(const f32x4*)(C.knw + dc * 8 + 4);
#pragma unroll
        for (int i = 0; i < 4; ++i) { const int j = (tid >> 3) + 64 * i, kp = kbase + j; const bool valid = (j < 192) && (kp >= 0) && (kp < LP);
            float f[8]; unpack8(rk[i], f); float ss = 0.f;
#pragma unroll
            for (int e = 0; e < 8; ++e) ss += f[e] * f[e];
            ss = sum8(ss);
            const float rs = rsqrtf(ss * (1.0f / 64.0f) + EPS);
#pragma unroll
            for (int e = 0; e < 4; ++e) { f[e] *= rs * kw0[e]; f[4 + e] *= rs * kw1[e]; }
            if (j < 208) { u32x4 o; o.x = pk2(f[0], f[1]); o.y = pk2(f[2], f[3]); o.z = pk2(f[4], f[5]); o.w = pk2(f[6], f[7]); *(LAS u32x4*)(Ks + j * 144 + dc * 16) = o; *(LAS u32x4*)(Vs + j * 144 + dc * 16) = rv[i]; }
            if (valid && j >= 128 && kp >= LP - 128) { const size_t oo = ((size_t)((C.l * NBATCH + b) * 128 + (kp - (LP - 128))) * 2 + g) * 64 + dc * 8;
                float* op = C.out + O_CKP + oo; *(f32x4*)op = (f32x4){f[0], f[1], f[2], f[3]}; *(f32x4*)(op + 4) = (f32x4){f[4], f[5], f[6], f[7]};
                float fv[8]; unpack8(rv[i], fv); float* ov = C.out + O_CVP + oo; *(f32x4*)ov = (f32x4){fv[0], fv[1], fv[2], fv[3]}; *(f32x4*)(ov + 4) = (f32x4){fv[4], fv[5], fv[6], fv[7]}; } }
    }
    __syncthreads();
    TICK(4);
    {
        const int tid2 = mk_tid(wave_s), lane = tid2 & 63, w = tid2 >> 6;
        const int s = w & 3, hp = w >> 2, c = lane & 15, fq = lane >> 4;
        if (16 * s < nq) {
            const int qp = p0 + 16 * s + c; const bool qv = qp < LP; const int h0 = g * 4 + hp * 2;
            u32x4 qr[2][2];
#pragma unroll
            for (int hh = 0; hh < 2; ++hh) { qr[hh][0] = (u32x4){0u, 0u, 0u, 0u}; qr[hh][1] = qr[hh][0];
                if (qv) { const bf16_t* qrow = C.Z + (size_t)(rowbase + qp) * ZP + ZQ + (h0 + hh) * 64; qr[hh][0] = *(const u32x4*)(qrow + 8 * fq); qr[hh][1] = *(const u32x4*)(qrow + 32 + 8 * fq); } }
#pragma unroll
            for (int hh = 0; hh < 2; ++hh) { const int h = h0 + hh;
                bf16_t* orow = qv ? C.MRG + (size_t)(rowbase + qp) * DM + h * 64 : nullptr;
                attn_wave(Ks + 16 * s * 144, Vs + 16 * s * 144, 144, qr[hh][0], qr[hh][1], C.qnw, C.sinks[h] * LOG2E, 128 - p0 - 16 * s, c, fq, orow); }
        }
    }
    __syncthreads();
    TICK(5);
}

DI void attn_sample_unit(const Ctx& C, int uidx, LAS unsigned char* lds, const int wave_s) {
    const int tid = mk_tid(wave_s);
    const int g = uidx & 1, b = uidx >> 1;
    constexpr int KSG = 160 * 144;
    TICK(0);
    const int row0 = MPROMPT + b * DECT;
    const size_t cbase = (size_t)(C.l * DECB + b) * 128;
#pragma unroll
    for (int i = 0; i < 2; ++i) {
        const int idx = tid + 512 * i, dc = idx & 7, j = idx >> 3;
        const size_t so = ((cbase + j) * 2 + g) * 64 + dc * 8;
        const f32x4 a = *(const f32x4*)(C.cache_k + so), bq = *(const f32x4*)(C.cache_k + so + 4), va = *(const f32x4*)(C.cache_v + so), vb = *(const f32x4*)(C.cache_v + so + 4);
        u32x4 o; o.x = pk2(a[0], a[1]); o.y = pk2(a[2], a[3]); o.z = pk2(bq[0], bq[1]); o.w = pk2(bq[2], bq[3]);
        *(LAS u32x4*)(lds + j * 144 + dc * 16) = o;
        u32x4 ov; ov.x = pk2(va[0], va[1]); ov.y = pk2(va[2], va[3]); ov.z = pk2(vb[0], vb[1]); ov.w = pk2(vb[2], vb[3]);
        *(LAS u32x4*)(lds + KSG + j * 144 + dc * 16) = ov;
        if (j >= 8) { const size_t oo = ((cbase + j - 8) * 2 + g) * 64 + dc * 8; float* op = C.out + O_CKS + oo; *(f32x4*)op = a; *(f32x4*)(op + 4) = bq; float* opv = C.out + O_CVS + oo; *(f32x4*)opv = va; *(f32x4*)(opv + 4) = vb; }
    }
    if (tid < 64) {
        const int dc = tid & 7, t = tid >> 3;
        const bf16_t* zr = C.Z + (size_t)(row0 + t) * ZP + g * 64 + dc * 8;
        const u32x4 raw = *(const u32x4*)(zr + ZK), rawv = *(const u32x4*)(zr + ZV);
        float f[8]; unpack8(raw, f); float ss = 0.f;
#pragma unroll
        for (int e = 0; e < 8; ++e) ss += f[e] * f[e];
        ss = sum8(ss);
        const float rs = rsqrtf(ss * (1.0f / 64.0f) + EPS);
        const f32x4 kw0 = *(const f32x4*)(C.knw + dc * 8), kw1 = *(const f32x4*)(C.knw + dc * 8 + 4);
#pragma unroll
        for (int e = 0; e < 4; ++e) { f[e] *= rs * kw0[e]; f[4 + e] *= rs * kw1[e]; }
        u32x4 o; o.x = pk2(f[0], f[1]); o.y = pk2(f[2], f[3]); o.z = pk2(f[4], f[5]); o.w = pk2(f[6], f[7]);
        *(LAS u32x4*)(lds + (128 + t) * 144 + dc * 16) = o;
        *(LAS u32x4*)(lds + KSG + (128 + t) * 144 + dc * 16) = rawv;
        const size_t oo = ((cbase + 120 + t) * 2 + g) * 64 + dc * 8;
        float* op = C.out + O_CKS + oo; *(f32x4*)op = (f32x4){f[0], f[1], f[2], f[3]}; *(f32x4*)(op + 4) = (f32x4){f[4], f[5], f[6], f[7]};
        float fv[8]; unpack8(rawv, fv); float* opv = C.out + O_CVS + oo; *(f32x4*)opv = (f32x4){fv[0], fv[1], fv[2], fv[3]}; *(f32x4*)(opv + 4) = (f32x4){fv[4], fv[5], fv[6], fv[7]};
    } else if (tid < 256) {
        const int idx = tid - 64, dc = idx & 7, r = idx >> 3;
        unsigned z0 = 0u; asm volatile("" : "+v"(z0));
        *(LAS u32x4*)(lds + (136 + r) * 144 + dc * 16) = (u32x4){z0, z0, z0, z0};
        *(LAS u32x4*)(lds + KSG + (136 + r) * 144 + dc * 16) = (u32x4){z0, z0, z0, z0};
    }
    __syncthreads();
    {
        const int tid2 = mk_tid(wave_s), lane = tid2 & 63, w2 = tid2 >> 6;
        if (w2 < 4) {
            const int h = g * 4 + w2, c = lane & 15, fq = lane >> 4;
            const bool qv = c < 8;
            const bf16_t* qrow = C.Z + (size_t)(row0 + (c & 7)) * ZP + ZQ + h * 64;
            const u32x4 qa = *(const u32x4*)(qrow + 8 * fq), qb = *(const u32x4*)(qrow + 32 + 8 * fq);
            bf16_t* orow = qv ? C.MRG + (size_t)(row0 + c) * DM + h * 64 : nullptr;
            attn_wave(lds, lds + KSG, 144, qa, qb, C.qnw, C.sinks[h] * LOG2E, 0, c, fq, orow);
        }
    }
    __syncthreads();
    TICK(8);
}

DI void gla_sample_unit(const Ctx& C, int uidx, LAS unsigned char* lds, const int wave_s) {
    const int tid = mk_tid(wave_s);
    const int h = uidx & 3, b = uidx >> 2, row0 = MPROMPT + b * DECT;
    TICK(0);
    LAS float* qs = (LAS float*)lds; LAS float* ks = qs + 512; LAS float* dec = ks + 512; LAS float* vs = dec + 512; LAS float* red = vs + 1024;
    {
        const int t = tid >> 6, k = tid & 63; const bf16_t* zr = C.Z + (size_t)(row0 + t) * ZP;
        qs[tid] = bf2f(zr[ZGQ + h * 64 + k]); ks[tid] = bf2f(zr[ZGK + h * 64 + k]); dec[tid] = __expf(C.LD[(size_t)(row0 + t) * 256 + h * 64 + k]);
#pragma unroll
        for (int i = 0; i < 2; ++i) { const int idx = tid + 512 * i, tt = idx >> 7, v = idx & 127; vs[idx] = bf2f(C.Z[(size_t)(row0 + tt) * ZP + ZGV + h * 128 + v]); }
    }
    const int v = tid & 127, kq = tid >> 7;
    const size_t sbase = ((size_t)((C.l * DECB + b) * 4 + h) * 64 + 16 * kq) * 128 + v;
    float S[16];
#pragma unroll
    for (int i = 0; i < 16; ++i) S[i] = C.state[sbase + (size_t)i * 128];
    __syncthreads();
#pragma unroll
    for (int t = 0; t < 8; ++t) { float a = 0.f; const float vv = vs[t * 128 + v];
#pragma unroll
        for (int i = 0; i < 16; ++i) { const int k = 16 * kq + i; S[i] = dec[t * 64 + k] * S[i] + ks[t * 64 + k] * vv; a += qs[t * 64 + k] * S[i]; }
        red[(kq * 8 + t) * 128 + v] = a; }
    float* so = C.out + O_SS + sbase;
#pragma unroll
    for (int i = 0; i < 16; ++i) so[(size_t)i * 128] = S[i];
    __syncthreads();
    {
        const int t = tid >> 6, lane = tid & 63; float o[2]; float ss = 0.f;
#pragma unroll
        for (int i = 0; i < 2; ++i) { const int vv = lane + 64 * i; o[i] = (red[(0 * 8 + t) * 128 + vv] + red[(1 * 8 + t) * 128 + vv]) + (red[(2 * 8 + t) * 128 + vv] + red[(3 * 8 + t) * 128 + vv]); ss += o[i] * o[i]; }
        ss = sum64(ss);
        const float rs = rsqrtf(ss * (1.0f / 128.0f) + EPS);
#pragma unroll
        for (int i = 0; i < 2; ++i) { const int vv = lane + 64 * i; const float og = bf2f(C.Z[(size_t)(row0 + t) * ZP + ZOG + h * 128 + vv]);
            const float y = o[i] * rs * C.gnw[vv] * silu_f(og); C.MRG[(size_t)(row0 + t) * DM + 512 + h * 128 + vv] = (bf16_t)(pk2(y, 0.f) & 0xffffu); }
    }
    __syncthreads();
    TICK(9);
}

DI void gla_prefix_load(const float* LD, int r0, int nv, int h, int lane, int w, float (&g)[16]) {
#pragma unroll
    for (int i = 0; i < 16; ++i) { const int t = 16 * w + i; g[i] = t < nv ? LD[(size_t)(r0 + t) * 256 + h * 64 + lane] : 0.f; }
}
DI float gla_prefix_finish(float (&g)[16], LAS float* Gs, LAS float* segtot, int lane, int w) {
    const int k = lane, seg = w;
#pragma unroll
    for (int i = 1; i < 16; ++i) g[i] += g[i - 1];
    segtot[seg * 64 + k] = g[15];
    __syncthreads();
    float off = 0.f, tot = 0.f;
#pragma unroll
    for (int s = 0; s < 8; ++s) { const float x = segtot[s * 64 + k]; off += (s < seg) ? x : 0.f; tot += x; }
#pragma unroll
    for (int i = 0; i < 16; ++i) { const int t = 16 * seg + i; Gs[t * 65 + k] = g[i] + off; }
    return tot;
}

DI void gla1_unit(const Ctx& C, int unit, LAS unsigned char* lds, const int wave_s) {
    const int tid = mk_tid(wave_s);
    const int c = unit % NCH, bh = unit / NCH, h = bh & 3, b = bh >> 2;
    const int r0 = b * LP + 128 * c, nv = (LP - 128 * c) < 128 ? (LP - 128 * c) : 128;
    LAS float* Gs = (LAS float*)lds; LAS float* segtot = (LAS float*)(lds + 33280); LAS float* gl = (LAS float*)(lds + 35328);
    LAS unsigned char* kdS = lds + 35840; LAS unsigned char* Vs = lds + 54272;
    const int lane = tid & 63, w = tid >> 6;
    TICK(0);
    float g[16]; gla_prefix_load(C.LD, r0, nv, h, lane, w, g);
    u32x4 rk[2], rv[4];
#pragma unroll
    for (int i = 0; i < 2; ++i) { const int t = (tid >> 3) + 64 * i; rk[i] = (u32x4){0u, 0u, 0u, 0u}; if (t < nv) rk[i] = *(const u32x4*)(C.Z + (size_t)(r0 + t) * ZP + ZGK + h * 64 + (tid & 7) * 8); }
#pragma unroll
    for (int i = 0; i < 4; ++i) { const int t = (tid >> 4) + 32 * i; rv[i] = (u32x4){0u, 0u, 0u, 0u}; if (t < nv) rv[i] = *(const u32x4*)(C.Z + (size_t)(r0 + t) * ZP + ZGV + h * 128 + (tid & 15) * 8); }
    { const float tot = gla_prefix_finish(g, Gs, segtot, lane, w); if (w == 0) { gl[lane] = tot; C.GL[(size_t)unit * 64 + lane] = tot; } }
#pragma unroll
    for (int i = 0; i < 4; ++i) { const int t = (tid >> 4) + 32 * i; *(LAS u32x4*)(Vs + t * 272 + (tid & 15) * 16) = rv[i]; }
    __syncthreads();
    {
        const int kc = tid & 7;
#pragma unroll
        for (int i = 0; i < 2; ++i) { const int t = (tid >> 3) + 64 * i; float f[8]; unpack8(rk[i], f);
#pragma unroll
            for (int e = 0; e < 8; ++e) f[e] *= __expf(gl[kc * 8 + e] - Gs[t * 65 + kc * 8 + e]);
            u32x4 o; o.x = pk2(f[0], f[1]); o.y = pk2(f[2], f[3]); o.z = pk2(f[4], f[5]); o.w = pk2(f[6], f[7]); *(LAS u32x4*)(kdS + t * 144 + kc * 16) = o; }
    }
    __syncthreads();
    {
        const int cc = lane & 15, fq = lane >> 4;
#pragma unroll
        for (int kt = 0; kt < 4; ++kt) { f32x4 acc = {0.f, 0.f, 0.f, 0.f};
#pragma unroll
            for (int ks = 0; ks < 4; ++ks) {
                const LAS unsigned char* ap = kdS + (32 * ks + 8 * fq + (cc >> 2)) * 144 + (16 * kt + 4 * (cc & 3)) * 2;
                const LAS unsigned char* bp = Vs + (32 * ks + 8 * fq + (cc >> 2)) * 272 + (16 * w + 4 * (cc & 3)) * 2;
                acc = MFMA16(mk8(tr4(ap), tr4(ap + 4 * 144)), mk8(tr4(bp), tr4(bp + 4 * 272)), acc); }
#pragma unroll
            for (int r = 0; r < 4; ++r) C.DS[((size_t)unit * 64 + 16 * kt + 4 * fq + r) * 128 + 16 * w + cc] = acc[r]; }
    }
    __syncthreads();
    TICK(6);
}

DI void gla3_unit(const Ctx& C, int unit, LAS unsigned char* lds, const int wave_s) {
    const int tid = mk_tid(wave_s);
    const int c = unit % NCH, bh = unit / NCH, h = bh & 3, b = bh >> 2;
    const int r0 = b * LP + 128 * c, nv = (LP - 128 * c) < 128 ? (LP - 128 * c) : 128;
    LAS unsigned char* qg = lds; LAS unsigned char* kg = lds + 18432; LAS unsigned char* Vs = lds + 36864; LAS unsigned char* Ss = lds + 71680;
    LAS float* Gs = (LAS float*)(lds + 89088); LAS float* segtot = (LAS float*)(lds + 122368);
    const int lane = tid & 63, w = __builtin_amdgcn_readfirstlane(tid >> 6);
    TICK(0);
    float g[16]; gla_prefix_load(C.LD, r0, nv, h, lane, w, g);
    u32x4 rq[2], rk[2], rv[4], rs_[2];
#pragma unroll
    for (int i = 0; i < 2; ++i) { const int t = (tid >> 3) + 64 * i; rq[i] = (u32x4){0u, 0u, 0u, 0u}; rk[i] = rq[i];
        if (t < nv) { const bf16_t* zr = C.Z + (size_t)(r0 + t) * ZP + h * 64 + (tid & 7) * 8; rq[i] = *(const u32x4*)(zr + ZGQ); rk[i] = *(const u32x4*)(zr + ZGK); } }
#pragma unroll
    for (int i = 0; i < 4; ++i) { const int t = (tid >> 4) + 32 * i; rv[i] = (u32x4){0u, 0u, 0u, 0u}; if (t < nv) rv[i] = *(const u32x4*)(C.Z + (size_t)(r0 + t) * ZP + ZGV + h * 128 + (tid & 15) * 8); }
#pragma unroll
    for (int i = 0; i < 2; ++i) { const int k = (tid >> 4) + 32 * i; rs_[i] = *(const u32x4*)(C.SC + ((size_t)unit * 64 + k) * 128 + (tid & 15) * 8); }
    (void)gla_prefix_finish(g, Gs, segtot, lane, w);
#pragma unroll
    for (int i = 0; i < 4; ++i) { const int t = (tid >> 4) + 32 * i; *(LAS u32x4*)(Vs + t * 272 + (tid & 15) * 16) = rv[i]; }
#pragma unroll
    for (int i = 0; i < 2; ++i) { const int k = (tid >> 4) + 32 * i; *(LAS u32x4*)(Ss + k * 272 + (tid & 15) * 16) = rs_[i]; }
    __syncthreads();
    TICK(1);
    {
        const int kc = tid & 7;
#pragma unroll
        for (int i = 0; i < 2; ++i) { const int t = (tid >> 3) + 64 * i; float fq_[8], fk_[8]; unpack8(rq[i], fq_); unpack8(rk[i], fk_);
#pragma unroll
            for (int e = 0; e < 8; ++e) { const float ev = __expf(Gs[t * 65 + kc * 8 + e]); fq_[e] *= ev; fk_[e] *= __builtin_amdgcn_rcpf(ev); }
            u32x4 oq, ok; oq.x = pk2(fq_[0], fq_[1]); oq.y = pk2(fq_[2], fq_[3]); oq.z = pk2(fq_[4], fq_[5]); oq.w = pk2(fq_[6], fq_[7]);
            ok.x = pk2(fk_[0], fk_[1]); ok.y = pk2(fk_[2], fk_[3]); ok.z = pk2(fk_[4], fk_[5]); ok.w = pk2(fk_[6], fk_[7]);
            *(LAS u32x4*)(qg + t * 144 + kc * 16) = oq; *(LAS u32x4*)(kg + t * 144 + kc * 16) = ok; }
    }
    __syncthreads();
    TICK(2);
    {
        const int cc = lane & 15, fq = lane >> 4;
        const int t = 16 * w + cc; const size_t row = (size_t)(r0 + (t < nv ? t : 0));
        u32x2 og[8];
#pragma unroll
        for (int Mt = 0; Mt < 8; ++Mt) og[Mt] = *(const u32x2*)(C.Z + row * ZP + ZOG + h * 128 + 16 * Mt + 4 * fq);
        const bf16x8 qB0 = *(const LAS bf16x8*)(qg + (16 * w + cc) * 144 + 16 * fq), qB1 = *(const LAS bf16x8*)(qg + (16 * w + cc) * 144 + 64 + 16 * fq);
        f32x4 A[8];
#pragma unroll
        for (int T = 0; T < 8; ++T) { f32x4 sa = {0.f, 0.f, 0.f, 0.f};
            const LAS unsigned char* kp = kg + (16 * T + cc) * 144 + 16 * fq; const bf16x8 a0 = *(const LAS bf16x8*)kp, a1 = *(const LAS bf16x8*)(kp + 64);
            sa = MFMA16(a0, qB0, sa); sa = MFMA16(a1, qB1, sa);
#pragma unroll
            for (int r = 0; r < 4; ++r) sa[r] = (16 * T + 4 * fq + r > t) ? 0.f : sa[r];
            A[T] = sa; }
        bf16x8 P[4];
#pragma unroll
        for (int kk = 0; kk < 4; ++kk) { u32x4 pw; pw.x = pk2(A[2 * kk][0], A[2 * kk][1]); pw.y = pk2(A[2 * kk][2], A[2 * kk][3]); pw.z = pk2(A[2 * kk + 1][0], A[2 * kk + 1][1]); pw.w = pk2(A[2 * kk + 1][2], A[2 * kk + 1][3]); P[kk] = __builtin_bit_cast(bf16x8, pw); }
        f32x4 o[8]; float ss = 0.f;
#pragma unroll
        for (int Mt = 0; Mt < 8; ++Mt) o[Mt] = (f32x4){0.f, 0.f, 0.f, 0.f};
#pragma unroll
        for (int kk = 0; kk < 4; ++kk)
#pragma unroll
            for (int Mt = 0; Mt < 8; ++Mt) {
                const LAS unsigned char* vp = Vs + (32 * kk + 4 * fq + (cc >> 2)) * 272 + (16 * Mt + 4 * (cc & 3)) * 2;
                o[Mt] = MFMA16(mk8(tr4(vp), tr4(vp + 16 * 272)), P[kk], o[Mt]); }
#pragma unroll
        for (int ks = 0; ks < 2; ++ks)
#pragma unroll
            for (int Mt = 0; Mt < 8; ++Mt) {
                const LAS unsigned char* sp = Ss + (32 * ks + 8 * fq + (cc >> 2)) * 272 + (16 * Mt + 4 * (cc & 3)) * 2;
                o[Mt] = MFMA16(mk8(tr4(sp), tr4(sp + 4 * 272)), ks ? qB1 : qB0, o[Mt]); }
#pragma unroll
        for (int Mt = 0; Mt < 8; ++Mt) ss += (o[Mt][0] * o[Mt][0] + o[Mt][1] * o[Mt][1]) + (o[Mt][2] * o[Mt][2] + o[Mt][3] * o[Mt][3]);
        ss = red4rows(ss);
        const float rs = rsqrtf(ss * (1.0f / 128.0f) + EPS);
        if (t < nv) {
#pragma unroll
            for (int Mt = 0; Mt < 8; ++Mt) { const int v0 = 16 * Mt + 4 * fq; const f32x4 gn = *(const f32x4*)(C.gnw + v0);
                const float y0 = o[Mt][0] * rs * gn[0] * silu_f(bflo(og[Mt].x)), y1 = o[Mt][1] * rs * gn[1] * silu_f(bfhi(og[Mt].x)), y2 = o[Mt][2] * rs * gn[2] * silu_f(bflo(og[Mt].y)), y3 = o[Mt][3] * rs * gn[3] * silu_f(bfhi(og[Mt].y));
                u32x2 wv; wv.x = pk2(y0, y1); wv.y = pk2(y2, y3); *(u32x2*)(C.MRG + row * DM + 512 + h * 128 + v0) = wv; } }
    }
    __syncthreads();
    TICK(3);
}

DI void gla_scan(const Ctx& C, int gtid, int gthreads) {
    for (int idx = gtid; idx < 16 * 64 * 128; idx += gthreads) {
        const int v = idx & 127, k = (idx >> 7) & 63, bh = idx >> 13;
        const size_t u0 = (size_t)bh * NCH;
        float ds[NCH], dg[NCH];
#pragma unroll
        for (int c = 0; c < NCH; ++c) { ds[c] = C.DS[((u0 + c) * 64 + k) * 128 + v]; dg[c] = C.GL[(u0 + c) * 64 + k]; }
        float S = 0.f;
#pragma unroll
        for (int c = 0; c < NCH; ++c) { C.SC[((u0 + c) * 64 + k) * 128 + v] = (bf16_t)(pk2(S, 0.f) & 0xffffu); S = __expf(dg[c]) * S + ds[c]; }
        const int h = bh & 3, b = bh >> 2;
        C.out[O_SP + ((size_t)((C.l * NBATCH + b) * 4 + h) * 64 + k) * 128 + v] = S;
    }
}

struct WSrc { int mat; const float* W; const float* W2; const float* gain; const float* wg2; };
DI float wsrc(const WSrc& s, int k, int n) {
    if (s.mat == 0) {
        if (n < 2304) { const int col = n < 1792 ? n : n + 16; const float sc = (n >= 768 && n < 1024) ? 0.125f : 1.0f; return s.W[(size_t)k * INW + col] * s.gain[k] * sc; }
        const int e = n - 2304; float a = 0.f;
#pragma unroll
        for (int r = 0; r < 16; ++r) a += s.W[(size_t)k * INW + 1792 + r] * s.wg2[r * 256 + e];
        return a * s.gain[k];
    } else if (s.mat == 1) { return s.W[(size_t)k * DM + n];
    } else if (s.mat == 2) { const int pn = n >> 8, j = n & 255; return (j < 128 ? s.W[(size_t)k * DFFN + 128 * pn + j] : s.W2[(size_t)k * DFFN + 128 * pn + j - 128]) * s.gain[k];
    } else { return s.W[(size_t)k * DM + n]; }
}
DI f32x4 wsrc4(const WSrc& s, int k, int n) {
    if (s.mat == 0) { const int col = n < 1792 ? n : n + 16; const float sc = ((n >= 768 && n < 1024) ? 0.125f : 1.0f) * s.gain[k]; return *(const f32x4*)(s.W + (size_t)k * INW + col) * sc; }
    else if (s.mat == 1) return *(const f32x4*)(s.W + (size_t)k * DM + n);
    else if (s.mat == 2) { const int pn = n >> 8, j = n & 255; const float* src = j < 128 ? s.W + (size_t)k * DFFN + 128 * pn + j : s.W2 + (size_t)k * DFFN + 128 * pn + j - 128; return *(const f32x4*)src * s.gain[k]; }
    else return *(const f32x4*)(s.W + (size_t)k * DM + n);
}
DI void conv_item_lr(const WSrc& s, int K, bf16_t* WT, LAS float* scr, int item, int lane) {
    const int kb = item >> 3, nb = item & 7, k0 = 64 * kb, n0 = 2304 + 32 * nb;
    const int e = lane & 31; float g2[16];
#pragma unroll
    for (int r = 0; r < 16; ++r) g2[r] = s.wg2[r * 256 + 32 * nb + e];
#pragma unroll 8
    for (int i = 0; i < 32; ++i) { const int kk = 2 * i + (lane >> 5); const f32x4* wp = (const f32x4*)(s.W + (size_t)(k0 + kk) * INW + 1792);
        const f32x4 a = wp[0], b = wp[1], c4 = wp[2], d = wp[3];
        const float acc = ((a[0] * g2[0] + a[1] * g2[1]) + (a[2] * g2[2] + a[3] * g2[3])) + ((b[0] * g2[4] + b[1] * g2[5]) + (b[2] * g2[6] + b[3] * g2[7]))
                        + ((c4[0] * g2[8] + c4[1] * g2[9]) + (c4[2] * g2[10] + c4[3] * g2[11])) + ((d[0] * g2[12] + d[1] * g2[13]) + (d[2] * g2[14] + d[3] * g2[15]));
        scr[kk * 33 + e] = acc * s.gain[k0 + kk]; }
    asm volatile("s_waitcnt lgkmcnt(0)" ::: "memory");
    const int c = lane & 7;
#pragma unroll
    for (int j = 0; j < 4; ++j) { const int n = (lane >> 3) + 8 * j; const LAS float* sp = scr + (8 * c) * 33 + n;
        u32x4 o; o.x = pk2(sp[0 * 33], sp[1 * 33]); o.y = pk2(sp[2 * 33], sp[3 * 33]); o.z = pk2(sp[4 * 33], sp[5 * 33]); o.w = pk2(sp[6 * 33], sp[7 * 33]);
        *(u32x4*)(WT + (size_t)(n0 + n) * K + k0 + 8 * c) = o; }
    asm volatile("s_waitcnt lgkmcnt(0)" ::: "memory");
}
DI void conv_item(const WSrc& s, int K, int nblk, bf16_t* WT, LAS unsigned char* tile, int item, int lane) {
    const int kb = item / nblk, nb = item % nblk, k0 = 64 * kb, n0 = 64 * nb;
    const int krow = lane >> 4, n4 = (lane & 15) * 4;
    f32x4 v[16];
#pragma unroll
    for (int st = 0; st < 16; ++st) v[st] = wsrc4(s, k0 + 4 * st + krow, n0 + n4);
#pragma unroll
    for (int st = 0; st < 16; ++st) { u32x2 w; w.x = pk2(v[st][0], v[st][1]); w.y = pk2(v[st][2], v[st][3]); *(LAS u32x2*)(tile + (4 * st + krow) * 136 + n4 * 2) = w; }
    asm volatile("s_waitcnt lgkmcnt(0)" ::: "memory");
    const int i = lane & 15, fq = lane >> 4;
#pragma unroll
    for (int q = 0; q < 2; ++q)
#pragma unroll
        for (int nbk = 0; nbk < 4; ++nbk) { const int kg = 4 * q + fq;
            const LAS unsigned char* tp = tile + (8 * kg + (i >> 2)) * 136 + (16 * nbk + 4 * (i & 3)) * 2;
            const u32x2 lo = tr4(tp), hi = tr4(tp + 4 * 136);
            u32x4 o; o.x = lo.x; o.y = lo.y; o.z = hi.x; o.w = hi.y;
            *(u32x4*)(WT + (size_t)(n0 + 16 * nbk + i) * K + k0 + 8 * kg) = o; }
    asm volatile("s_waitcnt lgkmcnt(0)" ::: "memory");
}
constexpr int NI_IN = 16 * 36, NI_LR = 16 * 8, NI_O = 16 * 16, NI_GU = 16 * 88, NI_D = 44 * 16, NI_L = NI_IN + NI_LR + NI_O + NI_GU + NI_D;

DI void prologue(KA ap, const RowMap& rm, LAS unsigned char* lds, int tid, int vcu, int G) {
    const int lane = tid & 63, wave = tid >> 6, gw = vcu * 8 + wave, NGW = G * 8;
    LAS unsigned char* tile = lds + wave * 16384;
    for (int it = gw; it < DEPTH * NI_L; it += NGW) {
        const int l = it / NI_L; int r = it % NI_L;
        unsigned char* wl = ap->ws + WS_W + (size_t)l * SZ_WL;
        if (r < NI_IN) { WSrc s{0, ap->in[7] + (size_t)l * DM * INW, nullptr, ap->in[6] + l * DM, nullptr}; conv_item(s, DM, 36, (bf16_t*)wl, tile, r, lane); continue; } r -= NI_IN;
        if (r < NI_LR) { WSrc s{0, ap->in[7] + (size_t)l * DM * INW, nullptr, ap->in[6] + l * DM, ap->in[11] + l * 16 * 256}; conv_item_lr(s, DM, (bf16_t*)wl, (LAS float*)tile, r, lane); continue; } r -= NI_LR;
        if (r < NI_O) { WSrc s{1, ap->in[14] + (size_t)l * DM * DM, nullptr, nullptr, nullptr}; conv_item(s, DM, 16, (bf16_t*)(wl + SZ_WIN), tile, r, lane); continue; } r -= NI_O;
        if (r < NI_GU) { WSrc s{2, ap->in[16] + (size_t)l * DM * DFFN, ap->in[17] + (size_t)l * DM * DFFN, ap->in[15] + l * DM, nullptr}; conv_item(s, DM, 88, (bf16_t*)(wl + SZ_WIN + SZ_WO), tile, r, lane); continue; } r -= NI_GU;
        { WSrc s{3, ap->in[18] + (size_t)l * DFFN * DM, nullptr, nullptr, nullptr}; conv_item(s, DFFN, 16, (bf16_t*)(wl + SZ_WIN + SZ_WO + SZ_WGU), tile, r, lane); }
    }
    bf16_t* XB = (bf16_t*)(ap->ws + WS_XB); bf16_t* MRG = (bf16_t*)(ap->ws + WS_MRG); float* ssqA = (float*)(ap->ws + WS_SSQA);
    for (int m = gw; m < MP; m += NGW) {
        const float* ip = row_in(rm, m); f32x4 v[4]; float s = 0.f;
#pragma unroll
        for (int j = 0; j < 4; ++j) { v[j] = ip ? ((const f32x4*)ip)[lane + 64 * j] : (f32x4){0.f, 0.f, 0.f, 0.f}; s += (v[j][0] * v[j][0] + v[j][1] * v[j][1]) + (v[j][2] * v[j][2] + v[j][3] * v[j][3]); }
        s = sum64(s);
#pragma unroll
        for (int j = 0; j < 4; ++j) { u32x2 w; w.x = pk2(v[j][0], v[j][1]); w.y = pk2(v[j][2], v[j][3]); ((u32x2*)(XB + (size_t)m * DM))[lane + 64 * j] = w; if (!ip) ((u32x2*)(MRG + (size_t)m * DM))[lane + 64 * j] = (u32x2){0u, 0u}; }
        if (lane < 16) ssqA[(size_t)m * 16 + lane] = lane == 0 ? s : 0.f;
    }
}

#define XB_TMO      128
#define XB_XCNT(j)  (256  + 64 * (j))
#define XB_XSUB(j)  (1280 + 64 * (j))
#define XB_XGEN(j)  (2304 + 64 * (j))
#define XB_TOP      3328
#define XB_TOPGEN   3392
#define XCD_BAR_WORDS 3456
#define XB_SPIN_CAP (1u << 18)

__device__ __forceinline__ unsigned xb_ld(unsigned* p)              { return __hip_atomic_load(p, __ATOMIC_RELAXED, __HIP_MEMORY_SCOPE_AGENT); }
__device__ __forceinline__ unsigned xb_add(unsigned* p, unsigned v) { return __hip_atomic_fetch_add(p, v, __ATOMIC_RELAXED, __HIP_MEMORY_SCOPE_AGENT); }
__device__ __forceinline__ unsigned xb_xcc_id() { return (unsigned)__builtin_amdgcn_s_getreg((3 << 11) | 20) & 0xFu; }
#define XB_SPIN(cond, bar) do { unsigned _sp = 0; while (cond) { __builtin_amdgcn_s_sleep(1); \
    if ((++_sp & 255u) == 0u) { if (xb_ld(&(bar)[XB_TMO])) break; if (_sp > XB_SPIN_CAP) { atomicAdd(&(bar)[XB_TMO], 1u); break; } } } } while (0)

struct XcdBarrier {
    unsigned* bar; unsigned x;
    volatile LAS unsigned* st;
};

__device__ __forceinline__ XcdBarrier xcd_barrier_post(unsigned* bar, volatile LAS unsigned* st, const bool t0) {
    XcdBarrier b; b.bar = bar; b.x = xb_xcc_id(); b.st = st;
    if (t0) (void)xb_add(&bar[XB_XCNT(b.x)], 1u);
    return b;
}
__device__ __forceinline__ void xcd_barrier_complete(unsigned* bar, unsigned x, unsigned& nloc, unsigned& nx) {
    const unsigned G = gridDim.x * gridDim.y * gridDim.z;
    unsigned sum, cnt, mine, sp = 0u;
    for (;;) {
        sum = 0u; cnt = 0u; mine = 0u;
#pragma unroll
        for (unsigned j = 0; j < 16; ++j) { const unsigned c = xb_ld(&bar[XB_XCNT(j)]); sum += c; cnt += (c > 0u) ? 1u : 0u; mine = (j == x) ? c : mine; }
        if (sum == G) break;
        __builtin_amdgcn_s_sleep(1);
        if ((++sp & 255u) == 0u) { if (xb_ld(&bar[XB_TMO])) break; if (sp > XB_SPIN_CAP) { atomicAdd(&bar[XB_TMO], 1u); break; } }
    }
    nloc = mine > 0u ? mine : 1u; nx = cnt > 0u ? cnt : 1u;
}

__device__ __forceinline__ void xcd_barrier(const XcdBarrier& b, const bool t0) {
    asm volatile("s_waitcnt vmcnt(0)" ::: "memory");
    __syncthreads();
    if (t0) {
        unsigned* bar = b.bar;
        __builtin_amdgcn_s_waitcnt(0);
        unsigned nloc = b.st[0], nx = b.st[1];
        if (nloc == 0u) { xcd_barrier_complete(bar, b.x, nloc, nx); b.st[0] = nloc; b.st[1] = nx; }
        const unsigned old = xb_add(&bar[XB_XSUB(b.x)], 1u);
        const unsigned gen = old / nloc;
        if (old + 1u == (gen + 1u) * nloc) {
            __builtin_amdgcn_fence(__ATOMIC_RELEASE, "agent");
            asm volatile("s_waitcnt vmcnt(0)" ::: "memory");
            const unsigned og = xb_add(&bar[XB_TOP], 1u);
            const unsigned tg = og / nx;
            if (og + 1u == (tg + 1u) * nx) xb_add(&bar[XB_TOPGEN], 1u);
            else XB_SPIN(xb_ld(&bar[XB_TOPGEN]) == tg, bar);
            __builtin_amdgcn_fence(__ATOMIC_ACQUIRE, "agent");
            xb_add(&bar[XB_XGEN(b.x)], 1u);
            asm volatile("s_waitcnt vmcnt(0)" ::: "memory");
        } else {
            XB_SPIN(xb_ld(&bar[XB_XGEN(b.x)]) == gen, bar);
            __builtin_amdgcn_fence(__ATOMIC_ACQUIRE, "agent");
            asm volatile("s_waitcnt vmcnt(0)" ::: "memory");
        }
    }
    __syncthreads();
}

template <class T> DI T* opq(T* p) { asm volatile("" : "+s"(p)); return p; }
DI Ctx make_ctx(int l) {
    KA ap = ka_ptr(); unsigned char* ws = ap->ws;
    Ctx C; C.l = l; C.Z = (const bf16_t*)(ws + WS_Z); C.LD = (float*)(ws + WS_LD); C.MRG = (bf16_t*)(ws + WS_MRG); C.DS = (float*)(ws + WS_DS); C.SC = (bf16_t*)(ws + WS_SC); C.GL = (float*)(ws + WS_GL);
    C.qnw = ap->in[8] + l * 64; C.knw = ap->in[9] + l * 64; C.sinks = ap->in[10] + l * 8; C.gnw = ap->in[13] + l * 128;
    C.cache_k = ap->in[2]; C.cache_v = ap->in[3]; C.state = ap->in[4]; C.out = ap->out;
    return C;
}
DI RowMap make_rm() { KA ap = ka_ptr(); float* out = ap->out; unsigned char* ws = ap->ws; return RowMap{ap->in[0], ap->in[1], ap->in[5], out + O_YP, out + O_YS, (float*)(ws + WS_XMETA)}; }

__global__ void __launch_bounds__(512, 2) hymba_fwd(Args a) {
    extern __shared__ __attribute__((aligned(16))) unsigned char lds_raw[];
    LAS unsigned char* lds = (LAS unsigned char*)lds_raw;
    const int G = gridDim.x, bx = blockIdx.x; const int wave_s = __builtin_amdgcn_readfirstlane((int)threadIdx.x >> 6);
#define opaque_tid() mk_tid(wave_s)
    const int vcu = (G % 8 == 0) ? (bx % 8) * (G / 8) + bx / 8 : bx;
    const int lo = ka_ptr()->ph_lo, hi = ka_ptr()->ph_hi;
#define IN(k) (lo <= (k) && (k) < hi)
#ifndef FAST_BAR
#define FAST_BAR 1
#endif
    volatile LAS unsigned* MISC = (volatile LAS unsigned*)(lds + 131072 + 320);
    { const int t = opaque_tid(); if (t < 160) MISC[t] = 0u; __syncthreads(); }
    XcdBarrier bar = xcd_barrier_post((unsigned*)ka_ptr()->ws, MISC + 8, opaque_tid() == 0);
#define GSYNC() do { if (FAST_BAR) xcd_barrier(bar, opaque_tid() == 0); else cg::this_grid().sync(); } while (0)
#define STAMP(k) do { if (TIME_PH >= 0 && bx == 0 && opaque_tid() == 0) { const unsigned long long t_ = __builtin_amdgcn_s_memrealtime(); MISC[16 + 2 * (k)] = (unsigned)t_; MISC[17 + 2 * (k)] = (unsigned)(t_ >> 32); } } while (0)
#define SEAM(k) do { if (TIME_BUSY) STAMP(32 + (k)); if (IN(k) && IN((k) + 1)) { GSYNC(); } STAMP((k) + 1); } while (0)
    if (lo < 0) cg::this_grid().sync();
    STAMP(0);
    if (IN(0)) { for (int rep = 0; rep < REP_PRO; ++rep) { const RowMap rm = make_rm(); prologue(ka_ptr(), rm, lds, opaque_tid(), vcu, G); if (rep + 1 < REP_PRO) GSYNC(); }
        for (int xs = 0; xs < XSYNC; ++xs) GSYNC(); }
    SEAM(0);
#pragma unroll 1
    for (int l = 0; l < DEPTH; ++l) {
        const int pb = 1 + 7 * l;
        if (IN(pb + 0)) for (int rep = 0; rep < REP_WIN; ++rep) {
            if (rep) GSYNC();
            KA ap = ka_ptr(); unsigned char* ws = ap->ws; unsigned char* wl = ws + WS_W + (size_t)l * SZ_WL;
            pg8::Gemm g{(const bf16_t*)(ws + WS_XB), (const bf16_t*)wl, MP, NIN, DM}; pg8::StaticOrder S; S.init(MP, NIN, G, bx);
            pg8::EpiIn E{(bf16_t*)(ws + WS_Z), (float*)(ws + WS_LD), (const float*)(ws + WS_SSQA), ap->in[12] + l * 256};
            pg8::gemm_phase<pg8::EpiIn, pg8::StaticOrder, true, true>(lds, g, S, E, opaque_tid());
        }
        SEAM(pb + 0);
        if (IN(pb + 1)) {
            const Ctx C = make_ctx(l);
            constexpr int N1 = DECB * 2, N2 = 16 * NCH, N3 = DECB * 4;
#pragma unroll 1
            for (int u = vcu; u < N1 + N2 + N3; u += G) {
                if (u < N1) attn_sample_unit(C, u, lds, wave_s); else if (u < N1 + N2) gla1_unit(C, u - N1, lds, wave_s); else gla_sample_unit(C, u - N1 - N2, lds, wave_s);
            }
        }
        SEAM(pb + 1);
        if (IN(pb + 2)) for (int rep = 0; rep < REP_SCAN; ++rep) { if (rep) GSYNC(); const Ctx C = make_ctx(l); gla_scan(C, bx * 512 + opaque_tid(), G * 512); }
        SEAM(pb + 2);
        if (IN(pb + 3)) for (int rep = 0; rep < REP_MB; ++rep) {   if (rep) GSYNC();
            const Ctx C = make_ctx(l);
            constexpr int N1 = 16 * NCH, N2 = NBATCH * 2 * 65;
#pragma unroll 1
            for (int u = vcu; u < N1 + N2; u += G) { if (u < N1) gla3_unit(C, u, lds, wave_s); else attn_prompt_unit(C, u - N1, lds, wave_s); }
        }
        SEAM(pb + 3);
        if (IN(pb + 4)) for (int rep = 0; rep < 1 + DRY_WO; ++rep) {
            if (rep) GSYNC();
            KA ap = ka_ptr(); unsigned char* ws = ap->ws; unsigned char* wl = ws + WS_W + (size_t)l * SZ_WL;
            pg8::Gemm g{(const bf16_t*)(ws + WS_MRG), (const bf16_t*)(wl + SZ_WIN), MP, DM, DM}; pg8::StreamK S; S.init((MP / 256) * 4, DM / 128, G, vcu, (unsigned*)(ws + WS_FLAGS) + (2 * l) * 256 * 16, ws + WS_Z, ws + WS_ZERO);
            pg8::EpiRes E{make_rm(), 0, (bf16_t*)(ws + WS_XB), (float*)(ws + WS_SSQB), rep};
            pg8::gemm_phase<pg8::EpiRes, pg8::StreamK, true, true>(lds, g, S, E, opaque_tid());
        }
        SEAM(pb + 4);
        if (IN(pb + 5)) for (int rep = 0; rep < REP_GU; ++rep) {
            if (rep) GSYNC();
            KA ap = ka_ptr(); unsigned char* ws = ap->ws; unsigned char* wl = ws + WS_W + (size_t)l * SZ_WL;
            pg8::Gemm g{(const bf16_t*)(ws + WS_XB), (const bf16_t*)(wl + SZ_WIN + SZ_WO), MP, NGU, DM}; pg8::StaticOrder S; S.init(MP, NGU, G, bx);
            pg8::EpiGU E{(bf16_t*)(ws + WS_U), (const float*)(ws + WS_SSQB)};
            pg8::gemm_phase<pg8::EpiGU, pg8::StaticOrder, true, true>(lds, g, S, E, opaque_tid());
        }
        SEAM(pb + 5);
        if (IN(pb + 6)) for (int rep = 0; rep < 1 + DRY_DN; ++rep) {
            if (rep) GSYNC();
            KA ap = ka_ptr(); unsigned char* ws = ap->ws; unsigned char* wl = ws + WS_W + (size_t)l * SZ_WL;
            pg8::Gemm g{(const bf16_t*)(ws + WS_U), (const bf16_t*)(wl + SZ_WIN + SZ_WO + SZ_WGU), MP, DM, DFFN}; pg8::StreamK S; S.init((MP / 256) * 4, DFFN / 128, G, vcu, (unsigned*)(ws + WS_FLAGS) + (2 * l + 1) * 256 * 16, ws + WS_MRG, ws + WS_ZERO);
            pg8::EpiRes E{make_rm(), l == DEPTH - 1 ? 1 : 0, (bf16_t*)(ws + WS_XB), (float*)(ws + WS_SSQA), rep};
            pg8::gemm_phase<pg8::EpiRes, pg8::StreamK, true, true>(lds, g, S, E, opaque_tid());
        }
        if (l + 1 < DEPTH) SEAM(pb + 6);
    }
    if (TIME_SUB >= 0) { if (bx == 0 && opaque_tid() == 0) { const unsigned long long tot = MISC[100 + (TIME_SUB >= 0 ? TIME_SUB : 0)]; const unsigned long long tend = __builtin_amdgcn_s_memrealtime();
            while (__builtin_amdgcn_s_memrealtime() - tend < (unsigned long long)TIME_MULT * tot) __builtin_amdgcn_s_sleep(8); } }
    if (TIME_PH >= 0) {
        STAMP(NPHASE);
        if (bx == 0 && opaque_tid() == 0) {
            unsigned long long tot = 0;
            for (int k = 0; k < NPHASE; ++k) { const bool pick = (TIME_PH == 7) ? (k == 0) : (k >= 1 && ((k - 1) % 7) == TIME_PH);
                if (pick) { const int ke = TIME_BUSY ? 32 + k : k + 1; const unsigned long long a0 = ((unsigned long long)MISC[17 + 2 * k] << 32) | MISC[16 + 2 * k], a1 = ((unsigned long long)MISC[17 + 2 * ke] << 32) | MISC[16 + 2 * ke]; tot += a1 - a0; } }
            const unsigned long long tend = __builtin_amdgcn_s_memrealtime();
            while (__builtin_amdgcn_s_memrealtime() - tend < (unsigned long long)TIME_MULT * tot) __builtin_amdgcn_s_sleep(8);
        }
    }
#undef IN
#undef SEAM
#undef STAMP
#undef GSYNC
#undef opaque_tid
}

#ifndef N_LAUNCH_MODE
#define N_LAUNCH_MODE 0
#endif
extern "C" void kernel_launch(void* const* d_in, const int* in_sizes, int n_in, void* d_out, int out_size, void* d_ws, size_t ws_size, hipStream_t stream) {
    static int grid = 0;
    if (grid == 0) {
        if (n_in != 19 || out_size != (int)O_END || ws_size < WS_END) { fprintf(stderr, "kernel_launch: unexpected shapes: n_in %d out %d ws %zu (need %zu)\n", n_in, out_size, ws_size, (size_t)WS_END); grid = -1; return; }
        int dev = 0, cus = 0, per_cu = 0;
        (void)hipGetDevice(&dev); (void)hipDeviceGetAttribute(&cus, hipDeviceAttributeMultiprocessorCount, dev);
        if (hipFuncSetAttribute((const void*)hymba_fwd, hipFuncAttributeMaxDynamicSharedMemorySize, LDS_BYTES) != hipSuccess) { fprintf(stderr, "kernel_launch: hipFuncSetAttribute failed\n"); grid = -1; return; }
        if (hipOccupancyMaxActiveBlocksPerMultiprocessor(&per_cu, (const void*)hymba_fwd, 512, LDS_BYTES) != hipSuccess || per_cu < 1) { fprintf(stderr, "kernel_launch: occupancy query says %d\n", per_cu); per_cu = 1; }
        (void)hipGetLastError();
        grid = cus > 0 ? cus : 256;
    }
    if (grid < 0) return;
    if (hipMemsetAsync(d_ws, 0, WS_W, stream) != hipSuccess) { fprintf(stderr, "kernel_launch: memset failed\n"); return; }
    Args a{};
    for (int i = 0; i < 19; ++i) a.in[i] = (const float*)d_in[i];
    a.out = (float*)d_out; a.ws = (unsigned char*)d_ws;
#if N_LAUNCH_MODE == 1
    for (int p = 0; p < NPHASE; ++p) { a.ph_lo = p; a.ph_hi = p + 1; hipLaunchKernelGGL(hymba_fwd, dim3(grid), dim3(512), LDS_BYTES, stream, a); }
#else
    a.ph_lo = 0; a.ph_hi = NPHASE;
    void* args[] = {&a};
    hipError_t e = hipLaunchCooperativeKernel((const void*)hymba_fwd, dim3(grid), dim3(512), args, LDS_BYTES, stream);
    if (e != hipSuccess) fprintf(stderr, "cooperative launch failed: %s (grid %d)\n", hipGetErrorString(e), grid);
#endif
}
```

```cpp
#include <hip/hip_runtime.h>
#include <hip/hip_cooperative_groups.h>
#include <cstdio>
#include <cstdint>
namespace cg = cooperative_groups;

#define DI __device__ __forceinline__
#define LAS __attribute__((address_space(3)))
typedef unsigned short bf16_t;
typedef short bf16x8 __attribute__((ext_vector_type(8)));
typedef float f32x4 __attribute__((ext_vector_type(4)));
typedef float f32x2 __attribute__((ext_vector_type(2)));
typedef unsigned u32x4 __attribute__((ext_vector_type(4)));
typedef unsigned u32x2 __attribute__((ext_vector_type(2)));
typedef __bf16 bf16x2_t __attribute__((ext_vector_type(2)));

constexpr int DM = 1024, NBATCH = 4, SEQ = 4096, LP = 4112  , DEPTH = 2, DECB = 128, DECT = 8;
constexpr int MPROMPT = NBATCH * LP, MREAL = MPROMPT + DECB * DECT, MP = 17664  ;
constexpr int INW = 2320, ZP = 2304, NIN = 2560, DFFN = 2816, NGU = 5632;
constexpr int ZQ = 0, ZK = 512, ZV = 640, ZGQ = 768, ZGK = 1024, ZGV = 1280, ZOG = 1792;
constexpr int NCH = 33;
constexpr float EPS = 1e-6f, LOG2E = 1.4426950408889634f;
constexpr size_t O_YP = 0, O_YS = 16777216, O_CKP = 17825792, O_CVP = 17956864, O_SP = 18087936, O_CKS = 18350080, O_CVS = 22544384, O_SS = 26738688, O_END = 35127296;

DI unsigned pk2(float lo, float hi) { f32x2 v = {lo, hi}; bf16x2_t b = __builtin_convertvector(v, bf16x2_t); return __builtin_bit_cast(unsigned, b); }
DI float bflo(unsigned w) { return __uint_as_float(w << 16); }
DI float bfhi(unsigned w) { return __uint_as_float(w & 0xffff0000u); }
DI float bf2f(bf16_t h) { return __uint_as_float((unsigned)h << 16); }
DI void unpack8(const u32x4 w, float* f) { f[0] = bflo(w.x); f[1] = bfhi(w.x); f[2] = bflo(w.y); f[3] = bfhi(w.y); f[4] = bflo(w.z); f[5] = bfhi(w.z); f[6] = bflo(w.w); f[7] = bfhi(w.w); }
DI float red4rows(float v) {
    auto r = __builtin_amdgcn_permlane16_swap(__float_as_uint(v), __float_as_uint(v), false, false); v = __uint_as_float(r[0]) + __uint_as_float(r[1]);
    auto q = __builtin_amdgcn_permlane32_swap(__float_as_uint(v), __float_as_uint(v), false, false); return __uint_as_float(q[0]) + __uint_as_float(q[1]);
}
DI float max4rows(float v) {
    auto r = __builtin_amdgcn_permlane16_swap(__float_as_uint(v), __float_as_uint(v), false, false); v = fmaxf(__uint_as_float(r[0]), __uint_as_float(r[1]));
    auto q = __builtin_amdgcn_permlane32_swap(__float_as_uint(v), __float_as_uint(v), false, false); return fmaxf(__uint_as_float(q[0]), __uint_as_float(q[1]));
}
template <int M> DI float shx(float v) { return __int_as_float(__builtin_amdgcn_ds_swizzle(__float_as_int(v), 0x1f | (M << 10))); }
DI float sum8(float v) { v += shx<1>(v); v += shx<2>(v); v += shx<4>(v); return v; }
DI float sum64(float v) { v += shx<1>(v); v += shx<2>(v); v += shx<4>(v); v += shx<8>(v); v += shx<16>(v);
    auto q = __builtin_amdgcn_permlane32_swap(__float_as_uint(v), __float_as_uint(v), false, false); return __uint_as_float(q[0]) + __uint_as_float(q[1]); }
DI float silu_f(float x) { return x * __builtin_amdgcn_rcpf(1.0f + __expf(-x)); }

struct RowMap { const float* xp; const float* xs; const float* meta; float* yp; float* ys; float* xmeta; };
DI const float* row_in(const RowMap& rm, int row) {
    if (row < MPROMPT) { const int b = row / LP, p = row - b * LP; return p < 16 ? rm.meta + (size_t)p * DM : rm.xp + ((size_t)b * SEQ + (p - 16)) * DM; }
    if (row < MREAL) return rm.xs + (size_t)(row - MPROMPT) * DM;
    return nullptr;
}
DI float* row_out(const RowMap& rm, int row) {
    if (row < MPROMPT) { const int b = row / LP, p = row - b * LP; return p < 16 ? nullptr : rm.yp + ((size_t)b * SEQ + (p - 16)) * DM; }
    if (row < MREAL) return rm.ys + (size_t)(row - MPROMPT) * DM;
    return nullptr;
}
namespace pg8 {
#define PG8_LAS __attribute__((address_space(3)))
typedef unsigned short bf16_t;
typedef short bf16x8 __attribute__((ext_vector_type(8)));
typedef float f32x4 __attribute__((ext_vector_type(4)));
typedef unsigned u32x4 __attribute__((ext_vector_type(4)));
constexpr int BM = 256, BK = 64, HALF = 128, HTB = HALF * BK * 2  , STAGE_BYTES = 8 * HTB, NXCD = 8, WGM = 8;

__host__ __device__ __forceinline__ int lds_byte(int r, int c) { const int st = (r >> 4) * 2 + (c >> 5), rr = r & 15, cc = c & 31, ob = rr * 64 + cc * 2; return st * 1024 + (ob ^ (((ob >> 9) & 1) << 5)); }
__host__ __device__ __forceinline__ void stage_rc(int b, int& R, int& C) { const int st = b / 1024, sb = b % 1024, swz = sb ^ (((sb >> 9) & 1) << 5); R = (st >> 1) * 16 + swz / 64; C = (st & 1) * 32 + (swz % 64) / 2; }
__host__ __device__ __forceinline__ int perm32(int rho) { const int n = rho >> 4, i = rho & 15; return 8 * (i >> 2) + 4 * n + (i & 3); }

struct Unit { int pm, pn, k0, nk, mode; };
struct Gemm { const bf16_t* A; const bf16_t* Bt; int M, N, K; };

struct StaticOrder {
    static constexpr bool STREAMK = false;
    int nM, nN, nwg, G, c;
    __host__ __device__ void init(int M, int N, int G_, int c_) { nM = M / BM; nN = N / BM; nwg = nM * nN; G = G_; c = c_; }
    __host__ __device__ bool next(int i, Unit& u) const {
        const long L = (long)i * G + c; if (L >= nwg) return false;
        int wgid = (int)L; { const int q = nwg / NXCD, r = nwg % NXCD, xcd = wgid % NXCD, off = wgid / NXCD; wgid = (xcd < r ? xcd * (q + 1) : r * (q + 1) + (xcd - r) * q) + off; }
        const int nig = WGM * nN, gid = wgid / nig, fm = gid * WGM, gsz = (nM - fm) < WGM ? (nM - fm) : WGM;
        u.pm = fm + ((wgid % nig) % gsz); u.pn = (wgid % nig) / gsz; u.k0 = 0; u.nk = 0; u.mode = 0; return true;
    }
    __device__ __forceinline__ void a_ready(const Unit&) const {}
    __device__ __forceinline__ void done(const Unit&) const {}
};


struct StreamK {
    static constexpr bool STREAMK = true;
    int P, r, s, e, nseg; unsigned* flags; unsigned char* part; const unsigned char* zero;
    __device__ __forceinline__ void init(int ntiles, int P_, int G, int r_, unsigned* flags_, unsigned char* part_, const unsigned char* zero_) {
        P = P_; r = r_; flags = flags_; part = part_; zero = zero_; const long TP = (long)ntiles * P; s = (int)(TP * r / G); e = (int)(TP * (r + 1) / G);
        nseg = 0; int cur = s; while (cur < e) { const int kb = cur % P; int ke = kb + (e - cur); ke = ke < P ? ke : P; cur += ke - kb; ++nseg; }
    }
    __device__ __forceinline__ bool next(int i, Unit& u) const {
        if (i >= nseg) return false;
        const int want = nseg - 1 - i; int cur = s, idx = 0;
        for (;;) { const int t = cur / P, kb = cur % P; int ke = kb + (e - cur); ke = ke < P ? ke : P;
            if (idx == want) { u.pm = t >> 2; u.pn = t & 3; u.k0 = 2 * kb; u.nk = 2 * (ke - kb); u.mode = (kb == 0 && ke == P) ? 0 : (kb == 0 ? 1 : 2); return true; }
            cur += ke - kb; ++idx; }
    }
    __device__ __forceinline__ void a_ready(const Unit&) const {}
    __device__ __forceinline__ void done(const Unit&) const {}
};

DI float rstd_from_slots(const float* ssq, int row) {
    const f32x4* p = (const f32x4*)(ssq + (size_t)row * 16);
    const f32x4 a = p[0], b = p[1], c = p[2], d = p[3];
    const float s = ((a[0] + a[1]) + (a[2] + a[3])) + ((b[0] + b[1]) + (b[2] + b[3])) + ((c[0] + c[1]) + (c[2] + c[3])) + ((d[0] + d[1]) + (d[2] + d[3]));
    return rsqrtf(s * (1.0f / 1024.0f) + EPS);
}
DI void rstd8(const float* ssq, int row0, float (&rs)[2][4]) {
#pragma unroll
    for (int ai = 0; ai < 2; ++ai) {
        f32x4 t[4][4];
#pragma unroll
        for (int m = 0; m < 4; ++m) { const f32x4* p = (const f32x4*)(ssq + (size_t)(row0 + ai * HALF + m * 16) * 16); t[m][0] = p[0]; t[m][1] = p[1]; t[m][2] = p[2]; t[m][3] = p[3]; }
#pragma unroll
        for (int m = 0; m < 4; ++m) { const f32x4 q = (t[m][0] + t[m][1]) + (t[m][2] + t[m][3]); rs[ai][m] = rsqrtf(((q[0] + q[1]) + (q[2] + q[3])) * (1.0f / 1024.0f) + EPS); }
        asm volatile("" ::: "memory");
    }
}
DI void rstd_tab_fill(const float* ssq, int pm, PG8_LAS float* tab, int tid) {
    if (tid < 256) { const f32x4* p = (const f32x4*)(ssq + (size_t)(pm * BM + tid) * 16); const f32x4 q = (p[0] + p[1]) + (p[2] + p[3]); tab[tid] = rsqrtf(((q[0] + q[1]) + (q[2] + q[3])) * (1.0f / 1024.0f) + EPS); }
}
DI void rstd8_tab(const PG8_LAS float* tab, int wr, int fr, float (&rs)[2][4]) {
#pragma unroll
    for (int ai = 0; ai < 2; ++ai)
#pragma unroll
        for (int m = 0; m < 4; ++m) rs[ai][m] = tab[ai * HALF + wr * 64 + m * 16 + fr];
}
struct EpiIn {
    static constexpr bool PERM = true, AFTER_DRAIN = false, RSTAB = true;
    bf16_t* Z; float* LD; const float* ssq; const float* bg;
    __device__ __forceinline__ void prefetch(const Unit& u, PG8_LAS float* tab, int tid) const { rstd_tab_fill(ssq, u.pm, tab, tid); }
    __device__ __forceinline__ void operator()(const f32x4 (&acc)[2][2][4][2], const Unit& u, int wr, int wc, int fr, int fq, const PG8_LAS float* tab) const {
        const int row0 = u.pm * BM + wr * 64 + fr;
        float rs[2][4]; rstd8_tab(tab, wr, fr, rs);
        if (u.pn < 9) {
#pragma unroll
            for (int ai = 0; ai < 2; ++ai)
#pragma unroll
                for (int m = 0; m < 4; ++m) { const int row = row0 + ai * HALF + m * 16; const float r = rs[ai][m];
                    bf16_t* rowp = Z + (size_t)row * ZP + u.pn * BM + wc * 32 + 8 * fq;
#pragma unroll
                    for (int bj = 0; bj < 2; ++bj) { const f32x4 v0 = acc[ai][bj][m][0] * r, v1 = acc[ai][bj][m][1] * r;
                        u32x4 w; w.x = pk2(v0[0], v0[1]); w.y = pk2(v0[2], v0[3]); w.z = pk2(v1[0], v1[1]); w.w = pk2(v1[2], v1[3]);
                        *(u32x4*)(rowp + bj * HALF) = w; } }
        } else {
            const int e0 = wc * 32 + 8 * fq;
#pragma unroll
            for (int bj = 0; bj < 2; ++bj) { const f32x4 b0 = *(const f32x4*)(bg + e0 + bj * HALF), b1 = *(const f32x4*)(bg + e0 + bj * HALF + 4);
#pragma unroll
                for (int ai = 0; ai < 2; ++ai)
#pragma unroll
                    for (int m = 0; m < 4; ++m) { const int row = row0 + ai * HALF + m * 16; const float r = rs[ai][m];
                        const f32x4 x0 = acc[ai][bj][m][0] * r + b0, x1 = acc[ai][bj][m][1] * r + b1; f32x4 o0, o1;
#pragma unroll
                        for (int i = 0; i < 4; ++i) { o0[i] = (fminf(x0[i], 0.f) - __logf(1.0f + __expf(-fabsf(x0[i])))) * 0.0625f; o1[i] = (fminf(x1[i], 0.f) - __logf(1.0f + __expf(-fabsf(x1[i])))) * 0.0625f; }
                        float* lp = LD + (size_t)row * 256 + e0 + bj * HALF; *(f32x4*)lp = o0; *(f32x4*)(lp + 4) = o1; } }
        }
    }
};
#ifndef EPIRES_BATCH4
#define EPIRES_BATCH4 1
#endif
#if EPIRES_BATCH4
struct EpiRes {
    static constexpr bool PERM = true, AFTER_DRAIN = false, RSTAB = false;
    RowMap rm; int final_; bf16_t* XB; float* ssq; int dry;
    __device__ __forceinline__ void operator()(const f32x4 (&acc)[2][2][4][2], const Unit& u, int wr, int wc, int fr, int fq, const unsigned char* pp) const {
        if (dry) return;
        const int row0 = u.pm * BM + wr * 64 + fr, col0 = u.pn * BM + wc * 32 + 8 * fq;
#pragma unroll
        for (int ai = 0; ai < 2; ++ai) {
            u32x4 res[4][2], par[4][2];
#pragma unroll
            for (int m = 0; m < 4; ++m) { const int row = row0 + ai * HALF + m * 16;
#pragma unroll
                for (int bj = 0; bj < 2; ++bj) { res[m][bj] = *(const u32x4*)(XB + (size_t)row * DM + col0 + bj * HALF); par[m][bj] = (u32x4){0u, 0u, 0u, 0u}; } }
            if (pp) {
#pragma unroll
                for (int m = 0; m < 4; ++m)
#pragma unroll
                    for (int bj = 0; bj < 2; ++bj) asm volatile("global_load_dwordx4 %0, %1, off sc0 sc1" : "=v"(par[m][bj]) : "v"(pp + ((ai * 2 + bj) * 4 + m) * 8192) : "memory");
                asm volatile("s_waitcnt vmcnt(0)" : "+v"(par[0][0]), "+v"(par[0][1]), "+v"(par[1][0]), "+v"(par[1][1]), "+v"(par[2][0]), "+v"(par[2][1]), "+v"(par[3][0]), "+v"(par[3][1]) :: "memory");
            }
#pragma unroll
            for (int m = 0; m < 4; ++m) { const int row = row0 + ai * HALF + m * 16; float ss = 0.f; float* op = final_ ? row_out(rm, row) : nullptr;
#pragma unroll
                for (int bj = 0; bj < 2; ++bj) { const int col = col0 + bj * HALF; float r[8], q[8]; unpack8(res[m][bj], r); unpack8(par[m][bj], q);
                    const f32x4 v0 = (acc[ai][bj][m][0] + (f32x4){q[0], q[1], q[2], q[3]}) + (f32x4){r[0], r[1], r[2], r[3]}, v1 = (acc[ai][bj][m][1] + (f32x4){q[4], q[5], q[6], q[7]}) + (f32x4){r[4], r[5], r[6], r[7]};
                    if (final_) { if (op) { *(f32x4*)(op + col) = v0; *(f32x4*)(op + col + 4) = v1; } }
                    else { u32x4 w; w.x = pk2(v0[0], v0[1]); w.y = pk2(v0[2], v0[3]); w.z = pk2(v1[0], v1[1]); w.w = pk2(v1[2], v1[3]);
                        *(u32x4*)(XB + (size_t)row * DM + col) = w;
                        const f32x4 q0 = {bflo(w.x), bfhi(w.x), bflo(w.y), bfhi(w.y)}, q1 = {bflo(w.z), bfhi(w.z), bflo(w.w), bfhi(w.w)};
                        ss += (q0[0] * q0[0] + q0[1] * q0[1]) + (q0[2] * q0[2] + q0[3] * q0[3]) + (q1[0] * q1[0] + q1[1] * q1[1]) + (q1[2] * q1[2] + q1[3] * q1[3]); } }
                if (!final_) { ss = red4rows(ss); if (fq == 0) ssq[(size_t)row * 16 + u.pn * 4 + wc] = ss; } }
            asm volatile("" ::: "memory");
        }
    }
};
#else
struct EpiRes {
    static constexpr bool PERM = true, AFTER_DRAIN = false, RSTAB = false;
    RowMap rm; int final_; bf16_t* XB; float* ssq; int dry;
    __device__ __forceinline__ void operator()(const f32x4 (&acc)[2][2][4][2], const Unit& u, int wr, int wc, int fr, int fq, const unsigned char* pp) const {
        if (dry) return;
        const int row0 = u.pm * BM + wr * 64 + fr, col0 = u.pn * BM + wc * 32 + 8 * fq;
#pragma unroll
        for (int ai = 0; ai < 2; ++ai)
#pragma unroll
        for (int mh = 0; mh < 2; ++mh) {
            u32x4 res[2][2], par[2][2];
#pragma unroll
            for (int mm = 0; mm < 2; ++mm) { const int row = row0 + ai * HALF + (2 * mh + mm) * 16;
#pragma unroll
                for (int bj = 0; bj < 2; ++bj) { res[mm][bj] = *(const u32x4*)(XB + (size_t)row * DM + col0 + bj * HALF); par[mm][bj] = (u32x4){0u, 0u, 0u, 0u}; } }
            if (pp) {
#pragma unroll
                for (int mm = 0; mm < 2; ++mm)
#pragma unroll
                    for (int bj = 0; bj < 2; ++bj) asm volatile("global_load_dwordx4 %0, %1, off sc0 sc1" : "=v"(par[mm][bj]) : "v"(pp + ((ai * 2 + bj) * 4 + 2 * mh + mm) * 8192) : "memory");
                asm volatile("s_waitcnt vmcnt(0)" : "+v"(par[0][0]), "+v"(par[0][1]), "+v"(par[1][0]), "+v"(par[1][1]) :: "memory");
            }
#pragma unroll
            for (int mm = 0; mm < 2; ++mm) { const int m = 2 * mh + mm; const int row = row0 + ai * HALF + m * 16; float ss = 0.f; float* op = final_ ? row_out(rm, row) : nullptr;
#pragma unroll
                for (int bj = 0; bj < 2; ++bj) { const int col = col0 + bj * HALF; float r[8], q[8]; unpack8(res[mm][bj], r); unpack8(par[mm][bj], q);
                    const f32x4 v0 = (acc[ai][bj][m][0] + (f32x4){q[0], q[1], q[2], q[3]}) + (f32x4){r[0], r[1], r[2], r[3]}, v1 = (acc[ai][bj][m][1] + (f32x4){q[4], q[5], q[6], q[7]}) + (f32x4){r[4], r[5], r[6], r[7]};
                    if (final_) { if (op) { *(f32x4*)(op + col) = v0; *(f32x4*)(op + col + 4) = v1; } }
                    else { u32x4 w; w.x = pk2(v0[0], v0[1]); w.y = pk2(v0[2], v0[3]); w.z = pk2(v1[0], v1[1]); w.w = pk2(v1[2], v1[3]);
                        *(u32x4*)(XB + (size_t)row * DM + col) = w;
                        const f32x4 q0 = {bflo(w.x), bfhi(w.x), bflo(w.y), bfhi(w.y)}, q1 = {bflo(w.z), bfhi(w.z), bflo(w.w), bfhi(w.w)};
                        ss += (q0[0] * q0[0] + q0[1] * q0[1]) + (q0[2] * q0[2] + q0[3] * q0[3]) + (q1[0] * q1[0] + q1[1] * q1[1]) + (q1[2] * q1[2] + q1[3] * q1[3]); } }
                if (!final_) { ss = red4rows(ss); if (fq == 0) ssq[(size_t)row * 16 + u.pn * 4 + wc] = ss; } }
            asm volatile("" ::: "memory");
        }
    }
};
#endif
struct EpiGU {
    static constexpr bool PERM = true, AFTER_DRAIN = false, RSTAB = true;
    bf16_t* U; const float* ssq;
    __device__ __forceinline__ void prefetch(const Unit& u, PG8_LAS float* tab, int tid) const { rstd_tab_fill(ssq, u.pm, tab, tid); }
    __device__ __forceinline__ void operator()(const f32x4 (&acc)[2][2][4][2], const Unit& u, int wr, int wc, int fr, int fq, const PG8_LAS float* tab) const {
        const int row0 = u.pm * BM + wr * 64 + fr, f0 = u.pn * HALF + wc * 32 + 8 * fq;
        float rs[2][4]; rstd8_tab(tab, wr, fr, rs);
#pragma unroll
        for (int ai = 0; ai < 2; ++ai)
#pragma unroll
            for (int m = 0; m < 4; ++m) { const int row = row0 + ai * HALF + m * 16; const float r = rs[ai][m];
                float o[8];
#pragma unroll
                for (int n = 0; n < 2; ++n)
#pragma unroll
                    for (int i = 0; i < 4; ++i) { const float g = acc[ai][0][m][n][i] * r, up = acc[ai][1][m][n][i] * r; o[4 * n + i] = silu_f(g) * up; }
                u32x4 w; w.x = pk2(o[0], o[1]); w.y = pk2(o[2], o[3]); w.z = pk2(o[4], o[5]); w.w = pk2(o[6], o[7]);
                *(u32x4*)(U + (size_t)row * DFFN + f0) = w; }
    }
};
template <class Epi, class Sched, bool ALIGN_EPI = false, bool SP2 = false>
__device__ __forceinline__ void gemm_phase(PG8_LAS unsigned char* lds, const Gemm g, const Sched& S, const Epi& E, const int tid_in) {
    const int tid = tid_in, wid = __builtin_amdgcn_readfirstlane(tid >> 6), lane = tid & 63, wr = wid >> 2, wc = wid & 3, fr = lane & 15, fq = lane >> 4;
    const int K = g.K;
    unsigned voffA[2], voffB[2];
#pragma unroll
    for (int i = 0; i < 2; ++i) { int R, C; stage_rc(tid * 16 + i * 8192, R, C); const int Rb = Epi::PERM ? ((R & ~31) + perm32(R & 31)) : R;
        voffA[i] = (unsigned)(R * K + C) * 2u; voffB[i] = (unsigned)(Rb * K + C) * 2u; }
    const size_t kstep = (size_t)(BK * 2);
    const size_t hstep = (size_t)HALF * K * 2;
    const size_t tstep = 2 * hstep;
    const unsigned ldsw = (unsigned)wid * 1024u;
    const int aoff = lds_byte(wr * 64 + fr, fq * 8), boff = lds_byte(wc * 32 + fr, fq * 8);
#define PG8_SA(b, h) (((b) * 2 + (h)) * HTB)
#define PG8_SB(b, h) ((4 + (b) * 2 + (h)) * HTB)
#define PG8_STAGE(bufoff, gbase, voff) do { _Pragma("unroll") for (int _i = 0; _i < 2; ++_i) \
        __builtin_amdgcn_global_load_lds((const unsigned*)((const char*)(gbase) + (voff)[_i]), (PG8_LAS unsigned*)(lds + (bufoff) + ldsw + _i * 8192), 16, 0, 0); } while (0)
#define PG8_LDA(dst, b, h) do { _Pragma("unroll") for (int m = 0; m < 4; ++m) _Pragma("unroll") for (int k = 0; k < 2; ++k) dst[m][k] = *(const PG8_LAS bf16x8*)(lds + PG8_SA(b, h) + aoff + m * 2048 + k * 1024); } while (0)
#define PG8_LDB(dst, b, h) do { _Pragma("unroll") for (int n = 0; n < 2; ++n) _Pragma("unroll") for (int k = 0; k < 2; ++k) dst[n][k] = *(const PG8_LAS bf16x8*)(lds + PG8_SB(b, h) + boff + n * 2048 + k * 1024); } while (0)
#define PG8_MMA(ai, bj, At, Bt) do { __builtin_amdgcn_s_setprio(1); _Pragma("unroll") for (int m = 0; m < 4; ++m) _Pragma("unroll") for (int n = 0; n < 2; ++n) _Pragma("unroll") for (int k = 0; k < 2; ++k) \
        acc[ai][bj][m][n] = __builtin_amdgcn_mfma_f32_16x16x32_bf16(Bt[n][k], At[m][k], acc[ai][bj][m][n], 0, 0, 0); __builtin_amdgcn_s_setprio(0); } while (0)
#define PG8_WAIT_V(n) asm volatile("s_waitcnt vmcnt(" #n ")" ::: "memory")
#define PG8_WAIT_L(n) asm volatile("s_waitcnt lgkmcnt(" #n ")" ::: "memory")
#define PG8_BAR __builtin_amdgcn_s_barrier()
#define PG8_SCHED __builtin_amdgcn_sched_barrier(0)
    Unit cur, nxt; int ui = 0;
    if (!S.next(0, cur)) return;
    f32x4 acc[2][2][4][2];
#pragma unroll
    for (int a = 0; a < 2; ++a)
#pragma unroll
        for (int b = 0; b < 2; ++b)
#pragma unroll
            for (int m = 0; m < 4; ++m)
#pragma unroll
                for (int n = 0; n < 2; ++n) acc[a][b][m][n] = (f32x4){0.f, 0.f, 0.f, 0.f};
    bf16x8 At[4][2], B0[2][2], B1[2][2];
    const char* cA = (const char*)g.A + (size_t)cur.pm * tstep + (size_t)cur.k0 * kstep; const char* cB = (const char*)g.Bt + (size_t)cur.pn * tstep + (size_t)cur.k0 * kstep;
    S.a_ready(cur);
    if constexpr (Epi::RSTAB) E.prefetch(cur, (PG8_LAS float*)(lds + STAGE_BYTES + 1024), tid);
    if constexpr (SP2) {
        PG8_STAGE(PG8_SB(0, 0), cB, voffB); PG8_STAGE(PG8_SB(0, 1), cB + hstep, voffB); PG8_STAGE(PG8_SA(0, 0), cA, voffA); PG8_STAGE(PG8_SA(0, 1), cA + hstep, voffA);
        if (wr == 1) PG8_BAR;
        PG8_WAIT_V(2); PG8_BAR;
        PG8_STAGE(PG8_SB(1, 0), cB + kstep, voffB); PG8_STAGE(PG8_SA(1, 0), cA + kstep, voffA); PG8_STAGE(PG8_SB(1, 1), cB + hstep + kstep, voffB);
        PG8_WAIT_V(6); PG8_BAR;
    } else {
        PG8_STAGE(PG8_SB(0, 0), cB, voffB); PG8_STAGE(PG8_SA(0, 0), cA, voffA); PG8_STAGE(PG8_SB(0, 1), cB + hstep, voffB); PG8_STAGE(PG8_SA(0, 1), cA + hstep, voffA);
        if (wr == 1) PG8_BAR;
        PG8_WAIT_V(4); PG8_BAR;
        PG8_STAGE(PG8_SB(1, 0), cB + kstep, voffB); PG8_STAGE(PG8_SA(1, 0), cA + kstep, voffA); PG8_STAGE(PG8_SB(1, 1), cB + hstep + kstep, voffB);
        PG8_WAIT_V(6); PG8_BAR;
    }
    for (;;) {
        const bool has_next = S.next(ui + 1, nxt);
        const char* nA = has_next ? (const char*)g.A + (size_t)nxt.pm * tstep + (size_t)nxt.k0 * kstep : cA; const char* nB = has_next ? (const char*)g.Bt + (size_t)nxt.pn * tstep + (size_t)nxt.k0 * kstep : cB;
        const int nt = cur.nk ? cur.nk : K / BK;
        for (int t = 0; t < nt; t += 2) {
            const bool last = (t == nt - 2);
            const char* a1 = cA + (size_t)(t + 1) * kstep;
            const char* a2 = last ? nA : cA + (size_t)(t + 2) * kstep; const char* b2 = last ? nB : cB + (size_t)(t + 2) * kstep;
            const char* a3 = a2 + kstep; const char* b3 = b2 + kstep;
            if (last && has_next) S.a_ready(nxt);
            if constexpr (SP2) {
            PG8_LDB(B0, 0, 0); PG8_LDB(B1, 0, 1); PG8_SCHED; PG8_LDA(At, 0, 0); PG8_STAGE(PG8_SA(1, 1), a1 + hstep, voffA);
            PG8_WAIT_V(8); PG8_WAIT_L(0); PG8_BAR; PG8_MMA(0, 0, At, B0); PG8_MMA(0, 1, At, B1); PG8_BAR; PG8_SCHED;
            PG8_LDA(At, 0, 1); PG8_STAGE(PG8_SB(0, 0), b2, voffB); PG8_STAGE(PG8_SB(0, 1), b2 + hstep, voffB); PG8_STAGE(PG8_SA(0, 0), a2, voffA);
            PG8_WAIT_V(8); PG8_WAIT_L(0); PG8_BAR; PG8_MMA(1, 0, At, B0); PG8_MMA(1, 1, At, B1); PG8_BAR; PG8_SCHED;
            PG8_LDB(B0, 1, 0); PG8_LDB(B1, 1, 1); PG8_SCHED; PG8_LDA(At, 1, 0); PG8_STAGE(PG8_SA(0, 1), a2 + hstep, voffA);
            PG8_WAIT_V(8); PG8_WAIT_L(0); PG8_BAR; PG8_MMA(0, 0, At, B0); PG8_MMA(0, 1, At, B1); PG8_BAR; PG8_SCHED;
            PG8_LDA(At, 1, 1); PG8_STAGE(PG8_SB(1, 0), b3, voffB); PG8_STAGE(PG8_SB(1, 1), b3 + hstep, voffB); PG8_STAGE(PG8_SA(1, 0), a3, voffA);
            PG8_WAIT_V(8); PG8_WAIT_L(0); PG8_BAR; PG8_MMA(1, 0, At, B0); PG8_MMA(1, 1, At, B1); PG8_BAR; PG8_SCHED;
            } else {
            PG8_LDB(B0, 0, 0); PG8_SCHED; PG8_LDA(At, 0, 0); PG8_STAGE(PG8_SA(1, 1), a1 + hstep, voffA);
            PG8_WAIT_L(8); PG8_BAR; PG8_WAIT_L(0); PG8_MMA(0, 0, At, B0); PG8_BAR; PG8_SCHED;
            PG8_LDB(B1, 0, 1); PG8_STAGE(PG8_SB(0, 0), b2, voffB);
            PG8_BAR; PG8_WAIT_L(0); PG8_MMA(0, 1, At, B1); PG8_BAR;
            PG8_LDA(At, 0, 1); PG8_STAGE(PG8_SA(0, 0), a2, voffA);
            PG8_BAR; PG8_WAIT_L(0); PG8_MMA(1, 0, At, B0); PG8_BAR; PG8_SCHED;
            PG8_STAGE(PG8_SB(0, 1), b2 + hstep, voffB);
            PG8_WAIT_V(6); PG8_BAR; PG8_MMA(1, 1, At, B1); PG8_BAR;
            PG8_LDB(B0, 1, 0); PG8_SCHED; PG8_LDA(At, 1, 0); PG8_STAGE(PG8_SA(0, 1), a2 + hstep, voffA);
            PG8_WAIT_L(8); PG8_BAR; PG8_WAIT_L(0); PG8_MMA(0, 0, At, B0); PG8_BAR; PG8_SCHED;
            PG8_LDB(B1, 1, 1); PG8_STAGE(PG8_SB(1, 0), b3, voffB);
            PG8_BAR; PG8_WAIT_L(0); PG8_MMA(0, 1, At, B1); PG8_BAR;
            PG8_LDA(At, 1, 1); PG8_STAGE(PG8_SA(1, 0), a3, voffA);
            PG8_BAR; PG8_WAIT_L(0); PG8_MMA(1, 0, At, B0); PG8_BAR; PG8_SCHED;
            PG8_STAGE(PG8_SB(1, 1), b3 + hstep, voffB);
            PG8_WAIT_V(6); PG8_BAR; PG8_MMA(1, 1, At, B1); PG8_BAR;
            }
        }
        if constexpr (ALIGN_EPI) { if (wr == 0) PG8_BAR; }
        int fr2 = fr, fq2 = fq, tid2 = tid; asm volatile("" : "+v"(fr2), "+v"(fq2), "+v"(tid2));
        if constexpr (Sched::STREAMK) {
            if (cur.mode == 1) {
                unsigned char* pp = S.part + (size_t)S.r * 131072 + (size_t)tid2 * 16;
#pragma unroll
                for (int a = 0; a < 2; ++a)
#pragma unroll
                    for (int b = 0; b < 2; ++b)
#pragma unroll
                        for (int m = 0; m < 4; ++m) { u32x4 w; w.x = pk2(acc[a][b][m][0][0], acc[a][b][m][0][1]); w.y = pk2(acc[a][b][m][0][2], acc[a][b][m][0][3]); w.z = pk2(acc[a][b][m][1][0], acc[a][b][m][1][1]); w.w = pk2(acc[a][b][m][1][2], acc[a][b][m][1][3]);
                            asm volatile("global_store_dwordx4 %0, %1, off sc0 sc1" :: "v"(pp + ((a * 2 + b) * 4 + m) * 8192), "v"(w) : "memory"); }
                asm volatile("s_waitcnt vmcnt(0)" ::: "memory");
                if (lane == 0) __hip_atomic_fetch_add(S.flags + 16 * S.r, 1u, __ATOMIC_RELAXED, __HIP_MEMORY_SCOPE_AGENT);
            } else {
                const bool tail = cur.mode == 2;
                if (tail) {
                    unsigned sp = 0;
                    while ((unsigned)__builtin_amdgcn_readfirstlane(__hip_atomic_load(S.flags + 16 * (S.r - 1), __ATOMIC_RELAXED, __HIP_MEMORY_SCOPE_AGENT)) < 8u) { __builtin_amdgcn_s_sleep(2); if (++sp > (1u << 22)) break; }
                }
                const unsigned char* pp = tail ? S.part + (size_t)(S.r - 1) * 131072 + (size_t)tid2 * 16 : nullptr;
                E(acc, cur, wr, wc, fr2, fq2, pp);
            }
        } else
        if constexpr (Epi::RSTAB) { E(acc, cur, wr, wc, fr2, fq2, (const PG8_LAS float*)(lds + STAGE_BYTES + 1024) + (ui & 1) * 256); } else
        if constexpr (!Epi::AFTER_DRAIN) { E(acc, cur, wr, wc, fr2, fq2); S.done(cur); }
        if (!has_next) break;
#pragma unroll
        for (int a = 0; a < 2; ++a)
#pragma unroll
            for (int b = 0; b < 2; ++b)
#pragma unroll
                for (int m = 0; m < 4; ++m)
#pragma unroll
                    for (int n = 0; n < 2; ++n) acc[a][b][m][n] = (f32x4){0.f, 0.f, 0.f, 0.f};
        cur = nxt; cA = nA; cB = nB; ++ui;
        if constexpr (Epi::RSTAB) E.prefetch(cur, (PG8_LAS float*)(lds + STAGE_BYTES + 1024) + (ui & 1) * 256, tid2);
        if constexpr (ALIGN_EPI) { if (wr == 1) PG8_BAR; }
    }
    PG8_WAIT_V(0);
    if constexpr (!ALIGN_EPI) { if (wr == 0) PG8_BAR; }
    PG8_BAR;
    if constexpr (Epi::AFTER_DRAIN) { E.fused(acc, cur, wr, wc, fr, fq, lds, wid, lane); S.done(cur); }
#undef PG8_SA
#undef PG8_SB
#undef PG8_STAGE
#undef PG8_LDA
#undef PG8_LDB
#undef PG8_MMA
#undef PG8_WAIT_V
#undef PG8_WAIT_L
#undef PG8_BAR
#undef PG8_SCHED
}
}

constexpr size_t SZ_WIN = (size_t)NIN * DM * 2, SZ_WO = (size_t)DM * DM * 2, SZ_WGU = (size_t)NGU * DM * 2, SZ_WD = (size_t)DM * DFFN * 2, SZ_WL = SZ_WIN + SZ_WO + SZ_WGU + SZ_WD;
constexpr size_t WS_CTL = 0;
constexpr size_t WS_FLAGS = 16384;
constexpr size_t WS_ZERO = 16384 + 4 * 256 * 64;
constexpr size_t WS_CTR = WS_ZERO + 256;
constexpr size_t WS_W = WS_CTR + 4 * 64;
constexpr size_t WS_XB = WS_W + DEPTH * SZ_WL;
constexpr size_t WS_MRG = WS_XB + (size_t)MP * DM * 2;
constexpr size_t WS_Z = WS_MRG + (size_t)MP * DM * 2;
constexpr size_t WS_LD = WS_Z + (size_t)MP * ZP * 2;
constexpr size_t WS_U = WS_Z;
constexpr size_t WS_DS = WS_LD + (size_t)MP * 256 * 4;
constexpr size_t WS_SC = WS_DS + (size_t)16 * NCH * 64 * 128 * 4;
constexpr size_t WS_GL = WS_SC + (size_t)16 * NCH * 64 * 128 * 2;
constexpr size_t WS_SSQA = WS_GL + (size_t)16 * NCH * 64 * 4;
constexpr size_t WS_SSQB = WS_SSQA + (size_t)MP * 16 * 4;
constexpr size_t WS_XMETA = WS_SSQB + (size_t)MP * 16 * 4;
constexpr size_t WS_END = WS_XMETA + (size_t)64 * DM * 4;
static_assert((size_t)MP * DFFN * 2 <= (size_t)MP * ZP * 2 + (size_t)MP * 256 * 4, "U overlay fits Z|LD");
static_assert(WS_END <= 268435456ull, "workspace map fits 256 MiB");

#ifndef REP_PRO
#define REP_PRO 1
#endif
#ifndef REP_WIN
#define REP_WIN 1
#endif
#ifndef REP_MB
#define REP_MB 1
#endif
#ifndef REP_SCAN
#define REP_SCAN 1
#endif
#ifndef REP_GU
#define REP_GU 1
#endif
#ifndef REP_G1
#define REP_G1 1
#endif
#ifndef REP_AS
#define REP_AS 1
#endif
#ifndef REP_GS
#define REP_GS 1
#endif
#ifndef REP_G3
#define REP_G3 1
#endif
#ifndef REP_AP
#define REP_AP 1
#endif
#ifndef REP_WO0
#define REP_WO0 1
#endif
#ifndef DRY_WO
#define DRY_WO 0
#endif
#ifndef DRY_DN
#define DRY_DN 0
#endif
#ifndef TIME_PH
#define TIME_PH -1
#endif
#ifndef TIME_MULT
#define TIME_MULT 4
#endif
#ifndef TIME_BUSY
#define TIME_BUSY 0
#endif
#ifndef TIME_SUB
#define TIME_SUB -1
#endif
#ifndef XSYNC
#define XSYNC 0
#endif
constexpr int LDS_BYTES = 147456;
constexpr int NPHASE = 1 + 7 * DEPTH;

struct Args { const float* in[19]; float* out; unsigned char* ws; int ph_lo, ph_hi; };
typedef const __attribute__((address_space(4))) Args* KA;
DI KA ka_ptr() { KA p = (KA)__builtin_amdgcn_kernarg_segment_ptr(); asm volatile("" : "+s"(p)); return p; }

DI int mk_tid(int wave_s) { int lane; asm volatile("v_mbcnt_lo_u32_b32 %0, -1, 0\n\tv_mbcnt_hi_u32_b32 %0, -1, %0" : "=v"(lane)); return wave_s * 64 + lane; }
typedef short v4i16_t __attribute__((ext_vector_type(4)));
DI u32x2 tr4(const LAS unsigned char* p) { return __builtin_bit_cast(u32x2, __builtin_amdgcn_ds_read_tr16_b64_v4i16((LAS v4i16_t*)p)); }
#if TIME_SUB >= 0
#define TICK(id) do { if (blockIdx.x == 0 && tid == 0) { volatile LAS unsigned* M_ = (volatile LAS unsigned*)(lds + 131072 + 320); const unsigned now_ = (unsigned)__builtin_amdgcn_s_memrealtime(); M_[100 + (id)] += now_ - M_[99]; M_[99] = now_; } } while (0)
#else
#define TICK(id) do {} while (0)
#endif
DI bf16x8 mk8(u32x2 lo, u32x2 hi) { u32x4 w; w.x = lo.x; w.y = lo.y; w.z = hi.x; w.w = hi.y; return __builtin_bit_cast(bf16x8, w); }
#define MFMA16(a, b, c) __builtin_amdgcn_mfma_f32_16x16x32_bf16((a), (b), (c), 0, 0, 0)

DI void attn_wave(const LAS unsigned char* Ks, const LAS unsigned char* Vt, const int VPB, const u32x4 qa, const u32x4 qb, const float* qnw, const float sink2, const int jmin, const int c, const int fq, bf16_t* orow) {
    float qf[16]; unpack8(qa, qf); unpack8(qb, qf + 8);
    float ss = 0.f;
#pragma unroll
    for (int i = 0; i < 16; ++i) ss += qf[i] * qf[i];
    ss = red4rows(ss);
    const float rs = rsqrtf(ss * (1.0f / 64.0f) + EPS) * (0.125f * LOG2E);
    const f32x4 w0 = *(const f32x4*)(qnw + 8 * fq), w1 = *(const f32x4*)(qnw + 8 * fq + 4), w2 = *(const f32x4*)(qnw + 32 + 8 * fq), w3 = *(const f32x4*)(qnw + 36 + 8 * fq);
#pragma unroll
    for (int i = 0; i < 4; ++i) { qf[i] *= rs * w0[i]; qf[4 + i] *= rs * w1[i]; qf[8 + i] *= rs * w2[i]; qf[12 + i] *= rs * w3[i]; }
    u32x4 q0, q1; q0.x = pk2(qf[0], qf[1]); q0.y = pk2(qf[2], qf[3]); q0.z = pk2(qf[4], qf[5]); q0.w = pk2(qf[6], qf[7]);
    q1.x = pk2(qf[8], qf[9]); q1.y = pk2(qf[10], qf[11]); q1.z = pk2(qf[12], qf[13]); q1.w = pk2(qf[14], qf[15]);
    const bf16x8 qB0 = __builtin_bit_cast(bf16x8, q0), qB1 = __builtin_bit_cast(bf16x8, q1);
    f32x4 acc[9];
    float mx = sink2;
#pragma unroll
    for (int T = 0; T < 9; ++T) {
        const LAS unsigned char* kp = Ks + (16 * T + c) * 144 + 16 * fq;
        const bf16x8 a0 = *(const LAS bf16x8*)kp, a1 = *(const LAS bf16x8*)(kp + 64);
        f32x4 s = {0.f, 0.f, 0.f, 0.f};
        s = MFMA16(a0, qB0, s); s = MFMA16(a1, qB1, s);
#pragma unroll
        for (int r = 0; r < 4; ++r) { const int jrel = 16 * T + 4 * fq + r, d = 128 + c - jrel; const bool ok = ((unsigned)d < 128u) && (jrel >= jmin); s[r] = ok ? s[r] : -1e30f; mx = fmaxf(mx, s[r]); }
        acc[T] = s;
    }
    mx = max4rows(mx);
    float sum = 0.f;
#pragma unroll
    for (int T = 0; T < 9; ++T)
#pragma unroll
        for (int r = 0; r < 4; ++r) { const float p = __builtin_amdgcn_exp2f(acc[T][r] - mx); acc[T][r] = p; sum += p; }
    sum = red4rows(sum);
    const float inv = 1.0f / (sum + __builtin_amdgcn_exp2f(sink2 - mx));
    f32x4 o[4];
#pragma unroll
    for (int i = 0; i < 4; ++i) o[i] = (f32x4){0.f, 0.f, 0.f, 0.f};
#pragma unroll
    for (int kk = 0; kk < 5; ++kk) {
        u32x4 pw; pw.x = pk2(acc[2 * kk][0], acc[2 * kk][1]); pw.y = pk2(acc[2 * kk][2], acc[2 * kk][3]);
        if (kk < 4) { pw.z = pk2(acc[2 * kk + 1][0], acc[2 * kk + 1][1]); pw.w = pk2(acc[2 * kk + 1][2], acc[2 * kk + 1][3]); } else { pw.z = 0u; pw.w = 0u; }
        const bf16x8 pB = __builtin_bit_cast(bf16x8, pw);
#pragma unroll
        for (int Mt = 0; Mt < 4; ++Mt) {
            const LAS unsigned char* vp = Vt + (32 * kk + 4 * fq + (c >> 2)) * VPB + (16 * Mt + 4 * (c & 3)) * 2;
            const u32x2 lo = tr4(vp), hi = tr4(vp + 16 * VPB);
            o[Mt] = MFMA16(mk8(lo, hi), pB, o[Mt]);
        }
    }
    if (orow) {
#pragma unroll
        for (int Mt = 0; Mt < 4; ++Mt) { u32x2 w; w.x = pk2(o[Mt][0] * inv, o[Mt][1] * inv); w.y = pk2(o[Mt][2] * inv, o[Mt][3] * inv); *(u32x2*)(orow + 16 * Mt + 4 * fq) = w; }
    }
}

struct Ctx {
    int l;
    const bf16_t* Z; float* LD; bf16_t* MRG; float* DS; bf16_t* SC; float* GL;
    const float *qnw, *knw, *sinks, *gnw;
    const float *cache_k, *cache_v, *state;
    float* out;
};

DI void attn_prompt_unit(const Ctx& C, int uidx, LAS unsigned char* lds, const int wave_s) {
    const int tid = mk_tid(wave_s);
    const int jb = uidx % 65, g = (uidx / 65) & 1, b = uidx / 130;
    const int p0 = 64 * jb, kbase = p0 - 128, rowbase = b * LP, nq = (LP - p0) < 64 ? (LP - p0) : 64;
    LAS unsigned char* Ks = lds; LAS unsigned char* Vs = lds + 208 * 144;
    TICK(0);
    {
        const int dc = tid & 7;
        u32x4 rk[4], rv[4];
#pragma unroll
        for (int i = 0; i < 4; ++i) { const int j = (tid >> 3) + 64 * i, kp = kbase + j; const bool valid = (j < 192) && (kp >= 0) && (kp < LP);
            rk[i] = (u32x4){0u, 0u, 0u, 0u}; rv[i] = rk[i];
            if (valid) { const bf16_t* zr = C.Z + (size_t)(rowbase + kp) * ZP + g * 64 + dc * 8; rk[i] = *(const u32x4*)(zr + ZK); rv[i] = *(const u32x4*)(zr + ZV); } }
        const f32x4 kw0 = *(const f32x4*)(C.knw + dc * 8), kw1 = *(const f32x4*)(C.knw + dc * 8 + 4);
#pragma unroll
        for (int i = 0; i < 4; ++i) { const int j = (tid >> 3) + 64 * i, kp = kbase + j; const bool valid = (j < 192) && (kp >= 0) && (kp < LP);
            float f[8]; unpack8(rk[i], f); float ss = 0.f;
#pragma unroll
            for (int e = 0; e < 8; ++e) ss += f[e] * f[e];
            ss = sum8(ss);
            const float rs = rsqrtf(ss * (1.0f / 64.0f) + EPS);
#pragma unroll
            for (int e = 0; e < 4; ++e) { f[e] *= rs * kw0[e]; f[4 + e] *= rs * kw1[e]; }
            if (j < 208) { u32x4 o; o.x = pk2(f[0], f[1]); o.y = pk2(f[2], f[3]); o.z = pk2(f[4], f[5]); o.w = pk2(f[6], f[7]); *(LAS u32x4*)(Ks + j * 144 + dc * 16) = o; *(LAS u32x4*)(Vs + j * 144 + dc * 16) = rv[i]; }
            if (valid && j >= 128 && kp >= LP - 128) { const size_t oo = ((size_t)((C.l * NBATCH + b) * 128 + (kp - (LP - 128))) * 2 + g) * 64 + dc * 8;
                float* op = C.out + O_CKP + oo; *(f32x4*)op = (f32x4){f[0], f[1], f[2], f[3]}; *(f32x4*)(op + 4) = (f32x4){f[4], f[5], f[6], f[7]};
                float fv[8]; unpack8(rv[i], fv); float* ov = C.out + O_CVP + oo; *(f32x4*)ov = (f32x4){fv[0], fv[1], fv[2], fv[3]}; *(f32x4*)(ov + 4) = (f32x4){fv[4], fv[5], fv[6], fv[7]}; } }
    }
    __syncthreads();
    TICK(4);
    {
        const int tid2 = mk_tid(wave_s), lane = tid2 & 63, w = tid2 >> 6;
        const int s = w & 3, hp = w >> 2, c = lane & 15, fq = lane >> 4;
        if (16 * s < nq) {
            const int qp = p0 + 16 * s + c; const bool qv = qp < LP; const int h0 = g * 4 + hp * 2;
            u32x4 qr[2][2];
#pragma unroll
            for (int hh = 0; hh < 2; ++hh) { qr[hh][0] = (u32x4){0u, 0u, 0u, 0u}; qr[hh][1] = qr[hh][0];
                if (qv) { const bf16_t* qrow = C.Z + (size_t)(rowbase + qp) * ZP + ZQ + (h0 + hh) * 64; qr[hh][0] = *(const u32x4*)(qrow + 8 * fq); qr[hh][1] = *(const u32x4*)(qrow + 32 + 8 * fq); } }
#pragma unroll
            for (int hh = 0; hh < 2; ++hh) { const int h = h0 + hh;
                bf16_t* orow = qv ? C.MRG + (size_t)(rowbase + qp) * DM + h * 64 : nullptr;
                attn_wave(Ks + 16 * s * 144, Vs + 16 * s * 144, 144, qr[hh][0], qr[hh][1], C.qnw, C.sinks[h] * LOG2E, 128 - p0 - 16 * s, c, fq, orow); }
        }
    }
    __syncthreads();
    TICK(5);
}

DI void attn_sample_unit(const Ctx& C, int uidx, LAS unsigned char* lds, const int wave_s) {
    const int tid = mk_tid(wave_s);
    const int g = uidx & 1, b = uidx >> 1;
    constexpr int KSG = 160 * 144;
    TICK(0);
    const int row0 = MPROMPT + b * DECT;
    const size_t cbase = (size_t)(C.l * DECB + b) * 128;
#pragma unroll
    for (int i = 0; i < 2; ++i) {
        const int idx = tid + 512 * i, dc = idx & 7, j = idx >> 3;
        const size_t so = ((cbase + j) * 2 + g) * 64 + dc * 8;
        const f32x4 a = *(const f32x4*)(C.cache_k + so), bq = *(const f32x4*)(C.cache_k + so + 4), va = *(const f32x4*)(C.cache_v + so), vb = *(const f32x4*)(C.cache_v + so + 4);
        u32x4 o; o.x = pk2(a[0], a[1]); o.y = pk2(a[2], a[3]); o.z = pk2(bq[0], bq[1]); o.w = pk2(bq[2], bq[3]);
        *(LAS u32x4*)(lds + j * 144 + dc * 16) = o;
        u32x4 ov; ov.x = pk2(va[0], va[1]); ov.y = pk2(va[2], va[3]); ov.z = pk2(vb[0], vb[1]); ov.w = pk2(vb[2], vb[3]);
        *(LAS u32x4*)(lds + KSG + j * 144 + dc * 16) = ov;
        if (j >= 8) { const size_t oo = ((cbase + j - 8) * 2 + g) * 64 + dc * 8; float* op = C.out + O_CKS + oo; *(f32x4*)op = a; *(f32x4*)(op + 4) = bq; float* opv = C.out + O_CVS + oo; *(f32x4*)opv = va; *(f32x4*)(opv + 4) = vb; }
    }
    if (tid < 64) {
        const int dc = tid & 7, t = tid >> 3;
        const bf16_t* zr = C.Z + (size_t)(row0 + t) * ZP + g * 64 + dc * 8;
        const u32x4 raw = *(const u32x4*)(zr + ZK), rawv = *(const u32x4*)(zr + ZV);
        float f[8]; unpack8(raw, f); float ss = 0.f;
#pragma unroll
        for (int e = 0; e < 8; ++e) ss += f[e] * f[e];
        ss = sum8(ss);
        const float rs = rsqrtf(ss * (1.0f / 64.0f) + EPS);
        const f32x4 kw0 = *(const f32x4*)(C.knw + dc * 8), kw1 = *(const f32x4*)(C.knw + dc * 8 + 4);
#pragma unroll
        for (int e = 0; e < 4; ++e) { f[e] *= rs * kw0[e]; f[4 + e] *= rs * kw1[e]; }
        u32x4 o; o.x = pk2(f[0], f[1]); o.y = pk2(f[2], f[3]); o.z = pk2(f[4], f[5]); o.w = pk2(f[6], f[7]);
        *(LAS u32x4*)(lds + (128 + t) * 144 + dc * 16) = o;
        *(LAS u32x4*)(lds + KSG + (128 + t) * 144 + dc * 16) = rawv;
        const size_t oo = ((cbase + 120 + t) * 2 + g) * 64 + dc * 8;
        float* op = C.out + O_CKS + oo; *(f32x4*)op = (f32x4){f[0], f[1], f[2], f[3]}; *(f32x4*)(op + 4) = (f32x4){f[4], f[5], f[6], f[7]};
        float fv[8]; unpack8(rawv, fv); float* opv = C.out + O_CVS + oo; *(f32x4*)opv = (f32x4){fv[0], fv[1], fv[2], fv[3]}; *(f32x4*)(opv + 4) = (f32x4){fv[4], fv[5], fv[6], fv[7]};
    } else if (tid < 256) {
        const int idx = tid - 64, dc = idx & 7, r = idx >> 3;
        unsigned z0 = 0u; asm volatile("" : "+v"(z0));
        *(LAS u32x4*)(lds + (136 + r) * 144 + dc * 16) = (u32x4){z0, z0, z0, z0};
        *(LAS u32x4*)(lds + KSG + (136 + r) * 144 + dc * 16) = (u32x4){z0, z0, z0, z0};
    }
    __syncthreads();
    {
        const int tid2 = mk_tid(wave_s), lane = tid2 & 63, w2 = tid2 >> 6;
        if (w2 < 4) {
            const int h = g * 4 + w2, c = lane & 15, fq = lane >> 4;
            const bool qv = c < 8;
            const bf16_t* qrow = C.Z + (size_t)(row0 + (c & 7)) * ZP + ZQ + h * 64;
            const u32x4 qa = *(const u32x4*)(qrow + 8 * fq), qb = *(const u32x4*)(qrow + 32 + 8 * fq);
            bf16_t* orow = qv ? C.MRG + (size_t)(row0 + c) * DM + h * 64 : nullptr;
            attn_wave(lds, lds + KSG, 144, qa, qb, C.qnw, C.sinks[h] * LOG2E, 0, c, fq, orow);
        }
    }
    __syncthreads();
    TICK(8);
}

DI void gla_sample_unit(const Ctx& C, int uidx, LAS unsigned char* lds, const int wave_s) {
    const int tid = mk_tid(wave_s);
    const int h = uidx & 3, b = uidx >> 2, row0 = MPROMPT + b * DECT;
    TICK(0);
    LAS float* qs = (LAS float*)lds; LAS float* ks = qs + 512; LAS float* dec = ks + 512; LAS float* vs = dec + 512; LAS float* red = vs + 1024;
    {
        const int t = tid >> 6, k = tid & 63; const bf16_t* zr = C.Z + (size_t)(row0 + t) * ZP;
        qs[tid] = bf2f(zr[ZGQ + h * 64 + k]); ks[tid] = bf2f(zr[ZGK + h * 64 + k]); dec[tid] = __expf(C.LD[(size_t)(row0 + t) * 256 + h * 64 + k]);
#pragma unroll
        for (int i = 0; i < 2; ++i) { const int idx = tid + 512 * i, tt = idx >> 7, v = idx & 127; vs[idx] = bf2f(C.Z[(size_t)(row0 + tt) * ZP + ZGV + h * 128 + v]); }
    }
    const int v = tid & 127, kq = tid >> 7;
    const size_t sbase = ((size_t)((C.l * DECB + b) * 4 + h) * 64 + 16 * kq) * 128 + v;
    float S[16];
#pragma unroll
    for (int i = 0; i < 16; ++i) S[i] = C.state[sbase + (size_t)i * 128];
    __syncthreads();
#pragma unroll
    for (int t = 0; t < 8; ++t) { float a = 0.f; const float vv = vs[t * 128 + v];
#pragma unroll
        for (int i = 0; i < 16; ++i) { const int k = 16 * kq + i; S[i] = dec[t * 64 + k] * S[i] + ks[t * 64 + k] * vv; a += qs[t * 64 + k] * S[i]; }
        red[(kq * 8 + t) * 128 + v] = a; }
    float* so = C.out + O_SS + sbase;
#pragma unroll
    for (int i = 0; i < 16; ++i) so[(size_t)i * 128] = S[i];
    __syncthreads();
    {
        const int t = tid >> 6, lane = tid & 63; float o[2]; float ss = 0.f;
#pragma unroll
        for (int i = 0; i < 2; ++i) { const int vv = lane + 64 * i; o[i] = (red[(0 * 8 + t) * 128 + vv] + red[(1 * 8 + t) * 128 + vv]) + (red[(2 * 8 + t) * 128 + vv] + red[(3 * 8 + t) * 128 + vv]); ss += o[i] * o[i]; }
        ss = sum64(ss);
        const float rs = rsqrtf(ss * (1.0f / 128.0f) + EPS);
#pragma unroll
        for (int i = 0; i < 2; ++i) { const int vv = lane + 64 * i; const float og = bf2f(C.Z[(size_t)(row0 + t) * ZP + ZOG + h * 128 + vv]);
            const float y = o[i] * rs * C.gnw[vv] * silu_f(og); C.MRG[(size_t)(row0 + t) * DM + 512 + h * 128 + vv] = (bf16_t)(pk2(y, 0.f) & 0xffffu); }
    }
    __syncthreads();
    TICK(9);
}

DI void gla_prefix_load(const float* LD, int r0, int nv, int h, int lane, int w, float (&g)[16]) {
#pragma unroll
    for (int i = 0; i < 16; ++i) { const int t = 16 * w + i; g[i] = t < nv ? LD[(size_t)(r0 + t) * 256 + h * 64 + lane] : 0.f; }
}
DI float gla_prefix_finish(float (&g)[16], LAS float* Gs, LAS float* segtot, int lane, int w) {
    const int k = lane, seg = w;
#pragma unroll
    for (int i = 1; i < 16; ++i) g[i] += g[i - 1];
    segtot[seg * 64 + k] = g[15];
    __syncthreads();
    float off = 0.f, tot = 0.f;
#pragma unroll
    for (int s = 0; s < 8; ++s) { const float x = segtot[s * 64 + k]; off += (s < seg) ? x : 0.f; tot += x; }
#pragma unroll
    for (int i = 0; i < 16; ++i) { const int t = 16 * seg + i; Gs[t * 65 + k] = g[i] + off; }
    return tot;
}

DI void gla1_unit(const Ctx& C, int unit, LAS unsigned char* lds, const int wave_s) {
    const int tid = mk_tid(wave_s);
    const int c = unit % NCH, bh = unit / NCH, h = bh & 3, b = bh >> 2;
    const int r0 = b * LP + 128 * c, nv = (LP - 128 * c) < 128 ? (LP - 128 * c) : 128;
    LAS float* Gs = (LAS float*)lds; LAS float* segtot = (LAS float*)(lds + 33280); LAS float* gl = (LAS float*)(lds + 35328);
    LAS unsigned char* kdS = lds + 35840; LAS unsigned char* Vs = lds + 54272;
    const int lane = tid & 63, w = tid >> 6;
    TICK(0);
    float g[16]; gla_prefix_load(C.LD, r0, nv, h, lane, w, g);
    u32x4 rk[2], rv[4];
#pragma unroll
    for (int i = 0; i < 2; ++i) { const int t = (tid >> 3) + 64 * i; rk[i] = (u32x4){0u, 0u, 0u, 0u}; if (t < nv) rk[i] = *(const u32x4*)(C.Z + (size_t)(r0 + t) * ZP + ZGK + h * 64 + (tid & 7) * 8); }
#pragma unroll
    for (int i = 0; i < 4; ++i) { const int t = (tid >> 4) + 32 * i; rv[i] = (u32x4){0u, 0u, 0u, 0u}; if (t < nv) rv[i] = *(const u32x4*)(C.Z + (size_t)(r0 + t) * ZP + ZGV + h * 128 + (tid & 15) * 8); }
    { const float tot = gla_prefix_finish(g, Gs, segtot, lane, w); if (w == 0) { gl[lane] = tot; C.GL[(size_t)unit * 64 + lane] = tot; } }
#pragma unroll
    for (int i = 0; i < 4; ++i) { const int t = (tid >> 4) + 32 * i; *(LAS u32x4*)(Vs + t * 272 + (tid & 15) * 16) = rv[i]; }
    __syncthreads();
    {
        const int kc = tid & 7;
#pragma unroll
        for (int i = 0; i < 2; ++i) { const int t = (tid >> 3) + 64 * i; float f[8]; unpack8(rk[i], f);
#pragma unroll
            for (int e = 0; e < 8; ++e) f[e] *= __expf(gl[kc * 8 + e] - Gs[t * 65 + kc * 8 + e]);
            u32x4 o; o.x = pk2(f[0], f[1]); o.y = pk2(f[2], f[3]); o.z = pk2(f[4], f[5]); o.w = pk2(f[6], f[7]); *(LAS u32x4*)(kdS + t * 144 + kc * 16) = o; }
    }
    __syncthreads();
    {
        const int cc = lane & 15, fq = lane >> 4;
#pragma unroll
        for (int kt = 0; kt < 4; ++kt) { f32x4 acc = {0.f, 0.f, 0.f, 0.f};
#pragma unroll
            for (int ks = 0; ks < 4; ++ks) {
                const LAS unsigned char* ap = kdS + (32 * ks + 8 * fq + (cc >> 2)) * 144 + (16 * kt + 4 * (cc & 3)) * 2;
                const LAS unsigned char* bp = Vs + (32 * ks + 8 * fq + (cc >> 2)) * 272 + (16 * w + 4 * (cc & 3)) * 2;
                acc = MFMA16(mk8(tr4(ap), tr4(ap + 4 * 144)), mk8(tr4(bp), tr4(bp + 4 * 272)), acc); }
#pragma unroll
            for (int r = 0; r < 4; ++r) C.DS[((size_t)unit * 64 + 16 * kt + 4 * fq + r) * 128 + 16 * w + cc] = acc[r]; }
    }
    __syncthreads();
    TICK(6);
}

DI void gla3_unit(const Ctx& C, int unit, LAS unsigned char* lds, const int wave_s) {
    const int tid = mk_tid(wave_s);
    const int c = unit % NCH, bh = unit / NCH, h = bh & 3, b = bh >> 2;
    const int r0 = b * LP + 128 * c, nv = (LP - 128 * c) < 128 ? (LP - 128 * c) : 128;
    LAS unsigned char* qg = lds; LAS unsigned char* kg = lds + 18432; LAS unsigned char* Vs = lds + 36864; LAS unsigned char* Ss = lds + 71680;
    LAS float* Gs = (LAS float*)(lds + 89088); LAS float* segtot = (LAS float*)(lds + 122368);
    const int lane = tid & 63, w = __builtin_amdgcn_readfirstlane(tid >> 6);
    TICK(0);
    float g[16]; gla_prefix_load(C.LD, r0, nv, h, lane, w, g);
    u32x4 rq[2], rk[2], rv[4], rs_[2];
#pragma unroll
    for (int i = 0; i < 2; ++i) { const int t = (tid >> 3) + 64 * i; rq[i] = (u32x4){0u, 0u, 0u, 0u}; rk[i] = rq[i];
        if (t < nv) { const bf16_t* zr = C.Z + (size_t)(r0 + t) * ZP + h * 64 + (tid & 7) * 8; rq[i] = *(const u32x4*)(zr + ZGQ); rk[i] = *(const u32x4*)(zr + ZGK); } }
#pragma unroll
    for (int i = 0; i < 4; ++i) { const int t = (tid >> 4) + 32 * i; rv[i] = (u32x4){0u, 0u, 0u, 0u}; if (t < nv) rv[i] = *(const u32x4*)(C.Z + (size_t)(r0 + t) * ZP + ZGV + h * 128 + (tid & 15) * 8); }
#pragma unroll
    for (int i = 0; i < 2; ++i) { const int k = (tid >> 4) + 32 * i; rs_[i] = *(const u32x4*)(C.SC + ((size_t)unit * 64 + k) * 128 + (tid & 15) * 8); }
    (void)gla_prefix_finish(g, Gs, segtot, lane, w);
#pragma unroll
    for (int i = 0; i < 4; ++i) { const int t = (tid >> 4) + 32 * i; *(LAS u32x4*)(Vs + t * 272 + (tid & 15) * 16) = rv[i]; }
#pragma unroll
    for (int i = 0; i < 2; ++i) { const int k = (tid >> 4) + 32 * i; *(LAS u32x4*)(Ss + k * 272 + (tid & 15) * 16) = rs_[i]; }
    __syncthreads();
    TICK(1);
    {
        const int kc = tid & 7;
#pragma unroll
        for (int i = 0; i < 2; ++i) { const int t = (tid >> 3) + 64 * i; float fq_[8], fk_[8]; unpack8(rq[i], fq_); unpack8(rk[i], fk_);
#pragma unroll
            for (int e = 0; e < 8; ++e) { const float ev = __expf(Gs[t * 65 + kc * 8 + e]); fq_[e] *= ev; fk_[e] *= __builtin_amdgcn_rcpf(ev); }
            u32x4 oq, ok; oq.x = pk2(fq_[0], fq_[1]); oq.y = pk2(fq_[2], fq_[3]); oq.z = pk2(fq_[4], fq_[5]); oq.w = pk2(fq_[6], fq_[7]);
            ok.x = pk2(fk_[0], fk_[1]); ok.y = pk2(fk_[2], fk_[3]); ok.z = pk2(fk_[4], fk_[5]); ok.w = pk2(fk_[6], fk_[7]);
            *(LAS u32x4*)(qg + t * 144 + kc * 16) = oq; *(LAS u32x4*)(kg + t * 144 + kc * 16) = ok; }
    }
    __syncthreads();
    TICK(2);
    {
        const int cc = lane & 15, fq = lane >> 4;
        const int t = 16 * w + cc; const size_t row = (size_t)(r0 + (t < nv ? t : 0));
        u32x2 og[8];
#pragma unroll
        for (int Mt = 0; Mt < 8; ++Mt) og[Mt] = *(const u32x2*)(C.Z + row * ZP + ZOG + h * 128 + 16 * Mt + 4 * fq);
        const bf16x8 qB0 = *(const LAS bf16x8*)(qg + (16 * w + cc) * 144 + 16 * fq), qB1 = *(const LAS bf16x8*)(qg + (16 * w + cc) * 144 + 64 + 16 * fq);
        f32x4 A[8];
#pragma unroll
        for (int T = 0; T < 8; ++T) { f32x4 sa = {0.f, 0.f, 0.f, 0.f};
            const LAS unsigned char* kp = kg + (16 * T + cc) * 144 + 16 * fq; const bf16x8 a0 = *(const LAS bf16x8*)kp, a1 = *(const LAS bf16x8*)(kp + 64);
            sa = MFMA16(a0, qB0, sa); sa = MFMA16(a1, qB1, sa);
#pragma unroll
            for (int r = 0; r < 4; ++r) sa[r] = (16 * T + 4 * fq + r > t) ? 0.f : sa[r];
            A[T] = sa; }
        bf16x8 P[4];
#pragma unroll
        for (int kk = 0; kk < 4; ++kk) { u32x4 pw; pw.x = pk2(A[2 * kk][0], A[2 * kk][1]); pw.y = pk2(A[2 * kk][2], A[2 * kk][3]); pw.z = pk2(A[2 * kk + 1][0], A[2 * kk + 1][1]); pw.w = pk2(A[2 * kk + 1][2], A[2 * kk + 1][3]); P[kk] = __builtin_bit_cast(bf16x8, pw); }
        f32x4 o[8]; float ss = 0.f;
#pragma unroll
        for (int Mt = 0; Mt < 8; ++Mt) o[Mt] = (f32x4){0.f, 0.f, 0.f, 0.f};
#pragma unroll
        for (int kk = 0; kk < 4; ++kk)
#pragma unroll
            for (int Mt = 0; Mt < 8; ++Mt) {
                const LAS unsigned char* vp = Vs + (32 * kk + 4 * fq + (cc >> 2)) * 272 + (16 * Mt + 4 * (cc & 3)) * 2;
                o[Mt] = MFMA16(mk8(tr4(vp), tr4(vp + 16 * 272)), P[kk], o[Mt]); }
#pragma unroll
        for (int ks = 0; ks < 2; ++ks)
#pragma unroll
            for (int Mt = 0; Mt < 8; ++Mt) {
                const LAS unsigned char* sp = Ss + (32 * ks + 8 * fq + (cc >> 2)) * 272 + (16 * Mt + 4 * (cc & 3)) * 2;
                o[Mt] = MFMA16(mk8(tr4(sp), tr4(sp + 4 * 272)), ks ? qB1 : qB0, o[Mt]); }
#pragma unroll
        for (int Mt = 0; Mt < 8; ++Mt) ss += (o[Mt][0] * o[Mt][0] + o[Mt][1] * o[Mt][1]) + (o[Mt][2] * o[Mt][2] + o[Mt][3] * o[Mt][3]);
        ss = red4rows(ss);
        const float rs = rsqrtf(ss * (1.0f / 128.0f) + EPS);
        if (t < nv) {
#pragma unroll
            for (int Mt = 0; Mt < 8; ++Mt) { const int v0 = 16 * Mt + 4 * fq; const f32x4 gn = *(const f32x4*)(C.gnw + v0);
                const float y0 = o[Mt][0] * rs * gn[0] * silu_f(bflo(og[Mt].x)), y1 = o[Mt][1] * rs * gn[1] * silu_f(bfhi(og[Mt].x)), y2 = o[Mt][2] * rs * gn[2] * silu_f(bflo(og[Mt].y)), y3 = o[Mt][3] * rs * gn[3] * silu_f(bfhi(og[Mt].y));
                u32x2 wv; wv.x = pk2(y0, y1); wv.y = pk2(y2, y3); *(u32x2*)(C.MRG + row * DM + 512 + h * 128 + v0) = wv; } }
    }
    __syncthreads();
    TICK(3);
}

DI void gla_scan(const Ctx& C, int gtid, int gthreads) {
    for (int idx = gtid; idx < 16 * 64 * 128; idx += gthreads) {
        const int v = idx & 127, k = (idx >> 7) & 63, bh = idx >> 13;
        const size_t u0 = (size_t)bh * NCH;
        float ds[NCH], dg[NCH];
#pragma unroll
        for (int c = 0; c < NCH; ++c) { ds[c] = C.DS[((u0 + c) * 64 + k) * 128 + v]; dg[c] = C.GL[(u0 + c) * 64 + k]; }
        float S = 0.f;
#pragma unroll
        for (int c = 0; c < NCH; ++c) { C.SC[((u0 + c) * 64 + k) * 128 + v] = (bf16_t)(pk2(S, 0.f) & 0xffffu); S = __expf(dg[c]) * S + ds[c]; }
        const int h = bh & 3, b = bh >> 2;
        C.out[O_SP + ((size_t)((C.l * NBATCH + b) * 4 + h) * 64 + k) * 128 + v] = S;
    }
}

struct WSrc { int mat; const float* W; const float* W2; const float* gain; const float* wg2; };
DI float wsrc(const WSrc& s, int k, int n) {
    if (s.mat == 0) {
        if (n < 2304) { const int col = n < 1792 ? n : n + 16; const float sc = (n >= 768 && n < 1024) ? 0.125f : 1.0f; return s.W[(size_t)k * INW + col] * s.gain[k] * sc; }
        const int e = n - 2304; float a = 0.f;
#pragma unroll
        for (int r = 0; r < 16; ++r) a += s.W[(size_t)k * INW + 1792 + r] * s.wg2[r * 256 + e];
        return a * s.gain[k];
    } else if (s.mat == 1) { return s.W[(size_t)k * DM + n];
    } else if (s.mat == 2) { const int pn = n >> 8, j = n & 255; return (j < 128 ? s.W[(size_t)k * DFFN + 128 * pn + j] : s.W2[(size_t)k * DFFN + 128 * pn + j - 128]) * s.gain[k];
    } else { return s.W[(size_t)k * DM + n]; }
}
DI f32x4 wsrc4(const WSrc& s, int k, int n) {
    if (s.mat == 0) { const int col = n < 1792 ? n : n + 16; const float sc = ((n >= 768 && n < 1024) ? 0.125f : 1.0f) * s.gain[k]; return *(const f32x4*)(s.W + (size_t)k * INW + col) * sc; }
    else if (s.mat == 1) return *(const f32x4*)(s.W + (size_t)k * DM + n);
    else if (s.mat == 2) { const int pn = n >> 8, j = n & 255; const float* src = j < 128 ? s.W + (size_t)k * DFFN + 128 * pn + j : s.W2 + (size_t)k * DFFN + 128 * pn + j - 128; return *(const f32x4*)src * s.gain[k]; }
    else return *(const f32x4*)(s.W + (size_t)k * DM + n);
}
DI void conv_item_lr(const WSrc& s, int K, bf16_t* WT, LAS float* scr, int item, int lane) {
    const int kb = item >> 3, nb = item & 7, k0 = 64 * kb, n0 = 2304 + 32 * nb;
    const int e = lane & 31; float g2[16];
#pragma unroll
    for (int r = 0; r < 16; ++r) g2[r] = s.wg2[r * 256 + 32 * nb + e];
#pragma unroll 8
    for (int i = 0; i < 32; ++i) { const int kk = 2 * i + (lane >> 5); const f32x4* wp = (const f32x4*)(s.W + (size_t)(k0 + kk) * INW + 1792);
        const f32x4 a = wp[0], b = wp[1], c4 = wp[2], d = wp[3];
        const float acc = ((a[0] * g2[0] + a[1] * g2[1]) + (a[2] * g2[2] + a[3] * g2[3])) + ((b[0] * g2[4] + b[1] * g2[5]) + (b[2] * g2[6] + b[3] * g2[7]))
                        + ((c4[0] * g2[8] + c4[1] * g2[9]) + (c4[2] * g2[10] + c4[3] * g2[11])) + ((d[0] * g2[12] + d[1] * g2[13]) + (d[2] * g2[14] + d[3] * g2[15]));
        scr[kk * 33 + e] = acc * s.gain[k0 + kk]; }
    asm volatile("s_waitcnt lgkmcnt(0)" ::: "memory");
    const int c = lane & 7;
#pragma unroll
    for (int j = 0; j < 4; ++j) { const int n = (lane >> 3) + 8 * j; const LAS float* sp = scr + (8 * c) * 33 + n;
        u32x4 o; o.x = pk2(sp[0 * 33], sp[1 * 33]); o.y = pk2(sp[2 * 33], sp[3 * 33]); o.z = pk2(sp[4 * 33], sp[5 * 33]); o.w = pk2(sp[6 * 33], sp[7 * 33]);
        *(u32x4*)(WT + (size_t)(n0 + n) * K + k0 + 8 * c) = o; }
    asm volatile("s_waitcnt lgkmcnt(0)" ::: "memory");
}
DI void conv_item(const WSrc& s, int K, int nblk, bf16_t* WT, LAS unsigned char* tile, int item, int lane) {
    const int kb = item / nblk, nb = item % nblk, k0 = 64 * kb, n0 = 64 * nb;
    const int krow = lane >> 4, n4 = (lane & 15) * 4;
    f32x4 v[16];
#pragma unroll
    for (int st = 0; st < 16; ++st) v[st] = wsrc4(s, k0 + 4 * st + krow, n0 + n4);
#pragma unroll
    for (int st = 0; st < 16; ++st) { u32x2 w; w.x = pk2(v[st][0], v[st][1]); w.y = pk2(v[st][2], v[st][3]); *(LAS u32x2*)(tile + (4 * st + krow) * 136 + n4 * 2) = w; }
    asm volatile("s_waitcnt lgkmcnt(0)" ::: "memory");
    const int i = lane & 15, fq = lane >> 4;
#pragma unroll
    for (int q = 0; q < 2; ++q)
#pragma unroll
        for (int nbk = 0; nbk < 4; ++nbk) { const int kg = 4 * q + fq;
            const LAS unsigned char* tp = tile + (8 * kg + (i >> 2)) * 136 + (16 * nbk + 4 * (i & 3)) * 2;
            const u32x2 lo = tr4(tp), hi = tr4(tp + 4 * 136);
            u32x4 o; o.x = lo.x; o.y = lo.y; o.z = hi.x; o.w = hi.y;
            *(u32x4*)(WT + (size_t)(n0 + 16 * nbk + i) * K + k0 + 8 * kg) = o; }
    asm volatile("s_waitcnt lgkmcnt(0)" ::: "memory");
}
constexpr int NI_IN = 16 * 36, NI_LR = 16 * 8, NI_O = 16 * 16, NI_GU = 16 * 88, NI_D = 44 * 16, NI_L = NI_IN + NI_LR + NI_O + NI_GU + NI_D;

DI void prologue(KA ap, const RowMap& rm, LAS unsigned char* lds, int tid, int vcu, int G) {
    const int lane = tid & 63, wave = tid >> 6, gw = vcu * 8 + wave, NGW = G * 8;
    LAS unsigned char* tile = lds + wave * 16384;
    for (int it = gw; it < DEPTH * NI_L; it += NGW) {
        const int l = it / NI_L; int r = it % NI_L;
        unsigned char* wl = ap->ws + WS_W + (size_t)l * SZ_WL;
        if (r < NI_IN) { WSrc s{0, ap->in[7] + (size_t)l * DM * INW, nullptr, ap->in[6] + l * DM, nullptr}; conv_item(s, DM, 36, (bf16_t*)wl, tile, r, lane); continue; } r -= NI_IN;
        if (r < NI_LR) { WSrc s{0, ap->in[7] + (size_t)l * DM * INW, nullptr, ap->in[6] + l * DM, ap->in[11] + l * 16 * 256}; conv_item_lr(s, DM, (bf16_t*)wl, (LAS float*)tile, r, lane); continue; } r -= NI_LR;
        if (r < NI_O) { WSrc s{1, ap->in[14] + (size_t)l * DM * DM, nullptr, nullptr, nullptr}; conv_item(s, DM, 16, (bf16_t*)(wl + SZ_WIN), tile, r, lane); continue; } r -= NI_O;
        if (r < NI_GU) { WSrc s{2, ap->in[16] + (size_t)l * DM * DFFN, ap->in[17] + (size_t)l * DM * DFFN, ap->in[15] + l * DM, nullptr}; conv_item(s, DM, 88, (bf16_t*)(wl + SZ_WIN + SZ_WO), tile, r, lane); continue; } r -= NI_GU;
        { WSrc s{3, ap->in[18] + (size_t)l * DFFN * DM, nullptr, nullptr, nullptr}; conv_item(s, DFFN, 16, (bf16_t*)(wl + SZ_WIN + SZ_WO + SZ_WGU), tile, r, lane); }
    }
    bf16_t* XB = (bf16_t*)(ap->ws + WS_XB); bf16_t* MRG = (bf16_t*)(ap->ws + WS_MRG); float* ssqA = (float*)(ap->ws + WS_SSQA);
    for (int m = gw; m < MP; m += NGW) {
        const float* ip = row_in(rm, m); f32x4 v[4]; float s = 0.f;
#pragma unroll
        for (int j = 0; j < 4; ++j) { v[j] = ip ? ((const f32x4*)ip)[lane + 64 * j] : (f32x4){0.f, 0.f, 0.f, 0.f}; s += (v[j][0] * v[j][0] + v[j][1] * v[j][1]) + (v[j][2] * v[j][2] + v[j][3] * v[j][3]); }
        s = sum64(s);
#pragma unroll
        for (int j = 0; j < 4; ++j) { u32x2 w; w.x = pk2(v[j][0], v[j][1]); w.y = pk2(v[j][2], v[j][3]); ((u32x2*)(XB + (size_t)m * DM))[lane + 64 * j] = w; if (!ip) ((u32x2*)(MRG + (size_t)m * DM))[lane + 64 * j] = (u32x2){0u, 0u}; }
        if (lane < 16) ssqA[(size_t)m * 16 + lane] = lane == 0 ? s : 0.f;
    }
}

#define XB_TMO      128
#define XB_XCNT(j)  (256  + 64 * (j))
#define XB_XSUB(j)  (1280 + 64 * (j))
#define XB_XGEN(j)  (2304 + 64 * (j))
#define XB_TOP      3328
#define XB_TOPGEN   3392
#define XCD_BAR_WORDS 3456
#define XB_SPIN_CAP (1u << 18)

__device__ __forceinline__ unsigned xb_ld(unsigned* p)              { return __hip_atomic_load(p, __ATOMIC_RELAXED, __HIP_MEMORY_SCOPE_AGENT); }
__device__ __forceinline__ unsigned xb_add(unsigned* p, unsigned v) { return __hip_atomic_fetch_add(p, v, __ATOMIC_RELAXED, __HIP_MEMORY_SCOPE_AGENT); }
__device__ __forceinline__ unsigned xb_xcc_id() { return (unsigned)__builtin_amdgcn_s_getreg((3 << 11) | 20) & 0xFu; }
#define XB_SPIN(cond, bar) do { unsigned _sp = 0; while (cond) { __builtin_amdgcn_s_sleep(1); \
    if ((++_sp & 255u) == 0u) { if (xb_ld(&(bar)[XB_TMO])) break; if (_sp > XB_SPIN_CAP) { atomicAdd(&(bar)[XB_TMO], 1u); break; } } } } while (0)

struct XcdBarrier {
    unsigned* bar; unsigned x;
    volatile LAS unsigned* st;
};

__device__ __forceinline__ XcdBarrier xcd_barrier_post(unsigned* bar, volatile LAS unsigned* st, const bool t0) {
    XcdBarrier b; b.bar = bar; b.x = xb_xcc_id(); b.st = st;
    if (t0) (void)xb_add(&bar[XB_XCNT(b.x)], 1u);
    return b;
}
__device__ __forceinline__ void xcd_barrier_complete(unsigned* bar, unsigned x, unsigned& nloc, unsigned& nx) {
    const unsigned G = gridDim.x * gridDim.y * gridDim.z;
    unsigned sum, cnt, mine, sp = 0u;
    for (;;) {
        sum = 0u; cnt = 0u; mine = 0u;
#pragma unroll
        for (unsigned j = 0; j < 16; ++j) { const unsigned c = xb_ld(&bar[XB_XCNT(j)]); sum += c; cnt += (c > 0u) ? 1u : 0u; mine = (j == x) ? c : mine; }
        if (sum == G) break;
        __builtin_amdgcn_s_sleep(1);
        if ((++sp & 255u) == 0u) { if (xb_ld(&bar[XB_TMO])) break; if (sp > XB_SPIN_CAP) { atomicAdd(&bar[XB_TMO], 1u); break; } }
    }
    nloc = mine > 0u ? mine : 1u; nx = cnt > 0u ? cnt : 1u;
}

__device__ __forceinline__ void xcd_barrier(const XcdBarrier& b, const bool t0) {
    asm volatile("s_waitcnt vmcnt(0)" ::: "memory");
    __syncthreads();
    if (t0) {
        unsigned* bar = b.bar;
        __builtin_amdgcn_s_waitcnt(0);
        unsigned nloc = b.st[0], nx = b.st[1];
        if (nloc == 0u) { xcd_barrier_complete(bar, b.x, nloc, nx); b.st[0] = nloc; b.st[1] = nx; }
        const unsigned old = xb_add(&bar[XB_XSUB(b.x)], 1u);
        const unsigned gen = old / nloc;
        if (old + 1u == (gen + 1u) * nloc) {
            __builtin_amdgcn_fence(__ATOMIC_RELEASE, "agent");
            asm volatile("s_waitcnt vmcnt(0)" ::: "memory");
            const unsigned og = xb_add(&bar[XB_TOP], 1u);
            const unsigned tg = og / nx;
            if (og + 1u == (tg + 1u) * nx) xb_add(&bar[XB_TOPGEN], 1u);
            else XB_SPIN(xb_ld(&bar[XB_TOPGEN]) == tg, bar);
            __builtin_amdgcn_fence(__ATOMIC_ACQUIRE, "agent");
            xb_add(&bar[XB_XGEN(b.x)], 1u);
            asm volatile("s_waitcnt vmcnt(0)" ::: "memory");
        } else {
            XB_SPIN(xb_ld(&bar[XB_XGEN(b.x)]) == gen, bar);
            __builtin_amdgcn_fence(__ATOMIC_ACQUIRE, "agent");
            asm volatile("s_waitcnt vmcnt(0)" ::: "memory");
        }
    }
    __syncthreads();
}

template <class T> DI T* opq(T* p) { asm volatile("" : "+s"(p)); return p; }
DI Ctx make_ctx(int l) {
    KA ap = ka_ptr(); unsigned char* ws = ap->ws;
    Ctx C; C.l = l; C.Z = (const bf16_t*)(ws + WS_Z); C.LD = (float*)(ws + WS_LD); C.MRG = (bf16_t*)(ws + WS_MRG); C.DS = (float*)(ws + WS_DS); C.SC = (bf16_t*)(ws + WS_SC); C.GL = (float*)(ws + WS_GL);
    C.qnw = ap->in[8] + l * 64; C.knw = ap->in[9] + l * 64; C.sinks = ap->in[10] + l * 8; C.gnw = ap->in[13] + l * 128;
    C.cache_k = ap->in[2]; C.cache_v = ap->in[3]; C.state = ap->in[4]; C.out = ap->out;
    return C;
}
DI RowMap make_rm() { KA ap = ka_ptr(); float* out = ap->out; unsigned char* ws = ap->ws; return RowMap{ap->in[0], ap->in[1], ap->in[5], out + O_YP, out + O_YS, (float*)(ws + WS_XMETA)}; }

__global__ void __launch_bounds__(512, 2) hymba_fwd(Args a) {
    extern __shared__ __attribute__((aligned(16))) unsigned char lds_raw[];
    LAS unsigned char* lds = (LAS unsigned char*)lds_raw;
    const int G = gridDim.x, bx = blockIdx.x; const int wave_s = __builtin_amdgcn_readfirstlane((int)threadIdx.x >> 6);
#define opaque_tid() mk_tid(wave_s)
    const int vcu = (G % 8 == 0) ? (bx % 8) * (G / 8) + bx / 8 : bx;
    const int lo = ka_ptr()->ph_lo, hi = ka_ptr()->ph_hi;
#define IN(k) (lo <= (k) && (k) < hi)
#ifndef FAST_BAR
#define FAST_BAR 1
#endif
    volatile LAS unsigned* MISC = (volatile LAS unsigned*)(lds + 131072 + 320);
    { const int t = opaque_tid(); if (t < 160) MISC[t] = 0u; __syncthreads(); }
    XcdBarrier bar = xcd_barrier_post((unsigned*)ka_ptr()->ws, MISC + 8, opaque_tid() == 0);
#define GSYNC() do { if (FAST_BAR) xcd_barrier(bar, opaque_tid() == 0); else cg::this_grid().sync(); } while (0)
#define STAMP(k) do { if (TIME_PH >= 0 && bx == 0 && opaque_tid() == 0) { const unsigned long long t_ = __builtin_amdgcn_s_memrealtime(); MISC[16 + 2 * (k)] = (unsigned)t_; MISC[17 + 2 * (k)] = (unsigned)(t_ >> 32); } } while (0)
#define SEAM(k) do { if (TIME_BUSY) STAMP(32 + (k)); if (IN(k) && IN((k) + 1)) { GSYNC(); } STAMP((k) + 1); } while (0)
    if (lo < 0) cg::this_grid().sync();
    STAMP(0);
    if (IN(0)) { for (int rep = 0; rep < REP_PRO; ++rep) { const RowMap rm = make_rm(); prologue(ka_ptr(), rm, lds, opaque_tid(), vcu, G); if (rep + 1 < REP_PRO) GSYNC(); }
        for (int xs = 0; xs < XSYNC; ++xs) GSYNC(); }
    SEAM(0);
#pragma unroll 1
    for (int l = 0; l < DEPTH; ++l) {
        const int pb = 1 + 7 * l;
        if (IN(pb + 0)) for (int rep = 0; rep < REP_WIN; ++rep) {
            if (rep) GSYNC();
            KA ap = ka_ptr(); unsigned char* ws = ap->ws; unsigned char* wl = ws + WS_W + (size_t)l * SZ_WL;
            pg8::Gemm g{(const bf16_t*)(ws + WS_XB), (const bf16_t*)wl, MP, NIN, DM}; pg8::StaticOrder S; S.init(MP, NIN, G, bx);
            pg8::EpiIn E{(bf16_t*)(ws + WS_Z), (float*)(ws + WS_LD), (const float*)(ws + WS_SSQA), ap->in[12] + l * 256};
            pg8::gemm_phase<pg8::EpiIn, pg8::StaticOrder, true, true>(lds, g, S, E, opaque_tid());
        }
        SEAM(pb + 0);
        if (IN(pb + 1)) {
            const Ctx C = make_ctx(l);
            constexpr int N1 = DECB * 2, N2 = 16 * NCH, N3 = DECB * 4, N4 = NBATCH * 2 * 65, NT = N1 + N2 + N3 + N4;
            const int cnt = (NT - vcu + G - 1) / G, rev = vcu & 1;
#pragma unroll 1
            for (int i = 0; i < cnt; ++i) { const int u = vcu + (rev ? cnt - 1 - i : i) * G;
                if (u < N1) attn_sample_unit(C, u, lds, wave_s); else if (u < N1 + N2) gla1_unit(C, u - N1, lds, wave_s); else if (u < N1 + N2 + N3) gla_sample_unit(C, u - N1 - N2, lds, wave_s); else attn_prompt_unit(C, u - N1 - N2 - N3, lds, wave_s);
            }
        }
        SEAM(pb + 1);
        if (IN(pb + 2)) for (int rep = 0; rep < REP_SCAN; ++rep) { if (rep) GSYNC(); const Ctx C = make_ctx(l); gla_scan(C, bx * 512 + opaque_tid(), G * 512); }
        SEAM(pb + 2);
        if (IN(pb + 3)) for (int rep = 0; rep < REP_MB; ++rep) {   if (rep) GSYNC();
            const Ctx C = make_ctx(l);
            constexpr int N1 = 16 * NCH;
#pragma unroll 1
            for (int u = vcu; u < N1; u += G) gla3_unit(C, u, lds, wave_s);
        }
        SEAM(pb + 3);
        if (IN(pb + 4)) for (int rep = 0; rep < 1 + DRY_WO; ++rep) {
            if (rep) GSYNC();
            KA ap = ka_ptr(); unsigned char* ws = ap->ws; unsigned char* wl = ws + WS_W + (size_t)l * SZ_WL;
            pg8::Gemm g{(const bf16_t*)(ws + WS_MRG), (const bf16_t*)(wl + SZ_WIN), MP, DM, DM}; pg8::StreamK S; S.init((MP / 256) * 4, DM / 128, G, vcu, (unsigned*)(ws + WS_FLAGS) + (2 * l) * 256 * 16, ws + WS_Z, ws + WS_ZERO);
            pg8::EpiRes E{make_rm(), 0, (bf16_t*)(ws + WS_XB), (float*)(ws + WS_SSQB), rep};
            pg8::gemm_phase<pg8::EpiRes, pg8::StreamK, true, true>(lds, g, S, E, opaque_tid());
        }
        SEAM(pb + 4);
        if (IN(pb + 5)) for (int rep = 0; rep < REP_GU; ++rep) {
            if (rep) GSYNC();
            KA ap = ka_ptr(); unsigned char* ws = ap->ws; unsigned char* wl = ws + WS_W + (size_t)l * SZ_WL;
            pg8::Gemm g{(const bf16_t*)(ws + WS_XB), (const bf16_t*)(wl + SZ_WIN + SZ_WO), MP, NGU, DM}; pg8::StaticOrder S; S.init(MP, NGU, G, bx);
            pg8::EpiGU E{(bf16_t*)(ws + WS_U), (const float*)(ws + WS_SSQB)};
            pg8::gemm_phase<pg8::EpiGU, pg8::StaticOrder, true, true>(lds, g, S, E, opaque_tid());
        }
        SEAM(pb + 5);
        if (IN(pb + 6)) for (int rep = 0; rep < 1 + DRY_DN; ++rep) {
            if (rep) GSYNC();
            KA ap = ka_ptr(); unsigned char* ws = ap->ws; unsigned char* wl = ws + WS_W + (size_t)l * SZ_WL;
            pg8::Gemm g{(const bf16_t*)(ws + WS_U), (const bf16_t*)(wl + SZ_WIN + SZ_WO + SZ_WGU), MP, DM, DFFN}; pg8::StreamK S; S.init((MP / 256) * 4, DFFN / 128, G, vcu, (unsigned*)(ws + WS_FLAGS) + (2 * l + 1) * 256 * 16, ws + WS_MRG, ws + WS_ZERO);
            pg8::EpiRes E{make_rm(), l == DEPTH - 1 ? 1 : 0, (bf16_t*)(ws + WS_XB), (float*)(ws + WS_SSQA), rep};
            pg8::gemm_phase<pg8::EpiRes, pg8::StreamK, true, true>(lds, g, S, E, opaque_tid());
        }
        if (l + 1 < DEPTH) SEAM(pb + 6);
    }
    if (TIME_SUB >= 0) { if (bx == 0 && opaque_tid() == 0) { const unsigned long long tot = MISC[100 + (TIME_SUB >= 0 ? TIME_SUB : 0)]; const unsigned long long tend = __builtin_amdgcn_s_memrealtime();
            while (__builtin_amdgcn_s_memrealtime() - tend < (unsigned long long)TIME_MULT * tot) __builtin_amdgcn_s_sleep(8); } }
    if (TIME_PH >= 0) {
        STAMP(NPHASE);
        if (bx == 0 && opaque_tid() == 0) {
            unsigned long long tot = 0;
            for (int k = 0; k < NPHASE; ++k) { const bool pick = (TIME_PH == 7) ? (k == 0) : (k >= 1 && ((k - 1) % 7) == TIME_PH);
                if (pick) { const int ke = TIME_BUSY ? 32 + k : k + 1; const unsigned long long a0 = ((unsigned long long)MISC[17 + 2 * k] << 32) | MISC[16 + 2 * k], a1 = ((unsigned long long)MISC[17 + 2 * ke] << 32) | MISC[16 + 2 * ke]; tot += a1 - a0; } }
            const unsigned long long tend = __builtin_amdgcn_s_memrealtime();
            while (__builtin_amdgcn_s_memrealtime() - tend < (unsigned long long)TIME_MULT * tot) __builtin_amdgcn_s_sleep(8);
        }
    }
#undef IN
#undef SEAM
#undef STAMP
#undef GSYNC
#undef opaque_tid
}

#ifndef N_LAUNCH_MODE
#define N_LAUNCH_MODE 0
#endif
extern "C" void kernel_launch(void* const* d_in, const int* in_sizes, int n_in, void* d_out, int out_size, void* d_ws, size_t ws_size, hipStream_t stream) {
    static int grid = 0;
    if (grid == 0) {
        if (n_in != 19 || out_size != (int)O_END || ws_size < WS_END) { fprintf(stderr, "kernel_launch: unexpected shapes: n_in %d out %d ws %zu (need %zu)\n", n_in, out_size, ws_size, (size_t)WS_END); grid = -1; return; }
        int dev = 0, cus = 0, per_cu = 0;
        (void)hipGetDevice(&dev); (void)hipDeviceGetAttribute(&cus, hipDeviceAttributeMultiprocessorCount, dev);
        if (hipFuncSetAttribute((const void*)hymba_fwd, hipFuncAttributeMaxDynamicSharedMemorySize, LDS_BYTES) != hipSuccess) { fprintf(stderr, "kernel_launch: hipFuncSetAttribute failed\n"); grid = -1; return; }
        if (hipOccupancyMaxActiveBlocksPerMultiprocessor(&per_cu, (const void*)hymba_fwd, 512, LDS_BYTES) != hipSuccess || per_cu < 1) { fprintf(stderr, "kernel_launch: occupancy query says %d\n", per_cu); per_cu = 1; }
        (void)hipGetLastError();
        grid = cus > 0 ? cus : 256;
    }
    if (grid < 0) return;
    if (hipMemsetAsync(d_ws, 0, WS_W, stream) != hipSuccess) { fprintf(stderr, "kernel_launch: memset failed\n"); return; }
    Args a{};
    for (int i = 0; i < 19; ++i) a.in[i] = (const float*)d_in[i];
    a.out = (float*)d_out; a.ws = (unsigned char*)d_ws;
#if N_LAUNCH_MODE == 1
    for (int p = 0; p < NPHASE; ++p) { a.ph_lo = p; a.ph_hi = p + 1; hipLaunchKernelGGL(hymba_fwd, dim3(grid), dim3(512), LDS_BYTES, stream, a); }
#else
    a.ph_lo = 0; a.ph_hi = NPHASE;
    void* args[] = {&a};
    hipError_t e = hipLaunchCooperativeKernel((const void*)hymba_fwd, dim3(grid), dim3(512), args, LDS_BYTES, stream);
    if (e != hipSuccess) fprintf(stderr, "cooperative launch failed: %s (grid %d)\n", hipGetErrorString(e), grid);
#endif
}
```

```cpp
#include <hip/hip_runtime.h>
#include <hip/hip_cooperative_groups.h>
#include <cstdio>
#include <cstdint>
namespace cg = cooperative_groups;

#define DI __device__ __forceinline__
#define LAS __attribute__((address_space(3)))
typedef unsigned short bf16_t;
typedef short bf16x8 __attribute__((ext_vector_type(8)));
typedef float f32x4 __attribute__((ext_vector_type(4)));
typedef float f32x2 __attribute__((ext_vector_type(2)));
typedef unsigned u32x4 __attribute__((ext_vector_type(4)));
typedef unsigned u32x2 __attribute__((ext_vector_type(2)));
typedef __bf16 bf16x2_t __attribute__((ext_vector_type(2)));

constexpr int DM = 1024, NBATCH = 4, SEQ = 4096, LP = 4112  , DEPTH = 2, DECB = 128, DECT = 8;
constexpr int MPROMPT = NBATCH * LP, MREAL = MPROMPT + DECB * DECT, MP = 17664  ;
constexpr int INW = 2320, ZP = 2304, NIN = 2560, DFFN = 2816, NGU = 5632;
constexpr int ZQ = 0, ZK = 512, ZV = 640, ZGQ = 768, ZGK = 1024, ZGV = 1280, ZOG = 1792;
constexpr int NCH = 33;
constexpr float EPS = 1e-6f, LOG2E = 1.4426950408889634f;
constexpr size_t O_YP = 0, O_YS = 16777216, O_CKP = 17825792, O_CVP = 17956864, O_SP = 18087936, O_CKS = 18350080, O_CVS = 22544384, O_SS = 26738688, O_END = 35127296;

DI unsigned pk2(float lo, float hi) { f32x2 v = {lo, hi}; bf16x2_t b = __builtin_convertvector(v, bf16x2_t); return __builtin_bit_cast(unsigned, b); }
DI float bflo(unsigned w) { return __uint_as_float(w << 16); }
DI float bfhi(unsigned w) { return __uint_as_float(w & 0xffff0000u); }
DI float bf2f(bf16_t h) { return __uint_as_float((unsigned)h << 16); }
DI void unpack8(const u32x4 w, float* f) { f[0] = bflo(w.x); f[1] = bfhi(w.x); f[2] = bflo(w.y); f[3] = bfhi(w.y); f[4] = bflo(w.z); f[5] = bfhi(w.z); f[6] = bflo(w.w); f[7] = bfhi(w.w); }
DI float red4rows(float v) {
    auto r = __builtin_amdgcn_permlane16_swap(__float_as_uint(v), __float_as_uint(v), false, false); v = __uint_as_float(r[0]) + __uint_as_float(r[1]);
    auto q = __builtin_amdgcn_permlane32_swap(__float_as_uint(v), __float_as_uint(v), false, false); return __uint_as_float(q[0]) + __uint_as_float(q[1]);
}
DI float max4rows(float v) {
    auto r = __builtin_amdgcn_permlane16_swap(__float_as_uint(v), __float_as_uint(v), false, false); v = fmaxf(__uint_as_float(r[0]), __uint_as_float(r[1]));
    auto q = __builtin_amdgcn_permlane32_swap(__float_as_uint(v), __float_as_uint(v), false, false); return fmaxf(__uint_as_float(q[0]), __uint_as_float(q[1]));
}
template <int M> DI float shx(float v) { return __int_as_float(__builtin_amdgcn_ds_swizzle(__float_as_int(v), 0x1f | (M << 10))); }
DI float sum8(float v) { v += shx<1>(v); v += shx<2>(v); v += shx<4>(v); return v; }
DI float sum64(float v) { v += shx<1>(v); v += shx<2>(v); v += shx<4>(v); v += shx<8>(v); v += shx<16>(v);
    auto q = __builtin_amdgcn_permlane32_swap(__float_as_uint(v), __float_as_uint(v), false, false); return __uint_as_float(q[0]) + __uint_as_float(q[1]); }
DI float silu_f(float x) { return x * __builtin_amdgcn_rcpf(1.0f + __expf(-x)); }

struct RowMap { const float* xp; const float* xs; const float* meta; float* yp; float* ys; float* xmeta; };
DI const float* row_in(const RowMap& rm, int row) {
    if (row < MPROMPT) { const int b = row / LP, p = row - b * LP; return p < 16 ? rm.meta + (size_t)p * DM : rm.xp + ((size_t)b * SEQ + (p - 16)) * DM; }
    if (row < MREAL) return rm.xs + (size_t)(row - MPROMPT) * DM;
    return nullptr;
}
DI float* row_out(const RowMap& rm, int row) {
    if (row < MPROMPT) { const int b = row / LP, p = row - b * LP; return p < 16 ? nullptr : rm.yp + ((size_t)b * SEQ + (p - 16)) * DM; }
    if (row < MREAL) return rm.ys + (size_t)(row - MPROMPT) * DM;
    return nullptr;
}
namespace pg8 {
#define PG8_LAS __attribute__((address_space(3)))
typedef unsigned short bf16_t;
typedef short bf16x8 __attribute__((ext_vector_type(8)));
typedef float f32x4 __attribute__((ext_vector_type(4)));
typedef unsigned u32x4 __attribute__((ext_vector_type(4)));
constexpr int BM = 256, BK = 64, HALF = 128, HTB = HALF * BK * 2  , STAGE_BYTES = 8 * HTB, NXCD = 8, WGM = 8;

__host__ __device__ __forceinline__ int lds_byte(int r, int c) { const int st = (r >> 4) * 2 + (c >> 5), rr = r & 15, cc = c & 31, ob = rr * 64 + cc * 2; return st * 1024 + (ob ^ (((ob >> 9) & 1) << 5)); }
__host__ __device__ __forceinline__ void stage_rc(int b, int& R, int& C) { const int st = b / 1024, sb = b % 1024, swz = sb ^ (((sb >> 9) & 1) << 5); R = (st >> 1) * 16 + swz / 64; C = (st & 1) * 32 + (swz % 64) / 2; }
__host__ __device__ __forceinline__ int perm32(int rho) { const int n = rho >> 4, i = rho & 15; return 8 * (i >> 2) + 4 * n + (i & 3); }

struct Unit { int pm, pn, k0, nk, mode; };
struct Gemm { const bf16_t* A; const bf16_t* Bt; int M, N, K; };

struct StaticOrder {
    static constexpr bool STREAMK = false;
    int nM, nN, nwg, G, c;
    __host__ __device__ void init(int M, int N, int G_, int c_) { nM = M / BM; nN = N / BM; nwg = nM * nN; G = G_; c = c_; }
    __host__ __device__ bool next(int i, Unit& u) const {
        const long L = (long)i * G + c; if (L >= nwg) return false;
        int wgid = (int)L; { const int q = nwg / NXCD, r = nwg % NXCD, xcd = wgid % NXCD, off = wgid / NXCD; wgid = (xcd < r ? xcd * (q + 1) : r * (q + 1) + (xcd - r) * q) + off; }
        const int nig = WGM * nN, gid = wgid / nig, fm = gid * WGM, gsz = (nM - fm) < WGM ? (nM - fm) : WGM;
        u.pm = fm + ((wgid % nig) % gsz); u.pn = (wgid % nig) / gsz; u.k0 = 0; u.nk = 0; u.mode = 0; return true;
    }
    __device__ __forceinline__ void a_ready(const Unit&) const {}
    __device__ __forceinline__ void done(const Unit&) const {}
};


struct StreamK {
    static constexpr bool STREAMK = true;
    int P, r, s, e, nseg; unsigned* flags; unsigned char* part; const unsigned char* zero;
    __device__ __forceinline__ void init(int ntiles, int P_, int G, int r_, unsigned* flags_, unsigned char* part_, const unsigned char* zero_) {
        P = P_; r = r_; flags = flags_; part = part_; zero = zero_; const long TP = (long)ntiles * P; s = (int)(TP * r / G); e = (int)(TP * (r + 1) / G);
        nseg = 0; int cur = s; while (cur < e) { const int kb = cur % P; int ke = kb + (e - cur); ke = ke < P ? ke : P; cur += ke - kb; ++nseg; }
    }
    __device__ __forceinline__ bool next(int i, Unit& u) const {
        if (i >= nseg) return false;
        const int want = nseg - 1 - i; int cur = s, idx = 0;
        for (;;) { const int t = cur / P, kb = cur % P; int ke = kb + (e - cur); ke = ke < P ? ke : P;
            if (idx == want) { u.pm = t >> 2; u.pn = t & 3; u.k0 = 2 * kb; u.nk = 2 * (ke - kb); u.mode = (kb == 0 && ke == P) ? 0 : (kb == 0 ? 1 : 2); return true; }
            cur += ke - kb; ++idx; }
    }
    __device__ __forceinline__ void a_ready(const Unit&) const {}
    __device__ __forceinline__ void done(const Unit&) const {}
};

DI float rstd_from_slots(const float* ssq, int row) {
    const f32x4* p = (const f32x4*)(ssq + (size_t)row * 16);
    const f32x4 a = p[0], b = p[1], c = p[2], d = p[3];
    const float s = ((a[0] + a[1]) + (a[2] + a[3])) + ((b[0] + b[1]) + (b[2] + b[3])) + ((c[0] + c[1]) + (c[2] + c[3])) + ((d[0] + d[1]) + (d[2] + d[3]));
    return rsqrtf(s * (1.0f / 1024.0f) + EPS);
}
DI void rstd8(const float* ssq, int row0, float (&rs)[2][4]) {
#pragma unroll
    for (int ai = 0; ai < 2; ++ai) {
        f32x4 t[4][4];
#pragma unroll
        for (int m = 0; m < 4; ++m) { const f32x4* p = (const f32x4*)(ssq + (size_t)(row0 + ai * HALF + m * 16) * 16); t[m][0] = p[0]; t[m][1] = p[1]; t[m][2] = p[2]; t[m][3] = p[3]; }
#pragma unroll
        for (int m = 0; m < 4; ++m) { const f32x4 q = (t[m][0] + t[m][1]) + (t[m][2] + t[m][3]); rs[ai][m] = rsqrtf(((q[0] + q[1]) + (q[2] + q[3])) * (1.0f / 1024.0f) + EPS); }
        asm volatile("" ::: "memory");
    }
}
DI void rstd_tab_fill(const float* ssq, int pm, PG8_LAS float* tab, int tid) {
    if (tid < 256) { const f32x4* p = (const f32x4*)(ssq + (size_t)(pm * BM + tid) * 16); const f32x4 q = (p[0] + p[1]) + (p[2] + p[3]); tab[tid] = rsqrtf(((q[0] + q[1]) + (q[2] + q[3])) * (1.0f / 1024.0f) + EPS); }
}
DI void rstd8_tab(const PG8_LAS float* tab, int wr, int fr, float (&rs)[2][4]) {
#pragma unroll
    for (int ai = 0; ai < 2; ++ai)
#pragma unroll
        for (int m = 0; m < 4; ++m) rs[ai][m] = tab[ai * HALF + wr * 64 + m * 16 + fr];
}
struct EpiIn {
    static constexpr bool PERM = true, AFTER_DRAIN = false, RSTAB = true;
    bf16_t* Z; float* LD; const float* ssq; const float* bg;
    __device__ __forceinline__ void prefetch(const Unit& u, PG8_LAS float* tab, int tid) const { rstd_tab_fill(ssq, u.pm, tab, tid); }
    __device__ __forceinline__ void operator()(const f32x4 (&acc)[2][2][4][2], const Unit& u, int wr, int wc, int fr, int fq, const PG8_LAS float* tab) const {
        const int row0 = u.pm * BM + wr * 64 + fr;
        float rs[2][4]; rstd8_tab(tab, wr, fr, rs);
        if (u.pn < 9) {
#pragma unroll
            for (int ai = 0; ai < 2; ++ai)
#pragma unroll
                for (int m = 0; m < 4; ++m) { const int row = row0 + ai * HALF + m * 16; const float r = rs[ai][m];
                    bf16_t* rowp = Z + (size_t)row * ZP + u.pn * BM + wc * 32 + 8 * fq;
#pragma unroll
                    for (int bj = 0; bj < 2; ++bj) { const f32x4 v0 = acc[ai][bj][m][0] * r, v1 = acc[ai][bj][m][1] * r;
                        u32x4 w; w.x = pk2(v0[0], v0[1]); w.y = pk2(v0[2], v0[3]); w.z = pk2(v1[0], v1[1]); w.w = pk2(v1[2], v1[3]);
                        *(u32x4*)(rowp + bj * HALF) = w; } }
        } else {
            const int e0 = wc * 32 + 8 * fq;
#pragma unroll
            for (int bj = 0; bj < 2; ++bj) { const f32x4 b0 = *(const f32x4*)(bg + e0 + bj * HALF), b1 = *(const f32x4*)(bg + e0 + bj * HALF + 4);
#pragma unroll
                for (int ai = 0; ai < 2; ++ai)
#pragma unroll
                    for (int m = 0; m < 4; ++m) { const int row = row0 + ai * HALF + m * 16; const float r = rs[ai][m];
                        const f32x4 x0 = acc[ai][bj][m][0] * r + b0, x1 = acc[ai][bj][m][1] * r + b1; f32x4 o0, o1;
#pragma unroll
                        for (int i = 0; i < 4; ++i) { o0[i] = (fminf(x0[i], 0.f) - __logf(1.0f + __expf(-fabsf(x0[i])))) * 0.0625f; o1[i] = (fminf(x1[i], 0.f) - __logf(1.0f + __expf(-fabsf(x1[i])))) * 0.0625f; }
                        float* lp = LD + (size_t)row * 256 + e0 + bj * HALF; *(f32x4*)lp = o0; *(f32x4*)(lp + 4) = o1; } }
        }
    }
};
#ifndef EPIRES_BATCH4
#define EPIRES_BATCH4 1
#endif
#if EPIRES_BATCH4
struct EpiRes {
    static constexpr bool PERM = true, AFTER_DRAIN = false, RSTAB = false;
    RowMap rm; int final_; bf16_t* XB; float* ssq; int dry;
    __device__ __forceinline__ void operator()(const f32x4 (&acc)[2][2][4][2], const Unit& u, int wr, int wc, int fr, int fq, const unsigned char* pp) const {
        if (dry) return;
        const int row0 = u.pm * BM + wr * 64 + fr, col0 = u.pn * BM + wc * 32 + 8 * fq;
#pragma unroll
        for (int ai = 0; ai < 2; ++ai) {
            u32x4 res[4][2], par[4][2];
#pragma unroll
            for (int m = 0; m < 4; ++m) { const int row = row0 + ai * HALF + m * 16;
#pragma unroll
                for (int bj = 0; bj < 2; ++bj) { res[m][bj] = *(const u32x4*)(XB + (size_t)row * DM + col0 + bj * HALF); par[m][bj] = (u32x4){0u, 0u, 0u, 0u}; } }
            if (pp) {
#pragma unroll
                for (int m = 0; m < 4; ++m)
#pragma unroll
                    for (int bj = 0; bj < 2; ++bj) asm volatile("global_load_dwordx4 %0, %1, off sc0 sc1" : "=v"(par[m][bj]) : "v"(pp + ((ai * 2 + bj) * 4 + m) * 8192) : "memory");
                asm volatile("s_waitcnt vmcnt(0)" : "+v"(par[0][0]), "+v"(par[0][1]), "+v"(par[1][0]), "+v"(par[1][1]), "+v"(par[2][0]), "+v"(par[2][1]), "+v"(par[3][0]), "+v"(par[3][1]) :: "memory");
            }
#pragma unroll
            for (int m = 0; m < 4; ++m) { const int row = row0 + ai * HALF + m * 16; float ss = 0.f; float* op = final_ ? row_out(rm, row) : nullptr;
#pragma unroll
                for (int bj = 0; bj < 2; ++bj) { const int col = col0 + bj * HALF; float r[8], q[8]; unpack8(res[m][bj], r); unpack8(par[m][bj], q);
                    const f32x4 v0 = (acc[ai][bj][m][0] + (f32x4){q[0], q[1], q[2], q[3]}) + (f32x4){r[0], r[1], r[2], r[3]}, v1 = (acc[ai][bj][m][1] + (f32x4){q[4], q[5], q[6], q[7]}) + (f32x4){r[4], r[5], r[6], r[7]};
                    if (final_) { if (op) { __builtin_nontemporal_store(v0, (f32x4*)(op + col)); __builtin_nontemporal_store(v1, (f32x4*)(op + col + 4)); } }
                    else { u32x4 w; w.x = pk2(v0[0], v0[1]); w.y = pk2(v0[2], v0[3]); w.z = pk2(v1[0], v1[1]); w.w = pk2(v1[2], v1[3]);
                        *(u32x4*)(XB + (size_t)row * DM + col) = w;
                        const f32x4 q0 = {bflo(w.x), bfhi(w.x), bflo(w.y), bfhi(w.y)}, q1 = {bflo(w.z), bfhi(w.z), bflo(w.w), bfhi(w.w)};
                        ss += (q0[0] * q0[0] + q0[1] * q0[1]) + (q0[2] * q0[2] + q0[3] * q0[3]) + (q1[0] * q1[0] + q1[1] * q1[1]) + (q1[2] * q1[2] + q1[3] * q1[3]); } }
                if (!final_) { ss = red4rows(ss); if (fq == 0) ssq[(size_t)row * 16 + u.pn * 4 + wc] = ss; } }
            asm volatile("" ::: "memory");
        }
    }
};
#else
struct EpiRes {
    static constexpr bool PERM = true, AFTER_DRAIN = false, RSTAB = false;
    RowMap rm; int final_; bf16_t* XB; float* ssq; int dry;
    __device__ __forceinline__ void operator()(const f32x4 (&acc)[2][2][4][2], const Unit& u, int wr, int wc, int fr, int fq, const unsigned char* pp) const {
        if (dry) return;
        const int row0 = u.pm * BM + wr * 64 + fr, col0 = u.pn * BM + wc * 32 + 8 * fq;
#pragma unroll
        for (int ai = 0; ai < 2; ++ai)
#pragma unroll
        for (int mh = 0; mh < 2; ++mh) {
            u32x4 res[2][2], par[2][2];
#pragma unroll
            for (int mm = 0; mm < 2; ++mm) { const int row = row0 + ai * HALF + (2 * mh + mm) * 16;
#pragma unroll
                for (int bj = 0; bj < 2; ++bj) { res[mm][bj] = *(const u32x4*)(XB + (size_t)row * DM + col0 + bj * HALF); par[mm][bj] = (u32x4){0u, 0u, 0u, 0u}; } }
            if (pp) {
#pragma unroll
                for (int mm = 0; mm < 2; ++mm)
#pragma unroll
                    for (int bj = 0; bj < 2; ++bj) asm volatile("global_load_dwordx4 %0, %1, off sc0 sc1" : "=v"(par[mm][bj]) : "v"(pp + ((ai * 2 + bj) * 4 + 2 * mh + mm) * 8192) : "memory");
                asm volatile("s_waitcnt vmcnt(0)" : "+v"(par[0][0]), "+v"(par[0][1]), "+v"(par[1][0]), "+v"(par[1][1]) :: "memory");
            }
#pragma unroll
            for (int mm = 0; mm < 2; ++mm) { const int m = 2 * mh + mm; const int row = row0 + ai * HALF + m * 16; float ss = 0.f; float* op = final_ ? row_out(rm, row) : nullptr;
#pragma unroll
                for (int bj = 0; bj < 2; ++bj) { const int col = col0 + bj * HALF; float r[8], q[8]; unpack8(res[mm][bj], r); unpack8(par[mm][bj], q);
                    const f32x4 v0 = (acc[ai][bj][m][0] + (f32x4){q[0], q[1], q[2], q[3]}) + (f32x4){r[0], r[1], r[2], r[3]}, v1 = (acc[ai][bj][m][1] + (f32x4){q[4], q[5], q[6], q[7]}) + (f32x4){r[4], r[5], r[6], r[7]};
                    if (final_) { if (op) { __builtin_nontemporal_store(v0, (f32x4*)(op + col)); __builtin_nontemporal_store(v1, (f32x4*)(op + col + 4)); } }
                    else { u32x4 w; w.x = pk2(v0[0], v0[1]); w.y = pk2(v0[2], v0[3]); w.z = pk2(v1[0], v1[1]); w.w = pk2(v1[2], v1[3]);
                        *(u32x4*)(XB + (size_t)row * DM + col) = w;
                        const f32x4 q0 = {bflo(w.x), bfhi(w.x), bflo(w.y), bfhi(w.y)}, q1 = {bflo(w.z), bfhi(w.z), bflo(w.w), bfhi(w.w)};
                        ss += (q0[0] * q0[0] + q0[1] * q0[1]) + (q0[2] * q0[2] + q0[3] * q0[3]) + (q1[0] * q1[0] + q1[1] * q1[1]) + (q1[2] * q1[2] + q1[3] * q1[3]); } }
                if (!final_) { ss = red4rows(ss); if (fq == 0) ssq[(size_t)row * 16 + u.pn * 4 + wc] = ss; } }
            asm volatile("" ::: "memory");
        }
    }
};
#endif
struct EpiGU {
    static constexpr bool PERM = true, AFTER_DRAIN = false, RSTAB = true;
    bf16_t* U; const float* ssq;
    __device__ __forceinline__ void prefetch(const Unit& u, PG8_LAS float* tab, int tid) const { rstd_tab_fill(ssq, u.pm, tab, tid); }
    __device__ __forceinline__ void operator()(const f32x4 (&acc)[2][2][4][2], const Unit& u, int wr, int wc, int fr, int fq, const PG8_LAS float* tab) const {
        const int row0 = u.pm * BM + wr * 64 + fr, f0 = u.pn * HALF + wc * 32 + 8 * fq;
        float rs[2][4]; rstd8_tab(tab, wr, fr, rs);
#pragma unroll
        for (int ai = 0; ai < 2; ++ai)
#pragma unroll
            for (int m = 0; m < 4; ++m) { const int row = row0 + ai * HALF + m * 16; const float r = rs[ai][m];
                float o[8];
#pragma unroll
                for (int n = 0; n < 2; ++n)
#pragma unroll
                    for (int i = 0; i < 4; ++i) { const float g = acc[ai][0][m][n][i] * r, up = acc[ai][1][m][n][i] * r; o[4 * n + i] = silu_f(g) * up; }
                u32x4 w; w.x = pk2(o[0], o[1]); w.y = pk2(o[2], o[3]); w.z = pk2(o[4], o[5]); w.w = pk2(o[6], o[7]);
                *(u32x4*)(U + (size_t)row * DFFN + f0) = w; }
    }
};
template <class Epi, class Sched, bool ALIGN_EPI = false, bool SP2 = false>
__device__ __forceinline__ void gemm_phase(PG8_LAS unsigned char* lds, const Gemm g, const Sched& S, const Epi& E, const int tid_in) {
    const int tid = tid_in, wid = __builtin_amdgcn_readfirstlane(tid >> 6), lane = tid & 63, wr = wid >> 2, wc = wid & 3, fr = lane & 15, fq = lane >> 4;
    const int K = g.K;
    unsigned voffA[2], voffB[2];
#pragma unroll
    for (int i = 0; i < 2; ++i) { int R, C; stage_rc(tid * 16 + i * 8192, R, C); const int Rb = Epi::PERM ? ((R & ~31) + perm32(R & 31)) : R;
        voffA[i] = (unsigned)(R * K + C) * 2u; voffB[i] = (unsigned)(Rb * K + C) * 2u; }
    const size_t kstep = (size_t)(BK * 2);
    const size_t hstep = (size_t)HALF * K * 2;
    const size_t tstep = 2 * hstep;
    const unsigned ldsw = (unsigned)wid * 1024u;
    const int aoff = lds_byte(wr * 64 + fr, fq * 8), boff = lds_byte(wc * 32 + fr, fq * 8);
#define PG8_SA(b, h) (((b) * 2 + (h)) * HTB)
#define PG8_SB(b, h) ((4 + (b) * 2 + (h)) * HTB)
#define PG8_STAGE(bufoff, gbase, voff) do { _Pragma("unroll") for (int _i = 0; _i < 2; ++_i) \
        __builtin_amdgcn_global_load_lds((const unsigned*)((const char*)(gbase) + (voff)[_i]), (PG8_LAS unsigned*)(lds + (bufoff) + ldsw + _i * 8192), 16, 0, 0); } while (0)
#define PG8_LDA(dst, b, h) do { _Pragma("unroll") for (int m = 0; m < 4; ++m) _Pragma("unroll") for (int k = 0; k < 2; ++k) dst[m][k] = *(const PG8_LAS bf16x8*)(lds + PG8_SA(b, h) + aoff + m * 2048 + k * 1024); } while (0)
#define PG8_LDB(dst, b, h) do { _Pragma("unroll") for (int n = 0; n < 2; ++n) _Pragma("unroll") for (int k = 0; k < 2; ++k) dst[n][k] = *(const PG8_LAS bf16x8*)(lds + PG8_SB(b, h) + boff + n * 2048 + k * 1024); } while (0)
#define PG8_MMA(ai, bj, At, Bt) do { __builtin_amdgcn_s_setprio(1); _Pragma("unroll") for (int m = 0; m < 4; ++m) _Pragma("unroll") for (int n = 0; n < 2; ++n) _Pragma("unroll") for (int k = 0; k < 2; ++k) \
        acc[ai][bj][m][n] = __builtin_amdgcn_mfma_f32_16x16x32_bf16(Bt[n][k], At[m][k], acc[ai][bj][m][n], 0, 0, 0); __builtin_amdgcn_s_setprio(0); } while (0)
#define PG8_WAIT_V(n) asm volatile("s_waitcnt vmcnt(" #n ")" ::: "memory")
#define PG8_WAIT_L(n) asm volatile("s_waitcnt lgkmcnt(" #n ")" ::: "memory")
#define PG8_BAR __builtin_amdgcn_s_barrier()
#define PG8_SCHED __builtin_amdgcn_sched_barrier(0)
    Unit cur, nxt; int ui = 0;
    if (!S.next(0, cur)) return;
    f32x4 acc[2][2][4][2];
#pragma unroll
    for (int a = 0; a < 2; ++a)
#pragma unroll
        for (int b = 0; b < 2; ++b)
#pragma unroll
            for (int m = 0; m < 4; ++m)
#pragma unroll
                for (int n = 0; n < 2; ++n) acc[a][b][m][n] = (f32x4){0.f, 0.f, 0.f, 0.f};
    bf16x8 At[4][2], B0[2][2], B1[2][2];
    const char* cA = (const char*)g.A + (size_t)cur.pm * tstep + (size_t)cur.k0 * kstep; const char* cB = (const char*)g.Bt + (size_t)cur.pn * tstep + (size_t)cur.k0 * kstep;
    S.a_ready(cur);
    if constexpr (Epi::RSTAB) E.prefetch(cur, (PG8_LAS float*)(lds + STAGE_BYTES + 1024), tid);
    if constexpr (SP2) {
        PG8_STAGE(PG8_SB(0, 0), cB, voffB); PG8_STAGE(PG8_SB(0, 1), cB + hstep, voffB); PG8_STAGE(PG8_SA(0, 0), cA, voffA); PG8_STAGE(PG8_SA(0, 1), cA + hstep, voffA);
        if (wr == 1) PG8_BAR;
        PG8_WAIT_V(2); PG8_BAR;
        PG8_STAGE(PG8_SB(1, 0), cB + kstep, voffB); PG8_STAGE(PG8_SA(1, 0), cA + kstep, voffA); PG8_STAGE(PG8_SB(1, 1), cB + hstep + kstep, voffB);
        PG8_WAIT_V(6); PG8_BAR;
    } else {
        PG8_STAGE(PG8_SB(0, 0), cB, voffB); PG8_STAGE(PG8_SA(0, 0), cA, voffA); PG8_STAGE(PG8_SB(0, 1), cB + hstep, voffB); PG8_STAGE(PG8_SA(0, 1), cA + hstep, voffA);
        if (wr == 1) PG8_BAR;
        PG8_WAIT_V(4); PG8_BAR;
        PG8_STAGE(PG8_SB(1, 0), cB + kstep, voffB); PG8_STAGE(PG8_SA(1, 0), cA + kstep, voffA); PG8_STAGE(PG8_SB(1, 1), cB + hstep + kstep, voffB);
        PG8_WAIT_V(6); PG8_BAR;
    }
    for (;;) {
        const bool has_next = S.next(ui + 1, nxt);
        const char* nA = has_next ? (const char*)g.A + (size_t)nxt.pm * tstep + (size_t)nxt.k0 * kstep : cA; const char* nB = has_next ? (const char*)g.Bt + (size_t)nxt.pn * tstep + (size_t)nxt.k0 * kstep : cB;
        const int nt = cur.nk ? cur.nk : K / BK;
        for (int t = 0; t < nt; t += 2) {
            const bool last = (t == nt - 2);
            const char* a1 = cA + (size_t)(t + 1) * kstep;
            const char* a2 = last ? nA : cA + (size_t)(t + 2) * kstep; const char* b2 = last ? nB : cB + (size_t)(t + 2) * kstep;
            const char* a3 = a2 + kstep; const char* b3 = b2 + kstep;
            if (last && has_next) S.a_ready(nxt);
            if constexpr (SP2) {
            PG8_LDB(B0, 0, 0); PG8_LDB(B1, 0, 1); PG8_SCHED; PG8_LDA(At, 0, 0); PG8_STAGE(PG8_SA(1, 1), a1 + hstep, voffA);
            PG8_WAIT_V(8); PG8_WAIT_L(0); PG8_BAR; PG8_MMA(0, 0, At, B0); PG8_MMA(0, 1, At, B1); PG8_BAR; PG8_SCHED;
            PG8_LDA(At, 0, 1); PG8_STAGE(PG8_SB(0, 0), b2, voffB); PG8_STAGE(PG8_SB(0, 1), b2 + hstep, voffB); PG8_STAGE(PG8_SA(0, 0), a2, voffA);
            PG8_WAIT_V(8); PG8_WAIT_L(0); PG8_BAR; PG8_MMA(1, 0, At, B0); PG8_MMA(1, 1, At, B1); PG8_BAR; PG8_SCHED;
            PG8_LDB(B0, 1, 0); PG8_LDB(B1, 1, 1); PG8_SCHED; PG8_LDA(At, 1, 0); PG8_STAGE(PG8_SA(0, 1), a2 + hstep, voffA);
            PG8_WAIT_V(8); PG8_WAIT_L(0); PG8_BAR; PG8_MMA(0, 0, At, B0); PG8_MMA(0, 1, At, B1); PG8_BAR; PG8_SCHED;
            PG8_LDA(At, 1, 1); PG8_STAGE(PG8_SB(1, 0), b3, voffB); PG8_STAGE(PG8_SB(1, 1), b3 + hstep, voffB); PG8_STAGE(PG8_SA(1, 0), a3, voffA);
            PG8_WAIT_V(8); PG8_WAIT_L(0); PG8_BAR; PG8_MMA(1, 0, At, B0); PG8_MMA(1, 1, At, B1); PG8_BAR; PG8_SCHED;
            } else {
            PG8_LDB(B0, 0, 0); PG8_SCHED; PG8_LDA(At, 0, 0); PG8_STAGE(PG8_SA(1, 1), a1 + hstep, voffA);
            PG8_WAIT_L(8); PG8_BAR; PG8_WAIT_L(0); PG8_MMA(0, 0, At, B0); PG8_BAR; PG8_SCHED;
            PG8_LDB(B1, 0, 1); PG8_STAGE(PG8_SB(0, 0), b2, voffB);
            PG8_BAR; PG8_WAIT_L(0); PG8_MMA(0, 1, At, B1); PG8_BAR;
            PG8_LDA(At, 0, 1); PG8_STAGE(PG8_SA(0, 0), a2, voffA);
            PG8_BAR; PG8_WAIT_L(0); PG8_MMA(1, 0, At, B0); PG8_BAR; PG8_SCHED;
            PG8_STAGE(PG8_SB(0, 1), b2 + hstep, voffB);
            PG8_WAIT_V(6); PG8_BAR; PG8_MMA(1, 1, At, B1); PG8_BAR;
            PG8_LDB(B0, 1, 0); PG8_SCHED; PG8_LDA(At, 1, 0); PG8_STAGE(PG8_SA(0, 1), a2 + hstep, voffA);
            PG8_WAIT_L(8); PG8_BAR; PG8_WAIT_L(0); PG8_MMA(0, 0, At, B0); PG8_BAR; PG8_SCHED;
            PG8_LDB(B1, 1, 1); PG8_STAGE(PG8_SB(1, 0), b3, voffB);
            PG8_BAR; PG8_WAIT_L(0); PG8_MMA(0, 1, At, B1); PG8_BAR;
            PG8_LDA(At, 1, 1); PG8_STAGE(PG8_SA(1, 0), a3, voffA);
            PG8_BAR; PG8_WAIT_L(0); PG8_MMA(1, 0, At, B0); PG8_BAR; PG8_SCHED;
            PG8_STAGE(PG8_SB(1, 1), b3 + hstep, voffB);
            PG8_WAIT_V(6); PG8_BAR; PG8_MMA(1, 1, At, B1); PG8_BAR;
            }
        }
        if constexpr (ALIGN_EPI) { if (wr == 0) PG8_BAR; }
        int fr2 = fr, fq2 = fq, tid2 = tid; asm volatile("" : "+v"(fr2), "+v"(fq2), "+v"(tid2));
        if constexpr (Sched::STREAMK) {
            if (cur.mode == 1) {
                unsigned char* pp = S.part + (size_t)S.r * 131072 + (size_t)tid2 * 16;
#pragma unroll
                for (int a = 0; a < 2; ++a)
#pragma unroll
                    for (int b = 0; b < 2; ++b)
#pragma unroll
                        for (int m = 0; m < 4; ++m) { u32x4 w; w.x = pk2(acc[a][b][m][0][0], acc[a][b][m][0][1]); w.y = pk2(acc[a][b][m][0][2], acc[a][b][m][0][3]); w.z = pk2(acc[a][b][m][1][0], acc[a][b][m][1][1]); w.w = pk2(acc[a][b][m][1][2], acc[a][b][m][1][3]);
                            asm volatile("global_store_dwordx4 %0, %1, off sc0 sc1" :: "v"(pp + ((a * 2 + b) * 4 + m) * 8192), "v"(w) : "memory"); }
                asm volatile("s_waitcnt vmcnt(0)" ::: "memory");
                if (lane == 0) __hip_atomic_fetch_add(S.flags + 16 * S.r, 1u, __ATOMIC_RELAXED, __HIP_MEMORY_SCOPE_AGENT);
            } else {
                const bool tail = cur.mode == 2;
                if (tail) {
                    unsigned sp = 0;
                    while ((unsigned)__builtin_amdgcn_readfirstlane(__hip_atomic_load(S.flags + 16 * (S.r - 1), __ATOMIC_RELAXED, __HIP_MEMORY_SCOPE_AGENT)) < 8u) { __builtin_amdgcn_s_sleep(2); if (++sp > (1u << 22)) break; }
                }
                const unsigned char* pp = tail ? S.part + (size_t)(S.r - 1) * 131072 + (size_t)tid2 * 16 : nullptr;
                E(acc, cur, wr, wc, fr2, fq2, pp);
            }
        } else
        if constexpr (Epi::RSTAB) { E(acc, cur, wr, wc, fr2, fq2, (const PG8_LAS float*)(lds + STAGE_BYTES + 1024) + (ui & 1) * 256); } else
        if constexpr (!Epi::AFTER_DRAIN) { E(acc, cur, wr, wc, fr2, fq2); S.done(cur); }
        if (!has_next) break;
#pragma unroll
        for (int a = 0; a < 2; ++a)
#pragma unroll
            for (int b = 0; b < 2; ++b)
#pragma unroll
                for (int m = 0; m < 4; ++m)
#pragma unroll
                    for (int n = 0; n < 2; ++n) acc[a][b][m][n] = (f32x4){0.f, 0.f, 0.f, 0.f};
        cur = nxt; cA = nA; cB = nB; ++ui;
        if constexpr (Epi::RSTAB) E.prefetch(cur, (PG8_LAS float*)(lds + STAGE_BYTES + 1024) + (ui & 1) * 256, tid2);
        if constexpr (ALIGN_EPI) { if (wr == 1) PG8_BAR; }
    }
    PG8_WAIT_V(0);
    if constexpr (!ALIGN_EPI) { if (wr == 0) PG8_BAR; }
    PG8_BAR;
    if constexpr (Epi::AFTER_DRAIN) { E.fused(acc, cur, wr, wc, fr, fq, lds, wid, lane); S.done(cur); }
#undef PG8_SA
#undef PG8_SB
#undef PG8_STAGE
#undef PG8_LDA
#undef PG8_LDB
#undef PG8_MMA
#undef PG8_WAIT_V
#undef PG8_WAIT_L
#undef PG8_BAR
#undef PG8_SCHED
}
}

constexpr size_t SZ_WIN = (size_t)NIN * DM * 2, SZ_WO = (size_t)DM * DM * 2, SZ_WGU = (size_t)NGU * DM * 2, SZ_WD = (size_t)DM * DFFN * 2, SZ_WL = SZ_WIN + SZ_WO + SZ_WGU + SZ_WD;
constexpr size_t WS_CTL = 0;
constexpr size_t WS_FLAGS = 16384;
constexpr size_t WS_ZERO = 16384 + 4 * 256 * 64;
constexpr size_t WS_CTR = WS_ZERO + 256;
constexpr size_t WS_W = WS_CTR + 4 * 64;
constexpr size_t WS_XB = WS_W + DEPTH * SZ_WL;
constexpr size_t WS_MRG = WS_XB + (size_t)MP * DM * 2;
constexpr size_t WS_Z = WS_MRG + (size_t)MP * DM * 2;
constexpr size_t WS_LD = WS_Z + (size_t)MP * ZP * 2;
constexpr size_t WS_U = WS_Z;
constexpr size_t WS_DS = WS_LD + (size_t)MP * 256 * 4;
constexpr size_t WS_SC = WS_DS + (size_t)16 * NCH * 64 * 128 * 4;
constexpr size_t WS_GL = WS_SC + (size_t)16 * NCH * 64 * 128 * 2;
constexpr size_t WS_SSQA = WS_GL + (size_t)16 * NCH * 64 * 4;
constexpr size_t WS_SSQB = WS_SSQA + (size_t)MP * 16 * 4;
constexpr size_t WS_XMETA = WS_SSQB + (size_t)MP * 16 * 4;
constexpr size_t WS_END = WS_XMETA + (size_t)64 * DM * 4;
static_assert((size_t)MP * DFFN * 2 <= (size_t)MP * ZP * 2 + (size_t)MP * 256 * 4, "U overlay fits Z|LD");
static_assert(WS_END <= 268435456ull, "workspace map fits 256 MiB");

#ifndef REP_PRO
#define REP_PRO 1
#endif
#ifndef REP_WIN
#define REP_WIN 1
#endif
#ifndef REP_MB
#define REP_MB 1
#endif
#ifndef REP_SCAN
#define REP_SCAN 1
#endif
#ifndef REP_GU
#define REP_GU 1
#endif
#ifndef REP_G1
#define REP_G1 1
#endif
#ifndef REP_AS
#define REP_AS 1
#endif
#ifndef REP_GS
#define REP_GS 1
#endif
#ifndef REP_G3
#define REP_G3 1
#endif
#ifndef REP_AP
#define REP_AP 1
#endif
#ifndef REP_WO0
#define REP_WO0 1
#endif
#ifndef DRY_WO
#define DRY_WO 0
#endif
#ifndef DRY_DN
#define DRY_DN 0
#endif
#ifndef TIME_PH
#define TIME_PH -1
#endif
#ifndef TIME_MULT
#define TIME_MULT 4
#endif
#ifndef TIME_BUSY
#define TIME_BUSY 0
#endif
#ifndef TIME_SUB
#define TIME_SUB -1
#endif
#ifndef XSYNC
#define XSYNC 0
#endif
constexpr int LDS_BYTES = 147456;
constexpr int NPHASE = 1 + 7 * DEPTH;

struct Args { const float* in[19]; float* out; unsigned char* ws; int ph_lo, ph_hi; };
typedef const __attribute__((address_space(4))) Args* KA;
DI KA ka_ptr() { KA p = (KA)__builtin_amdgcn_kernarg_segment_ptr(); asm volatile("" : "+s"(p)); return p; }

DI int mk_tid(int wave_s) { int lane; asm volatile("v_mbcnt_lo_u32_b32 %0, -1, 0\n\tv_mbcnt_hi_u32_b32 %0, -1, %0" : "=v"(lane)); return wave_s * 64 + lane; }
typedef short v4i16_t __attribute__((ext_vector_type(4)));
DI u32x2 tr4(const LAS unsigned char* p) { return __builtin_bit_cast(u32x2, __builtin_amdgcn_ds_read_tr16_b64_v4i16((LAS v4i16_t*)p)); }
#if TIME_SUB >= 0
#define TICK(id) do { if (blockIdx.x == 0 && tid == 0) { volatile LAS unsigned* M_ = (volatile LAS unsigned*)(lds + 131072 + 320); const unsigned now_ = (unsigned)__builtin_amdgcn_s_memrealtime(); M_[100 + (id)] += now_ - M_[99]; M_[99] = now_; } } while (0)
#else
#define TICK(id) do {} while (0)
#endif
DI bf16x8 mk8(u32x2 lo, u32x2 hi) { u32x4 w; w.x = lo.x; w.y = lo.y; w.z = hi.x; w.w = hi.y; return __builtin_bit_cast(bf16x8, w); }
#define MFMA16(a, b, c) __builtin_amdgcn_mfma_f32_16x16x32_bf16((a), (b), (c), 0, 0, 0)

DI void attn_wave(const LAS unsigned char* Ks, const LAS unsigned char* Vt, const int VPB, const u32x4 qa, const u32x4 qb, const float* qnw, const float sink2, const int jmin, const int c, const int fq, bf16_t* orow) {
    float qf[16]; unpack8(qa, qf); unpack8(qb, qf + 8);
    float ss = 0.f;
#pragma unroll
    for (int i = 0; i < 16; ++i) ss += qf[i] * qf[i];
    ss = red4rows(ss);
    const float rs = rsqrtf(ss * (1.0f / 64.0f) + EPS) * (0.125f * LOG2E);
    const f32x4 w0 = *(const f32x4*)(qnw + 8 * fq), w1 = *(const f32x4*)(qnw + 8 * fq + 4), w2 = *(const f32x4*)(qnw + 32 + 8 * fq), w3 = *(const f32x4*)(qnw + 36 + 8 * fq);
#pragma unroll
    for (int i = 0; i < 4; ++i) { qf[i] *= rs * w0[i]; qf[4 + i] *= rs * w1[i]; qf[8 + i] *= rs * w2[i]; qf[12 + i] *= rs * w3[i]; }
    u32x4 q0, q1; q0.x = pk2(qf[0], qf[1]); q0.y = pk2(qf[2], qf[3]); q0.z = pk2(qf[4], qf[5]); q0.w = pk2(qf[6], qf[7]);
    q1.x = pk2(qf[8], qf[9]); q1.y = pk2(qf[10], qf[11]); q1.z = pk2(qf[12], qf[13]); q1.w = pk2(qf[14], qf[15]);
    const bf16x8 qB0 = __builtin_bit_cast(bf16x8, q0), qB1 = __builtin_bit_cast(bf16x8, q1);
    f32x4 acc[9];
    float mx = sink2;
#pragma unroll
    for (int T = 0; T < 9; ++T) {
        const LAS unsigned char* kp = Ks + (16 * T + c) * 144 + 16 * fq;
        const bf16x8 a0 = *(const LAS bf16x8*)kp, a1 = *(const LAS bf16x8*)(kp + 64);
        f32x4 s = {0.f, 0.f, 0.f, 0.f};
        s = MFMA16(a0, qB0, s); s = MFMA16(a1, qB1, s);
#pragma unroll
        for (int r = 0; r < 4; ++r) { const int jrel = 16 * T + 4 * fq + r, d = 128 + c - jrel; const bool ok = ((unsigned)d < 128u) && (jrel >= jmin); s[r] = ok ? s[r] : -1e30f; mx = fmaxf(mx, s[r]); }
        acc[T] = s;
    }
    mx = max4rows(mx);
    float sum = 0.f;
#pragma unroll
    for (int T = 0; T < 9; ++T)
#pragma unroll
        for (int r = 0; r < 4; ++r) { const float p = __builtin_amdgcn_exp2f(acc[T][r] - mx); acc[T][r] = p; sum += p; }
    sum = red4rows(sum);
    const float inv = 1.0f / (sum + __builtin_amdgcn_exp2f(sink2 - mx));
    f32x4 o[4];
#pragma unroll
    for (int i = 0; i < 4; ++i) o[i] = (f32x4){0.f, 0.f, 0.f, 0.f};
#pragma unroll
    for (int kk = 0; kk < 5; ++kk) {
        u32x4 pw; pw.x = pk2(acc[2 * kk][0], acc[2 * kk][1]); pw.y = pk2(acc[2 * kk][2], acc[2 * kk][3]);
        if (kk < 4) { pw.z = pk2(acc[2 * kk + 1][0], acc[2 * kk + 1][1]); pw.w = pk2(acc[2 * kk + 1][2], acc[2 * kk + 1][3]); } else { pw.z = 0u; pw.w = 0u; }
        const bf16x8 pB = __builtin_bit_cast(bf16x8, pw);
#pragma unroll
        for (int Mt = 0; Mt < 4; ++Mt) {
            const LAS unsigned char* vp = Vt + (32 * kk + 4 * fq + (c >> 2)) * VPB + (16 * Mt + 4 * (c & 3)) * 2;
            const u32x2 lo = tr4(vp), hi = tr4(vp + 16 * VPB);
            o[Mt] = MFMA16(mk8(lo, hi), pB, o[Mt]);
        }
    }
    if (orow) {
#pragma unroll
        for (int Mt = 0; Mt < 4; ++Mt) { u32x2 w; w.x = pk2(o[Mt][0] * inv, o[Mt][1] * inv); w.y = pk2(o[Mt][2] * inv, o[Mt][3] * inv); *(u32x2*)(orow + 16 * Mt + 4 * fq) = w; }
    }
}

struct Ctx {
    int l;
    const bf16_t* Z; float* LD; bf16_t* MRG; float* DS; bf16_t* SC; float* GL;
    const float *qnw, *knw, *sinks, *gnw;
    const float *cache_k, *cache_v, *state;
    float* out;
};

DI void attn_prompt_unit(const Ctx& C, int uidx, LAS unsigned char* lds, const int wave_s) {
    const int tid = mk_tid(wave_s);
    const int jb = uidx % 65, g = (uidx / 65) & 1, b = uidx / 130;
    const int p0 = 64 * jb, kbase = p0 - 128, rowbase = b * LP, nq = (LP - p0) < 64 ? (LP - p0) : 64;
    LAS unsigned char* Ks = lds; LAS unsigned char* Vs = lds + 208 * 144;
    TICK(0);
    {
        const int dc = tid & 7;
        u32x4 rk[4], rv[4];
#pragma unroll
        for (int i = 0; i < 4; ++i) { const int j = (tid >> 3) + 64 * i, kp = kbase + j; const bool valid = (j < 192) && (kp >= 0) && (kp < LP);
            rk[i] = (u32x4){0u, 0u, 0u, 0u}; rv[i] = rk[i];
            if (valid) { const bf16_t* zr = C.Z + (size_t)(rowbase + kp) * ZP + g * 64 + dc * 8; rk[i] = *(const u32x4*)(zr + ZK); rv[i] = *(const u32x4*)(zr + ZV); } }
        const f32x4 kw0 = *(const f32x4*)(C.knw + dc * 8), kw1 = *(const f32x4*)(C.knw + dc * 8 + 4);
#pragma unroll
        for (int i = 0; i < 4; ++i) { const int j = (tid >> 3) + 64 * i, kp = kbase + j; const bool valid = (j < 192) && (kp >= 0) && (kp < LP);
            float f[8]; unpack8(rk[i], f); float ss = 0.f;
#pragma unroll
            for (int e = 0; e < 8; ++e) ss += f[e] * f[e];
            ss = sum8(ss);
            const float rs = rsqrtf(ss * (1.0f / 64.0f) + EPS);
#pragma unroll
            for (int e = 0; e < 4; ++e) { f[e] *= rs * kw0[e]; f[4 + e] *= rs * kw1[e]; }
            if (j < 208) { u32x4 o; o.x = pk2(f[0], f[1]); o.y = pk2(f[2], f[3]); o.z = pk2(f[4], f[5]); o.w = pk2(f[6], f[7]); *(LAS u32x4*)(Ks + j * 144 + dc * 16) = o; *(LAS u32x4*)(Vs + j * 144 + dc * 16) = rv[i]; }
            if (valid && j >= 128 && kp >= LP - 128) { const size_t oo = ((size_t)((C.l * NBATCH + b) * 128 + (kp - (LP - 128))) * 2 + g) * 64 + dc * 8;
                float* op = C.out + O_CKP + oo; *(f32x4*)op = (f32x4){f[0], f[1], f[2], f[3]}; *(f32x4*)(op + 4) = (f32x4){f[4], f[5], f[6], f[7]};
                float fv[8]; unpack8(rv[i], fv); float* ov = C.out + O_CVP + oo; *(f32x4*)ov = (f32x4){fv[0], fv[1], fv[2], fv[3]}; *(f32x4*)(ov + 4) = (f32x4){fv[4], fv[5], fv[6], fv[7]}; } }
    }
    __syncthreads();
    TICK(4);
    {
        const int tid2 = mk_tid(wave_s), lane = tid2 & 63, w = tid2 >> 6;
        const int s = w & 3, hp = w >> 2, c = lane & 15, fq = lane >> 4;
        if (16 * s < nq) {
            const int qp = p0 + 16 * s + c; const bool qv = qp < LP; const int h0 = g * 4 + hp * 2;
            u32x4 qr[2][2];
#pragma unroll
            for (int hh = 0; hh < 2; ++hh) { qr[hh][0] = (u32x4){0u, 0u, 0u, 0u}; qr[hh][1] = qr[hh][0];
                if (qv) { const bf16_t* qrow = C.Z + (size_t)(rowbase + qp) * ZP + ZQ + (h0 + hh) * 64; qr[hh][0] = *(const u32x4*)(qrow + 8 * fq); qr[hh][1] = *(const u32x4*)(qrow + 32 + 8 * fq); } }
#pragma unroll
            for (int hh = 0; hh < 2; ++hh) { const int h = h0 + hh;
                bf16_t* orow = qv ? C.MRG + (size_t)(rowbase + qp) * DM + h * 64 : nullptr;
                attn_wave(Ks + 16 * s * 144, Vs + 16 * s * 144, 144, qr[hh][0], qr[hh][1], C.qnw, C.sinks[h] * LOG2E, 128 - p0 - 16 * s, c, fq, orow); }
        }
    }
    __syncthreads();
    TICK(5);
}

DI void attn_sample_unit(const Ctx& C, int uidx, LAS unsigned char* lds, const int wave_s) {
    const int tid = mk_tid(wave_s);
    const int g = uidx & 1, b = uidx >> 1;
    constexpr int KSG = 160 * 144;
    TICK(0);
    const int row0 = MPROMPT + b * DECT;
    const size_t cbase = (size_t)(C.l * DECB + b) * 128;
#pragma unroll
    for (int i = 0; i < 2; ++i) {
        const int idx = tid + 512 * i, dc = idx & 7, j = idx >> 3;
        const size_t so = ((cbase + j) * 2 + g) * 64 + dc * 8;
        const f32x4 a = __builtin_nontemporal_load((const f32x4*)(C.cache_k + so)), bq = __builtin_nontemporal_load((const f32x4*)(C.cache_k + so + 4)), va = __builtin_nontemporal_load((const f32x4*)(C.cache_v + so)), vb = __builtin_nontemporal_load((const f32x4*)(C.cache_v + so + 4));
        u32x4 o; o.x = pk2(a[0], a[1]); o.y = pk2(a[2], a[3]); o.z = pk2(bq[0], bq[1]); o.w = pk2(bq[2], bq[3]);
        *(LAS u32x4*)(lds + j * 144 + dc * 16) = o;
        u32x4 ov; ov.x = pk2(va[0], va[1]); ov.y = pk2(va[2], va[3]); ov.z = pk2(vb[0], vb[1]); ov.w = pk2(vb[2], vb[3]);
        *(LAS u32x4*)(lds + KSG + j * 144 + dc * 16) = ov;
        if (j >= 8) { const size_t oo = ((cbase + j - 8) * 2 + g) * 64 + dc * 8; float* op = C.out + O_CKS + oo; __builtin_nontemporal_store(a, (f32x4*)op); __builtin_nontemporal_store(bq, (f32x4*)(op + 4)); float* opv = C.out + O_CVS + oo; __builtin_nontemporal_store(va, (f32x4*)opv); __builtin_nontemporal_store(vb, (f32x4*)(opv + 4)); }
    }
    if (tid < 64) {
        const int dc = tid & 7, t = tid >> 3;
        const bf16_t* zr = C.Z + (size_t)(row0 + t) * ZP + g * 64 + dc * 8;
        const u32x4 raw = *(const u32x4*)(zr + ZK), rawv = *(const u32x4*)(zr + ZV);
        float f[8]; unpack8(raw, f); float ss = 0.f;
#pragma unroll
        for (int e = 0; e < 8; ++e) ss += f[e] * f[e];
        ss = sum8(ss);
        const float rs = rsqrtf(ss * (1.0f / 64.0f) + EPS);
        const f32x4 kw0 = *(const f32x4*)(C.knw + dc * 8), kw1 = *(const f32x4*)(C.knw + dc * 8 + 4);
#pragma unroll
        for (int e = 0; e < 4; ++e) { f[e] *= rs * kw0[e]; f[4 + e] *= rs * kw1[e]; }
        u32x4 o; o.x = pk2(f[0], f[1]); o.y = pk2(f[2], f[3]); o.z = pk2(f[4], f[5]); o.w = pk2(f[6], f[7]);
        *(LAS u32x4*)(lds + (128 + t) * 144 + dc * 16) = o;
        *(LAS u32x4*)(lds + KSG + (128 + t) * 144 + dc * 16) = rawv;
        const size_t oo = ((cbase + 120 + t) * 2 + g) * 64 + dc * 8;
        float* op = C.out + O_CKS + oo; *(f32x4*)op = (f32x4){f[0], f[1], f[2], f[3]}; *(f32x4*)(op + 4) = (f32x4){f[4], f[5], f[6], f[7]};
        float fv[8]; unpack8(rawv, fv); float* opv = C.out + O_CVS + oo; *(f32x4*)opv = (f32x4){fv[0], fv[1], fv[2], fv[3]}; *(f32x4*)(opv + 4) = (f32x4){fv[4], fv[5], fv[6], fv[7]};
    } else if (tid < 256) {
        const int idx = tid - 64, dc = idx & 7, r = idx >> 3;
        unsigned z0 = 0u; asm volatile("" : "+v"(z0));
        *(LAS u32x4*)(lds + (136 + r) * 144 + dc * 16) = (u32x4){z0, z0, z0, z0};
        *(LAS u32x4*)(lds + KSG + (136 + r) * 144 + dc * 16) = (u32x4){z0, z0, z0, z0};
    }
    __syncthreads();
    {
        const int tid2 = mk_tid(wave_s), lane = tid2 & 63, w2 = tid2 >> 6;
        if (w2 < 4) {
            const int h = g * 4 + w2, c = lane & 15, fq = lane >> 4;
            const bool qv = c < 8;
            const bf16_t* qrow = C.Z + (size_t)(row0 + (c & 7)) * ZP + ZQ + h * 64;
            const u32x4 qa = *(const u32x4*)(qrow + 8 * fq), qb = *(const u32x4*)(qrow + 32 + 8 * fq);
            bf16_t* orow = qv ? C.MRG + (size_t)(row0 + c) * DM + h * 64 : nullptr;
            attn_wave(lds, lds + KSG, 144, qa, qb, C.qnw, C.sinks[h] * LOG2E, 0, c, fq, orow);
        }
    }
    __syncthreads();
    TICK(8);
}

DI void gla_sample_unit(const Ctx& C, int uidx, LAS unsigned char* lds, const int wave_s) {
    const int tid = mk_tid(wave_s);
    const int h = uidx & 3, b = uidx >> 2, row0 = MPROMPT + b * DECT;
    TICK(0);
    LAS float* qs = (LAS float*)lds; LAS float* ks = qs + 512; LAS float* dec = ks + 512; LAS float* vs = dec + 512; LAS float* red = vs + 1024;
    {
        const int t = tid >> 6, k = tid & 63; const bf16_t* zr = C.Z + (size_t)(row0 + t) * ZP;
        qs[tid] = bf2f(zr[ZGQ + h * 64 + k]); ks[tid] = bf2f(zr[ZGK + h * 64 + k]); dec[tid] = __expf(C.LD[(size_t)(row0 + t) * 256 + h * 64 + k]);
#pragma unroll
        for (int i = 0; i < 2; ++i) { const int idx = tid + 512 * i, tt = idx >> 7, v = idx & 127; vs[idx] = bf2f(C.Z[(size_t)(row0 + tt) * ZP + ZGV + h * 128 + v]); }
    }
    const int v = tid & 127, kq = tid >> 7;
    const size_t sbase = ((size_t)((C.l * DECB + b) * 4 + h) * 64 + 16 * kq) * 128 + v;
    float S[16];
#pragma unroll
    for (int i = 0; i < 16; ++i) S[i] = __builtin_nontemporal_load(C.state + sbase + (size_t)i * 128);
    __syncthreads();
#pragma unroll
    for (int t = 0; t < 8; ++t) { float a = 0.f; const float vv = vs[t * 128 + v];
#pragma unroll
        for (int i = 0; i < 16; ++i) { const int k = 16 * kq + i; S[i] = dec[t * 64 + k] * S[i] + ks[t * 64 + k] * vv; a += qs[t * 64 + k] * S[i]; }
        red[(kq * 8 + t) * 128 + v] = a; }
    float* so = C.out + O_SS + sbase;
#pragma unroll
    for (int i = 0; i < 16; ++i) __builtin_nontemporal_store(S[i], so + (size_t)i * 128);
    __syncthreads();
    {
        const int t = tid >> 6, lane = tid & 63; float o[2]; float ss = 0.f;
#pragma unroll
        for (int i = 0; i < 2; ++i) { const int vv = lane + 64 * i; o[i] = (red[(0 * 8 + t) * 128 + vv] + red[(1 * 8 + t) * 128 + vv]) + (red[(2 * 8 + t) * 128 + vv] + red[(3 * 8 + t) * 128 + vv]); ss += o[i] * o[i]; }
        ss = sum64(ss);
        const float rs = rsqrtf(ss * (1.0f / 128.0f) + EPS);
#pragma unroll
        for (int i = 0; i < 2; ++i) { const int vv = lane + 64 * i; const float og = bf2f(C.Z[(size_t)(row0 + t) * ZP + ZOG + h * 128 + vv]);
            const float y = o[i] * rs * C.gnw[vv] * silu_f(og); C.MRG[(size_t)(row0 + t) * DM + 512 + h * 128 + vv] = (bf16_t)(pk2(y, 0.f) & 0xffffu); }
    }
    __syncthreads();
    TICK(9);
}

DI void gla_prefix_load(const float* LD, int r0, int nv, int h, int lane, int w, float (&g)[16]) {
#pragma unroll
    for (int i = 0; i < 16; ++i) { const int t = 16 * w + i; g[i] = t < nv ? LD[(size_t)(r0 + t) * 256 + h * 64 + lane] : 0.f; }
}
DI float gla_prefix_finish(float (&g)[16], LAS float* Gs, LAS float* segtot, int lane, int w) {
    const int k = lane, seg = w;
#pragma unroll
    for (int i = 1; i < 16; ++i) g[i] += g[i - 1];
    segtot[seg * 64 + k] = g[15];
    __syncthreads();
    float off = 0.f, tot = 0.f;
#pragma unroll
    for (int s = 0; s < 8; ++s) { const float x = segtot[s * 64 + k]; off += (s < seg) ? x : 0.f; tot += x; }
#pragma unroll
    for (int i = 0; i < 16; ++i) { const int t = 16 * seg + i; Gs[t * 65 + k] = g[i] + off; }
    return tot;
}

DI void gla1_unit(const Ctx& C, int unit, LAS unsigned char* lds, const int wave_s) {
    const int tid = mk_tid(wave_s);
    const int c = unit % NCH, bh = unit / NCH, h = bh & 3, b = bh >> 2;
    const int r0 = b * LP + 128 * c, nv = (LP - 128 * c) < 128 ? (LP - 128 * c) : 128;
    LAS float* Gs = (LAS float*)lds; LAS float* segtot = (LAS float*)(lds + 33280); LAS float* gl = (LAS float*)(lds + 35328);
    LAS unsigned char* kdS = lds + 35840; LAS unsigned char* Vs = lds + 54272;
    const int lane = tid & 63, w = tid >> 6;
    TICK(0);
    float g[16]; gla_prefix_load(C.LD, r0, nv, h, lane, w, g);
    u32x4 rk[2], rv[4];
#pragma unroll
    for (int i = 0; i < 2; ++i) { const int t = (tid >> 3) + 64 * i; rk[i] = (u32x4){0u, 0u, 0u, 0u}; if (t < nv) rk[i] = *(const u32x4*)(C.Z + (size_t)(r0 + t) * ZP + ZGK + h * 64 + (tid & 7) * 8); }
#pragma unroll
    for (int i = 0; i < 4; ++i) { const int t = (tid >> 4) + 32 * i; rv[i] = (u32x4){0u, 0u, 0u, 0u}; if (t < nv) rv[i] = *(const u32x4*)(C.Z + (size_t)(r0 + t) * ZP + ZGV + h * 128 + (tid & 15) * 8); }
    { const float tot = gla_prefix_finish(g, Gs, segtot, lane, w); if (w == 0) { gl[lane] = tot; C.GL[(size_t)unit * 64 + lane] = tot; } }
#pragma unroll
    for (int i = 0; i < 4; ++i) { const int t = (tid >> 4) + 32 * i; *(LAS u32x4*)(Vs + t * 272 + (tid & 15) * 16) = rv[i]; }
    __syncthreads();
    {
        const int kc = tid & 7;
#pragma unroll
        for (int i = 0; i < 2; ++i) { const int t = (tid >> 3) + 64 * i; float f[8]; unpack8(rk[i], f);
#pragma unroll
            for (int e = 0; e < 8; ++e) f[e] *= __expf(gl[kc * 8 + e] - Gs[t * 65 + kc * 8 + e]);
            u32x4 o; o.x = pk2(f[0], f[1]); o.y = pk2(f[2], f[3]); o.z = pk2(f[4], f[5]); o.w = pk2(f[6], f[7]); *(LAS u32x4*)(kdS + t * 144 + kc * 16) = o; }
    }
    __syncthreads();
    {
        const int cc = lane & 15, fq = lane >> 4;
#pragma unroll
        for (int kt = 0; kt < 4; ++kt) { f32x4 acc = {0.f, 0.f, 0.f, 0.f};
#pragma unroll
            for (int ks = 0; ks < 4; ++ks) {
                const LAS unsigned char* ap = kdS + (32 * ks + 8 * fq + (cc >> 2)) * 144 + (16 * kt + 4 * (cc & 3)) * 2;
                const LAS unsigned char* bp = Vs + (32 * ks + 8 * fq + (cc >> 2)) * 272 + (16 * w + 4 * (cc & 3)) * 2;
                acc = MFMA16(mk8(tr4(ap), tr4(ap + 4 * 144)), mk8(tr4(bp), tr4(bp + 4 * 272)), acc); }
#pragma unroll
            for (int r = 0; r < 4; ++r) C.DS[((size_t)unit * 64 + 16 * kt + 4 * fq + r) * 128 + 16 * w + cc] = acc[r]; }
    }
    __syncthreads();
    TICK(6);
}

DI void gla3_unit(const Ctx& C, int unit, LAS unsigned char* lds, const int wave_s) {
    const int tid = mk_tid(wave_s);
    const int c = unit % NCH, bh = unit / NCH, h = bh & 3, b = bh >> 2;
    const int r0 = b * LP + 128 * c, nv = (LP - 128 * c) < 128 ? (LP - 128 * c) : 128;
    LAS unsigned char* qg = lds; LAS unsigned char* kg = lds + 18432; LAS unsigned char* Vs = lds + 36864; LAS unsigned char* Ss = lds + 71680;
    LAS float* Gs = (LAS float*)(lds + 89088); LAS float* segtot = (LAS float*)(lds + 122368);
    const int lane = tid & 63, w = __builtin_amdgcn_readfirstlane(tid >> 6);
    TICK(0);
    float g[16]; gla_prefix_load(C.LD, r0, nv, h, lane, w, g);
    u32x4 rq[2], rk[2], rv[4], rs_[2];
#pragma unroll
    for (int i = 0; i < 2; ++i) { const int t = (tid >> 3) + 64 * i; rq[i] = (u32x4){0u, 0u, 0u, 0u}; rk[i] = rq[i];
        if (t < nv) { const bf16_t* zr = C.Z + (size_t)(r0 + t) * ZP + h * 64 + (tid & 7) * 8; rq[i] = *(const u32x4*)(zr + ZGQ); rk[i] = *(const u32x4*)(zr + ZGK); } }
#pragma unroll
    for (int i = 0; i < 4; ++i) { const int t = (tid >> 4) + 32 * i; rv[i] = (u32x4){0u, 0u, 0u, 0u}; if (t < nv) rv[i] = *(const u32x4*)(C.Z + (size_t)(r0 + t) * ZP + ZGV + h * 128 + (tid & 15) * 8); }
#pragma unroll
    for (int i = 0; i < 2; ++i) { const int k = (tid >> 4) + 32 * i; rs_[i] = *(const u32x4*)(C.SC + ((size_t)unit * 64 + k) * 128 + (tid & 15) * 8); }
    (void)gla_prefix_finish(g, Gs, segtot, lane, w);
#pragma unroll
    for (int i = 0; i < 4; ++i) { const int t = (tid >> 4) + 32 * i; *(LAS u32x4*)(Vs + t * 272 + (tid & 15) * 16) = rv[i]; }
#pragma unroll
    for (int i = 0; i < 2; ++i) { const int k = (tid >> 4) + 32 * i; *(LAS u32x4*)(Ss + k * 272 + (tid & 15) * 16) = rs_[i]; }
    __syncthreads();
    TICK(1);
    {
        const int kc = tid & 7;
#pragma unroll
        for (int i = 0; i < 2; ++i) { const int t = (tid >> 3) + 64 * i; float fq_[8], fk_[8]; unpack8(rq[i], fq_); unpack8(rk[i], fk_);
#pragma unroll
            for (int e = 0; e < 8; ++e) { const float ev = __expf(Gs[t * 65 + kc * 8 + e]); fq_[e] *= ev; fk_[e] *= __builtin_amdgcn_rcpf(ev); }
            u32x4 oq, ok; oq.x = pk2(fq_[0], fq_[1]); oq.y = pk2(fq_[2], fq_[3]); oq.z = pk2(fq_[4], fq_[5]); oq.w = pk2(fq_[6], fq_[7]);
            ok.x = pk2(fk_[0], fk_[1]); ok.y = pk2(fk_[2], fk_[3]); ok.z = pk2(fk_[4], fk_[5]); ok.w = pk2(fk_[6], fk_[7]);
            *(LAS u32x4*)(qg + t * 144 + kc * 16) = oq; *(LAS u32x4*)(kg + t * 144 + kc * 16) = ok; }
    }
    __syncthreads();
    TICK(2);
    {
        const int cc = lane & 15, fq = lane >> 4;
        const int t = 16 * w + cc; const size_t row = (size_t)(r0 + (t < nv ? t : 0));
        u32x2 og[8];
#pragma unroll
        for (int Mt = 0; Mt < 8; ++Mt) og[Mt] = *(const u32x2*)(C.Z + row * ZP + ZOG + h * 128 + 16 * Mt + 4 * fq);
        const bf16x8 qB0 = *(const LAS bf16x8*)(qg + (16 * w + cc) * 144 + 16 * fq), qB1 = *(const LAS bf16x8*)(qg + (16 * w + cc) * 144 + 64 + 16 * fq);
        f32x4 A[8];
#pragma unroll
        for (int T = 0; T < 8; ++T) { f32x4 sa = {0.f, 0.f, 0.f, 0.f};
            const LAS unsigned char* kp = kg + (16 * T + cc) * 144 + 16 * fq; const bf16x8 a0 = *(const LAS bf16x8*)kp, a1 = *(const LAS bf16x8*)(kp + 64);
            sa = MFMA16(a0, qB0, sa); sa = MFMA16(a1, qB1, sa);
#pragma unroll
            for (int r = 0; r < 4; ++r) sa[r] = (16 * T + 4 * fq + r > t) ? 0.f : sa[r];
            A[T] = sa; }
        bf16x8 P[4];
#pragma unroll
        for (int kk = 0; kk < 4; ++kk) { u32x4 pw; pw.x = pk2(A[2 * kk][0], A[2 * kk][1]); pw.y = pk2(A[2 * kk][2], A[2 * kk][3]); pw.z = pk2(A[2 * kk + 1][0], A[2 * kk + 1][1]); pw.w = pk2(A[2 * kk + 1][2], A[2 * kk + 1][3]); P[kk] = __builtin_bit_cast(bf16x8, pw); }
        f32x4 o[8]; float ss = 0.f;
#pragma unroll
        for (int Mt = 0; Mt < 8; ++Mt) o[Mt] = (f32x4){0.f, 0.f, 0.f, 0.f};
#pragma unroll
        for (int kk = 0; kk < 4; ++kk)
#pragma unroll
            for (int Mt = 0; Mt < 8; ++Mt) {
                const LAS unsigned char* vp = Vs + (32 * kk + 4 * fq + (cc >> 2)) * 272 + (16 * Mt + 4 * (cc & 3)) * 2;
                o[Mt] = MFMA16(mk8(tr4(vp), tr4(vp + 16 * 272)), P[kk], o[Mt]); }
#pragma unroll
        for (int ks = 0; ks < 2; ++ks)
#pragma unroll
            for (int Mt = 0; Mt < 8; ++Mt) {
                const LAS unsigned char* sp = Ss + (32 * ks + 8 * fq + (cc >> 2)) * 272 + (16 * Mt + 4 * (cc & 3)) * 2;
                o[Mt] = MFMA16(mk8(tr4(sp), tr4(sp + 4 * 272)), ks ? qB1 : qB0, o[Mt]); }
#pragma unroll
        for (int Mt = 0; Mt < 8; ++Mt) ss += (o[Mt][0] * o[Mt][0] + o[Mt][1] * o[Mt][1]) + (o[Mt][2] * o[Mt][2] + o[Mt][3] * o[Mt][3]);
        ss = red4rows(ss);
        const float rs = rsqrtf(ss * (1.0f / 128.0f) + EPS);
        if (t < nv) {
#pragma unroll
            for (int Mt = 0; Mt < 8; ++Mt) { const int v0 = 16 * Mt + 4 * fq; const f32x4 gn = *(const f32x4*)(C.gnw + v0);
                const float y0 = o[Mt][0] * rs * gn[0] * silu_f(bflo(og[Mt].x)), y1 = o[Mt][1] * rs * gn[1] * silu_f(bfhi(og[Mt].x)), y2 = o[Mt][2] * rs * gn[2] * silu_f(bflo(og[Mt].y)), y3 = o[Mt][3] * rs * gn[3] * silu_f(bfhi(og[Mt].y));
                u32x2 wv; wv.x = pk2(y0, y1); wv.y = pk2(y2, y3); *(u32x2*)(C.MRG + row * DM + 512 + h * 128 + v0) = wv; } }
    }
    __syncthreads();
    TICK(3);
}

DI void gla_scan(const Ctx& C, int gtid, int gthreads) {
    for (int idx = gtid; idx < 16 * 64 * 128; idx += gthreads) {
        const int v = idx & 127, k = (idx >> 7) & 63, bh = idx >> 13;
        const size_t u0 = (size_t)bh * NCH;
        float ds[NCH], dg[NCH];
#pragma unroll
        for (int c = 0; c < NCH; ++c) { ds[c] = C.DS[((u0 + c) * 64 + k) * 128 + v]; dg[c] = C.GL[(u0 + c) * 64 + k]; }
        float S = 0.f;
#pragma unroll
        for (int c = 0; c < NCH; ++c) { C.SC[((u0 + c) * 64 + k) * 128 + v] = (bf16_t)(pk2(S, 0.f) & 0xffffu); S = __expf(dg[c]) * S + ds[c]; }
        const int h = bh & 3, b = bh >> 2;
        C.out[O_SP + ((size_t)((C.l * NBATCH + b) * 4 + h) * 64 + k) * 128 + v] = S;
    }
}

struct WSrc { int mat; const float* W; const float* W2; const float* gain; const float* wg2; };
DI float wsrc(const WSrc& s, int k, int n) {
    if (s.mat == 0) {
        if (n < 2304) { const int col = n < 1792 ? n : n + 16; const float sc = (n >= 768 && n < 1024) ? 0.125f : 1.0f; return s.W[(size_t)k * INW + col] * s.gain[k] * sc; }
        const int e = n - 2304; float a = 0.f;
#pragma unroll
        for (int r = 0; r < 16; ++r) a += s.W[(size_t)k * INW + 1792 + r] * s.wg2[r * 256 + e];
        return a * s.gain[k];
    } else if (s.mat == 1) { return s.W[(size_t)k * DM + n];
    } else if (s.mat == 2) { const int pn = n >> 8, j = n & 255; return (j < 128 ? s.W[(size_t)k * DFFN + 128 * pn + j] : s.W2[(size_t)k * DFFN + 128 * pn + j - 128]) * s.gain[k];
    } else { return s.W[(size_t)k * DM + n]; }
}
DI f32x4 wsrc4(const WSrc& s, int k, int n) {
    if (s.mat == 0) { const int col = n < 1792 ? n : n + 16; const float sc = ((n >= 768 && n < 1024) ? 0.125f : 1.0f) * s.gain[k]; return *(const f32x4*)(s.W + (size_t)k * INW + col) * sc; }
    else if (s.mat == 1) return *(const f32x4*)(s.W + (size_t)k * DM + n);
    else if (s.mat == 2) { const int pn = n >> 8, j = n & 255; const float* src = j < 128 ? s.W + (size_t)k * DFFN + 128 * pn + j : s.W2 + (size_t)k * DFFN + 128 * pn + j - 128; return *(const f32x4*)src * s.gain[k]; }
    else return *(const f32x4*)(s.W + (size_t)k * DM + n);
}
DI void conv_item_lr(const WSrc& s, int K, bf16_t* WT, LAS float* scr, int item, int lane) {
    const int kb = item >> 3, nb = item & 7, k0 = 64 * kb, n0 = 2304 + 32 * nb;
    const int e = lane & 31; float g2[16];
#pragma unroll
    for (int r = 0; r < 16; ++r) g2[r] = s.wg2[r * 256 + 32 * nb + e];
#pragma unroll 8
    for (int i = 0; i < 32; ++i) { const int kk = 2 * i + (lane >> 5); const f32x4* wp = (const f32x4*)(s.W + (size_t)(k0 + kk) * INW + 1792);
        const f32x4 a = wp[0], b = wp[1], c4 = wp[2], d = wp[3];
        const float acc = ((a[0] * g2[0] + a[1] * g2[1]) + (a[2] * g2[2] + a[3] * g2[3])) + ((b[0] * g2[4] + b[1] * g2[5]) + (b[2] * g2[6] + b[3] * g2[7]))
                        + ((c4[0] * g2[8] + c4[1] * g2[9]) + (c4[2] * g2[10] + c4[3] * g2[11])) + ((d[0] * g2[12] + d[1] * g2[13]) + (d[2] * g2[14] + d[3] * g2[15]));
        scr[kk * 33 + e] = acc * s.gain[k0 + kk]; }
    asm volatile("s_waitcnt lgkmcnt(0)" ::: "memory");
    const int c = lane & 7;
#pragma unroll
    for (int j = 0; j < 4; ++j) { const int n = (lane >> 3) + 8 * j; const LAS float* sp = scr + (8 * c) * 33 + n;
        u32x4 o; o.x = pk2(sp[0 * 33], sp[1 * 33]); o.y = pk2(sp[2 * 33], sp[3 * 33]); o.z = pk2(sp[4 * 33], sp[5 * 33]); o.w = pk2(sp[6 * 33], sp[7 * 33]);
        *(u32x4*)(WT + (size_t)(n0 + n) * K + k0 + 8 * c) = o; }
    asm volatile("s_waitcnt lgkmcnt(0)" ::: "memory");
}
DI void conv_item(const WSrc& s, int K, int nblk, bf16_t* WT, LAS unsigned char* tile, int item, int lane) {
    const int kb = item / nblk, nb = item % nblk, k0 = 64 * kb, n0 = 64 * nb;
    const int krow = lane >> 4, n4 = (lane & 15) * 4;
    f32x4 v[16];
#pragma unroll
    for (int st = 0; st < 16; ++st) v[st] = wsrc4(s, k0 + 4 * st + krow, n0 + n4);
#pragma unroll
    for (int st = 0; st < 16; ++st) { u32x2 w; w.x = pk2(v[st][0], v[st][1]); w.y = pk2(v[st][2], v[st][3]); *(LAS u32x2*)(tile + (4 * st + krow) * 136 + n4 * 2) = w; }
    asm volatile("s_waitcnt lgkmcnt(0)" ::: "memory");
    const int i = lane & 15, fq = lane >> 4;
#pragma unroll
    for (int q = 0; q < 2; ++q)
#pragma unroll
        for (int nbk = 0; nbk < 4; ++nbk) { const int kg = 4 * q + fq;
            const LAS unsigned char* tp = tile + (8 * kg + (i >> 2)) * 136 + (16 * nbk + 4 * (i & 3)) * 2;
            const u32x2 lo = tr4(tp), hi = tr4(tp + 4 * 136);
            u32x4 o; o.x = lo.x; o.y = lo.y; o.z = hi.x; o.w = hi.y;
            *(u32x4*)(WT + (size_t)(n0 + 16 * nbk + i) * K + k0 + 8 * kg) = o; }
    asm volatile("s_waitcnt lgkmcnt(0)" ::: "memory");
}
constexpr int NI_IN = 16 * 36, NI_LR = 16 * 8, NI_O = 16 * 16, NI_GU = 16 * 88, NI_D = 44 * 16, NI_L = NI_IN + NI_LR + NI_O + NI_GU + NI_D;

DI void prologue(KA ap, const RowMap& rm, LAS unsigned char* lds, int tid, int vcu, int G) {
    const int lane = tid & 63, wave = tid >> 6, gw = vcu * 8 + wave, NGW = G * 8;
    LAS unsigned char* tile = lds + wave * 16384;
    for (int it = gw; it < DEPTH * NI_L; it += NGW) {
        const int l = it / NI_L; int r = it % NI_L;
        unsigned char* wl = ap->ws + WS_W + (size_t)l * SZ_WL;
        if (r < NI_IN) { WSrc s{0, ap->in[7] + (size_t)l * DM * INW, nullptr, ap->in[6] + l * DM, nullptr}; conv_item(s, DM, 36, (bf16_t*)wl, tile, r, lane); continue; } r -= NI_IN;
        if (r < NI_LR) { WSrc s{0, ap->in[7] + (size_t)l * DM * INW, nullptr, ap->in[6] + l * DM, ap->in[11] + l * 16 * 256}; conv_item_lr(s, DM, (bf16_t*)wl, (LAS float*)tile, r, lane); continue; } r -= NI_LR;
        if (r < NI_O) { WSrc s{1, ap->in[14] + (size_t)l * DM * DM, nullptr, nullptr, nullptr}; conv_item(s, DM, 16, (bf16_t*)(wl + SZ_WIN), tile, r, lane); continue; } r -= NI_O;
        if (r < NI_GU) { WSrc s{2, ap->in[16] + (size_t)l * DM * DFFN, ap->in[17] + (size_t)l * DM * DFFN, ap->in[15] + l * DM, nullptr}; conv_item(s, DM, 88, (bf16_t*)(wl + SZ_WIN + SZ_WO), tile, r, lane); continue; } r -= NI_GU;
        { WSrc s{3, ap->in[18] + (size_t)l * DFFN * DM, nullptr, nullptr, nullptr}; conv_item(s, DFFN, 16, (bf16_t*)(wl + SZ_WIN + SZ_WO + SZ_WGU), tile, r, lane); }
    }
    bf16_t* XB = (bf16_t*)(ap->ws + WS_XB); bf16_t* MRG = (bf16_t*)(ap->ws + WS_MRG); float* ssqA = (float*)(ap->ws + WS_SSQA);
    for (int m = gw; m < MP; m += NGW) {
        const float* ip = row_in(rm, m); f32x4 v[4]; float s = 0.f;
#pragma unroll
        for (int j = 0; j < 4; ++j) { v[j] = ip ? __builtin_nontemporal_load((const f32x4*)ip + lane + 64 * j) : (f32x4){0.f, 0.f, 0.f, 0.f}; s += (v[j][0] * v[j][0] + v[j][1] * v[j][1]) + (v[j][2] * v[j][2] + v[j][3] * v[j][3]); }
        s = sum64(s);
#pragma unroll
        for (int j = 0; j < 4; ++j) { u32x2 w; w.x = pk2(v[j][0], v[j][1]); w.y = pk2(v[j][2], v[j][3]); ((u32x2*)(XB + (size_t)m * DM))[lane + 64 * j] = w; if (!ip) ((u32x2*)(MRG + (size_t)m * DM))[lane + 64 * j] = (u32x2){0u, 0u}; }
        if (lane < 16) ssqA[(size_t)m * 16 + lane] = lane == 0 ? s : 0.f;
    }
}

#define XB_TMO      128
#define XB_XCNT(j)  (256  + 64 * (j))
#define XB_XSUB(j)  (1280 + 64 * (j))
#define XB_XGEN(j)  (2304 + 64 * (j))
#define XB_TOP      3328
#define XB_TOPGEN   3392
#define XCD_BAR_WORDS 3456
#define XB_SPIN_CAP (1u << 18)

__device__ __forceinline__ unsigned xb_ld(unsigned* p)              { return __hip_atomic_load(p, __ATOMIC_RELAXED, __HIP_MEMORY_SCOPE_AGENT); }
__device__ __forceinline__ unsigned xb_add(unsigned* p, unsigned v) { return __hip_atomic_fetch_add(p, v, __ATOMIC_RELAXED, __HIP_MEMORY_SCOPE_AGENT); }
__device__ __forceinline__ unsigned xb_xcc_id() { return (unsigned)__builtin_amdgcn_s_getreg((3 << 11) | 20) & 0xFu; }
#define XB_SPIN(cond, bar) do { unsigned _sp = 0; while (cond) { __builtin_amdgcn_s_sleep(1); \
    if ((++_sp & 255u) == 0u) { if (xb_ld(&(bar)[XB_TMO])) break; if (_sp > XB_SPIN_CAP) { atomicAdd(&(bar)[XB_TMO], 1u); break; } } } } while (0)

struct XcdBarrier {
    unsigned* bar; unsigned x;
    volatile LAS unsigned* st;
};

__device__ __forceinline__ XcdBarrier xcd_barrier_post(unsigned* bar, volatile LAS unsigned* st, const bool t0) {
    XcdBarrier b; b.bar = bar; b.x = xb_xcc_id(); b.st = st;
    if (t0) (void)xb_add(&bar[XB_XCNT(b.x)], 1u);
    return b;
}
__device__ __forceinline__ void xcd_barrier_complete(unsigned* bar, unsigned x, unsigned& nloc, unsigned& nx) {
    const unsigned G = gridDim.x * gridDim.y * gridDim.z;
    unsigned sum, cnt, mine, sp = 0u;
    for (;;) {
        sum = 0u; cnt = 0u; mine = 0u;
#pragma unroll
        for (unsigned j = 0; j < 16; ++j) { const unsigned c = xb_ld(&bar[XB_XCNT(j)]); sum += c; cnt += (c > 0u) ? 1u : 0u; mine = (j == x) ? c : mine; }
        if (sum == G) break;
        __builtin_amdgcn_s_sleep(1);
        if ((++sp & 255u) == 0u) { if (xb_ld(&bar[XB_TMO])) break; if (sp > XB_SPIN_CAP) { atomicAdd(&bar[XB_TMO], 1u); break; } }
    }
    nloc = mine > 0u ? mine : 1u; nx = cnt > 0u ? cnt : 1u;
}

__device__ __forceinline__ void xcd_barrier(const XcdBarrier& b, const bool t0) {
    asm volatile("s_waitcnt vmcnt(0)" ::: "memory");
    __syncthreads();
    if (t0) {
        unsigned* bar = b.bar;
        __builtin_amdgcn_s_waitcnt(0);
        unsigned nloc = b.st[0], nx = b.st[1];
        if (nloc == 0u) { xcd_barrier_complete(bar, b.x, nloc, nx); b.st[0] = nloc; b.st[1] = nx; }
        const unsigned old = xb_add(&bar[XB_XSUB(b.x)], 1u);
        const unsigned gen = old / nloc;
        if (old + 1u == (gen + 1u) * nloc) {
            __builtin_amdgcn_fence(__ATOMIC_RELEASE, "agent");
            asm volatile("s_waitcnt vmcnt(0)" ::: "memory");
            const unsigned og = xb_add(&bar[XB_TOP], 1u);
            const unsigned tg = og / nx;
            if (og + 1u == (tg + 1u) * nx) xb_add(&bar[XB_TOPGEN], 1u);
            else XB_SPIN(xb_ld(&bar[XB_TOPGEN]) == tg, bar);
            __builtin_amdgcn_fence(__ATOMIC_ACQUIRE, "agent");
            xb_add(&bar[XB_XGEN(b.x)], 1u);
            asm volatile("s_waitcnt vmcnt(0)" ::: "memory");
        } else {
            XB_SPIN(xb_ld(&bar[XB_XGEN(b.x)]) == gen, bar);
            __builtin_amdgcn_fence(__ATOMIC_ACQUIRE, "agent");
            asm volatile("s_waitcnt vmcnt(0)" ::: "memory");
        }
    }
    __syncthreads();
}

template <class T> DI T* opq(T* p) { asm volatile("" : "+s"(p)); return p; }
DI Ctx make_ctx(int l) {
    KA ap = ka_ptr(); unsigned char* ws = ap->ws;
    Ctx C; C.l = l; C.Z = (const bf16_t*)(ws + WS_Z); C.LD = (float*)(ws + WS_LD); C.MRG = (bf16_t*)(ws + WS_MRG); C.DS = (float*)(ws + WS_DS); C.SC = (bf16_t*)(ws + WS_SC); C.GL = (float*)(ws + WS_GL);
    C.qnw = ap->in[8] + l * 64; C.knw = ap->in[9] + l * 64; C.sinks = ap->in[10] + l * 8; C.gnw = ap->in[13] + l * 128;
    C.cache_k = ap->in[2]; C.cache_v = ap->in[3]; C.state = ap->in[4]; C.out = ap->out;
    return C;
}
DI RowMap make_rm() { KA ap = ka_ptr(); float* out = ap->out; unsigned char* ws = ap->ws; return RowMap{ap->in[0], ap->in[1], ap->in[5], out + O_YP, out + O_YS, (float*)(ws + WS_XMETA)}; }

__global__ void __launch_bounds__(512, 2) hymba_fwd(Args a) {
    extern __shared__ __attribute__((aligned(16))) unsigned char lds_raw[];
    LAS unsigned char* lds = (LAS unsigned char*)lds_raw;
    const int G = gridDim.x, bx = blockIdx.x; const int wave_s = __builtin_amdgcn_readfirstlane((int)threadIdx.x >> 6);
#define opaque_tid() mk_tid(wave_s)
    const int vcu = (G % 8 == 0) ? (bx % 8) * (G / 8) + bx / 8 : bx;
    const int lo = ka_ptr()->ph_lo, hi = ka_ptr()->ph_hi;
#define IN(k) (lo <= (k) && (k) < hi)
#ifndef FAST_BAR
#define FAST_BAR 1
#endif
    volatile LAS unsigned* MISC = (volatile LAS unsigned*)(lds + 131072 + 320);
    { const int t = opaque_tid(); if (t < 160) MISC[t] = 0u; __syncthreads(); }
    XcdBarrier bar = xcd_barrier_post((unsigned*)ka_ptr()->ws, MISC + 8, opaque_tid() == 0);
#define GSYNC() do { if (FAST_BAR) xcd_barrier(bar, opaque_tid() == 0); else cg::this_grid().sync(); } while (0)
#define STAMP(k) do { if (TIME_PH >= 0 && bx == 0 && opaque_tid() == 0) { const unsigned long long t_ = __builtin_amdgcn_s_memrealtime(); MISC[16 + 2 * (k)] = (unsigned)t_; MISC[17 + 2 * (k)] = (unsigned)(t_ >> 32); } } while (0)
#define SEAM(k) do { if (TIME_BUSY) STAMP(32 + (k)); if (IN(k) && IN((k) + 1)) { GSYNC(); } STAMP((k) + 1); } while (0)
    if (lo < 0) cg::this_grid().sync();
    STAMP(0);
    if (IN(0)) { for (int rep = 0; rep < REP_PRO; ++rep) { const RowMap rm = make_rm(); prologue(ka_ptr(), rm, lds, opaque_tid(), vcu, G); if (rep + 1 < REP_PRO) GSYNC(); }
        for (int xs = 0; xs < XSYNC; ++xs) GSYNC(); }
    SEAM(0);
#pragma unroll 1
    for (int l = 0; l < DEPTH; ++l) {
        const int pb = 1 + 7 * l;
        if (IN(pb + 0)) for (int rep = 0; rep < REP_WIN; ++rep) {
            if (rep) GSYNC();
            KA ap = ka_ptr(); unsigned char* ws = ap->ws; unsigned char* wl = ws + WS_W + (size_t)l * SZ_WL;
            pg8::Gemm g{(const bf16_t*)(ws + WS_XB), (const bf16_t*)wl, MP, NIN, DM}; pg8::StaticOrder S; S.init(MP, NIN, G, bx);
            pg8::EpiIn E{(bf16_t*)(ws + WS_Z), (float*)(ws + WS_LD), (const float*)(ws + WS_SSQA), ap->in[12] + l * 256};
            pg8::gemm_phase<pg8::EpiIn, pg8::StaticOrder, true, true>(lds, g, S, E, opaque_tid());
        }
        SEAM(pb + 0);
        if (IN(pb + 1)) {
            const Ctx C = make_ctx(l);
            constexpr int N1 = DECB * 2, N2 = 16 * NCH, N3 = DECB * 4;
#pragma unroll 1
            for (int u = vcu; u < N1 + N2 + N3; u += G) {
                if (u < N1) attn_sample_unit(C, u, lds, wave_s); else if (u < N1 + N2) gla1_unit(C, u - N1, lds, wave_s); else gla_sample_unit(C, u - N1 - N2, lds, wave_s);
            }
        }
        SEAM(pb + 1);
        if (IN(pb + 2)) for (int rep = 0; rep < REP_SCAN; ++rep) { if (rep) GSYNC(); const Ctx C = make_ctx(l); gla_scan(C, bx * 512 + opaque_tid(), G * 512); }
        SEAM(pb + 2);
        if (IN(pb + 3)) for (int rep = 0; rep < REP_MB; ++rep) {   if (rep) GSYNC();
            const Ctx C = make_ctx(l);
            constexpr int N1 = 16 * NCH, N2 = NBATCH * 2 * 65;
#pragma unroll 1
            for (int u = vcu; u < N1 + N2; u += G) { if (u < N1) gla3_unit(C, u, lds, wave_s); else attn_prompt_unit(C, u - N1, lds, wave_s); }
        }
        SEAM(pb + 3);
        if (IN(pb + 4)) for (int rep = 0; rep < 1 + DRY_WO; ++rep) {
            if (rep) GSYNC();
            KA ap = ka_ptr(); unsigned char* ws = ap->ws; unsigned char* wl = ws + WS_W + (size_t)l * SZ_WL;
            pg8::Gemm g{(const bf16_t*)(ws + WS_MRG), (const bf16_t*)(wl + SZ_WIN), MP, DM, DM}; pg8::StreamK S; S.init((MP / 256) * 4, DM / 128, G, vcu, (unsigned*)(ws + WS_FLAGS) + (2 * l) * 256 * 16, ws + WS_Z, ws + WS_ZERO);
            pg8::EpiRes E{make_rm(), 0, (bf16_t*)(ws + WS_XB), (float*)(ws + WS_SSQB), rep};
            pg8::gemm_phase<pg8::EpiRes, pg8::StreamK, true, true>(lds, g, S, E, opaque_tid());
        }
        SEAM(pb + 4);
        if (IN(pb + 5)) for (int rep = 0; rep < REP_GU; ++rep) {
            if (rep) GSYNC();
            KA ap = ka_ptr(); unsigned char* ws = ap->ws; unsigned char* wl = ws + WS_W + (size_t)l * SZ_WL;
            pg8::Gemm g{(const bf16_t*)(ws + WS_XB), (const bf16_t*)(wl + SZ_WIN + SZ_WO), MP, NGU, DM}; pg8::StaticOrder S; S.init(MP, NGU, G, bx);
            pg8::EpiGU E{(bf16_t*)(ws + WS_U), (const float*)(ws + WS_SSQB)};
            pg8::gemm_phase<pg8::EpiGU, pg8::StaticOrder, true, true>(lds, g, S, E, opaque_tid());
        }
        SEAM(pb + 5);
        if (IN(pb + 6)) for (int rep = 0; rep < 1 + DRY_DN; ++rep) {
            if (rep) GSYNC();
            KA ap = ka_ptr(); unsigned char* ws = ap->ws; unsigned char* wl = ws + WS_W + (size_t)l * SZ_WL;
            pg8::Gemm g{(const bf16_t*)(ws + WS_U), (const bf16_t*)(wl + SZ_WIN + SZ_WO + SZ_WGU), MP, DM, DFFN}; pg8::StreamK S; S.init((MP / 256) * 4, DFFN / 128, G, vcu, (unsigned*)(ws + WS_FLAGS) + (2 * l + 1) * 256 * 16, ws + WS_MRG, ws + WS_ZERO);
            pg8::EpiRes E{make_rm(), l == DEPTH - 1 ? 1 : 0, (bf16_t*)(ws + WS_XB), (float*)(ws + WS_SSQA), rep};
            pg8::gemm_phase<pg8::EpiRes, pg8::StreamK, true, true>(lds, g, S, E, opaque_tid());
        }
        if (l + 1 < DEPTH) SEAM(pb + 6);
    }
    if (TIME_SUB >= 0) { if (bx == 0 && opaque_tid() == 0) { const unsigned long long tot = MISC[100 + (TIME_SUB >= 0 ? TIME_SUB : 0)]; const unsigned long long tend = __builtin_amdgcn_s_memrealtime();
            while (__builtin_amdgcn_s_memrealtime() - tend < (unsigned long long)TIME_MULT * tot) __builtin_amdgcn_s_sleep(8); } }
    if (TIME_PH >= 0) {
        STAMP(NPHASE);
        if (bx == 0 && opaque_tid() == 0) {
            unsigned long long tot = 0;
            for (int k = 0; k < NPHASE; ++k) { const bool pick = (TIME_PH == 7) ? (k == 0) : (k >= 1 && ((k - 1) % 7) == TIME_PH);
                if (pick) { const int ke = TIME_BUSY ? 32 + k : k + 1; const unsigned long long a0 = ((unsigned long long)MISC[17 + 2 * k] << 32) | MISC[16 + 2 * k], a1 = ((unsigned long long)MISC[17 + 2 * ke] << 32) | MISC[16 + 2 * ke]; tot += a1 - a0; } }
            const unsigned long long tend = __builtin_amdgcn_s_memrealtime();
            while (__builtin_amdgcn_s_memrealtime() - tend < (unsigned long long)TIME_MULT * tot) __builtin_amdgcn_s_sleep(8);
        }
    }
#undef IN
#undef SEAM
#undef STAMP
#undef GSYNC
#undef opaque_tid
}

#ifndef N_LAUNCH_MODE
#define N_LAUNCH_MODE 0
#endif
extern "C" void kernel_launch(void* const* d_in, const int* in_sizes, int n_in, void* d_out, int out_size, void* d_ws, size_t ws_size, hipStream_t stream) {
    static int grid = 0;
    if (grid == 0) {
        if (n_in != 19 || out_size != (int)O_END || ws_size < WS_END) { fprintf(stderr, "kernel_launch: unexpected shapes: n_in %d out %d ws %zu (need %zu)\n", n_in, out_size, ws_size, (size_t)WS_END); grid = -1; return; }
        int dev = 0, cus = 0, per_cu = 0;
        (void)hipGetDevice(&dev); (void)hipDeviceGetAttribute(&cus, hipDeviceAttributeMultiprocessorCount, dev);
        if (hipFuncSetAttribute((const void*)hymba_fwd, hipFuncAttributeMaxDynamicSharedMemorySize, LDS_BYTES) != hipSuccess) { fprintf(stderr, "kernel_launch: hipFuncSetAttribute failed\n"); grid = -1; return; }
        if (hipOccupancyMaxActiveBlocksPerMultiprocessor(&per_cu, (const void*)hymba_fwd, 512, LDS_BYTES) != hipSuccess || per_cu < 1) { fprintf(stderr, "kernel_launch: occupancy query says %d\n", per_cu); per_cu = 1; }
        (void)hipGetLastError();
        grid = cus > 0 ? cus : 256;
    }
    if (grid < 0) return;
    if (hipMemsetAsync(d_ws, 0, WS_W, stream) != hipSuccess) { fprintf(stderr, "kernel_launch: memset failed\n"); return; }
    Args a{};
    for (int i = 0; i < 19; ++i) a.in[i] = (const float*)d_in[i];
    a.out = (float*)d_out; a.ws = (unsigned char*)d_ws;
#if N_LAUNCH_MODE == 1
    for (int p = 0; p < NPHASE; ++p) { a.ph_lo = p; a.ph_hi = p + 1; hipLaunchKernelGGL(hymba_fwd, dim3(grid), dim3(512), LDS_BYTES, stream, a); }
#else
    a.ph_lo = 0; a.ph_hi = NPHASE;
    void* args[] = {&a};
    hipError_t e = hipLaunchCooperativeKernel((const void*)hymba_fwd, dim3(grid), dim3(512), args, LDS_BYTES, stream);
    if (e != hipSuccess) fprintf(stderr, "cooperative launch failed: %s (grid %d)\n", hipGetErrorString(e), grid);
#endif
}
```

```cpp
#include <hip/hip_runtime.h>
#include <hip/hip_cooperative_groups.h>
#include <cstdio>
#include <cstdint>
namespace cg = cooperative_groups;

#define DI __device__ __forceinline__
#define LAS __attribute__((address_space(3)))
typedef unsigned short bf16_t;
typedef short bf16x8 __attribute__((ext_vector_type(8)));
typedef float f32x4 __attribute__((ext_vector_type(4)));
typedef float f32x2 __attribute__((ext_vector_type(2)));
typedef unsigned u32x4 __attribute__((ext_vector_type(4)));
typedef unsigned u32x2 __attribute__((ext_vector_type(2)));
typedef __bf16 bf16x2_t __attribute__((ext_vector_type(2)));

constexpr int DM = 1024, NBATCH = 4, SEQ = 4096, LP = 4112  , DEPTH = 2, DECB = 128, DECT = 8;
constexpr int MPROMPT = NBATCH * LP, MREAL = MPROMPT + DECB * DECT, MP = 17664  ;
constexpr int INW = 2320, ZP = 2304, NIN = 2560, DFFN = 2816, NGU = 5632;
constexpr int ZQ = 0, ZK = 512, ZV = 640, ZGQ = 768, ZGK = 1024, ZGV = 1280, ZOG = 1792;
constexpr int NCH = 33;
constexpr float EPS = 1e-6f, LOG2E = 1.4426950408889634f;
constexpr size_t O_YP = 0, O_YS = 16777216, O_CKP = 17825792, O_CVP = 17956864, O_SP = 18087936, O_CKS = 18350080, O_CVS = 22544384, O_SS = 26738688, O_END = 35127296;

DI unsigned pk2(float lo, float hi) { f32x2 v = {lo, hi}; bf16x2_t b = __builtin_convertvector(v, bf16x2_t); return __builtin_bit_cast(unsigned, b); }
DI float bflo(unsigned w) { return __uint_as_float(w << 16); }
DI float bfhi(unsigned w) { return __uint_as_float(w & 0xffff0000u); }
DI float bf2f(bf16_t h) { return __uint_as_float((unsigned)h << 16); }
DI void unpack8(const u32x4 w, float* f) { f[0] = bflo(w.x); f[1] = bfhi(w.x); f[2] = bflo(w.y); f[3] = bfhi(w.y); f[4] = bflo(w.z); f[5] = bfhi(w.z); f[6] = bflo(w.w); f[7] = bfhi(w.w); }
DI float red4rows(float v) {
    auto r = __builtin_amdgcn_permlane16_swap(__float_as_uint(v), __float_as_uint(v), false, false); v = __uint_as_float(r[0]) + __uint_as_float(r[1]);
    auto q = __builtin_amdgcn_permlane32_swap(__float_as_uint(v), __float_as_uint(v), false, false); return __uint_as_float(q[0]) + __uint_as_float(q[1]);
}
DI float max4rows(float v) {
    auto r = __builtin_amdgcn_permlane16_swap(__float_as_uint(v), __float_as_uint(v), false, false); v = fmaxf(__uint_as_float(r[0]), __uint_as_float(r[1]));
    auto q = __builtin_amdgcn_permlane32_swap(__float_as_uint(v), __float_as_uint(v), false, false); return fmaxf(__uint_as_float(q[0]), __uint_as_float(q[1]));
}
template <int M> DI float shx(float v) { return __int_as_float(__builtin_amdgcn_ds_swizzle(__float_as_int(v), 0x1f | (M << 10))); }
DI float sum8(float v) { v += shx<1>(v); v += shx<2>(v); v += shx<4>(v); return v; }
DI float sum64(float v) { v += shx<1>(v); v += shx<2>(v); v += shx<4>(v); v += shx<8>(v); v += shx<16>(v);
    auto q = __builtin_amdgcn_permlane32_swap(__float_as_uint(v), __float_as_uint(v), false, false); return __uint_as_float(q[0]) + __uint_as_float(q[1]); }
DI float silu_f(float x) { return x * __builtin_amdgcn_rcpf(1.0f + __expf(-x)); }

struct RowMap { const float* xp; const float* xs; const float* meta; float* yp; float* ys; float* xmeta; };
DI const float* row_in(const RowMap& rm, int row) {
    if (row < MPROMPT) { const int b = row / LP, p = row - b * LP; return p < 16 ? rm.meta + (size_t)p * DM : rm.xp + ((size_t)b * SEQ + (p - 16)) * DM; }
    if (row < MREAL) return rm.xs + (size_t)(row - MPROMPT) * DM;
    return nullptr;
}
DI float* row_out(const RowMap& rm, int row) {
    if (row < MPROMPT) { const int b = row / LP, p = row - b * LP; return p < 16 ? nullptr : rm.yp + ((size_t)b * SEQ + (p - 16)) * DM; }
    if (row < MREAL) return rm.ys + (size_t)(row - MPROMPT) * DM;
    return nullptr;
}
namespace pg8 {
#define PG8_LAS __attribute__((address_space(3)))
typedef unsigned short bf16_t;
typedef short bf16x8 __attribute__((ext_vector_type(8)));
typedef float f32x4 __attribute__((ext_vector_type(4)));
typedef unsigned u32x4 __attribute__((ext_vector_type(4)));
constexpr int BM = 256, BK = 64, HALF = 128, HTB = HALF * BK * 2  , STAGE_BYTES = 8 * HTB, NXCD = 8, WGM = 8;

__host__ __device__ __forceinline__ int lds_byte(int r, int c) { const int st = (r >> 4) * 2 + (c >> 5), rr = r & 15, cc = c & 31, ob = rr * 64 + cc * 2; return st * 1024 + (ob ^ (((ob >> 9) & 1) << 5)); }
__host__ __device__ __forceinline__ void stage_rc(int b, int& R, int& C) { const int st = b / 1024, sb = b % 1024, swz = sb ^ (((sb >> 9) & 1) << 5); R = (st >> 1) * 16 + swz / 64; C = (st & 1) * 32 + (swz % 64) / 2; }
__host__ __device__ __forceinline__ int perm32(int rho) { const int n = rho >> 4, i = rho & 15; return 8 * (i >> 2) + 4 * n + (i & 3); }

struct Unit { int pm, pn, k0, nk, mode; };
struct Gemm { const bf16_t* A; const bf16_t* Bt; int M, N, K; };

struct StaticOrder {
    static constexpr bool STREAMK = false;
    int nM, nN, nwg, G, c;
    __host__ __device__ void init(int M, int N, int G_, int c_) { nM = M / BM; nN = N / BM; nwg = nM * nN; G = G_; c = c_; }
    __host__ __device__ bool next(int i, Unit& u) const {
        const long L = (long)i * G + c; if (L >= nwg) return false;
        int wgid = (int)L; { const int q = nwg / NXCD, r = nwg % NXCD, xcd = wgid % NXCD, off = wgid / NXCD; wgid = (xcd < r ? xcd * (q + 1) : r * (q + 1) + (xcd - r) * q) + off; }
        const int nig = WGM * nN, gid = wgid / nig, fm = gid * WGM, gsz = (nM - fm) < WGM ? (nM - fm) : WGM;
        u.pm = fm + ((wgid % nig) % gsz); u.pn = (wgid % nig) / gsz; u.k0 = 0; u.nk = 0; u.mode = 0; return true;
    }
    __device__ __forceinline__ void a_ready(const Unit&) const {}
    __device__ __forceinline__ void done(const Unit&) const {}
};


struct StreamK {
    static constexpr bool STREAMK = true;
    int P, r, s, e, nseg; unsigned* flags; unsigned char* part; const unsigned char* zero;
    __device__ __forceinline__ void init(int ntiles, int P_, int G, int r_, unsigned* flags_, unsigned char* part_, const unsigned char* zero_) {
        P = P_; r = r_; flags = flags_; part = part_; zero = zero_; const long TP = (long)ntiles * P; s = (int)(TP * r / G); e = (int)(TP * (r + 1) / G);
        nseg = 0; int cur = s; while (cur < e) { const int kb = cur % P; int ke = kb + (e - cur); ke = ke < P ? ke : P; cur += ke - kb; ++nseg; }
    }
    __device__ __forceinline__ bool next(int i, Unit& u) const {
        if (i >= nseg) return false;
        const int want = nseg - 1 - i; int cur = s, idx = 0;
        for (;;) { const int t = cur / P, kb = cur % P; int ke = kb + (e - cur); ke = ke < P ? ke : P;
            if (idx == want) { u.pm = t >> 2; u.pn = t & 3; u.k0 = 2 * kb; u.nk = 2 * (ke - kb); u.mode = (kb == 0 && ke == P) ? 0 : (kb == 0 ? 1 : 2); return true; }
            cur += ke - kb; ++idx; }
    }
    __device__ __forceinline__ void a_ready(const Unit&) const {}
    __device__ __forceinline__ void done(const Unit&) const {}
};

DI float rstd_from_slots(const float* ssq, int row) {
    const f32x4* p = (const f32x4*)(ssq + (size_t)row * 16);
    const f32x4 a = p[0], b = p[1], c = p[2], d = p[3];
    const float s = ((a[0] + a[1]) + (a[2] + a[3])) + ((b[0] + b[1]) + (b[2] + b[3])) + ((c[0] + c[1]) + (c[2] + c[3])) + ((d[0] + d[1]) + (d[2] + d[3]));
    return rsqrtf(s * (1.0f / 1024.0f) + EPS);
}
DI void rstd8(const float* ssq, int row0, float (&rs)[2][4]) {
#pragma unroll
    for (int ai = 0; ai < 2; ++ai) {
        f32x4 t[4][4];
#pragma unroll
        for (int m = 0; m < 4; ++m) { const f32x4* p = (const f32x4*)(ssq + (size_t)(row0 + ai * HALF + m * 16) * 16); t[m][0] = p[0]; t[m][1] = p[1]; t[m][2] = p[2]; t[m][3] = p[3]; }
#pragma unroll
        for (int m = 0; m < 4; ++m) { const f32x4 q = (t[m][0] + t[m][1]) + (t[m][2] + t[m][3]); rs[ai][m] = rsqrtf(((q[0] + q[1]) + (q[2] + q[3])) * (1.0f / 1024.0f) + EPS); }
        asm volatile("" ::: "memory");
    }
}
DI void rstd_tab_fill(const float* ssq, int pm, PG8_LAS float* tab, int tid) {
    if (tid < 256) { const f32x4* p = (const f32x4*)(ssq + (size_t)(pm * BM + tid) * 16); const f32x4 q = (p[0] + p[1]) + (p[2] + p[3]); tab[tid] = rsqrtf(((q[0] + q[1]) + (q[2] + q[3])) * (1.0f / 1024.0f) + EPS); }
}
DI void rstd8_tab(const PG8_LAS float* tab, int wr, int fr, float (&rs)[2][4]) {
#pragma unroll
    for (int ai = 0; ai < 2; ++ai)
#pragma unroll
        for (int m = 0; m < 4; ++m) rs[ai][m] = tab[ai * HALF + wr * 64 + m * 16 + fr];
}
struct EpiIn {
    static constexpr bool PERM = true, AFTER_DRAIN = false, RSTAB = true;
    bf16_t* Z; float* LD; const float* ssq; const float* bg;
    __device__ __forceinline__ void prefetch(const Unit& u, PG8_LAS float* tab, int tid) const { rstd_tab_fill(ssq, u.pm, tab, tid); }
    __device__ __forceinline__ void operator()(const f32x4 (&acc)[2][2][4][2], const Unit& u, int wr, int wc, int fr, int fq, const PG8_LAS float* tab) const {
        const int row0 = u.pm * BM + wr * 64 + fr;
        float rs[2][4]; rstd8_tab(tab, wr, fr, rs);
        if (u.pn < 9) {
#pragma unroll
            for (int ai = 0; ai < 2; ++ai)
#pragma unroll
                for (int m = 0; m < 4; ++m) { const int row = row0 + ai * HALF + m * 16; const float r = rs[ai][m];
                    bf16_t* rowp = Z + (size_t)row * ZP + u.pn * BM + wc * 32 + 8 * fq;
#pragma unroll
                    for (int bj = 0; bj < 2; ++bj) { const f32x4 v0 = acc[ai][bj][m][0] * r, v1 = acc[ai][bj][m][1] * r;
                        u32x4 w; w.x = pk2(v0[0], v0[1]); w.y = pk2(v0[2], v0[3]); w.z = pk2(v1[0], v1[1]); w.w = pk2(v1[2], v1[3]);
                        *(u32x4*)(rowp + bj * HALF) = w; } }
        } else {
            const int e0 = wc * 32 + 8 * fq;
#pragma unroll
            for (int bj = 0; bj < 2; ++bj) { const f32x4 b0 = *(const f32x4*)(bg + e0 + bj * HALF), b1 = *(const f32x4*)(bg + e0 + bj * HALF + 4);
#pragma unroll
                for (int ai = 0; ai < 2; ++ai)
#pragma unroll
                    for (int m = 0; m < 4; ++m) { const int row = row0 + ai * HALF + m * 16; const float r = rs[ai][m];
                        const f32x4 x0 = acc[ai][bj][m][0] * r + b0, x1 = acc[ai][bj][m][1] * r + b1; f32x4 o0, o1;
#pragma unroll
                        for (int i = 0; i < 4; ++i) { o0[i] = (fminf(x0[i], 0.f) - __logf(1.0f + __expf(-fabsf(x0[i])))) * 0.0625f; o1[i] = (fminf(x1[i], 0.f) - __logf(1.0f + __expf(-fabsf(x1[i])))) * 0.0625f; }
                        float* lp = LD + (size_t)row * 256 + e0 + bj * HALF; *(f32x4*)lp = o0; *(f32x4*)(lp + 4) = o1; } }
        }
    }
};
#ifndef EPIRES_BATCH4
#define EPIRES_BATCH4 1
#endif
#if EPIRES_BATCH4
struct EpiRes {
    static constexpr bool PERM = true, AFTER_DRAIN = false, RSTAB = false;
    RowMap rm; int final_; bf16_t* XB; float* ssq; int dry;
    __device__ __forceinline__ void operator()(const f32x4 (&acc)[2][2][4][2], const Unit& u, int wr, int wc, int fr, int fq, const unsigned char* pp) const {
        if (dry) return;
        const int row0 = u.pm * BM + wr * 64 + fr, col0 = u.pn * BM + wc * 32 + 8 * fq;
#pragma unroll
        for (int ai = 0; ai < 2; ++ai) {
            u32x4 res[4][2], par[4][2];
#pragma unroll
            for (int m = 0; m < 4; ++m) { const int row = row0 + ai * HALF + m * 16;
#pragma unroll
                for (int bj = 0; bj < 2; ++bj) { res[m][bj] = *(const u32x4*)(XB + (size_t)row * DM + col0 + bj * HALF); par[m][bj] = (u32x4){0u, 0u, 0u, 0u}; } }
            if (pp) {
#pragma unroll
                for (int m = 0; m < 4; ++m)
#pragma unroll
                    for (int bj = 0; bj < 2; ++bj) asm volatile("global_load_dwordx4 %0, %1, off sc0 sc1" : "=v"(par[m][bj]) : "v"(pp + ((ai * 2 + bj) * 4 + m) * 8192) : "memory");
                asm volatile("s_waitcnt vmcnt(0)" : "+v"(par[0][0]), "+v"(par[0][1]), "+v"(par[1][0]), "+v"(par[1][1]), "+v"(par[2][0]), "+v"(par[2][1]), "+v"(par[3][0]), "+v"(par[3][1]) :: "memory");
            }
#pragma unroll
            for (int m = 0; m < 4; ++m) { const int row = row0 + ai * HALF + m * 16; float ss = 0.f; float* op = final_ ? row_out(rm, row) : nullptr;
#pragma unroll
                for (int bj = 0; bj < 2; ++bj) { const int col = col0 + bj * HALF; float r[8], q[8]; unpack8(res[m][bj], r); unpack8(par[m][bj], q);
                    const f32x4 v0 = (acc[ai][bj][m][0] + (f32x4){q[0], q[1], q[2], q[3]}) + (f32x4){r[0], r[1], r[2], r[3]}, v1 = (acc[ai][bj][m][1] + (f32x4){q[4], q[5], q[6], q[7]}) + (f32x4){r[4], r[5], r[6], r[7]};
                    if (final_) { if (op) { __builtin_nontemporal_store(v0, (f32x4*)(op + col)); __builtin_nontemporal_store(v1, (f32x4*)(op + col + 4)); } }
                    else { u32x4 w; w.x = pk2(v0[0], v0[1]); w.y = pk2(v0[2], v0[3]); w.z = pk2(v1[0], v1[1]); w.w = pk2(v1[2], v1[3]);
                        *(u32x4*)(XB + (size_t)row * DM + col) = w;
                        const f32x4 q0 = {bflo(w.x), bfhi(w.x), bflo(w.y), bfhi(w.y)}, q1 = {bflo(w.z), bfhi(w.z), bflo(w.w), bfhi(w.w)};
                        ss += (q0[0] * q0[0] + q0[1] * q0[1]) + (q0[2] * q0[2] + q0[3] * q0[3]) + (q1[0] * q1[0] + q1[1] * q1[1]) + (q1[2] * q1[2] + q1[3] * q1[3]); } }
                if (!final_) { ss = red4rows(ss); if (fq == 0) ssq[(size_t)row * 16 + u.pn * 4 + wc] = ss; } }
            asm volatile("" ::: "memory");
        }
    }
};
#else
struct EpiRes {
    static constexpr bool PERM = true, AFTER_DRAIN = false, RSTAB = false;
    RowMap rm; int final_; bf16_t* XB; float* ssq; int dry;
    __device__ __forceinline__ void operator()(const f32x4 (&acc)[2][2][4][2], const Unit& u, int wr, int wc, int fr, int fq, const unsigned char* pp) const {
        if (dry) return;
        const int row0 = u.pm * BM + wr * 64 + fr, col0 = u.pn * BM + wc * 32 + 8 * fq;
#pragma unroll
        for (int ai = 0; ai < 2; ++ai)
#pragma unroll
        for (int mh = 0; mh < 2; ++mh) {
            u32x4 res[2][2], par[2][2];
#pragma unroll
            for (int mm = 0; mm < 2; ++mm) { const int row = row0 + ai * HALF + (2 * mh + mm) * 16;
#pragma unroll
                for (int bj = 0; bj < 2; ++bj) { res[mm][bj] = *(const u32x4*)(XB + (size_t)row * DM + col0 + bj * HALF); par[mm][bj] = (u32x4){0u, 0u, 0u, 0u}; } }
            if (pp) {
#pragma unroll
                for (int mm = 0; mm < 2; ++mm)
#pragma unroll
                    for (int bj = 0; bj < 2; ++bj) asm volatile("global_load_dwordx4 %0, %1, off sc0 sc1" : "=v"(par[mm][bj]) : "v"(pp + ((ai * 2 + bj) * 4 + 2 * mh + mm) * 8192) : "memory");
                asm volatile("s_waitcnt vmcnt(0)" : "+v"(par[0][0]), "+v"(par[0][1]), "+v"(par[1][0]), "+v"(par[1][1]) :: "memory");
            }
#pragma unroll
            for (int mm = 0; mm < 2; ++mm) { const int m = 2 * mh + mm; const int row = row0 + ai * HALF + m * 16; float ss = 0.f; float* op = final_ ? row_out(rm, row) : nullptr;
#pragma unroll
                for (int bj = 0; bj < 2; ++bj) { const int col = col0 + bj * HALF; float r[8], q[8]; unpack8(res[mm][bj], r); unpack8(par[mm][bj], q);
                    const f32x4 v0 = (acc[ai][bj][m][0] + (f32x4){q[0], q[1], q[2], q[3]}) + (f32x4){r[0], r[1], r[2], r[3]}, v1 = (acc[ai][bj][m][1] + (f32x4){q[4], q[5], q[6], q[7]}) + (f32x4){r[4], r[5], r[6], r[7]};
                    if (final_) { if (op) { __builtin_nontemporal_store(v0, (f32x4*)(op + col)); __builtin_nontemporal_store(v1, (f32x4*)(op + col + 4)); } }
                    else { u32x4 w; w.x = pk2(v0[0], v0[1]); w.y = pk2(v0[2], v0[3]); w.z = pk2(v1[0], v1[1]); w.w = pk2(v1[2], v1[3]);
                        *(u32x4*)(XB + (size_t)row * DM + col) = w;
                        const f32x4 q0 = {bflo(w.x), bfhi(w.x), bflo(w.y), bfhi(w.y)}, q1 = {bflo(w.z), bfhi(w.z), bflo(w.w), bfhi(w.w)};
                        ss += (q0[0] * q0[0] + q0[1] * q0[1]) + (q0[2] * q0[2] + q0[3] * q0[3]) + (q1[0] * q1[0] + q1[1] * q1[1]) + (q1[2] * q1[2] + q1[3] * q1[3]); } }
                if (!final_) { ss = red4rows(ss); if (fq == 0) ssq[(size_t)row * 16 + u.pn * 4 + wc] = ss; } }
            asm volatile("" ::: "memory");
        }
    }
};
#endif
struct EpiGU {
    static constexpr bool PERM = true, AFTER_DRAIN = false, RSTAB = true;
    bf16_t* U; const float* ssq;
    __device__ __forceinline__ void prefetch(const Unit& u, PG8_LAS float* tab, int tid) const { rstd_tab_fill(ssq, u.pm, tab, tid); }
    __device__ __forceinline__ void operator()(const f32x4 (&acc)[2][2][4][2], const Unit& u, int wr, int wc, int fr, int fq, const PG8_LAS float* tab) const {
        const int row0 = u.pm * BM + wr * 64 + fr, f0 = u.pn * HALF + wc * 32 + 8 * fq;
        float rs[2][4]; rstd8_tab(tab, wr, fr, rs);
#pragma unroll
        for (int ai = 0; ai < 2; ++ai)
#pragma unroll
            for (int m = 0; m < 4; ++m) { const int row = row0 + ai * HALF + m * 16; const float r = rs[ai][m];
                float o[8];
#pragma unroll
                for (int n = 0; n < 2; ++n)
#pragma unroll
                    for (int i = 0; i < 4; ++i) { const float g = acc[ai][0][m][n][i] * r, up = acc[ai][1][m][n][i] * r; o[4 * n + i] = silu_f(g) * up; }
                u32x4 w; w.x = pk2(o[0], o[1]); w.y = pk2(o[2], o[3]); w.z = pk2(o[4], o[5]); w.w = pk2(o[6], o[7]);
                *(u32x4*)(U + (size_t)row * DFFN + f0) = w; }
    }
};
template <class Epi, class Sched, bool ALIGN_EPI = false, bool SP2 = false>
__device__ __forceinline__ void gemm_phase(PG8_LAS unsigned char* lds, const Gemm g, const Sched& S, const Epi& E, const int tid_in) {
    const int tid = tid_in, wid = __builtin_amdgcn_readfirstlane(tid >> 6), lane = tid & 63, wr = wid >> 2, wc = wid & 3, fr = lane & 15, fq = lane >> 4;
    const int K = g.K;
    unsigned voffA[2], voffB[2];
#pragma unroll
    for (int i = 0; i < 2; ++i) { int R, C; stage_rc(tid * 16 + i * 8192, R, C); const int Rb = Epi::PERM ? ((R & ~31) + perm32(R & 31)) : R;
        voffA[i] = (unsigned)(R * K + C) * 2u; voffB[i] = (unsigned)(Rb * K + C) * 2u; }
    const size_t kstep = (size_t)(BK * 2);
    const size_t hstep = (size_t)HALF * K * 2;
    const size_t tstep = 2 * hstep;
    const unsigned ldsw = (unsigned)wid * 1024u;
    const int aoff = lds_byte(wr * 64 + fr, fq * 8), boff = lds_byte(wc * 32 + fr, fq * 8);
#define PG8_SA(b, h) (((b) * 2 + (h)) * HTB)
#define PG8_SB(b, h) ((4 + (b) * 2 + (h)) * HTB)
#define PG8_STAGE(bufoff, gbase, voff) do { _Pragma("unroll") for (int _i = 0; _i < 2; ++_i) \
        __builtin_amdgcn_global_load_lds((const unsigned*)((const char*)(gbase) + (voff)[_i]), (PG8_LAS unsigned*)(lds + (bufoff) + ldsw + _i * 8192), 16, 0, 0); } while (0)
#define PG8_LDA(dst, b, h) do { _Pragma("unroll") for (int m = 0; m < 4; ++m) _Pragma("unroll") for (int k = 0; k < 2; ++k) dst[m][k] = *(const PG8_LAS bf16x8*)(lds + PG8_SA(b, h) + aoff + m * 2048 + k * 1024); } while (0)
#define PG8_LDB(dst, b, h) do { _Pragma("unroll") for (int n = 0; n < 2; ++n) _Pragma("unroll") for (int k = 0; k < 2; ++k) dst[n][k] = *(const PG8_LAS bf16x8*)(lds + PG8_SB(b, h) + boff + n * 2048 + k * 1024); } while (0)
#define PG8_MMA(ai, bj, At, Bt) do { __builtin_amdgcn_s_setprio(1); _Pragma("unroll") for (int m = 0; m < 4; ++m) _Pragma("unroll") for (int n = 0; n < 2; ++n) _Pragma("unroll") for (int k = 0; k < 2; ++k) \
        acc[ai][bj][m][n] = __builtin_amdgcn_mfma_f32_16x16x32_bf16(Bt[n][k], At[m][k], acc[ai][bj][m][n], 0, 0, 0); __builtin_amdgcn_s_setprio(0); } while (0)
#define PG8_WAIT_V(n) asm volatile("s_waitcnt vmcnt(" #n ")" ::: "memory")
#define PG8_WAIT_L(n) asm volatile("s_waitcnt lgkmcnt(" #n ")" ::: "memory")
#define PG8_BAR __builtin_amdgcn_s_barrier()
#define PG8_SCHED __builtin_amdgcn_sched_barrier(0)
    Unit cur, nxt; int ui = 0;
    if (!S.next(0, cur)) return;
    f32x4 acc[2][2][4][2];
#pragma unroll
    for (int a = 0; a < 2; ++a)
#pragma unroll
        for (int b = 0; b < 2; ++b)
#pragma unroll
            for (int m = 0; m < 4; ++m)
#pragma unroll
                for (int n = 0; n < 2; ++n) acc[a][b][m][n] = (f32x4){0.f, 0.f, 0.f, 0.f};
    bf16x8 At[4][2], B0[2][2], B1[2][2];
    const char* cA = (const char*)g.A + (size_t)cur.pm * tstep + (size_t)cur.k0 * kstep; const char* cB = (const char*)g.Bt + (size_t)cur.pn * tstep + (size_t)cur.k0 * kstep;
    S.a_ready(cur);
    if constexpr (Epi::RSTAB) E.prefetch(cur, (PG8_LAS float*)(lds + STAGE_BYTES + 1024), tid);
    if constexpr (SP2) {
        PG8_STAGE(PG8_SB(0, 0), cB, voffB); PG8_STAGE(PG8_SB(0, 1), cB + hstep, voffB); PG8_STAGE(PG8_SA(0, 0), cA, voffA); PG8_STAGE(PG8_SA(0, 1), cA + hstep, voffA);
        if (wr == 1) PG8_BAR;
        PG8_WAIT_V(2); PG8_BAR;
        PG8_STAGE(PG8_SB(1, 0), cB + kstep, voffB); PG8_STAGE(PG8_SA(1, 0), cA + kstep, voffA); PG8_STAGE(PG8_SB(1, 1), cB + hstep + kstep, voffB);
        PG8_WAIT_V(6); PG8_BAR;
    } else {
        PG8_STAGE(PG8_SB(0, 0), cB, voffB); PG8_STAGE(PG8_SA(0, 0), cA, voffA); PG8_STAGE(PG8_SB(0, 1), cB + hstep, voffB); PG8_STAGE(PG8_SA(0, 1), cA + hstep, voffA);
        if (wr == 1) PG8_BAR;
        PG8_WAIT_V(4); PG8_BAR;
        PG8_STAGE(PG8_SB(1, 0), cB + kstep, voffB); PG8_STAGE(PG8_SA(1, 0), cA + kstep, voffA); PG8_STAGE(PG8_SB(1, 1), cB + hstep + kstep, voffB);
        PG8_WAIT_V(6); PG8_BAR;
    }
    for (;;) {
        const bool has_next = S.next(ui + 1, nxt);
        const char* nA = has_next ? (const char*)g.A + (size_t)nxt.pm * tstep + (size_t)nxt.k0 * kstep : cA; const char* nB = has_next ? (const char*)g.Bt + (size_t)nxt.pn * tstep + (size_t)nxt.k0 * kstep : cB;
        const int nt = cur.nk ? cur.nk : K / BK;
        for (int t = 0; t < nt; t += 2) {
            const bool last = (t == nt - 2);
            const char* a1 = cA + (size_t)(t + 1) * kstep;
            const char* a2 = last ? nA : cA + (size_t)(t + 2) * kstep; const char* b2 = last ? nB : cB + (size_t)(t + 2) * kstep;
            const char* a3 = a2 + kstep; const char* b3 = b2 + kstep;
            if (last && has_next) S.a_ready(nxt);
            if constexpr (SP2) {
            PG8_LDB(B0, 0, 0); PG8_LDB(B1, 0, 1); PG8_SCHED; PG8_LDA(At, 0, 0); PG8_STAGE(PG8_SA(1, 1), a1 + hstep, voffA);
            PG8_WAIT_V(8); PG8_WAIT_L(0); PG8_BAR; PG8_MMA(0, 0, At, B0); PG8_MMA(0, 1, At, B1); PG8_BAR; PG8_SCHED;
            PG8_LDA(At, 0, 1); PG8_STAGE(PG8_SB(0, 0), b2, voffB); PG8_STAGE(PG8_SB(0, 1), b2 + hstep, voffB); PG8_STAGE(PG8_SA(0, 0), a2, voffA);
            PG8_WAIT_V(8); PG8_WAIT_L(0); PG8_BAR; PG8_MMA(1, 0, At, B0); PG8_MMA(1, 1, At, B1); PG8_BAR; PG8_SCHED;
            PG8_LDB(B0, 1, 0); PG8_LDB(B1, 1, 1); PG8_SCHED; PG8_LDA(At, 1, 0); PG8_STAGE(PG8_SA(0, 1), a2 + hstep, voffA);
            PG8_WAIT_V(8); PG8_WAIT_L(0); PG8_BAR; PG8_MMA(0, 0, At, B0); PG8_MMA(0, 1, At, B1); PG8_BAR; PG8_SCHED;
            PG8_LDA(At, 1, 1); PG8_STAGE(PG8_SB(1, 0), b3, voffB); PG8_STAGE(PG8_SB(1, 1), b3 + hstep, voffB); PG8_STAGE(PG8_SA(1, 0), a3, voffA);
            PG8_WAIT_V(8); PG8_WAIT_L(0); PG8_BAR; PG8_MMA(1, 0, At, B0); PG8_MMA(1, 1, At, B1); PG8_BAR; PG8_SCHED;
            } else {
            PG8_LDB(B0, 0, 0); PG8_SCHED; PG8_LDA(At, 0, 0); PG8_STAGE(PG8_SA(1, 1), a1 + hstep, voffA);
            PG8_WAIT_L(8); PG8_BAR; PG8_WAIT_L(0); PG8_MMA(0, 0, At, B0); PG8_BAR; PG8_SCHED;
            PG8_LDB(B1, 0, 1); PG8_STAGE(PG8_SB(0, 0), b2, voffB);
            PG8_BAR; PG8_WAIT_L(0); PG8_MMA(0, 1, At, B1); PG8_BAR;
            PG8_LDA(At, 0, 1); PG8_STAGE(PG8_SA(0, 0), a2, voffA);
            PG8_BAR; PG8_WAIT_L(0); PG8_MMA(1, 0, At, B0); PG8_BAR; PG8_SCHED;
            PG8_STAGE(PG8_SB(0, 1), b2 + hstep, voffB);
            PG8_WAIT_V(6); PG8_BAR; PG8_MMA(1, 1, At, B1); PG8_BAR;
            PG8_LDB(B0, 1, 0); PG8_SCHED; PG8_LDA(At, 1, 0); PG8_STAGE(PG8_SA(0, 1), a2 + hstep, voffA);
            PG8_WAIT_L(8); PG8_BAR; PG8_WAIT_L(0); PG8_MMA(0, 0, At, B0); PG8_BAR; PG8_SCHED;
            PG8_LDB(B1, 1, 1); PG8_STAGE(PG8_SB(1, 0), b3, voffB);
            PG8_BAR; PG8_WAIT_L(0); PG8_MMA(0, 1, At, B1); PG8_BAR;
            PG8_LDA(At, 1, 1); PG8_STAGE(PG8_SA(1, 0), a3, voffA);
            PG8_BAR; PG8_WAIT_L(0); PG8_MMA(1, 0, At, B0); PG8_BAR; PG8_SCHED;
            PG8_STAGE(PG8_SB(1, 1), b3 + hstep, voffB);
            PG8_WAIT_V(6); PG8_BAR; PG8_MMA(1, 1, At, B1); PG8_BAR;
            }
        }
        if constexpr (ALIGN_EPI) { if (wr == 0) PG8_BAR; }
        int fr2 = fr, fq2 = fq, tid2 = tid; asm volatile("" : "+v"(fr2), "+v"(fq2), "+v"(tid2));
        if constexpr (Sched::STREAMK) {
            if (cur.mode == 1) {
                unsigned char* pp = S.part + (size_t)S.r * 131072 + (size_t)tid2 * 16;
#pragma unroll
                for (int a = 0; a < 2; ++a)
#pragma unroll
                    for (int b = 0; b < 2; ++b)
#pragma unroll
                        for (int m = 0; m < 4; ++m) { u32x4 w; w.x = pk2(acc[a][b][m][0][0], acc[a][b][m][0][1]); w.y = pk2(acc[a][b][m][0][2], acc[a][b][m][0][3]); w.z = pk2(acc[a][b][m][1][0], acc[a][b][m][1][1]); w.w = pk2(acc[a][b][m][1][2], acc[a][b][m][1][3]);
                            asm volatile("global_store_dwordx4 %0, %1, off sc0 sc1" :: "v"(pp + ((a * 2 + b) * 4 + m) * 8192), "v"(w) : "memory"); }
                asm volatile("s_waitcnt vmcnt(0)" ::: "memory");
                if (lane == 0) __hip_atomic_fetch_add(S.flags + 16 * S.r, 1u, __ATOMIC_RELAXED, __HIP_MEMORY_SCOPE_AGENT);
            } else {
                const bool tail = cur.mode == 2;
                if (tail) {
                    unsigned sp = 0;
                    while ((unsigned)__builtin_amdgcn_readfirstlane(__hip_atomic_load(S.flags + 16 * (S.r - 1), __ATOMIC_RELAXED, __HIP_MEMORY_SCOPE_AGENT)) < 8u) { __builtin_amdgcn_s_sleep(2); if (++sp > (1u << 22)) break; }
                }
                const unsigned char* pp = tail ? S.part + (size_t)(S.r - 1) * 131072 + (size_t)tid2 * 16 : nullptr;
                E(acc, cur, wr, wc, fr2, fq2, pp);
            }
        } else
        if constexpr (Epi::RSTAB) { E(acc, cur, wr, wc, fr2, fq2, (const PG8_LAS float*)(lds + STAGE_BYTES + 1024) + (ui & 1) * 256); } else
        if constexpr (!Epi::AFTER_DRAIN) { E(acc, cur, wr, wc, fr2, fq2); S.done(cur); }
        if (!has_next) break;
#pragma unroll
        for (int a = 0; a < 2; ++a)
#pragma unroll
            for (int b = 0; b < 2; ++b)
#pragma unroll
                for (int m = 0; m < 4; ++m)
#pragma unroll
                    for (int n = 0; n < 2; ++n) acc[a][b][m][n] = (f32x4){0.f, 0.f, 0.f, 0.f};
        cur = nxt; cA = nA; cB = nB; ++ui;
        if constexpr (Epi::RSTAB) E.prefetch(cur, (PG8_LAS float*)(lds + STAGE_BYTES + 1024) + (ui & 1) * 256, tid2);
        if constexpr (ALIGN_EPI) { if (wr == 1) PG8_BAR; }
    }
    PG8_WAIT_V(0);
    if constexpr (!ALIGN_EPI) { if (wr == 0) PG8_BAR; }
    PG8_BAR;
    if constexpr (Epi::AFTER_DRAIN) { E.fused(acc, cur, wr, wc, fr, fq, lds, wid, lane); S.done(cur); }
#undef PG8_SA
#undef PG8_SB
#undef PG8_STAGE
#undef PG8_LDA
#undef PG8_LDB
#undef PG8_MMA
#undef PG8_WAIT_V
#undef PG8_WAIT_L
#undef PG8_BAR
#undef PG8_SCHED
}
}

constexpr size_t SZ_WIN = (size_t)NIN * DM * 2, SZ_WO = (size_t)DM * DM * 2, SZ_WGU = (size_t)NGU * DM * 2, SZ_WD = (size_t)DM * DFFN * 2, SZ_WL = SZ_WIN + SZ_WO + SZ_WGU + SZ_WD;
constexpr size_t WS_CTL = 0;
constexpr size_t WS_FLAGS = 16384;
constexpr size_t WS_ZERO = 16384 + 4 * 256 * 64;
constexpr size_t WS_CTR = WS_ZERO + 256;
constexpr size_t WS_W = WS_CTR + 4 * 64;
constexpr size_t WS_XB = WS_W + DEPTH * SZ_WL;
constexpr size_t WS_MRG = WS_XB + (size_t)MP * DM * 2;
constexpr size_t WS_Z = WS_MRG + (size_t)MP * DM * 2;
constexpr size_t WS_LD = WS_Z + (size_t)MP * ZP * 2;
constexpr size_t WS_U = WS_Z;
constexpr size_t WS_DS = WS_LD + (size_t)MP * 256 * 4;
constexpr size_t WS_SC = WS_DS + (size_t)16 * NCH * 64 * 128 * 4;
constexpr size_t WS_GL = WS_SC + (size_t)16 * NCH * 64 * 128 * 2;
constexpr size_t WS_SSQA = WS_GL + (size_t)16 * NCH * 64 * 4;
constexpr size_t WS_SSQB = WS_SSQA + (size_t)MP * 16 * 4;
constexpr size_t WS_XMETA = WS_SSQB + (size_t)MP * 16 * 4;
constexpr size_t WS_END = WS_XMETA + (size_t)64 * DM * 4;
static_assert((size_t)MP * DFFN * 2 <= (size_t)MP * ZP * 2 + (size_t)MP * 256 * 4, "U overlay fits Z|LD");
static_assert(WS_END <= 268435456ull, "workspace map fits 256 MiB");

#ifndef REP_PRO
#define REP_PRO 1
#endif
#ifndef REP_WIN
#define REP_WIN 1
#endif
#ifndef REP_MB
#define REP_MB 1
#endif
#ifndef REP_SCAN
#define REP_SCAN 1
#endif
#ifndef REP_GU
#define REP_GU 1
#endif
#ifndef REP_G1
#define REP_G1 1
#endif
#ifndef REP_AS
#define REP_AS 1
#endif
#ifndef REP_GS
#define REP_GS 1
#endif
#ifndef REP_G3
#define REP_G3 1
#endif
#ifndef REP_AP
#define REP_AP 1
#endif
#ifndef REP_WO0
#define REP_WO0 1
#endif
#ifndef DRY_WO
#define DRY_WO 0
#endif
#ifndef DRY_DN
#define DRY_DN 0
#endif
#ifndef TIME_PH
#define TIME_PH -1
#endif
#ifndef TIME_MULT
#define TIME_MULT 4
#endif
#ifndef TIME_BUSY
#define TIME_BUSY 0
#endif
#ifndef TIME_SUB
#define TIME_SUB -1
#endif
#ifndef XSYNC
#define XSYNC 0
#endif
constexpr int LDS_BYTES = 147456;
constexpr int NPHASE = 1 + 7 * DEPTH;

struct Args { const float* in[19]; float* out; unsigned char* ws; int ph_lo, ph_hi; };
typedef const __attribute__((address_space(4))) Args* KA;
DI KA ka_ptr() { KA p = (KA)__builtin_amdgcn_kernarg_segment_ptr(); asm volatile("" : "+s"(p)); return p; }

DI int mk_tid(int wave_s) { int lane; asm volatile("v_mbcnt_lo_u32_b32 %0, -1, 0\n\tv_mbcnt_hi_u32_b32 %0, -1, %0" : "=v"(lane)); return wave_s * 64 + lane; }
typedef short v4i16_t __attribute__((ext_vector_type(4)));
DI u32x2 tr4(const LAS unsigned char* p) { return __builtin_bit_cast(u32x2, __builtin_amdgcn_ds_read_tr16_b64_v4i16((LAS v4i16_t*)p)); }
#if TIME_SUB >= 0
#define TICK(id) do { if (blockIdx.x == 0 && tid == 0) { volatile LAS unsigned* M_ = (volatile LAS unsigned*)(lds + 131072 + 320); const unsigned now_ = (unsigned)__builtin_amdgcn_s_memrealtime(); M_[100 + (id)] += now_ - M_[99]; M_[99] = now_; } } while (0)
#else
#define TICK(id) do {} while (0)
#endif
DI bf16x8 mk8(u32x2 lo, u32x2 hi) { u32x4 w; w.x = lo.x; w.y = lo.y; w.z = hi.x; w.w = hi.y; return __builtin_bit_cast(bf16x8, w); }
#define MFMA16(a, b, c) __builtin_amdgcn_mfma_f32_16x16x32_bf16((a), (b), (c), 0, 0, 0)

DI void attn_wave(const LAS unsigned char* Ks, const LAS unsigned char* Vt, const int VPB, const u32x4 qa, const u32x4 qb, const float* qnw, const float sink2, const int jmin, const int c, const int fq, bf16_t* orow) {
    float qf[16]; unpack8(qa, qf); unpack8(qb, qf + 8);
    float ss = 0.f;
#pragma unroll
    for (int i = 0; i < 16; ++i) ss += qf[i] * qf[i];
    ss = red4rows(ss);
    const float rs = rsqrtf(ss * (1.0f / 64.0f) + EPS) * (0.125f * LOG2E);
    const f32x4 w0 = *(const f32x4*)(qnw + 8 * fq), w1 = *(const f32x4*)(qnw + 8 * fq + 4), w2 = *(const f32x4*)(qnw + 32 + 8 * fq), w3 = *(const f32x4*)(qnw + 36 + 8 * fq);
#pragma unroll
    for (int i = 0; i < 4; ++i) { qf[i] *= rs * w0[i]; qf[4 + i] *= rs * w1[i]; qf[8 + i] *= rs * w2[i]; qf[12 + i] *= rs * w3[i]; }
    u32x4 q0, q1; q0.x = pk2(qf[0], qf[1]); q0.y = pk2(qf[2], qf[3]); q0.z = pk2(qf[4], qf[5]); q0.w = pk2(qf[6], qf[7]);
    q1.x = pk2(qf[8], qf[9]); q1.y = pk2(qf[10], qf[11]); q1.z = pk2(qf[12], qf[13]); q1.w = pk2(qf[14], qf[15]);
    const bf16x8 qB0 = __builtin_bit_cast(bf16x8, q0), qB1 = __builtin_bit_cast(bf16x8, q1);
    f32x4 acc[9];
    float mx = sink2;
#pragma unroll
    for (int T = 0; T < 9; ++T) {
        const LAS unsigned char* kp = Ks + (16 * T + c) * 144 + 16 * fq;
        const bf16x8 a0 = *(const LAS bf16x8*)kp, a1 = *(const LAS bf16x8*)(kp + 64);
        f32x4 s = {0.f, 0.f, 0.f, 0.f};
        s = MFMA16(a0, qB0, s); s = MFMA16(a1, qB1, s);
#pragma unroll
        for (int r = 0; r < 4; ++r) { const int jrel = 16 * T + 4 * fq + r, d = 128 + c - jrel; const bool ok = ((unsigned)d < 128u) && (jrel >= jmin); s[r] = ok ? s[r] : -1e30f; mx = fmaxf(mx, s[r]); }
        acc[T] = s;
    }
    mx = max4rows(mx);
    float sum = 0.f;
#pragma unroll
    for (int T = 0; T < 9; ++T)
#pragma unroll
        for (int r = 0; r < 4; ++r) { const float p = __builtin_amdgcn_exp2f(acc[T][r] - mx); acc[T][r] = p; sum += p; }
    sum = red4rows(sum);
    const float inv = 1.0f / (sum + __builtin_amdgcn_exp2f(sink2 - mx));
    f32x4 o[4];
#pragma unroll
    for (int i = 0; i < 4; ++i) o[i] = (f32x4){0.f, 0.f, 0.f, 0.f};
#pragma unroll
    for (int kk = 0; kk < 5; ++kk) {
        u32x4 pw; pw.x = pk2(acc[2 * kk][0], acc[2 * kk][1]); pw.y = pk2(acc[2 * kk][2], acc[2 * kk][3]);
        if (kk < 4) { pw.z = pk2(acc[2 * kk + 1][0], acc[2 * kk + 1][1]); pw.w = pk2(acc[2 * kk + 1][2], acc[2 * kk + 1][3]); } else { pw.z = 0u; pw.w = 0u; }
        const bf16x8 pB = __builtin_bit_cast(bf16x8, pw);
#pragma unroll
        for (int Mt = 0; Mt < 4; ++Mt) {
            const LAS unsigned char* vp = Vt + (32 * kk + 4 * fq + (c >> 2)) * VPB + (16 * Mt + 4 * (c & 3)) * 2;
            const u32x2 lo = tr4(vp), hi = tr4(vp + 16 * VPB);
            o[Mt] = MFMA16(mk8(lo, hi), pB, o[Mt]);
        }
    }
    if (orow) {
#pragma unroll
        for (int Mt = 0; Mt < 4; ++Mt) { u32x2 w; w.x = pk2(o[Mt][0] * inv, o[Mt][1] * inv); w.y = pk2(o[Mt][2] * inv, o[Mt][3] * inv); *(u32x2*)(orow + 16 * Mt + 4 * fq) = w; }
    }
}

struct Ctx {
    int l;
    const bf16_t* Z; float* LD; bf16_t* MRG; float* DS; bf16_t* SC; float* GL;
    const float *qnw, *knw, *sinks, *gnw;
    const float *cache_k, *cache_v, *state;
    float* out;
};

DI void attn_prompt_unit(const Ctx& C, int uidx, LAS unsigned char* lds, const int wave_s) {
    const int tid = mk_tid(wave_s);
    const int jb = uidx % 65, g = (uidx / 65) & 1, b = uidx / 130;
    const int p0 = 64 * jb, kbase = p0 - 128, rowbase = b * LP, nq = (LP - p0) < 64 ? (LP - p0) : 64;
    LAS unsigned char* Ks = lds; LAS unsigned char* Vs = lds + 208 * 144;
    TICK(0);
    {
        const int dc = tid & 7;
        u32x4 rk[4], rv[4];
#pragma unroll
        for (int i = 0; i < 4; ++i) { const int j = (tid >> 3) + 64 * i, kp = kbase + j; const bool valid = (j < 192) && (kp >= 0) && (kp < LP);
            rk[i] = (u32x4){0u, 0u, 0u, 0u}; rv[i] = rk[i];
            if (valid) { const bf16_t* zr = C.Z + (size_t)(rowbase + kp) * ZP + g * 64 + dc * 8; rk[i] = *(const u32x4*)(zr + ZK); rv[i] = *(const u32x4*)(zr + ZV); } }
        const f32x4 kw0 = *(const f32x4*)(C.knw + dc * 8), kw1 = *(const f32x4*)(C.knw + dc * 8 + 4);
#pragma unroll
        for (int i = 0; i < 4; ++i) { const int j = (tid >> 3) + 64 * i, kp = kbase + j; const bool valid = (j < 192) && (kp >= 0) && (kp < LP);
            float f[8]; unpack8(rk[i], f); float ss = 0.f;
#pragma unroll
            for (int e = 0; e < 8; ++e) ss += f[e] * f[e];
            ss = sum8(ss);
            const float rs = rsqrtf(ss * (1.0f / 64.0f) + EPS);
#pragma unroll
            for (int e = 0; e < 4; ++e) { f[e] *= rs * kw0[e]; f[4 + e] *= rs * kw1[e]; }
            if (j < 208) { u32x4 o; o.x = pk2(f[0], f[1]); o.y = pk2(f[2], f[3]); o.z = pk2(f[4], f[5]); o.w = pk2(f[6], f[7]); *(LAS u32x4*)(Ks + j * 144 + dc * 16) = o; *(LAS u32x4*)(Vs + j * 144 + dc * 16) = rv[i]; }
            if (valid && j >= 128 && kp >= LP - 128) { const size_t oo = ((size_t)((C.l * NBATCH + b) * 128 + (kp - (LP - 128))) * 2 + g) * 64 + dc * 8;
                float* op = C.out + O_CKP + oo; *(f32x4*)op = (f32x4){f[0], f[1], f[2], f[3]}; *(f32x4*)(op + 4) = (f32x4){f[4], f[5], f[6], f[7]};
                float fv[8]; unpack8(rv[i], fv); float* ov = C.out + O_CVP + oo; *(f32x4*)ov = (f32x4){fv[0], fv[1], fv[2], fv[3]}; *(f32x4*)(ov + 4) = (f32x4){fv[4], fv[5], fv[6], fv[7]}; } }
    }
    __syncthreads();
    TICK(4);
    {
        const int tid2 = mk_tid(wave_s), lane = tid2 & 63, w = tid2 >> 6;
        const int s = w & 3, hp = w >> 2, c = lane & 15, fq = lane >> 4;
        if (16 * s < nq) {
            const int qp = p0 + 16 * s + c; const bool qv = qp < LP; const int h0 = g * 4 + hp * 2;
            u32x4 qr[2][2];
#pragma unroll
            for (int hh = 0; hh < 2; ++hh) { qr[hh][0] = (u32x4){0u, 0u, 0u, 0u}; qr[hh][1] = qr[hh][0];
                if (qv) { const bf16_t* qrow = C.Z + (size_t)(rowbase + qp) * ZP + ZQ + (h0 + hh) * 64; qr[hh][0] = *(const u32x4*)(qrow + 8 * fq); qr[hh][1] = *(const u32x4*)(qrow + 32 + 8 * fq); } }
#pragma unroll
            for (int hh = 0; hh < 2; ++hh) { const int h = h0 + hh;
                bf16_t* orow = qv ? C.MRG + (size_t)(rowbase + qp) * DM + h * 64 : nullptr;
                attn_wave(Ks + 16 * s * 144, Vs + 16 * s * 144, 144, qr[hh][0], qr[hh][1], C.qnw, C.sinks[h] * LOG2E, 128 - p0 - 16 * s, c, fq, orow); }
        }
    }
    __syncthreads();
    TICK(5);
}

DI void attn_sample_unit(const Ctx& C, int uidx, LAS unsigned char* lds, const int wave_s) {
    const int tid = mk_tid(wave_s);
    const int g = uidx & 1, b = uidx >> 1;
    constexpr int KSG = 160 * 144;
    TICK(0);
    const int row0 = MPROMPT + b * DECT;
    const size_t cbase = (size_t)(C.l * DECB + b) * 128;
#pragma unroll
    for (int i = 0; i < 2; ++i) {
        const int idx = tid + 512 * i, dc = idx & 7, j = idx >> 3;
        const size_t so = ((cbase + j) * 2 + g) * 64 + dc * 8;
        const f32x4 a = __builtin_nontemporal_load((const f32x4*)(C.cache_k + so)), bq = __builtin_nontemporal_load((const f32x4*)(C.cache_k + so + 4)), va = __builtin_nontemporal_load((const f32x4*)(C.cache_v + so)), vb = __builtin_nontemporal_load((const f32x4*)(C.cache_v + so + 4));
        u32x4 o; o.x = pk2(a[0], a[1]); o.y = pk2(a[2], a[3]); o.z = pk2(bq[0], bq[1]); o.w = pk2(bq[2], bq[3]);
        *(LAS u32x4*)(lds + j * 144 + dc * 16) = o;
        u32x4 ov; ov.x = pk2(va[0], va[1]); ov.y = pk2(va[2], va[3]); ov.z = pk2(vb[0], vb[1]); ov.w = pk2(vb[2], vb[3]);
        *(LAS u32x4*)(lds + KSG + j * 144 + dc * 16) = ov;
        if (j >= 8) { const size_t oo = ((cbase + j - 8) * 2 + g) * 64 + dc * 8; float* op = C.out + O_CKS + oo; __builtin_nontemporal_store(a, (f32x4*)op); __builtin_nontemporal_store(bq, (f32x4*)(op + 4)); float* opv = C.out + O_CVS + oo; __builtin_nontemporal_store(va, (f32x4*)opv); __builtin_nontemporal_store(vb, (f32x4*)(opv + 4)); }
    }
    if (tid < 64) {
        const int dc = tid & 7, t = tid >> 3;
        const bf16_t* zr = C.Z + (size_t)(row0 + t) * ZP + g * 64 + dc * 8;
        const u32x4 raw = *(const u32x4*)(zr + ZK), rawv = *(const u32x4*)(zr + ZV);
        float f[8]; unpack8(raw, f); float ss = 0.f;
#pragma unroll
        for (int e = 0; e < 8; ++e) ss += f[e] * f[e];
        ss = sum8(ss);
        const float rs = rsqrtf(ss * (1.0f / 64.0f) + EPS);
        const f32x4 kw0 = *(const f32x4*)(C.knw + dc * 8), kw1 = *(const f32x4*)(C.knw + dc * 8 + 4);
#pragma unroll
        for (int e = 0; e < 4; ++e) { f[e] *= rs * kw0[e]; f[4 + e] *= rs * kw1[e]; }
        u32x4 o; o.x = pk2(f[0], f[1]); o.y = pk2(f[2], f[3]); o.z = pk2(f[4], f[5]); o.w = pk2(f[6], f[7]);
        *(LAS u32x4*)(lds + (128 + t) * 144 + dc * 16) = o;
        *(LAS u32x4*)(lds + KSG + (128 + t) * 144 + dc * 16) = rawv;
        const size_t oo = ((cbase + 120 + t) * 2 + g) * 64 + dc * 8;
        float* op = C.out + O_CKS + oo; *(f32x4*)op = (f32x4){f[0], f[1], f[2], f[3]}; *(f32x4*)(op + 4) = (f32x4){f[4], f[5], f[6], f[7]};
        float fv[8]; unpack8(rawv, fv); float* opv = C.out + O_CVS + oo; *(f32x4*)opv = (f32x4){fv[0], fv[1], fv[2], fv[3]}; *(f32x4*)(opv + 4) = (f32x4){fv[4], fv[5], fv[6], fv[7]};
    } else if (tid < 256) {
        const int idx = tid - 64, dc = idx & 7, r = idx >> 3;
        unsigned z0 = 0u; asm volatile("" : "+v"(z0));
        *(LAS u32x4*)(lds + (136 + r) * 144 + dc * 16) = (u32x4){z0, z0, z0, z0};
        *(LAS u32x4*)(lds + KSG + (136 + r) * 144 + dc * 16) = (u32x4){z0, z0, z0, z0};
    }
    __syncthreads();
    {
        const int tid2 = mk_tid(wave_s), lane = tid2 & 63, w2 = tid2 >> 6;
        if (w2 < 4) {
            const int h = g * 4 + w2, c = lane & 15, fq = lane >> 4;
            const bool qv = c < 8;
            const bf16_t* qrow = C.Z + (size_t)(row0 + (c & 7)) * ZP + ZQ + h * 64;
            const u32x4 qa = *(const u32x4*)(qrow + 8 * fq), qb = *(const u32x4*)(qrow + 32 + 8 * fq);
            bf16_t* orow = qv ? C.MRG + (size_t)(row0 + c) * DM + h * 64 : nullptr;
            attn_wave(lds, lds + KSG, 144, qa, qb, C.qnw, C.sinks[h] * LOG2E, 0, c, fq, orow);
        }
    }
    __syncthreads();
    TICK(8);
}

DI void gla_sample_unit(const Ctx& C, int uidx, LAS unsigned char* lds, const int wave_s) {
    const int tid = mk_tid(wave_s);
    const int h = uidx & 3, b = uidx >> 2, row0 = MPROMPT + b * DECT;
    TICK(0);
    LAS float* qs = (LAS float*)lds; LAS float* ks = qs + 512; LAS float* dec = ks + 512; LAS float* vs = dec + 512; LAS float* red = vs + 1024;
    {
        const int t = tid >> 6, k = tid & 63; const bf16_t* zr = C.Z + (size_t)(row0 + t) * ZP;
        qs[tid] = bf2f(zr[ZGQ + h * 64 + k]); ks[tid] = bf2f(zr[ZGK + h * 64 + k]); dec[tid] = __expf(C.LD[(size_t)(row0 + t) * 256 + h * 64 + k]);
#pragma unroll
        for (int i = 0; i < 2; ++i) { const int idx = tid + 512 * i, tt = idx >> 7, v = idx & 127; vs[idx] = bf2f(C.Z[(size_t)(row0 + tt) * ZP + ZGV + h * 128 + v]); }
    }
    const int v = tid & 127, kq = tid >> 7;
    const size_t sbase = ((size_t)((C.l * DECB + b) * 4 + h) * 64 + 16 * kq) * 128 + v;
    float S[16];
#pragma unroll
    for (int i = 0; i < 16; ++i) S[i] = __builtin_nontemporal_load(C.state + sbase + (size_t)i * 128);
    __syncthreads();
#pragma unroll
    for (int t = 0; t < 8; ++t) { float a = 0.f; const float vv = vs[t * 128 + v];
#pragma unroll
        for (int i = 0; i < 16; ++i) { const int k = 16 * kq + i; S[i] = dec[t * 64 + k] * S[i] + ks[t * 64 + k] * vv; a += qs[t * 64 + k] * S[i]; }
        red[(kq * 8 + t) * 128 + v] = a; }
    float* so = C.out + O_SS + sbase;
#pragma unroll
    for (int i = 0; i < 16; ++i) __builtin_nontemporal_store(S[i], so + (size_t)i * 128);
    __syncthreads();
    {
        const int t = tid >> 6, lane = tid & 63; float o[2]; float ss = 0.f;
#pragma unroll
        for (int i = 0; i < 2; ++i) { const int vv = lane + 64 * i; o[i] = (red[(0 * 8 + t) * 128 + vv] + red[(1 * 8 + t) * 128 + vv]) + (red[(2 * 8 + t) * 128 + vv] + red[(3 * 8 + t) * 128 + vv]); ss += o[i] * o[i]; }
        ss = sum64(ss);
        const float rs = rsqrtf(ss * (1.0f / 128.0f) + EPS);
#pragma unroll
        for (int i = 0; i < 2; ++i) { const int vv = lane + 64 * i; const float og = bf2f(C.Z[(size_t)(row0 + t) * ZP + ZOG + h * 128 + vv]);
            const float y = o[i] * rs * C.gnw[vv] * silu_f(og); C.MRG[(size_t)(row0 + t) * DM + 512 + h * 128 + vv] = (bf16_t)(pk2(y, 0.f) & 0xffffu); }
    }
    __syncthreads();
    TICK(9);
}

DI void gla_prefix_load(const float* LD, int r0, int nv, int h, int lane, int w, float (&g)[16]) {
#pragma unroll
    for (int i = 0; i < 16; ++i) { const int t = 16 * w + i; g[i] = t < nv ? LD[(size_t)(r0 + t) * 256 + h * 64 + lane] : 0.f; }
}
DI float gla_prefix_finish(float (&g)[16], LAS float* Gs, LAS float* segtot, int lane, int w) {
    const int k = lane, seg = w;
#pragma unroll
    for (int i = 1; i < 16; ++i) g[i] += g[i - 1];
    segtot[seg * 64 + k] = g[15];
    __syncthreads();
    float off = 0.f, tot = 0.f;
#pragma unroll
    for (int s = 0; s < 8; ++s) { const float x = segtot[s * 64 + k]; off += (s < seg) ? x : 0.f; tot += x; }
#pragma unroll
    for (int i = 0; i < 16; ++i) { const int t = 16 * seg + i; Gs[t * 65 + k] = g[i] + off; }
    return tot;
}

DI void gla1_unit(const Ctx& C, int unit, LAS unsigned char* lds, const int wave_s) {
    const int tid = mk_tid(wave_s);
    const int c = unit % NCH, bh = unit / NCH, h = bh & 3, b = bh >> 2;
    const int r0 = b * LP + 128 * c, nv = (LP - 128 * c) < 128 ? (LP - 128 * c) : 128;
    LAS float* Gs = (LAS float*)lds; LAS float* segtot = (LAS float*)(lds + 33280); LAS float* gl = (LAS float*)(lds + 35328);
    LAS unsigned char* kdS = lds + 35840; LAS unsigned char* Vs = lds + 54272;
    const int lane = tid & 63, w = tid >> 6;
    TICK(0);
    float g[16]; gla_prefix_load(C.LD, r0, nv, h, lane, w, g);
    u32x4 rk[2], rv[4];
#pragma unroll
    for (int i = 0; i < 2; ++i) { const int t = (tid >> 3) + 64 * i; rk[i] = (u32x4){0u, 0u, 0u, 0u}; if (t < nv) rk[i] = *(const u32x4*)(C.Z + (size_t)(r0 + t) * ZP + ZGK + h * 64 + (tid & 7) * 8); }
#pragma unroll
    for (int i = 0; i < 4; ++i) { const int t = (tid >> 4) + 32 * i; rv[i] = (u32x4){0u, 0u, 0u, 0u}; if (t < nv) rv[i] = *(const u32x4*)(C.Z + (size_t)(r0 + t) * ZP + ZGV + h * 128 + (tid & 15) * 8); }
    { const float tot = gla_prefix_finish(g, Gs, segtot, lane, w); if (w == 0) { gl[lane] = tot; C.GL[(size_t)unit * 64 + lane] = tot; } }
#pragma unroll
    for (int i = 0; i < 4; ++i) { const int t = (tid >> 4) + 32 * i; *(LAS u32x4*)(Vs + t * 272 + (tid & 15) * 16) = rv[i]; }
    __syncthreads();
    {
        const int kc = tid & 7;
#pragma unroll
        for (int i = 0; i < 2; ++i) { const int t = (tid >> 3) + 64 * i; float f[8]; unpack8(rk[i], f);
#pragma unroll
            for (int e = 0; e < 8; ++e) f[e] *= __expf(gl[kc * 8 + e] - Gs[t * 65 + kc * 8 + e]);
            u32x4 o; o.x = pk2(f[0], f[1]); o.y = pk2(f[2], f[3]); o.z = pk2(f[4], f[5]); o.w = pk2(f[6], f[7]); *(LAS u32x4*)(kdS + t * 144 + kc * 16) = o; }
    }
    __syncthreads();
    {
        const int cc = lane & 15, fq = lane >> 4;
#pragma unroll
        for (int kt = 0; kt < 4; ++kt) { f32x4 acc = {0.f, 0.f, 0.f, 0.f};
#pragma unroll
            for (int ks = 0; ks < 4; ++ks) {
                const LAS unsigned char* ap = kdS + (32 * ks + 8 * fq + (cc >> 2)) * 144 + (16 * kt + 4 * (cc & 3)) * 2;
                const LAS unsigned char* bp = Vs + (32 * ks + 8 * fq + (cc >> 2)) * 272 + (16 * w + 4 * (cc & 3)) * 2;
                acc = MFMA16(mk8(tr4(ap), tr4(ap + 4 * 144)), mk8(tr4(bp), tr4(bp + 4 * 272)), acc); }
#pragma unroll
            for (int r = 0; r < 4; ++r) C.DS[((size_t)unit * 64 + 16 * kt + 4 * fq + r) * 128 + 16 * w + cc] = acc[r]; }
    }
    __syncthreads();
    TICK(6);
}

DI void gla3_unit(const Ctx& C, int unit, LAS unsigned char* lds, const int wave_s) {
    const int tid = mk_tid(wave_s);
    const int c = unit % NCH, bh = unit / NCH, h = bh & 3, b = bh >> 2;
    const int r0 = b * LP + 128 * c, nv = (LP - 128 * c) < 128 ? (LP - 128 * c) : 128;
    LAS unsigned char* qg = lds; LAS unsigned char* kg = lds + 18432; LAS unsigned char* Vs = lds + 36864; LAS unsigned char* Ss = lds + 71680;
    LAS float* Gs = (LAS float*)(lds + 89088); LAS float* segtot = (LAS float*)(lds + 122368);
    const int lane = tid & 63, w = __builtin_amdgcn_readfirstlane(tid >> 6);
    TICK(0);
    float g[16]; gla_prefix_load(C.LD, r0, nv, h, lane, w, g);
    u32x4 rq[2], rk[2], rv[4], rs_[2];
#pragma unroll
    for (int i = 0; i < 2; ++i) { const int t = (tid >> 3) + 64 * i; rq[i] = (u32x4){0u, 0u, 0u, 0u}; rk[i] = rq[i];
        if (t < nv) { const bf16_t* zr = C.Z + (size_t)(r0 + t) * ZP + h * 64 + (tid & 7) * 8; rq[i] = *(const u32x4*)(zr + ZGQ); rk[i] = *(const u32x4*)(zr + ZGK); } }
#pragma unroll
    for (int i = 0; i < 4; ++i) { const int t = (tid >> 4) + 32 * i; rv[i] = (u32x4){0u, 0u, 0u, 0u}; if (t < nv) rv[i] = *(const u32x4*)(C.Z + (size_t)(r0 + t) * ZP + ZGV + h * 128 + (tid & 15) * 8); }
#pragma unroll
    for (int i = 0; i < 2; ++i) { const int k = (tid >> 4) + 32 * i; rs_[i] = *(const u32x4*)(C.SC + ((size_t)unit * 64 + k) * 128 + (tid & 15) * 8); }
    (void)gla_prefix_finish(g, Gs, segtot, lane, w);
#pragma unroll
    for (int i = 0; i < 4; ++i) { const int t = (tid >> 4) + 32 * i; *(LAS u32x4*)(Vs + t * 272 + (tid & 15) * 16) = rv[i]; }
#pragma unroll
    for (int i = 0; i < 2; ++i) { const int k = (tid >> 4) + 32 * i; *(LAS u32x4*)(Ss + k * 272 + (tid & 15) * 16) = rs_[i]; }
    __syncthreads();
    TICK(1);
    {
        const int kc = tid & 7;
#pragma unroll
        for (int i = 0; i < 2; ++i) { const int t = (tid >> 3) + 64 * i; float fq_[8], fk_[8]; unpack8(rq[i], fq_); unpack8(rk[i], fk_);
#pragma unroll
            for (int e = 0; e < 8; ++e) { const float ev = __expf(Gs[t * 65 + kc * 8 + e]); fq_[e] *= ev; fk_[e] *= __builtin_amdgcn_rcpf(ev); }
            u32x4 oq, ok; oq.x = pk2(fq_[0], fq_[1]); oq.y = pk2(fq_[2], fq_[3]); oq.z = pk2(fq_[4], fq_[5]); oq.w = pk2(fq_[6], fq_[7]);
            ok.x = pk2(fk_[0], fk_[1]); ok.y = pk2(fk_[2], fk_[3]); ok.z = pk2(fk_[4], fk_[5]); ok.w = pk2(fk_[6], fk_[7]);
            *(LAS u32x4*)(qg + t * 144 + kc * 16) = oq; *(LAS u32x4*)(kg + t * 144 + kc * 16) = ok; }
    }
    __syncthreads();
    TICK(2);
    {
        const int cc = lane & 15, fq = lane >> 4;
        const int t = 16 * w + cc; const size_t row = (size_t)(r0 + (t < nv ? t : 0));
        u32x2 og[8];
#pragma unroll
        for (int Mt = 0; Mt < 8; ++Mt) og[Mt] = *(const u32x2*)(C.Z + row * ZP + ZOG + h * 128 + 16 * Mt + 4 * fq);
        const bf16x8 qB0 = *(const LAS bf16x8*)(qg + (16 * w + cc) * 144 + 16 * fq), qB1 = *(const LAS bf16x8*)(qg + (16 * w + cc) * 144 + 64 + 16 * fq);
        f32x4 A[8];
#pragma unroll
        for (int T = 0; T < 8; ++T) { f32x4 sa = {0.f, 0.f, 0.f, 0.f};
            const LAS unsigned char* kp = kg + (16 * T + cc) * 144 + 16 * fq; const bf16x8 a0 = *(const LAS bf16x8*)kp, a1 = *(const LAS bf16x8*)(kp + 64);
            sa = MFMA16(a0, qB0, sa); sa = MFMA16(a1, qB1, sa);
#pragma unroll
            for (int r = 0; r < 4; ++r) sa[r] = (16 * T + 4 * fq + r > t) ? 0.f : sa[r];
            A[T] = sa; }
        bf16x8 P[4];
#pragma unroll
        for (int kk = 0; kk < 4; ++kk) { u32x4 pw; pw.x = pk2(A[2 * kk][0], A[2 * kk][1]); pw.y = pk2(A[2 * kk][2], A[2 * kk][3]); pw.z = pk2(A[2 * kk + 1][0], A[2 * kk + 1][1]); pw.w = pk2(A[2 * kk + 1][2], A[2 * kk + 1][3]); P[kk] = __builtin_bit_cast(bf16x8, pw); }
        f32x4 o[8]; float ss = 0.f;
#pragma unroll
        for (int Mt = 0; Mt < 8; ++Mt) o[Mt] = (f32x4){0.f, 0.f, 0.f, 0.f};
#pragma unroll
        for (int kk = 0; kk < 4; ++kk)
#pragma unroll
            for (int Mt = 0; Mt < 8; ++Mt) {
                const LAS unsigned char* vp = Vs + (32 * kk + 4 * fq + (cc >> 2)) * 272 + (16 * Mt + 4 * (cc & 3)) * 2;
                o[Mt] = MFMA16(mk8(tr4(vp), tr4(vp + 16 * 272)), P[kk], o[Mt]); }
#pragma unroll
        for (int ks = 0; ks < 2; ++ks)
#pragma unroll
            for (int Mt = 0; Mt < 8; ++Mt) {
                const LAS unsigned char* sp = Ss + (32 * ks + 8 * fq + (cc >> 2)) * 272 + (16 * Mt + 4 * (cc & 3)) * 2;
                o[Mt] = MFMA16(mk8(tr4(sp), tr4(sp + 4 * 272)), ks ? qB1 : qB0, o[Mt]); }
#pragma unroll
        for (int Mt = 0; Mt < 8; ++Mt) ss += (o[Mt][0] * o[Mt][0] + o[Mt][1] * o[Mt][1]) + (o[Mt][2] * o[Mt][2] + o[Mt][3] * o[Mt][3]);
        ss = red4rows(ss);
        const float rs = rsqrtf(ss * (1.0f / 128.0f) + EPS);
        if (t < nv) {
#pragma unroll
            for (int Mt = 0; Mt < 8; ++Mt) { const int v0 = 16 * Mt + 4 * fq; const f32x4 gn = *(const f32x4*)(C.gnw + v0);
                const float y0 = o[Mt][0] * rs * gn[0] * silu_f(bflo(og[Mt].x)), y1 = o[Mt][1] * rs * gn[1] * silu_f(bfhi(og[Mt].x)), y2 = o[Mt][2] * rs * gn[2] * silu_f(bflo(og[Mt].y)), y3 = o[Mt][3] * rs * gn[3] * silu_f(bfhi(og[Mt].y));
                u32x2 wv; wv.x = pk2(y0, y1); wv.y = pk2(y2, y3); *(u32x2*)(C.MRG + row * DM + 512 + h * 128 + v0) = wv; } }
    }
    __syncthreads();
    TICK(3);
}

DI void gla_scan(const Ctx& C, int gtid, int gthreads) {
    for (int idx = gtid; idx < 16 * 64 * 128; idx += gthreads) {
        const int v = idx & 127, k = (idx >> 7) & 63, bh = idx >> 13;
        const size_t u0 = (size_t)bh * NCH;
        float ds[NCH], dg[NCH];
#pragma unroll
        for (int c = 0; c < NCH; ++c) { ds[c] = C.DS[((u0 + c) * 64 + k) * 128 + v]; dg[c] = C.GL[(u0 + c) * 64 + k]; }
        float S = 0.f;
#pragma unroll
        for (int c = 0; c < NCH; ++c) { C.SC[((u0 + c) * 64 + k) * 128 + v] = (bf16_t)(pk2(S, 0.f) & 0xffffu); S = __expf(dg[c]) * S + ds[c]; }
        const int h = bh & 3, b = bh >> 2;
        C.out[O_SP + ((size_t)((C.l * NBATCH + b) * 4 + h) * 64 + k) * 128 + v] = S;
    }
}

struct WSrc { int mat; const float* W; const float* W2; const float* gain; const float* wg2; };
DI float wsrc(const WSrc& s, int k, int n) {
    if (s.mat == 0) {
        if (n < 2304) { const int col = n < 1792 ? n : n + 16; const float sc = (n >= 768 && n < 1024) ? 0.125f : 1.0f; return s.W[(size_t)k * INW + col] * s.gain[k] * sc; }
        const int e = n - 2304; float a = 0.f;
#pragma unroll
        for (int r = 0; r < 16; ++r) a += s.W[(size_t)k * INW + 1792 + r] * s.wg2[r * 256 + e];
        return a * s.gain[k];
    } else if (s.mat == 1) { return s.W[(size_t)k * DM + n];
    } else if (s.mat == 2) { const int pn = n >> 8, j = n & 255; return (j < 128 ? s.W[(size_t)k * DFFN + 128 * pn + j] : s.W2[(size_t)k * DFFN + 128 * pn + j - 128]) * s.gain[k];
    } else { return s.W[(size_t)k * DM + n]; }
}
DI f32x4 wsrc4(const WSrc& s, int k, int n) {
    if (s.mat == 0) { const int col = n < 1792 ? n : n + 16; const float sc = ((n >= 768 && n < 1024) ? 0.125f : 1.0f) * s.gain[k]; return __builtin_nontemporal_load((const f32x4*)(s.W + (size_t)k * INW + col)) * sc; }
    else if (s.mat == 1) return __builtin_nontemporal_load((const f32x4*)(s.W + (size_t)k * DM + n));
    else if (s.mat == 2) { const int pn = n >> 8, j = n & 255; const float* src = j < 128 ? s.W + (size_t)k * DFFN + 128 * pn + j : s.W2 + (size_t)k * DFFN + 128 * pn + j - 128; return __builtin_nontemporal_load((const f32x4*)src) * s.gain[k]; }
    else return __builtin_nontemporal_load((const f32x4*)(s.W + (size_t)k * DM + n));
}
DI void conv_item_lr(const WSrc& s, int K, bf16_t* WT, LAS float* scr, int item, int lane) {
    const int kb = item >> 3, nb = item & 7, k0 = 64 * kb, n0 = 2304 + 32 * nb;
    const int e = lane & 31; float g2[16];
#pragma unroll
    for (int r = 0; r < 16; ++r) g2[r] = s.wg2[r * 256 + 32 * nb + e];
#pragma unroll 8
    for (int i = 0; i < 32; ++i) { const int kk = 2 * i + (lane >> 5); const f32x4* wp = (const f32x4*)(s.W + (size_t)(k0 + kk) * INW + 1792);
        const f32x4 a = wp[0], b = wp[1], c4 = wp[2], d = wp[3];
        const float acc = ((a[0] * g2[0] + a[1] * g2[1]) + (a[2] * g2[2] + a[3] * g2[3])) + ((b[0] * g2[4] + b[1] * g2[5]) + (b[2] * g2[6] + b[3] * g2[7]))
                        + ((c4[0] * g2[8] + c4[1] * g2[9]) + (c4[2] * g2[10] + c4[3] * g2[11])) + ((d[0] * g2[12] + d[1] * g2[13]) + (d[2] * g2[14] + d[3] * g2[15]));
        scr[kk * 33 + e] = acc * s.gain[k0 + kk]; }
    asm volatile("s_waitcnt lgkmcnt(0)" ::: "memory");
    const int c = lane & 7;
#pragma unroll
    for (int j = 0; j < 4; ++j) { const int n = (lane >> 3) + 8 * j; const LAS float* sp = scr + (8 * c) * 33 + n;
        u32x4 o; o.x = pk2(sp[0 * 33], sp[1 * 33]); o.y = pk2(sp[2 * 33], sp[3 * 33]); o.z = pk2(sp[4 * 33], sp[5 * 33]); o.w = pk2(sp[6 * 33], sp[7 * 33]);
        *(u32x4*)(WT + (size_t)(n0 + n) * K + k0 + 8 * c) = o; }
    asm volatile("s_waitcnt lgkmcnt(0)" ::: "memory");
}
DI void conv_item(const WSrc& s, int K, int nblk, bf16_t* WT, LAS unsigned char* tile, int item, int lane) {
    const int kb = item / nblk, nb = item % nblk, k0 = 64 * kb, n0 = 64 * nb;
    const int krow = lane >> 4, n4 = (lane & 15) * 4;
    f32x4 v[16];
#pragma unroll
    for (int st = 0; st < 16; ++st) v[st] = wsrc4(s, k0 + 4 * st + krow, n0 + n4);
#pragma unroll
    for (int st = 0; st < 16; ++st) { u32x2 w; w.x = pk2(v[st][0], v[st][1]); w.y = pk2(v[st][2], v[st][3]); *(LAS u32x2*)(tile + (4 * st + krow) * 136 + n4 * 2) = w; }
    asm volatile("s_waitcnt lgkmcnt(0)" ::: "memory");
    const int i = lane & 15, fq = lane >> 4;
#pragma unroll
    for (int q = 0; q < 2; ++q)
#pragma unroll
        for (int nbk = 0; nbk < 4; ++nbk) { const int kg = 4 * q + fq;
            const LAS unsigned char* tp = tile + (8 * kg + (i >> 2)) * 136 + (16 * nbk + 4 * (i & 3)) * 2;
            const u32x2 lo = tr4(tp), hi = tr4(tp + 4 * 136);
            u32x4 o; o.x = lo.x; o.y = lo.y; o.z = hi.x; o.w = hi.y;
            *(u32x4*)(WT + (size_t)(n0 + 16 * nbk + i) * K + k0 + 8 * kg) = o; }
    asm volatile("s_waitcnt lgkmcnt(0)" ::: "memory");
}
constexpr int NI_IN = 16 * 36, NI_LR = 16 * 8, NI_O = 16 * 16, NI_GU = 16 * 88, NI_D = 44 * 16, NI_L = NI_IN + NI_LR + NI_O + NI_GU + NI_D;

DI void prologue(KA ap, const RowMap& rm, LAS unsigned char* lds, int tid, int vcu, int G) {
    const int lane = tid & 63, wave = tid >> 6, gw = vcu * 8 + wave, NGW = G * 8;
    LAS unsigned char* tile = lds + wave * 16384;
    for (int it = gw; it < DEPTH * NI_L; it += NGW) {
        const int l = it / NI_L; int r = it % NI_L;
        unsigned char* wl = ap->ws + WS_W + (size_t)l * SZ_WL;
        if (r < NI_IN) { WSrc s{0, ap->in[7] + (size_t)l * DM * INW, nullptr, ap->in[6] + l * DM, nullptr}; conv_item(s, DM, 36, (bf16_t*)wl, tile, r, lane); continue; } r -= NI_IN;
        if (r < NI_LR) { WSrc s{0, ap->in[7] + (size_t)l * DM * INW, nullptr, ap->in[6] + l * DM, ap->in[11] + l * 16 * 256}; conv_item_lr(s, DM, (bf16_t*)wl, (LAS float*)tile, r, lane); continue; } r -= NI_LR;
        if (r < NI_O) { WSrc s{1, ap->in[14] + (size_t)l * DM * DM, nullptr, nullptr, nullptr}; conv_item(s, DM, 16, (bf16_t*)(wl + SZ_WIN), tile, r, lane); continue; } r -= NI_O;
        if (r < NI_GU) { WSrc s{2, ap->in[16] + (size_t)l * DM * DFFN, ap->in[17] + (size_t)l * DM * DFFN, ap->in[15] + l * DM, nullptr}; conv_item(s, DM, 88, (bf16_t*)(wl + SZ_WIN + SZ_WO), tile, r, lane); continue; } r -= NI_GU;
        { WSrc s{3, ap->in[18] + (size_t)l * DFFN * DM, nullptr, nullptr, nullptr}; conv_item(s, DFFN, 16, (bf16_t*)(wl + SZ_WIN + SZ_WO + SZ_WGU), tile, r, lane); }
    }
    bf16_t* XB = (bf16_t*)(ap->ws + WS_XB); bf16_t* MRG = (bf16_t*)(ap->ws + WS_MRG); float* ssqA = (float*)(ap->ws + WS_SSQA);
    for (int m = gw; m < MP; m += NGW) {
        const float* ip = row_in(rm, m); f32x4 v[4]; float s = 0.f;
#pragma unroll
        for (int j = 0; j < 4; ++j) { v[j] = ip ? __builtin_nontemporal_load((const f32x4*)ip + lane + 64 * j) : (f32x4){0.f, 0.f, 0.f, 0.f}; s += (v[j][0] * v[j][0] + v[j][1] * v[j][1]) + (v[j][2] * v[j][2] + v[j][3] * v[j][3]); }
        s = sum64(s);
#pragma unroll
        for (int j = 0; j < 4; ++j) { u32x2 w; w.x = pk2(v[j][0], v[j][1]); w.y = pk2(v[j][2], v[j][3]); ((u32x2*)(XB + (size_t)m * DM))[lane + 64 * j] = w; if (!ip) ((u32x2*)(MRG + (size_t)m * DM))[lane + 64 * j] = (u32x2){0u, 0u}; }
        if (lane < 16) ssqA[(size_t)m * 16 + lane] = lane == 0 ? s : 0.f;
    }
}

#define XB_TMO      128
#define XB_XCNT(j)  (256  + 64 * (j))
#define XB_XSUB(j)  (1280 + 64 * (j))
#define XB_XGEN(j)  (2304 + 64 * (j))
#define XB_TOP      3328
#define XB_TOPGEN   3392
#define XCD_BAR_WORDS 3456
#define XB_SPIN_CAP (1u << 18)

__device__ __forceinline__ unsigned xb_ld(unsigned* p)              { return __hip_atomic_load(p, __ATOMIC_RELAXED, __HIP_MEMORY_SCOPE_AGENT); }
__device__ __forceinline__ unsigned xb_add(unsigned* p, unsigned v) { return __hip_atomic_fetch_add(p, v, __ATOMIC_RELAXED, __HIP_MEMORY_SCOPE_AGENT); }
__device__ __forceinline__ unsigned xb_xcc_id() { return (unsigned)__builtin_amdgcn_s_getreg((3 << 11) | 20) & 0xFu; }
#define XB_SPIN(cond, bar) do { unsigned _sp = 0; while (cond) { __builtin_amdgcn_s_sleep(1); \
    if ((++_sp & 255u) == 0u) { if (xb_ld(&(bar)[XB_TMO])) break; if (_sp > XB_SPIN_CAP) { atomicAdd(&(bar)[XB_TMO], 1u); break; } } } } while (0)

struct XcdBarrier {
    unsigned* bar; unsigned x;
    volatile LAS unsigned* st;
};

__device__ __forceinline__ XcdBarrier xcd_barrier_post(unsigned* bar, volatile LAS unsigned* st, const bool t0) {
    XcdBarrier b; b.bar = bar; b.x = xb_xcc_id(); b.st = st;
    if (t0) (void)xb_add(&bar[XB_XCNT(b.x)], 1u);
    return b;
}
__device__ __forceinline__ void xcd_barrier_complete(unsigned* bar, unsigned x, unsigned& nloc, unsigned& nx) {
    const unsigned G = gridDim.x * gridDim.y * gridDim.z;
    unsigned sum, cnt, mine, sp = 0u;
    for (;;) {
        sum = 0u; cnt = 0u; mine = 0u;
#pragma unroll
        for (unsigned j = 0; j < 16; ++j) { const unsigned c = xb_ld(&bar[XB_XCNT(j)]); sum += c; cnt += (c > 0u) ? 1u : 0u; mine = (j == x) ? c : mine; }
        if (sum == G) break;
        __builtin_amdgcn_s_sleep(1);
        if ((++sp & 255u) == 0u) { if (xb_ld(&bar[XB_TMO])) break; if (sp > XB_SPIN_CAP) { atomicAdd(&bar[XB_TMO], 1u); break; } }
    }
    nloc = mine > 0u ? mine : 1u; nx = cnt > 0u ? cnt : 1u;
}

__device__ __forceinline__ void xcd_barrier(const XcdBarrier& b, const bool t0) {
    asm volatile("s_waitcnt vmcnt(0)" ::: "memory");
    __syncthreads();
    if (t0) {
        unsigned* bar = b.bar;
        __builtin_amdgcn_s_waitcnt(0);
        unsigned nloc = b.st[0], nx = b.st[1];
        if (nloc == 0u) { xcd_barrier_complete(bar, b.x, nloc, nx); b.st[0] = nloc; b.st[1] = nx; }
        const unsigned old = xb_add(&bar[XB_XSUB(b.x)], 1u);
        const unsigned gen = old / nloc;
        if (old + 1u == (gen + 1u) * nloc) {
            __builtin_amdgcn_fence(__ATOMIC_RELEASE, "agent");
            asm volatile("s_waitcnt vmcnt(0)" ::: "memory");
            const unsigned og = xb_add(&bar[XB_TOP], 1u);
            const unsigned tg = og / nx;
            if (og + 1u == (tg + 1u) * nx) xb_add(&bar[XB_TOPGEN], 1u);
            else XB_SPIN(xb_ld(&bar[XB_TOPGEN]) == tg, bar);
            __builtin_amdgcn_fence(__ATOMIC_ACQUIRE, "agent");
            xb_add(&bar[XB_XGEN(b.x)], 1u);
            asm volatile("s_waitcnt vmcnt(0)" ::: "memory");
        } else {
            XB_SPIN(xb_ld(&bar[XB_XGEN(b.x)]) == gen, bar);
            __builtin_amdgcn_fence(__ATOMIC_ACQUIRE, "agent");
            asm volatile("s_waitcnt vmcnt(0)" ::: "memory");
        }
    }
    __syncthreads();
}

template <class T> DI T* opq(T* p) { asm volatile("" : "+s"(p)); return p; }
DI Ctx make_ctx(int l) {
    KA ap = ka_ptr(); unsigned char* ws = ap->ws;
    Ctx C; C.l = l; C.Z = (const bf16_t*)(ws + WS_Z); C.LD = (float*)(ws + WS_LD); C.MRG = (bf16_t*)(ws + WS_MRG); C.DS = (float*)(ws + WS_DS); C.SC = (bf16_t*)(ws + WS_SC); C.GL = (float*)(ws + WS_GL);
    C.qnw = ap->in[8] + l * 64; C.knw = ap->in[9] + l * 64; C.sinks = ap->in[10] + l * 8; C.gnw = ap->in[13] + l * 128;
    C.cache_k = ap->in[2]; C.cache_v = ap->in[3]; C.state = ap->in[4]; C.out = ap->out;
    return C;
}
DI RowMap make_rm() { KA ap = ka_ptr(); float* out = ap->out; unsigned char* ws = ap->ws; return RowMap{ap->in[0], ap->in[1], ap->in[5], out + O_YP, out + O_YS, (float*)(ws + WS_XMETA)}; }

__global__ void __launch_bounds__(512, 2) hymba_fwd(Args a) {
    extern __shared__ __attribute__((aligned(16))) unsigned char lds_raw[];
    LAS unsigned char* lds = (LAS unsigned char*)lds_raw;
    const int G = gridDim.x, bx = blockIdx.x; const int wave_s = __builtin_amdgcn_readfirstlane((int)threadIdx.x >> 6);
#define opaque_tid() mk_tid(wave_s)
    const int vcu = (G % 8 == 0) ? (bx % 8) * (G / 8) + bx / 8 : bx;
    const int lo = ka_ptr()->ph_lo, hi = ka_ptr()->ph_hi;
#define IN(k) (lo <= (k) && (k) < hi)
#ifndef FAST_BAR
#define FAST_BAR 1
#endif
    volatile LAS unsigned* MISC = (volatile LAS unsigned*)(lds + 131072 + 320);
    { const int t = opaque_tid(); if (t < 160) MISC[t] = 0u; __syncthreads(); }
    XcdBarrier bar = xcd_barrier_post((unsigned*)ka_ptr()->ws, MISC + 8, opaque_tid() == 0);
#define GSYNC() do { if (FAST_BAR) xcd_barrier(bar, opaque_tid() == 0); else cg::this_grid().sync(); } while (0)
#define STAMP(k) do { if (TIME_PH >= 0 && bx == 0 && opaque_tid() == 0) { const unsigned long long t_ = __builtin_amdgcn_s_memrealtime(); MISC[16 + 2 * (k)] = (unsigned)t_; MISC[17 + 2 * (k)] = (unsigned)(t_ >> 32); } } while (0)
#define SEAM(k) do { if (TIME_BUSY) STAMP(32 + (k)); if (IN(k) && IN((k) + 1)) { GSYNC(); } STAMP((k) + 1); } while (0)
    if (lo < 0) cg::this_grid().sync();
    STAMP(0);
    if (IN(0)) { for (int rep = 0; rep < REP_PRO; ++rep) { const RowMap rm = make_rm(); prologue(ka_ptr(), rm, lds, opaque_tid(), vcu, G); if (rep + 1 < REP_PRO) GSYNC(); }
        for (int xs = 0; xs < XSYNC; ++xs) GSYNC(); }
    SEAM(0);
#pragma unroll 1
    for (int l = 0; l < DEPTH; ++l) {
        const int pb = 1 + 7 * l;
        if (IN(pb + 0)) for (int rep = 0; rep < REP_WIN; ++rep) {
            if (rep) GSYNC();
            KA ap = ka_ptr(); unsigned char* ws = ap->ws; unsigned char* wl = ws + WS_W + (size_t)l * SZ_WL;
            pg8::Gemm g{(const bf16_t*)(ws + WS_XB), (const bf16_t*)wl, MP, NIN, DM}; pg8::StaticOrder S; S.init(MP, NIN, G, bx);
            pg8::EpiIn E{(bf16_t*)(ws + WS_Z), (float*)(ws + WS_LD), (const float*)(ws + WS_SSQA), ap->in[12] + l * 256};
            pg8::gemm_phase<pg8::EpiIn, pg8::StaticOrder, true, true>(lds, g, S, E, opaque_tid());
        }
        SEAM(pb + 0);
        if (IN(pb + 1)) {
            const Ctx C = make_ctx(l);
            constexpr int N1 = DECB * 2, N2 = 16 * NCH, N3 = DECB * 4;
#pragma unroll 1
            for (int u = vcu; u < N1 + N2 + N3; u += G) {
                if (u < N1) attn_sample_unit(C, u, lds, wave_s); else if (u < N1 + N2) gla1_unit(C, u - N1, lds, wave_s); else gla_sample_unit(C, u - N1 - N2, lds, wave_s);
            }
        }
        SEAM(pb + 1);
        if (IN(pb + 2)) for (int rep = 0; rep < REP_SCAN; ++rep) { if (rep) GSYNC(); const Ctx C = make_ctx(l); gla_scan(C, bx * 512 + opaque_tid(), G * 512); }
        SEAM(pb + 2);
        if (IN(pb + 3)) for (int rep = 0; rep < REP_MB; ++rep) {   if (rep) GSYNC();
            const Ctx C = make_ctx(l);
            constexpr int N1 = 16 * NCH, N2 = NBATCH * 2 * 65;
#pragma unroll 1
            for (int u = vcu; u < N1 + N2; u += G) { if (u < N1) gla3_unit(C, u, lds, wave_s); else attn_prompt_unit(C, u - N1, lds, wave_s); }
        }
        SEAM(pb + 3);
        if (IN(pb + 4)) for (int rep = 0; rep < 1 + DRY_WO; ++rep) {
            if (rep) GSYNC();
            KA ap = ka_ptr(); unsigned char* ws = ap->ws; unsigned char* wl = ws + WS_W + (size_t)l * SZ_WL;
            pg8::Gemm g{(const bf16_t*)(ws + WS_MRG), (const bf16_t*)(wl + SZ_WIN), MP, DM, DM}; pg8::StreamK S; S.init((MP / 256) * 4, DM / 128, G, vcu, (unsigned*)(ws + WS_FLAGS) + (2 * l) * 256 * 16, ws + WS_Z, ws + WS_ZERO);
            pg8::EpiRes E{make_rm(), 0, (bf16_t*)(ws + WS_XB), (float*)(ws + WS_SSQB), rep};
            pg8::gemm_phase<pg8::EpiRes, pg8::StreamK, true, true>(lds, g, S, E, opaque_tid());
        }
        SEAM(pb + 4);
        if (IN(pb + 5)) for (int rep = 0; rep < REP_GU; ++rep) {
            if (rep) GSYNC();
            KA ap = ka_ptr(); unsigned char* ws = ap->ws; unsigned char* wl = ws + WS_W + (size_t)l * SZ_WL;
            pg8::Gemm g{(const bf16_t*)(ws + WS_XB), (const bf16_t*)(wl + SZ_WIN + SZ_WO), MP, NGU, DM}; pg8::StaticOrder S; S.init(MP, NGU, G, bx);
            pg8::EpiGU E{(bf16_t*)(ws + WS_U), (const float*)(ws + WS_SSQB)};
            pg8::gemm_phase<pg8::EpiGU, pg8::StaticOrder, true, true>(lds, g, S, E, opaque_tid());
        }
        SEAM(pb + 5);
        if (IN(pb + 6)) for (int rep = 0; rep < 1 + DRY_DN; ++rep) {
            if (rep) GSYNC();
            KA ap = ka_ptr(); unsigned char* ws = ap->ws; unsigned char* wl = ws + WS_W + (size_t)l * SZ_WL;
            pg8::Gemm g{(const bf16_t*)(ws + WS_U), (const bf16_t*)(wl + SZ_WIN + SZ_WO + SZ_WGU), MP, DM, DFFN}; pg8::StreamK S; S.init((MP / 256) * 4, DFFN / 128, G, vcu, (unsigned*)(ws + WS_FLAGS) + (2 * l + 1) * 256 * 16, ws + WS_MRG, ws + WS_ZERO);
            pg8::EpiRes E{make_rm(), l == DEPTH - 1 ? 1 : 0, (bf16_t*)(ws + WS_XB), (float*)(ws + WS_SSQA), rep};
            pg8::gemm_phase<pg8::EpiRes, pg8::StreamK, true, true>(lds, g, S, E, opaque_tid());
        }
        if (l + 1 < DEPTH) SEAM(pb + 6);
    }
    if (TIME_SUB >= 0) { if (bx == 0 && opaque_tid() == 0) { const unsigned long long tot = MISC[100 + (TIME_SUB >= 0 ? TIME_SUB : 0)]; const unsigned long long tend = __builtin_amdgcn_s_memrealtime();
            while (__builtin_amdgcn_s_memrealtime() - tend < (unsigned long long)TIME_MULT * tot) __builtin_amdgcn_s_sleep(8); } }
    if (TIME_PH >= 0) {
        STAMP(NPHASE);
        if (bx == 0 && opaque_tid() == 0) {
            unsigned long long tot = 0;
            for (int k = 0; k < NPHASE; ++k) { const bool pick = (TIME_PH == 7) ? (k == 0) : (k >= 1 && ((k - 1) % 7) == TIME_PH);
                if (pick) { const int ke = TIME_BUSY ? 32 + k : k + 1; const unsigned long long a0 = ((unsigned long long)MISC[17 + 2 * k] << 32) | MISC[16 + 2 * k], a1 = ((unsigned long long)MISC[17 + 2 * ke] << 32) | MISC[16 + 2 * ke]; tot += a1 - a0; } }
            const unsigned long long tend = __builtin_amdgcn_s_memrealtime();
            while (__builtin_amdgcn_s_memrealtime() - tend < (unsigned long long)TIME_MULT * tot) __builtin_amdgcn_s_sleep(8);
        }
    }
#undef IN
#undef SEAM
#undef STAMP
#undef GSYNC
#undef opaque_tid
}

#ifndef N_LAUNCH_MODE
#define N_LAUNCH_MODE 0
#endif
extern "C" void kernel_launch(void* const* d_in, const int* in_sizes, int n_in, void* d_out, int out_size, void* d_ws, size_t ws_size, hipStream_t stream) {
    static int grid = 0;
    if (grid == 0) {
        if (n_in != 19 || out_size != (int)O_END || ws_size < WS_END) { fprintf(stderr, "kernel_launch: unexpected shapes: n_in %d out %d ws %zu (need %zu)\n", n_in, out_size, ws_size, (size_t)WS_END); grid = -1; return; }
        int dev = 0, cus = 0, per_cu = 0;
        (void)hipGetDevice(&dev); (void)hipDeviceGetAttribute(&cus, hipDeviceAttributeMultiprocessorCount, dev);
        if (hipFuncSetAttribute((const void*)hymba_fwd, hipFuncAttributeMaxDynamicSharedMemorySize, LDS_BYTES) != hipSuccess) { fprintf(stderr, "kernel_launch: hipFuncSetAttribute failed\n"); grid = -1; return; }
        if (hipOccupancyMaxActiveBlocksPerMultiprocessor(&per_cu, (const void*)hymba_fwd, 512, LDS_BYTES) != hipSuccess || per_cu < 1) { fprintf(stderr, "kernel_launch: occupancy query says %d\n", per_cu); per_cu = 1; }
        (void)hipGetLastError();
        grid = cus > 0 ? cus : 256;
    }
    if (grid < 0) return;
    if (hipMemsetAsync(d_ws, 0, WS_W, stream) != hipSuccess) { fprintf(stderr, "kernel_launch: memset failed\n"); return; }
    Args a{};
    for (int i = 0; i < 19; ++i) a.in[i] = (const float*)d_in[i];
    a.out = (float*)d_out; a.ws = (unsigned char*)d_ws;
#if N_LAUNCH_MODE == 1
    for (int p = 0; p < NPHASE; ++p) { a.ph_lo = p; a.ph_hi = p + 1; hipLaunchKernelGGL(hymba_fwd, dim3(grid), dim3(512), LDS_BYTES, stream, a); }
#else
    a.ph_lo = 0; a.ph_hi = NPHASE;
    void* args[] = {&a};
    hipError_t e = hipLaunchCooperativeKernel((const void*)hymba_fwd, dim3(grid), dim3(512), args, LDS_BYTES, stream);
    if (e != hipSuccess) fprintf(stderr, "cooperative launch failed: %s (grid %d)\n", hipGetErrorString(e), grid);
#endif
}
```

```cpp
#include <hip/hip_runtime.h>
#include <hip/hip_cooperative_groups.h>
#include <cstdio>
#include <cstdint>
namespace cg = cooperative_groups;

#define DI __device__ __forceinline__
#define LAS __attribute__((address_space(3)))
typedef unsigned short bf16_t;
typedef short bf16x8 __attribute__((ext_vector_type(8)));
typedef float f32x4 __attribute__((ext_vector_type(4)));
typedef float f32x2 __attribute__((ext_vector_type(2)));
typedef unsigned u32x4 __attribute__((ext_vector_type(4)));
typedef unsigned u32x2 __attribute__((ext_vector_type(2)));
typedef __bf16 bf16x2_t __attribute__((ext_vector_type(2)));

constexpr int DM = 1024, NBATCH = 4, SEQ = 4096, LP = 4112  , DEPTH = 2, DECB = 128, DECT = 8;
constexpr int MPROMPT = NBATCH * LP, MREAL = MPROMPT + DECB * DECT, MP = 17664  ;
constexpr int INW = 2320, ZP = 2304, NIN = 2560, DFFN = 2816, NGU = 5632;
constexpr int ZQ = 0, ZK = 512, ZV = 640, ZGQ = 768, ZGK = 1024, ZGV = 1280, ZOG = 1792;
constexpr int NCH = 33;
constexpr float EPS = 1e-6f, LOG2E = 1.4426950408889634f;
constexpr size_t O_YP = 0, O_YS = 16777216, O_CKP = 17825792, O_CVP = 17956864, O_SP = 18087936, O_CKS = 18350080, O_CVS = 22544384, O_SS = 26738688, O_END = 35127296;

DI unsigned pk2(float lo, float hi) { f32x2 v = {lo, hi}; bf16x2_t b = __builtin_convertvector(v, bf16x2_t); return __builtin_bit_cast(unsigned, b); }
DI float bflo(unsigned w) { return __uint_as_float(w << 16); }
DI float bfhi(unsigned w) { return __uint_as_float(w & 0xffff0000u); }
DI float bf2f(bf16_t h) { return __uint_as_float((unsigned)h << 16); }
DI void unpack8(const u32x4 w, float* f) { f[0] = bflo(w.x); f[1] = bfhi(w.x); f[2] = bflo(w.y); f[3] = bfhi(w.y); f[4] = bflo(w.z); f[5] = bfhi(w.z); f[6] = bflo(w.w); f[7] = bfhi(w.w); }
DI float red4rows(float v) {
    auto r = __builtin_amdgcn_permlane16_swap(__float_as_uint(v), __float_as_uint(v), false, false); v = __uint_as_float(r[0]) + __uint_as_float(r[1]);
    auto q = __builtin_amdgcn_permlane32_swap(__float_as_uint(v), __float_as_uint(v), false, false); return __uint_as_float(q[0]) + __uint_as_float(q[1]);
}
DI float max4rows(float v) {
    auto r = __builtin_amdgcn_permlane16_swap(__float_as_uint(v), __float_as_uint(v), false, false); v = fmaxf(__uint_as_float(r[0]), __uint_as_float(r[1]));
    auto q = __builtin_amdgcn_permlane32_swap(__float_as_uint(v), __float_as_uint(v), false, false); return fmaxf(__uint_as_float(q[0]), __uint_as_float(q[1]));
}
template <int M> DI float shx(float v) { return __int_as_float(__builtin_amdgcn_ds_swizzle(__float_as_int(v), 0x1f | (M << 10))); }
DI float sum8(float v) { v += shx<1>(v); v += shx<2>(v); v += shx<4>(v); return v; }
DI float sum64(float v) { v += shx<1>(v); v += shx<2>(v); v += shx<4>(v); v += shx<8>(v); v += shx<16>(v);
    auto q = __builtin_amdgcn_permlane32_swap(__float_as_uint(v), __float_as_uint(v), false, false); return __uint_as_float(q[0]) + __uint_as_float(q[1]); }
DI float silu_f(float x) { return x * __builtin_amdgcn_rcpf(1.0f + __expf(-x)); }

struct RowMap { const float* xp; const float* xs; const float* meta; float* yp; float* ys; float* xmeta; };
DI const float* row_in(const RowMap& rm, int row) {
    if (row < MPROMPT) { const int b = row / LP, p = row - b * LP; return p < 16 ? rm.meta + (size_t)p * DM : rm.xp + ((size_t)b * SEQ + (p - 16)) * DM; }
    if (row < MREAL) return rm.xs + (size_t)(row - MPROMPT) * DM;
    return nullptr;
}
DI float* row_out(const RowMap& rm, int row) {
    if (row < MPROMPT) { const int b = row / LP, p = row - b * LP; return p < 16 ? nullptr : rm.yp + ((size_t)b * SEQ + (p - 16)) * DM; }
    if (row < MREAL) return rm.ys + (size_t)(row - MPROMPT) * DM;
    return nullptr;
}
namespace pg8 {
#define PG8_LAS __attribute__((address_space(3)))
typedef unsigned short bf16_t;
typedef short bf16x8 __attribute__((ext_vector_type(8)));
typedef float f32x4 __attribute__((ext_vector_type(4)));
typedef unsigned u32x4 __attribute__((ext_vector_type(4)));
constexpr int BM = 256, BK = 64, HALF = 128, HTB = HALF * BK * 2  , STAGE_BYTES = 8 * HTB, NXCD = 8, WGM = 8;

__host__ __device__ __forceinline__ int lds_byte(int r, int c) { const int st = (r >> 4) * 2 + (c >> 5), rr = r & 15, cc = c & 31, ob = rr * 64 + cc * 2; return st * 1024 + (ob ^ (((ob >> 9) & 1) << 5)); }
__host__ __device__ __forceinline__ void stage_rc(int b, int& R, int& C) { const int st = b / 1024, sb = b % 1024, swz = sb ^ (((sb >> 9) & 1) << 5); R = (st >> 1) * 16 + swz / 64; C = (st & 1) * 32 + (swz % 64) / 2; }
__host__ __device__ __forceinline__ int perm32(int rho) { const int n = rho >> 4, i = rho & 15; return 8 * (i >> 2) + 4 * n + (i & 3); }

struct Unit { int pm, pn, k0, nk, mode; };
struct Gemm { const bf16_t* A; const bf16_t* Bt; int M, N, K; };

struct StaticOrder {
    static constexpr bool STREAMK = false;
    int nM, nN, nwg, G, c;
    __host__ __device__ void init(int M, int N, int G_, int c_) { nM = M / BM; nN = N / BM; nwg = nM * nN; G = G_; c = c_; }
    __host__ __device__ bool next(int i, Unit& u) const {
        const long L = (long)i * G + c; if (L >= nwg) return false;
        int wgid = (int)L; { const int q = nwg / NXCD, r = nwg % NXCD, xcd = wgid % NXCD, off = wgid / NXCD; wgid = (xcd < r ? xcd * (q + 1) : r * (q + 1) + (xcd - r) * q) + off; }
        const int nig = WGM * nN, gid = wgid / nig, fm = gid * WGM, gsz = (nM - fm) < WGM ? (nM - fm) : WGM;
        u.pm = fm + ((wgid % nig) % gsz); u.pn = (wgid % nig) / gsz; u.k0 = 0; u.nk = 0; u.mode = 0; return true;
    }
    __device__ __forceinline__ void a_ready(const Unit&) const {}
    __device__ __forceinline__ void done(const Unit&) const {}
};


struct StreamK {
    static constexpr bool STREAMK = true;
    int P, r, s, e, nseg; unsigned* flags; unsigned char* part; const unsigned char* zero;
    __device__ __forceinline__ void init(int ntiles, int P_, int G, int r_, unsigned* flags_, unsigned char* part_, const unsigned char* zero_) {
        P = P_; r = r_; flags = flags_; part = part_; zero = zero_; const long TP = (long)ntiles * P; s = (int)(TP * r / G); e = (int)(TP * (r + 1) / G);
        nseg = 0; int cur = s; while (cur < e) { const int kb = cur % P; int ke = kb + (e - cur); ke = ke < P ? ke : P; cur += ke - kb; ++nseg; }
    }
    __device__ __forceinline__ bool next(int i, Unit& u) const {
        if (i >= nseg) return false;
        const int want = nseg - 1 - i; int cur = s, idx = 0;
        for (;;) { const int t = cur / P, kb = cur % P; int ke = kb + (e - cur); ke = ke < P ? ke : P;
            if (idx == want) { u.pm = t >> 2; u.pn = t & 3; u.k0 = 2 * kb; u.nk = 2 * (ke - kb); u.mode = (kb == 0 && ke == P) ? 0 : (kb == 0 ? 1 : 2); return true; }
            cur += ke - kb; ++idx; }
    }
    __device__ __forceinline__ void a_ready(const Unit&) const {}
    __device__ __forceinline__ void done(const Unit&) const {}
};

DI float rstd_from_slots(const float* ssq, int row) {
    const f32x4* p = (const f32x4*)(ssq + (size_t)row * 16);
    const f32x4 a = p[0], b = p[1], c = p[2], d = p[3];
    const float s = ((a[0] + a[1]) + (a[2] + a[3])) + ((b[0] + b[1]) + (b[2] + b[3])) + ((c[0] + c[1]) + (c[2] + c[3])) + ((d[0] + d[1]) + (d[2] + d[3]));
    return rsqrtf(s * (1.0f / 1024.0f) + EPS);
}
DI void rstd8(const float* ssq, int row0, float (&rs)[2][4]) {
#pragma unroll
    for (int ai = 0; ai < 2; ++ai) {
        f32x4 t[4][4];
#pragma unroll
        for (int m = 0; m < 4; ++m) { const f32x4* p = (const f32x4*)(ssq + (size_t)(row0 + ai * HALF + m * 16) * 16); t[m][0] = p[0]; t[m][1] = p[1]; t[m][2] = p[2]; t[m][3] = p[3]; }
#pragma unroll
        for (int m = 0; m < 4; ++m) { const f32x4 q = (t[m][0] + t[m][1]) + (t[m][2] + t[m][3]); rs[ai][m] = rsqrtf(((q[0] + q[1]) + (q[2] + q[3])) * (1.0f / 1024.0f) + EPS); }
        asm volatile("" ::: "memory");
    }
}
DI void rstd_tab_fill(const float* ssq, int pm, PG8_LAS float* tab, int tid) {
    if (tid < 256) { const f32x4* p = (const f32x4*)(ssq + (size_t)(pm * BM + tid) * 16); const f32x4 q = (p[0] + p[1]) + (p[2] + p[3]); tab[tid] = rsqrtf(((q[0] + q[1]) + (q[2] + q[3])) * (1.0f / 1024.0f) + EPS); }
}
DI void rstd8_tab(const PG8_LAS float* tab, int wr, int fr, float (&rs)[2][4]) {
#pragma unroll
    for (int ai = 0; ai < 2; ++ai)
#pragma unroll
        for (int m = 0; m < 4; ++m) rs[ai][m] = tab[ai * HALF + wr * 64 + m * 16 + fr];
}
struct EpiIn {
    static constexpr bool PERM = true, AFTER_DRAIN = false, RSTAB = true;
    bf16_t* Z; float* LD; const float* ssq; const float* bg;
    __device__ __forceinline__ void prefetch(const Unit& u, PG8_LAS float* tab, int tid) const { rstd_tab_fill(ssq, u.pm, tab, tid); }
    __device__ __forceinline__ void operator()(const f32x4 (&acc)[2][2][4][2], const Unit& u, int wr, int wc, int fr, int fq, const PG8_LAS float* tab) const {
        const int row0 = u.pm * BM + wr * 64 + fr;
        float rs[2][4]; rstd8_tab(tab, wr, fr, rs);
        if (u.pn < 9) {
#pragma unroll
            for (int ai = 0; ai < 2; ++ai)
#pragma unroll
                for (int m = 0; m < 4; ++m) { const int row = row0 + ai * HALF + m * 16; const float r = rs[ai][m];
                    bf16_t* rowp = Z + (size_t)row * ZP + u.pn * BM + wc * 32 + 8 * fq;
#pragma unroll
                    for (int bj = 0; bj < 2; ++bj) { const f32x4 v0 = acc[ai][bj][m][0] * r, v1 = acc[ai][bj][m][1] * r;
                        u32x4 w; w.x = pk2(v0[0], v0[1]); w.y = pk2(v0[2], v0[3]); w.z = pk2(v1[0], v1[1]); w.w = pk2(v1[2], v1[3]);
                        *(u32x4*)(rowp + bj * HALF) = w; } }
        } else {
            const int e0 = wc * 32 + 8 * fq;
#pragma unroll
            for (int bj = 0; bj < 2; ++bj) { const f32x4 b0 = *(const f32x4*)(bg + e0 + bj * HALF), b1 = *(const f32x4*)(bg + e0 + bj * HALF + 4);
#pragma unroll
                for (int ai = 0; ai < 2; ++ai)
#pragma unroll
                    for (int m = 0; m < 4; ++m) { const int row = row0 + ai * HALF + m * 16; const float r = rs[ai][m];
                        const f32x4 x0 = acc[ai][bj][m][0] * r + b0, x1 = acc[ai][bj][m][1] * r + b1; f32x4 o0, o1;
#pragma unroll
                        for (int i = 0; i < 4; ++i) { o0[i] = (fminf(x0[i], 0.f) - __logf(1.0f + __expf(-fabsf(x0[i])))) * 0.0625f; o1[i] = (fminf(x1[i], 0.f) - __logf(1.0f + __expf(-fabsf(x1[i])))) * 0.0625f; }
                        float* lp = LD + (size_t)row * 256 + e0 + bj * HALF; *(f32x4*)lp = o0; *(f32x4*)(lp + 4) = o1; } }
        }
    }
};
#ifndef EPIRES_BATCH4
#define EPIRES_BATCH4 1
#endif
#if EPIRES_BATCH4
struct EpiRes {
    static constexpr bool PERM = true, AFTER_DRAIN = false, RSTAB = false;
    RowMap rm; int final_; bf16_t* XB; float* ssq; int dry;
    __device__ __forceinline__ void operator()(const f32x4 (&acc)[2][2][4][2], const Unit& u, int wr, int wc, int fr, int fq, const unsigned char* pp) const {
        if (dry) return;
        const int row0 = u.pm * BM + wr * 64 + fr, col0 = u.pn * BM + wc * 32 + 8 * fq;
#pragma unroll
        for (int ai = 0; ai < 2; ++ai) {
            u32x4 res[4][2], par[4][2];
#pragma unroll
            for (int m = 0; m < 4; ++m) { const int row = row0 + ai * HALF + m * 16;
#pragma unroll
                for (int bj = 0; bj < 2; ++bj) { res[m][bj] = *(const u32x4*)(XB + (size_t)row * DM + col0 + bj * HALF); par[m][bj] = (u32x4){0u, 0u, 0u, 0u}; } }
            if (pp) {
#pragma unroll
                for (int m = 0; m < 4; ++m)
#pragma unroll
                    for (int bj = 0; bj < 2; ++bj) asm volatile("global_load_dwordx4 %0, %1, off sc0 sc1" : "=v"(par[m][bj]) : "v"(pp + ((ai * 2 + bj) * 4 + m) * 8192) : "memory");
                asm volatile("s_waitcnt vmcnt(0)" : "+v"(par[0][0]), "+v"(par[0][1]), "+v"(par[1][0]), "+v"(par[1][1]), "+v"(par[2][0]), "+v"(par[2][1]), "+v"(par[3][0]), "+v"(par[3][1]) :: "memory");
            }
#pragma unroll
            for (int m = 0; m < 4; ++m) { const int row = row0 + ai * HALF + m * 16; float ss = 0.f; float* op = final_ ? row_out(rm, row) : nullptr;
#pragma unroll
                for (int bj = 0; bj < 2; ++bj) { const int col = col0 + bj * HALF; float r[8], q[8]; unpack8(res[m][bj], r); unpack8(par[m][bj], q);
                    const f32x4 v0 = (acc[ai][bj][m][0] + (f32x4){q[0], q[1], q[2], q[3]}) + (f32x4){r[0], r[1], r[2], r[3]}, v1 = (acc[ai][bj][m][1] + (f32x4){q[4], q[5], q[6], q[7]}) + (f32x4){r[4], r[5], r[6], r[7]};
                    if (final_) { if (op) { __builtin_nontemporal_store(v0, (f32x4*)(op + col)); __builtin_nontemporal_store(v1, (f32x4*)(op + col + 4)); } }
                    else { u32x4 w; w.x = pk2(v0[0], v0[1]); w.y = pk2(v0[2], v0[3]); w.z = pk2(v1[0], v1[1]); w.w = pk2(v1[2], v1[3]);
                        *(u32x4*)(XB + (size_t)row * DM + col) = w;
                        const f32x4 q0 = {bflo(w.x), bfhi(w.x), bflo(w.y), bfhi(w.y)}, q1 = {bflo(w.z), bfhi(w.z), bflo(w.w), bfhi(w.w)};
                        ss += (q0[0] * q0[0] + q0[1] * q0[1]) + (q0[2] * q0[2] + q0[3] * q0[3]) + (q1[0] * q1[0] + q1[1] * q1[1]) + (q1[2] * q1[2] + q1[3] * q1[3]); } }
                if (!final_) { ss = red4rows(ss); if (fq == 0) ssq[(size_t)row * 16 + u.pn * 4 + wc] = ss; } }
            asm volatile("" ::: "memory");
        }
    }
};
#else
struct EpiRes {
    static constexpr bool PERM = true, AFTER_DRAIN = false, RSTAB = false;
    RowMap rm; int final_; bf16_t* XB; float* ssq; int dry;
    __device__ __forceinline__ void operator()(const f32x4 (&acc)[2][2][4][2], const Unit& u, int wr, int wc, int fr, int fq, const unsigned char* pp) const {
        if (dry) return;
        const int row0 = u.pm * BM + wr * 64 + fr, col0 = u.pn * BM + wc * 32 + 8 * fq;
#pragma unroll
        for (int ai = 0; ai < 2; ++ai)
#pragma unroll
        for (int mh = 0; mh < 2; ++mh) {
            u32x4 res[2][2], par[2][2];
#pragma unroll
            for (int mm = 0; mm < 2; ++mm) { const int row = row0 + ai * HALF + (2 * mh + mm) * 16;
#pragma unroll
                for (int bj = 0; bj < 2; ++bj) { res[mm][bj] = *(const u32x4*)(XB + (size_t)row * DM + col0 + bj * HALF); par[mm][bj] = (u32x4){0u, 0u, 0u, 0u}; } }
            if (pp) {
#pragma unroll
                for (int mm = 0; mm < 2; ++mm)
#pragma unroll
                    for (int bj = 0; bj < 2; ++bj) asm volatile("global_load_dwordx4 %0, %1, off sc0 sc1" : "=v"(par[mm][bj]) : "v"(pp + ((ai * 2 + bj) * 4 + 2 * mh + mm) * 8192) : "memory");
                asm volatile("s_waitcnt vmcnt(0)" : "+v"(par[0][0]), "+v"(par[0][1]), "+v"(par[1][0]), "+v"(par[1][1]) :: "memory");
            }
#pragma unroll
            for (int mm = 0; mm < 2; ++mm) { const int m = 2 * mh + mm; const int row = row0 + ai * HALF + m * 16; float ss = 0.f; float* op = final_ ? row_out(rm, row) : nullptr;
#pragma unroll
                for (int bj = 0; bj < 2; ++bj) { const int col = col0 + bj * HALF; float r[8], q[8]; unpack8(res[mm][bj], r); unpack8(par[mm][bj], q);
                    const f32x4 v0 = (acc[ai][bj][m][0] + (f32x4){q[0], q[1], q[2], q[3]}) + (f32x4){r[0], r[1], r[2], r[3]}, v1 = (acc[ai][bj][m][1] + (f32x4){q[4], q[5], q[6], q[7]}) + (f32x4){r[4], r[5], r[6], r[7]};
                    if (final_) { if (op) { __builtin_nontemporal_store(v0, (f32x4*)(op + col)); __builtin_nontemporal_store(v1, (f32x4*)(op + col + 4)); } }
                    else { u32x4 w; w.x = pk2(v0[0], v0[1]); w.y = pk2(v0[2], v0[3]); w.z = pk2(v1[0], v1[1]); w.w = pk2(v1[2], v1[3]);
                        *(u32x4*)(XB + (size_t)row * DM + col) = w;
                        const f32x4 q0 = {bflo(w.x), bfhi(w.x), bflo(w.y), bfhi(w.y)}, q1 = {bflo(w.z), bfhi(w.z), bflo(w.w), bfhi(w.w)};
                        ss += (q0[0] * q0[0] + q0[1] * q0[1]) + (q0[2] * q0[2] + q0[3] * q0[3]) + (q1[0] * q1[0] + q1[1] * q1[1]) + (q1[2] * q1[2] + q1[3] * q1[3]); } }
                if (!final_) { ss = red4rows(ss); if (fq == 0) ssq[(size_t)row * 16 + u.pn * 4 + wc] = ss; } }
            asm volatile("" ::: "memory");
        }
    }
};
#endif
struct EpiGU {
    static constexpr bool PERM = true, AFTER_DRAIN = false, RSTAB = true;
    bf16_t* U; const float* ssq;
    __device__ __forceinline__ void prefetch(const Unit& u, PG8_LAS float* tab, int tid) const { rstd_tab_fill(ssq, u.pm, tab, tid); }
    __device__ __forceinline__ void operator()(const f32x4 (&acc)[2][2][4][2], const Unit& u, int wr, int wc, int fr, int fq, const PG8_LAS float* tab) const {
        const int row0 = u.pm * BM + wr * 64 + fr, f0 = u.pn * HALF + wc * 32 + 8 * fq;
        float rs[2][4]; rstd8_tab(tab, wr, fr, rs);
#pragma unroll
        for (int ai = 0; ai < 2; ++ai)
#pragma unroll
            for (int m = 0; m < 4; ++m) { const int row = row0 + ai * HALF + m * 16; const float r = rs[ai][m];
                float o[8];
#pragma unroll
                for (int n = 0; n < 2; ++n)
#pragma unroll
                    for (int i = 0; i < 4; ++i) { const float g = acc[ai][0][m][n][i] * r, up = acc[ai][1][m][n][i] * r; o[4 * n + i] = silu_f(g) * up; }
                u32x4 w; w.x = pk2(o[0], o[1]); w.y = pk2(o[2], o[3]); w.z = pk2(o[4], o[5]); w.w = pk2(o[6], o[7]);
                *(u32x4*)(U + (size_t)row * DFFN + f0) = w; }
    }
};
template <class Epi, class Sched, bool ALIGN_EPI = false, bool SP2 = false>
__device__ __forceinline__ void gemm_phase(PG8_LAS unsigned char* lds, const Gemm g, const Sched& S, const Epi& E, const int tid_in) {
    const int tid = tid_in, wid = __builtin_amdgcn_readfirstlane(tid >> 6), lane = tid & 63, wr = wid >> 2, wc = wid & 3, fr = lane & 15, fq = lane >> 4;
    const int K = g.K;
    unsigned voffA[2], voffB[2];
#pragma unroll
    for (int i = 0; i < 2; ++i) { int R, C; stage_rc(tid * 16 + i * 8192, R, C); const int Rb = Epi::PERM ? ((R & ~31) + perm32(R & 31)) : R;
        voffA[i] = (unsigned)(R * K + C) * 2u; voffB[i] = (unsigned)(Rb * K + C) * 2u; }
    const size_t kstep = (size_t)(BK * 2);
    const size_t hstep = (size_t)HALF * K * 2;
    const size_t tstep = 2 * hstep;
    const unsigned ldsw = (unsigned)wid * 1024u;
    const int aoff = lds_byte(wr * 64 + fr, fq * 8), boff = lds_byte(wc * 32 + fr, fq * 8);
#define PG8_SA(b, h) (((b) * 2 + (h)) * HTB)
#define PG8_SB(b, h) ((4 + (b) * 2 + (h)) * HTB)
#define PG8_STAGE(bufoff, gbase, voff) do { _Pragma("unroll") for (int _i = 0; _i < 2; ++_i) \
        __builtin_amdgcn_global_load_lds((const unsigned*)((const char*)(gbase) + (voff)[_i]), (PG8_LAS unsigned*)(lds + (bufoff) + ldsw + _i * 8192), 16, 0, 0); } while (0)
#define PG8_LDA(dst, b, h) do { _Pragma("unroll") for (int m = 0; m < 4; ++m) _Pragma("unroll") for (int k = 0; k < 2; ++k) dst[m][k] = *(const PG8_LAS bf16x8*)(lds + PG8_SA(b, h) + aoff + m * 2048 + k * 1024); } while (0)
#define PG8_LDB(dst, b, h) do { _Pragma("unroll") for (int n = 0; n < 2; ++n) _Pragma("unroll") for (int k = 0; k < 2; ++k) dst[n][k] = *(const PG8_LAS bf16x8*)(lds + PG8_SB(b, h) + boff + n * 2048 + k * 1024); } while (0)
#define PG8_MMA(ai, bj, At, Bt) do { __builtin_amdgcn_s_setprio(1); _Pragma("unroll") for (int m = 0; m < 4; ++m) _Pragma("unroll") for (int n = 0; n < 2; ++n) _Pragma("unroll") for (int k = 0; k < 2; ++k) \
        acc[ai][bj][m][n] = __builtin_amdgcn_mfma_f32_16x16x32_bf16(Bt[n][k], At[m][k], acc[ai][bj][m][n], 0, 0, 0); __builtin_amdgcn_s_setprio(0); } while (0)
#define PG8_WAIT_V(n) asm volatile("s_waitcnt vmcnt(" #n ")" ::: "memory")
#define PG8_WAIT_L(n) asm volatile("s_waitcnt lgkmcnt(" #n ")" ::: "memory")
#define PG8_BAR __builtin_amdgcn_s_barrier()
#define PG8_SCHED __builtin_amdgcn_sched_barrier(0)
    Unit cur, nxt; int ui = 0;
    if (!S.next(0, cur)) return;
    f32x4 acc[2][2][4][2];
#pragma unroll
    for (int a = 0; a < 2; ++a)
#pragma unroll
        for (int b = 0; b < 2; ++b)
#pragma unroll
            for (int m = 0; m < 4; ++m)
#pragma unroll
                for (int n = 0; n < 2; ++n) acc[a][b][m][n] = (f32x4){0.f, 0.f, 0.f, 0.f};
    bf16x8 At[4][2], B0[2][2], B1[2][2];
    const char* cA = (const char*)g.A + (size_t)cur.pm * tstep + (size_t)cur.k0 * kstep; const char* cB = (const char*)g.Bt + (size_t)cur.pn * tstep + (size_t)cur.k0 * kstep;
    S.a_ready(cur);
    if constexpr (Epi::RSTAB) E.prefetch(cur, (PG8_LAS float*)(lds + STAGE_BYTES + 1024), tid);
    if constexpr (SP2) {
        PG8_STAGE(PG8_SB(0, 0), cB, voffB); PG8_STAGE(PG8_SB(0, 1), cB + hstep, voffB); PG8_STAGE(PG8_SA(0, 0), cA, voffA); PG8_STAGE(PG8_SA(0, 1), cA + hstep, voffA);
        if (wr == 1) PG8_BAR;
        PG8_WAIT_V(2); PG8_BAR;
        PG8_STAGE(PG8_SB(1, 0), cB + kstep, voffB); PG8_STAGE(PG8_SA(1, 0), cA + kstep, voffA); PG8_STAGE(PG8_SB(1, 1), cB + hstep + kstep, voffB);
        PG8_WAIT_V(6); PG8_BAR;
    } else {
        PG8_STAGE(PG8_SB(0, 0), cB, voffB); PG8_STAGE(PG8_SA(0, 0), cA, voffA); PG8_STAGE(PG8_SB(0, 1), cB + hstep, voffB); PG8_STAGE(PG8_SA(0, 1), cA + hstep, voffA);
        if (wr == 1) PG8_BAR;
        PG8_WAIT_V(4); PG8_BAR;
        PG8_STAGE(PG8_SB(1, 0), cB + kstep, voffB); PG8_STAGE(PG8_SA(1, 0), cA + kstep, voffA); PG8_STAGE(PG8_SB(1, 1), cB + hstep + kstep, voffB);
        PG8_WAIT_V(6); PG8_BAR;
    }
    for (;;) {
        const bool has_next = S.next(ui + 1, nxt);
        const char* nA = has_next ? (const char*)g.A + (size_t)nxt.pm * tstep + (size_t)nxt.k0 * kstep : cA; const char* nB = has_next ? (const char*)g.Bt + (size_t)nxt.pn * tstep + (size_t)nxt.k0 * kstep : cB;
        const int nt = cur.nk ? cur.nk : K / BK;
        for (int t = 0; t < nt; t += 2) {
            const bool last = (t == nt - 2);
            const char* a1 = cA + (size_t)(t + 1) * kstep;
            const char* a2 = last ? nA : cA + (size_t)(t + 2) * kstep; const char* b2 = last ? nB : cB + (size_t)(t + 2) * kstep;
            const char* a3 = a2 + kstep; const char* b3 = b2 + kstep;
            if (last && has_next) S.a_ready(nxt);
            if constexpr (SP2) {
            PG8_LDB(B0, 0, 0); PG8_LDB(B1, 0, 1); PG8_SCHED; PG8_LDA(At, 0, 0); PG8_STAGE(PG8_SA(1, 1), a1 + hstep, voffA);
            PG8_WAIT_V(8); PG8_WAIT_L(0); PG8_BAR; PG8_MMA(0, 0, At, B0); PG8_MMA(0, 1, At, B1); PG8_BAR; PG8_SCHED;
            PG8_LDA(At, 0, 1); PG8_STAGE(PG8_SB(0, 0), b2, voffB); PG8_STAGE(PG8_SB(0, 1), b2 + hstep, voffB); PG8_STAGE(PG8_SA(0, 0), a2, voffA);
            PG8_WAIT_V(8); PG8_WAIT_L(0); PG8_BAR; PG8_MMA(1, 0, At, B0); PG8_MMA(1, 1, At, B1); PG8_BAR; PG8_SCHED;
            PG8_LDB(B0, 1, 0); PG8_LDB(B1, 1, 1); PG8_SCHED; PG8_LDA(At, 1, 0); PG8_STAGE(PG8_SA(0, 1), a2 + hstep, voffA);
            PG8_WAIT_V(8); PG8_WAIT_L(0); PG8_BAR; PG8_MMA(0, 0, At, B0); PG8_MMA(0, 1, At, B1); PG8_BAR; PG8_SCHED;
            PG8_LDA(At, 1, 1); PG8_STAGE(PG8_SB(1, 0), b3, voffB); PG8_STAGE(PG8_SB(1, 1), b3 + hstep, voffB); PG8_STAGE(PG8_SA(1, 0), a3, voffA);
            PG8_WAIT_V(8); PG8_WAIT_L(0); PG8_BAR; PG8_MMA(1, 0, At, B0); PG8_MMA(1, 1, At, B1); PG8_BAR; PG8_SCHED;
            } else {
            PG8_LDB(B0, 0, 0); PG8_SCHED; PG8_LDA(At, 0, 0); PG8_STAGE(PG8_SA(1, 1), a1 + hstep, voffA);
            PG8_WAIT_L(8); PG8_BAR; PG8_WAIT_L(0); PG8_MMA(0, 0, At, B0); PG8_BAR; PG8_SCHED;
            PG8_LDB(B1, 0, 1); PG8_STAGE(PG8_SB(0, 0), b2, voffB);
            PG8_BAR; PG8_WAIT_L(0); PG8_MMA(0, 1, At, B1); PG8_BAR;
            PG8_LDA(At, 0, 1); PG8_STAGE(PG8_SA(0, 0), a2, voffA);
            PG8_BAR; PG8_WAIT_L(0); PG8_MMA(1, 0, At, B0); PG8_BAR; PG8_SCHED;
            PG8_STAGE(PG8_SB(0, 1), b2 + hstep, voffB);
            PG8_WAIT_V(6); PG8_BAR; PG8_MMA(1, 1, At, B1); PG8_BAR;
            PG8_LDB(B0, 1, 0); PG8_SCHED; PG8_LDA(At, 1, 0); PG8_STAGE(PG8_SA(0, 1), a2 + hstep, voffA);
            PG8_WAIT_L(8); PG8_BAR; PG8_WAIT_L(0); PG8_MMA(0, 0, At, B0); PG8_BAR; PG8_SCHED;
            PG8_LDB(B1, 1, 1); PG8_STAGE(PG8_SB(1, 0), b3, voffB);
            PG8_BAR; PG8_WAIT_L(0); PG8_MMA(0, 1, At, B1); PG8_BAR;
            PG8_LDA(At, 1, 1); PG8_STAGE(PG8_SA(1, 0), a3, voffA);
            PG8_BAR; PG8_WAIT_L(0); PG8_MMA(1, 0, At, B0); PG8_BAR; PG8_SCHED;
            PG8_STAGE(PG8_SB(1, 1), b3 + hstep, voffB);
            PG8_WAIT_V(6); PG8_BAR; PG8_MMA(1, 1, At, B1); PG8_BAR;
            }
        }
        if constexpr (ALIGN_EPI) { if (wr == 0) PG8_BAR; }
        int fr2 = fr, fq2 = fq, tid2 = tid; asm volatile("" : "+v"(fr2), "+v"(fq2), "+v"(tid2));
        if constexpr (Sched::STREAMK) {
            if (cur.mode == 1) {
                unsigned char* pp = S.part + (size_t)S.r * 131072 + (size_t)tid2 * 16;
#pragma unroll
                for (int a = 0; a < 2; ++a)
#pragma unroll
                    for (int b = 0; b < 2; ++b)
#pragma unroll
                        for (int m = 0; m < 4; ++m) { u32x4 w; w.x = pk2(acc[a][b][m][0][0], acc[a][b][m][0][1]); w.y = pk2(acc[a][b][m][0][2], acc[a][b][m][0][3]); w.z = pk2(acc[a][b][m][1][0], acc[a][b][m][1][1]); w.w = pk2(acc[a][b][m][1][2], acc[a][b][m][1][3]);
                            asm volatile("global_store_dwordx4 %0, %1, off sc0 sc1" :: "v"(pp + ((a * 2 + b) * 4 + m) * 8192), "v"(w) : "memory"); }
                asm volatile("s_waitcnt vmcnt(0)" ::: "memory");
                if (lane == 0) __hip_atomic_fetch_add(S.flags + 16 * S.r, 1u, __ATOMIC_RELAXED, __HIP_MEMORY_SCOPE_AGENT);
            } else {
                const bool tail = cur.mode == 2;
                if (tail) {
                    unsigned sp = 0;
                    while ((unsigned)__builtin_amdgcn_readfirstlane(__hip_atomic_load(S.flags + 16 * (S.r - 1), __ATOMIC_RELAXED, __HIP_MEMORY_SCOPE_AGENT)) < 8u) { __builtin_amdgcn_s_sleep(2); if (++sp > (1u << 22)) break; }
                }
                const unsigned char* pp = tail ? S.part + (size_t)(S.r - 1) * 131072 + (size_t)tid2 * 16 : nullptr;
                E(acc, cur, wr, wc, fr2, fq2, pp);
            }
        } else
        if constexpr (Epi::RSTAB) { E(acc, cur, wr, wc, fr2, fq2, (const PG8_LAS float*)(lds + STAGE_BYTES + 1024) + (ui & 1) * 256); } else
        if constexpr (!Epi::AFTER_DRAIN) { E(acc, cur, wr, wc, fr2, fq2); S.done(cur); }
        if (!has_next) break;
#pragma unroll
        for (int a = 0; a < 2; ++a)
#pragma unroll
            for (int b = 0; b < 2; ++b)
#pragma unroll
                for (int m = 0; m < 4; ++m)
#pragma unroll
                    for (int n = 0; n < 2; ++n) acc[a][b][m][n] = (f32x4){0.f, 0.f, 0.f, 0.f};
        cur = nxt; cA = nA; cB = nB; ++ui;
        if constexpr (Epi::RSTAB) E.prefetch(cur, (PG8_LAS float*)(lds + STAGE_BYTES + 1024) + (ui & 1) * 256, tid2);
        if constexpr (ALIGN_EPI) { if (wr == 1) PG8_BAR; }
    }
    PG8_WAIT_V(0);
    if constexpr (!ALIGN_EPI) { if (wr == 0) PG8_BAR; }
    PG8_BAR;
    if constexpr (Epi::AFTER_DRAIN) { E.fused(acc, cur, wr, wc, fr, fq, lds, wid, lane); S.done(cur); }
#undef PG8_SA
#undef PG8_SB
#undef PG8_STAGE
#undef PG8_LDA
#undef PG8_LDB
#undef PG8_MMA
#undef PG8_WAIT_V
#undef PG8_WAIT_L
#undef PG8_BAR
#undef PG8_SCHED
}
}

constexpr size_t SZ_WIN = (size_t)NIN * DM * 2, SZ_WO = (size_t)DM * DM * 2, SZ_WGU = (size_t)NGU * DM * 2, SZ_WD = (size_t)DM * DFFN * 2, SZ_WL = SZ_WIN + SZ_WO + SZ_WGU + SZ_WD;
constexpr size_t WS_CTL = 0;
constexpr size_t WS_FLAGS = 16384;
constexpr size_t WS_ZERO = 16384 + 4 * 256 * 64;
constexpr size_t WS_CTR = WS_ZERO + 256;
constexpr size_t WS_W = WS_CTR + 4 * 64;
constexpr size_t WS_XB = WS_W + DEPTH * SZ_WL;
constexpr size_t WS_MRG = WS_XB + (size_t)MP * DM * 2;
constexpr size_t WS_Z = WS_MRG + (size_t)MP * DM * 2;
constexpr size_t WS_LD = WS_Z + (size_t)MP * ZP * 2;
constexpr size_t WS_U = WS_Z;
constexpr size_t WS_DS = WS_LD + (size_t)MP * 256 * 4;
constexpr size_t WS_SC = WS_DS + (size_t)16 * NCH * 64 * 128 * 4;
constexpr size_t WS_GL = WS_SC + (size_t)16 * NCH * 64 * 128 * 2;
constexpr size_t WS_SSQA = WS_GL + (size_t)16 * NCH * 64 * 4;
constexpr size_t WS_SSQB = WS_SSQA + (size_t)MP * 16 * 4;
constexpr size_t WS_XMETA = WS_SSQB + (size_t)MP * 16 * 4;
constexpr size_t WS_END = WS_XMETA + (size_t)64 * DM * 4;
static_assert((size_t)MP * DFFN * 2 <= (size_t)MP * ZP * 2 + (size_t)MP * 256 * 4, "U overlay fits Z|LD");
static_assert(WS_END <= 268435456ull, "workspace map fits 256 MiB");

#ifndef REP_PRO
#define REP_PRO 1
#endif
#ifndef REP_WIN
#define REP_WIN 1
#endif
#ifndef REP_MB
#define REP_MB 1
#endif
#ifndef REP_SCAN
#define REP_SCAN 1
#endif
#ifndef REP_GU
#define REP_GU 1
#endif
#ifndef REP_G1
#define REP_G1 1
#endif
#ifndef REP_AS
#define REP_AS 1
#endif
#ifndef REP_GS
#define REP_GS 1
#endif
#ifndef REP_G3
#define REP_G3 1
#endif
#ifndef REP_AP
#define REP_AP 1
#endif
#ifndef REP_WO0
#define REP_WO0 1
#endif
#ifndef DRY_WO
#define DRY_WO 0
#endif
#ifndef DRY_DN
#define DRY_DN 0
#endif
#ifndef TIME_PH
#define TIME_PH -1
#endif
#ifndef TIME_MULT
#define TIME_MULT 4
#endif
#ifndef TIME_BUSY
#define TIME_BUSY 0
#endif
#ifndef TIME_SUB
#define TIME_SUB -1
#endif
#ifndef XSYNC
#define XSYNC 0
#endif
constexpr int LDS_BYTES = 147456;
constexpr int NPHASE = 1 + 7 * DEPTH;

struct Args { const float* in[19]; float* out; unsigned char* ws; int ph_lo, ph_hi; };
typedef const __attribute__((address_space(4))) Args* KA;
DI KA ka_ptr() { KA p = (KA)__builtin_amdgcn_kernarg_segment_ptr(); asm volatile("" : "+s"(p)); return p; }

DI int mk_tid(int wave_s) { int lane; asm volatile("v_mbcnt_lo_u32_b32 %0, -1, 0\n\tv_mbcnt_hi_u32_b32 %0, -1, %0" : "=v"(lane)); return wave_s * 64 + lane; }
typedef short v4i16_t __attribute__((ext_vector_type(4)));
DI u32x2 tr4(const LAS unsigned char* p) { return __builtin_bit_cast(u32x2, __builtin_amdgcn_ds_read_tr16_b64_v4i16((LAS v4i16_t*)p)); }
#if TIME_SUB >= 0
#define TICK(id) do { if (blockIdx.x == 0 && tid == 0) { volatile LAS unsigned* M_ = (volatile LAS unsigned*)(lds + 131072 + 320); const unsigned now_ = (unsigned)__builtin_amdgcn_s_memrealtime(); M_[100 + (id)] += now_ - M_[99]; M_[99] = now_; } } while (0)
#else
#define TICK(id) do {} while (0)
#endif
DI bf16x8 mk8(u32x2 lo, u32x2 hi) { u32x4 w; w.x = lo.x; w.y = lo.y; w.z = hi.x; w.w = hi.y; return __builtin_bit_cast(bf16x8, w); }
#define MFMA16(a, b, c) __builtin_amdgcn_mfma_f32_16x16x32_bf16((a), (b), (c), 0, 0, 0)

DI void attn_wave(const LAS unsigned char* Ks, const LAS unsigned char* Vt, const int VPB, const u32x4 qa, const u32x4 qb, const float* qnw, const float sink2, const int jmin, const int c, const int fq, bf16_t* orow) {
    float qf[16]; unpack8(qa, qf); unpack8(qb, qf + 8);
    float ss = 0.f;
#pragma unroll
    for (int i = 0; i < 16; ++i) ss += qf[i] * qf[i];
    ss = red4rows(ss);
    const float rs = rsqrtf(ss * (1.0f / 64.0f) + EPS) * (0.125f * LOG2E);
    const f32x4 w0 = *(const f32x4*)(qnw + 8 * fq), w1 = *(const f32x4*)(qnw + 8 * fq + 4), w2 = *(const f32x4*)(qnw + 32 + 8 * fq), w3 = *(const f32x4*)(qnw + 36 + 8 * fq);
#pragma unroll
    for (int i = 0; i < 4; ++i) { qf[i] *= rs * w0[i]; qf[4 + i] *= rs * w1[i]; qf[8 + i] *= rs * w2[i]; qf[12 + i] *= rs * w3[i]; }
    u32x4 q0, q1; q0.x = pk2(qf[0], qf[1]); q0.y = pk2(qf[2], qf[3]); q0.z = pk2(qf[4], qf[5]); q0.w = pk2(qf[6], qf[7]);
    q1.x = pk2(qf[8], qf[9]); q1.y = pk2(qf[10], qf[11]); q1.z = pk2(qf[12], qf[13]); q1.w = pk2(qf[14], qf[15]);
    const bf16x8 qB0 = __builtin_bit_cast(bf16x8, q0), qB1 = __builtin_bit_cast(bf16x8, q1);
    f32x4 acc[9];
    float mx = sink2;
#pragma unroll
    for (int T = 0; T < 9; ++T) {
        const LAS unsigned char* kp = Ks + (16 * T + c) * 144 + 16 * fq;
        const bf16x8 a0 = *(const LAS bf16x8*)kp, a1 = *(const LAS bf16x8*)(kp + 64);
        f32x4 s = {0.f, 0.f, 0.f, 0.f};
        s = MFMA16(a0, qB0, s); s = MFMA16(a1, qB1, s);
#pragma unroll
        for (int r = 0; r < 4; ++r) { const int jrel = 16 * T + 4 * fq + r, d = 128 + c - jrel; const bool ok = ((unsigned)d < 128u) && (jrel >= jmin); s[r] = ok ? s[r] : -1e30f; mx = fmaxf(mx, s[r]); }
        acc[T] = s;
    }
    mx = max4rows(mx);
    float sum = 0.f;
#pragma unroll
    for (int T = 0; T < 9; ++T)
#pragma unroll
        for (int r = 0; r < 4; ++r) { const float p = __builtin_amdgcn_exp2f(acc[T][r] - mx); acc[T][r] = p; sum += p; }
    sum = red4rows(sum);
    const float inv = 1.0f / (sum + __builtin_amdgcn_exp2f(sink2 - mx));
    f32x4 o[4];
#pragma unroll
    for (int i = 0; i < 4; ++i) o[i] = (f32x4){0.f, 0.f, 0.f, 0.f};
#pragma unroll
    for (int kk = 0; kk < 5; ++kk) {
        u32x4 pw; pw.x = pk2(acc[2 * kk][0], acc[2 * kk][1]); pw.y = pk2(acc[2 * kk][2], acc[2 * kk][3]);
        if (kk < 4) { pw.z = pk2(acc[2 * kk + 1][0], acc[2 * kk + 1][1]); pw.w = pk2(acc[2 * kk + 1][2], acc[2 * kk + 1][3]); } else { pw.z = 0u; pw.w = 0u; }
        const bf16x8 pB = __builtin_bit_cast(bf16x8, pw);
#pragma unroll
        for (int Mt = 0; Mt < 4; ++Mt) {
            const LAS unsigned char* vp = Vt + (32 * kk + 4 * fq + (c >> 2)) * VPB + (16 * Mt + 4 * (c & 3)) * 2;
            const u32x2 lo = tr4(vp), hi = tr4(vp + 16 * VPB);
            o[Mt] = MFMA16(mk8(lo, hi), pB, o[Mt]);
        }
    }
    if (orow) {
#pragma unroll
        for (int Mt = 0; Mt < 4; ++Mt) { u32x2 w; w.x = pk2(o[Mt][0] * inv, o[Mt][1] * inv); w.y = pk2(o[Mt][2] * inv, o[Mt][3] * inv); *(u32x2*)(orow + 16 * Mt + 4 * fq) = w; }
    }
}

struct Ctx {
    int l;
    const bf16_t* Z; float* LD; bf16_t* MRG; float* DS; bf16_t* SC; float* GL;
    const float *qnw, *knw, *sinks, *gnw;
    const float *cache_k, *cache_v, *state;
    float* out;
};

DI void attn_prompt_unit(const Ctx& C, int uidx, LAS unsigned char* lds, const int wave_s) {
    const int tid = mk_tid(wave_s);
    const int jb = uidx % 65, g = (uidx / 65) & 1, b = uidx / 130;
    const int p0 = 64 * jb, kbase = p0 - 128, rowbase = b * LP, nq = (LP - p0) < 64 ? (LP - p0) : 64;
    LAS unsigned char* Ks = lds; LAS unsigned char* Vs = lds + 208 * 144;
    TICK(0);
    {
        const int dc = tid & 7;
        u32x4 rk[4], rv[4];
#pragma unroll
        for (int i = 0; i < 4; ++i) { const int j = (tid >> 3) + 64 * i, kp = kbase + j; const bool valid = (j < 192) && (kp >= 0) && (kp < LP);
            rk[i] = (u32x4){0u, 0u, 0u, 0u}; rv[i] = rk[i];
            if (valid) { const bf16_t* zr = C.Z + (size_t)(rowbase + kp) * ZP + g * 64 + dc * 8; rk[i] = *(const u32x4*)(zr + ZK); rv[i] = *(const u32x4*)(zr + ZV); } }
        const f32x4 kw0 = *(const f32x4*)(C.knw + dc * 8), kw1 = *(const f32x4*)(C.knw + dc * 8 + 4);
#pragma unroll
        for (int i = 0; i < 4; ++i) { const int j = (tid >> 3) + 64 * i, kp = kbase + j; const bool valid = (j < 192) && (kp >= 0) && (kp < LP);
            float f[8]; unpack8(rk[i], f); float ss = 0.f;
#pragma unroll
            for (int e = 0; e < 8; ++e) ss += f[e] * f[e];
            ss = sum8(ss);
            const float rs = rsqrtf(ss * (1.0f / 64.0f) + EPS);
#pragma unroll
            for (int e = 0; e < 4; ++e) { f[e] *= rs * kw0[e]; f[4 + e] *= rs * kw1[e]; }
            if (j < 208) { u32x4 o; o.x = pk2(f[0], f[1]); o.y = pk2(f[2], f[3]); o.z = pk2(f[4], f[5]); o.w = pk2(f[6], f[7]); *(LAS u32x4*)(Ks + j * 144 + dc * 16) = o; *(LAS u32x4*)(Vs + j * 144 + dc * 16) = rv[i]; }
            if (valid && j >= 128 && kp >= LP - 128) { const size_t oo = ((size_t)((C.l * NBATCH + b) * 128 + (kp - (LP - 128))) * 2 + g) * 64 + dc * 8;
                float* op = C.out + O_CKP + oo; *(f32x4*)op = (f32x4){f[0], f[1], f[2], f[3]}; *(f32x4*)(op + 4) = (f32x4){f[4], f[5], f[6], f[7]};
                float fv[8]; unpack8(rv[i], fv); float* ov = C.out + O_CVP + oo; *(f32x4*)ov = (f32x4){fv[0], fv[1], fv[2], fv[3]}; *(f32x4*)(ov + 4) = (f32x4){fv[4], fv[5], fv[6], fv[7]}; } }
    }
    __syncthreads();
    TICK(4);
    {
        const int tid2 = mk_tid(wave_s), lane = tid2 & 63, w = tid2 >> 6;
        const int s = w & 3, hp = w >> 2, c = lane & 15, fq = lane >> 4;
        if (16 * s < nq) {
            const int qp = p0 + 16 * s + c; const bool qv = qp < LP; const int h0 = g * 4 + hp * 2;
            u32x4 qr[2][2];
#pragma unroll
            for (int hh = 0; hh < 2; ++hh) { qr[hh][0] = (u32x4){0u, 0u, 0u, 0u}; qr[hh][1] = qr[hh][0];
                if (qv) { const bf16_t* qrow = C.Z + (size_t)(rowbase + qp) * ZP + ZQ + (h0 + hh) * 64; qr[hh][0] = __builtin_nontemporal_load((const u32x4*)(qrow + 8 * fq)); qr[hh][1] = __builtin_nontemporal_load((const u32x4*)(qrow + 32 + 8 * fq)); } }
#pragma unroll
            for (int hh = 0; hh < 2; ++hh) { const int h = h0 + hh;
                bf16_t* orow = qv ? C.MRG + (size_t)(rowbase + qp) * DM + h * 64 : nullptr;
                attn_wave(Ks + 16 * s * 144, Vs + 16 * s * 144, 144, qr[hh][0], qr[hh][1], C.qnw, C.sinks[h] * LOG2E, 128 - p0 - 16 * s, c, fq, orow); }
        }
    }
    __syncthreads();
    TICK(5);
}

DI void attn_sample_unit(const Ctx& C, int uidx, LAS unsigned char* lds, const int wave_s) {
    const int tid = mk_tid(wave_s);
    const int g = uidx & 1, b = uidx >> 1;
    constexpr int KSG = 160 * 144;
    TICK(0);
    const int row0 = MPROMPT + b * DECT;
    const size_t cbase = (size_t)(C.l * DECB + b) * 128;
#pragma unroll
    for (int i = 0; i < 2; ++i) {
        const int idx = tid + 512 * i, dc = idx & 7, j = idx >> 3;
        const size_t so = ((cbase + j) * 2 + g) * 64 + dc * 8;
        const f32x4 a = __builtin_nontemporal_load((const f32x4*)(C.cache_k + so)), bq = __builtin_nontemporal_load((const f32x4*)(C.cache_k + so + 4)), va = __builtin_nontemporal_load((const f32x4*)(C.cache_v + so)), vb = __builtin_nontemporal_load((const f32x4*)(C.cache_v + so + 4));
        u32x4 o; o.x = pk2(a[0], a[1]); o.y = pk2(a[2], a[3]); o.z = pk2(bq[0], bq[1]); o.w = pk2(bq[2], bq[3]);
        *(LAS u32x4*)(lds + j * 144 + dc * 16) = o;
        u32x4 ov; ov.x = pk2(va[0], va[1]); ov.y = pk2(va[2], va[3]); ov.z = pk2(vb[0], vb[1]); ov.w = pk2(vb[2], vb[3]);
        *(LAS u32x4*)(lds + KSG + j * 144 + dc * 16) = ov;
        if (j >= 8) { const size_t oo = ((cbase + j - 8) * 2 + g) * 64 + dc * 8; float* op = C.out + O_CKS + oo; __builtin_nontemporal_store(a, (f32x4*)op); __builtin_nontemporal_store(bq, (f32x4*)(op + 4)); float* opv = C.out + O_CVS + oo; __builtin_nontemporal_store(va, (f32x4*)opv); __builtin_nontemporal_store(vb, (f32x4*)(opv + 4)); }
    }
    if (tid < 64) {
        const int dc = tid & 7, t = tid >> 3;
        const bf16_t* zr = C.Z + (size_t)(row0 + t) * ZP + g * 64 + dc * 8;
        const u32x4 raw = *(const u32x4*)(zr + ZK), rawv = *(const u32x4*)(zr + ZV);
        float f[8]; unpack8(raw, f); float ss = 0.f;
#pragma unroll
        for (int e = 0; e < 8; ++e) ss += f[e] * f[e];
        ss = sum8(ss);
        const float rs = rsqrtf(ss * (1.0f / 64.0f) + EPS);
        const f32x4 kw0 = *(const f32x4*)(C.knw + dc * 8), kw1 = *(const f32x4*)(C.knw + dc * 8 + 4);
#pragma unroll
        for (int e = 0; e < 4; ++e) { f[e] *= rs * kw0[e]; f[4 + e] *= rs * kw1[e]; }
        u32x4 o; o.x = pk2(f[0], f[1]); o.y = pk2(f[2], f[3]); o.z = pk2(f[4], f[5]); o.w = pk2(f[6], f[7]);
        *(LAS u32x4*)(lds + (128 + t) * 144 + dc * 16) = o;
        *(LAS u32x4*)(lds + KSG + (128 + t) * 144 + dc * 16) = rawv;
        const size_t oo = ((cbase + 120 + t) * 2 + g) * 64 + dc * 8;
        float* op = C.out + O_CKS + oo; *(f32x4*)op = (f32x4){f[0], f[1], f[2], f[3]}; *(f32x4*)(op + 4) = (f32x4){f[4], f[5], f[6], f[7]};
        float fv[8]; unpack8(rawv, fv); float* opv = C.out + O_CVS + oo; *(f32x4*)opv = (f32x4){fv[0], fv[1], fv[2], fv[3]}; *(f32x4*)(opv + 4) = (f32x4){fv[4], fv[5], fv[6], fv[7]};
    } else if (tid < 256) {
        const int idx = tid - 64, dc = idx & 7, r = idx >> 3;
        unsigned z0 = 0u; asm volatile("" : "+v"(z0));
        *(LAS u32x4*)(lds + (136 + r) * 144 + dc * 16) = (u32x4){z0, z0, z0, z0};
        *(LAS u32x4*)(lds + KSG + (136 + r) * 144 + dc * 16) = (u32x4){z0, z0, z0, z0};
    }
    __syncthreads();
    {
        const int tid2 = mk_tid(wave_s), lane = tid2 & 63, w2 = tid2 >> 6;
        if (w2 < 4) {
            const int h = g * 4 + w2, c = lane & 15, fq = lane >> 4;
            const bool qv = c < 8;
            const bf16_t* qrow = C.Z + (size_t)(row0 + (c & 7)) * ZP + ZQ + h * 64;
            const u32x4 qa = *(const u32x4*)(qrow + 8 * fq), qb = *(const u32x4*)(qrow + 32 + 8 * fq);
            bf16_t* orow = qv ? C.MRG + (size_t)(row0 + c) * DM + h * 64 : nullptr;
            attn_wave(lds, lds + KSG, 144, qa, qb, C.qnw, C.sinks[h] * LOG2E, 0, c, fq, orow);
        }
    }
    __syncthreads();
    TICK(8);
}

DI void gla_sample_unit(const Ctx& C, int uidx, LAS unsigned char* lds, const int wave_s) {
    const int tid = mk_tid(wave_s);
    const int h = uidx & 3, b = uidx >> 2, row0 = MPROMPT + b * DECT;
    TICK(0);
    LAS float* qs = (LAS float*)lds; LAS float* ks = qs + 512; LAS float* dec = ks + 512; LAS float* vs = dec + 512; LAS float* red = vs + 1024;
    {
        const int t = tid >> 6, k = tid & 63; const bf16_t* zr = C.Z + (size_t)(row0 + t) * ZP;
        qs[tid] = bf2f(zr[ZGQ + h * 64 + k]); ks[tid] = bf2f(zr[ZGK + h * 64 + k]); dec[tid] = __expf(C.LD[(size_t)(row0 + t) * 256 + h * 64 + k]);
#pragma unroll
        for (int i = 0; i < 2; ++i) { const int idx = tid + 512 * i, tt = idx >> 7, v = idx & 127; vs[idx] = bf2f(C.Z[(size_t)(row0 + tt) * ZP + ZGV + h * 128 + v]); }
    }
    const int v = tid & 127, kq = tid >> 7;
    const size_t sbase = ((size_t)((C.l * DECB + b) * 4 + h) * 64 + 16 * kq) * 128 + v;
    float S[16];
#pragma unroll
    for (int i = 0; i < 16; ++i) S[i] = __builtin_nontemporal_load(C.state + sbase + (size_t)i * 128);
    __syncthreads();
#pragma unroll
    for (int t = 0; t < 8; ++t) { float a = 0.f; const float vv = vs[t * 128 + v];
#pragma unroll
        for (int i = 0; i < 16; ++i) { const int k = 16 * kq + i; S[i] = dec[t * 64 + k] * S[i] + ks[t * 64 + k] * vv; a += qs[t * 64 + k] * S[i]; }
        red[(kq * 8 + t) * 128 + v] = a; }
    float* so = C.out + O_SS + sbase;
#pragma unroll
    for (int i = 0; i < 16; ++i) __builtin_nontemporal_store(S[i], so + (size_t)i * 128);
    __syncthreads();
    {
        const int t = tid >> 6, lane = tid & 63; float o[2]; float ss = 0.f;
#pragma unroll
        for (int i = 0; i < 2; ++i) { const int vv = lane + 64 * i; o[i] = (red[(0 * 8 + t) * 128 + vv] + red[(1 * 8 + t) * 128 + vv]) + (red[(2 * 8 + t) * 128 + vv] + red[(3 * 8 + t) * 128 + vv]); ss += o[i] * o[i]; }
        ss = sum64(ss);
        const float rs = rsqrtf(ss * (1.0f / 128.0f) + EPS);
#pragma unroll
        for (int i = 0; i < 2; ++i) { const int vv = lane + 64 * i; const float og = bf2f(C.Z[(size_t)(row0 + t) * ZP + ZOG + h * 128 + vv]);
            const float y = o[i] * rs * C.gnw[vv] * silu_f(og); C.MRG[(size_t)(row0 + t) * DM + 512 + h * 128 + vv] = (bf16_t)(pk2(y, 0.f) & 0xffffu); }
    }
    __syncthreads();
    TICK(9);
}

DI void gla_prefix_load(const float* LD, int r0, int nv, int h, int lane, int w, float (&g)[16]) {
#pragma unroll
    for (int i = 0; i < 16; ++i) { const int t = 16 * w + i; g[i] = t < nv ? LD[(size_t)(r0 + t) * 256 + h * 64 + lane] : 0.f; }
}
DI float gla_prefix_finish(float (&g)[16], LAS float* Gs, LAS float* segtot, int lane, int w) {
    const int k = lane, seg = w;
#pragma unroll
    for (int i = 1; i < 16; ++i) g[i] += g[i - 1];
    segtot[seg * 64 + k] = g[15];
    __syncthreads();
    float off = 0.f, tot = 0.f;
#pragma unroll
    for (int s = 0; s < 8; ++s) { const float x = segtot[s * 64 + k]; off += (s < seg) ? x : 0.f; tot += x; }
#pragma unroll
    for (int i = 0; i < 16; ++i) { const int t = 16 * seg + i; Gs[t * 65 + k] = g[i] + off; }
    return tot;
}

DI void gla1_unit(const Ctx& C, int unit, LAS unsigned char* lds, const int wave_s) {
    const int tid = mk_tid(wave_s);
    const int c = unit % NCH, bh = unit / NCH, h = bh & 3, b = bh >> 2;
    const int r0 = b * LP + 128 * c, nv = (LP - 128 * c) < 128 ? (LP - 128 * c) : 128;
    LAS float* Gs = (LAS float*)lds; LAS float* segtot = (LAS float*)(lds + 33280); LAS float* gl = (LAS float*)(lds + 35328);
    LAS unsigned char* kdS = lds + 35840; LAS unsigned char* Vs = lds + 54272;
    const int lane = tid & 63, w = tid >> 6;
    TICK(0);
    float g[16]; gla_prefix_load(C.LD, r0, nv, h, lane, w, g);
    u32x4 rk[2], rv[4];
#pragma unroll
    for (int i = 0; i < 2; ++i) { const int t = (tid >> 3) + 64 * i; rk[i] = (u32x4){0u, 0u, 0u, 0u}; if (t < nv) rk[i] = *(const u32x4*)(C.Z + (size_t)(r0 + t) * ZP + ZGK + h * 64 + (tid & 7) * 8); }
#pragma unroll
    for (int i = 0; i < 4; ++i) { const int t = (tid >> 4) + 32 * i; rv[i] = (u32x4){0u, 0u, 0u, 0u}; if (t < nv) rv[i] = *(const u32x4*)(C.Z + (size_t)(r0 + t) * ZP + ZGV + h * 128 + (tid & 15) * 8); }
    { const float tot = gla_prefix_finish(g, Gs, segtot, lane, w); if (w == 0) { gl[lane] = tot; C.GL[(size_t)unit * 64 + lane] = tot; } }
#pragma unroll
    for (int i = 0; i < 4; ++i) { const int t = (tid >> 4) + 32 * i; *(LAS u32x4*)(Vs + t * 272 + (tid & 15) * 16) = rv[i]; }
    __syncthreads();
    {
        const int kc = tid & 7;
#pragma unroll
        for (int i = 0; i < 2; ++i) { const int t = (tid >> 3) + 64 * i; float f[8]; unpack8(rk[i], f);
#pragma unroll
            for (int e = 0; e < 8; ++e) f[e] *= __expf(gl[kc * 8 + e] - Gs[t * 65 + kc * 8 + e]);
            u32x4 o; o.x = pk2(f[0], f[1]); o.y = pk2(f[2], f[3]); o.z = pk2(f[4], f[5]); o.w = pk2(f[6], f[7]); *(LAS u32x4*)(kdS + t * 144 + kc * 16) = o; }
    }
    __syncthreads();
    {
        const int cc = lane & 15, fq = lane >> 4;
#pragma unroll
        for (int kt = 0; kt < 4; ++kt) { f32x4 acc = {0.f, 0.f, 0.f, 0.f};
#pragma unroll
            for (int ks = 0; ks < 4; ++ks) {
                const LAS unsigned char* ap = kdS + (32 * ks + 8 * fq + (cc >> 2)) * 144 + (16 * kt + 4 * (cc & 3)) * 2;
                const LAS unsigned char* bp = Vs + (32 * ks + 8 * fq + (cc >> 2)) * 272 + (16 * w + 4 * (cc & 3)) * 2;
                acc = MFMA16(mk8(tr4(ap), tr4(ap + 4 * 144)), mk8(tr4(bp), tr4(bp + 4 * 272)), acc); }
#pragma unroll
            for (int r = 0; r < 4; ++r) C.DS[((size_t)unit * 64 + 16 * kt + 4 * fq + r) * 128 + 16 * w + cc] = acc[r]; }
    }
    __syncthreads();
    TICK(6);
}

DI void gla3_unit(const Ctx& C, int unit, LAS unsigned char* lds, const int wave_s) {
    const int tid = mk_tid(wave_s);
    const int c = unit % NCH, bh = unit / NCH, h = bh & 3, b = bh >> 2;
    const int r0 = b * LP + 128 * c, nv = (LP - 128 * c) < 128 ? (LP - 128 * c) : 128;
    LAS unsigned char* qg = lds; LAS unsigned char* kg = lds + 18432; LAS unsigned char* Vs = lds + 36864; LAS unsigned char* Ss = lds + 71680;
    LAS float* Gs = (LAS float*)(lds + 89088); LAS float* segtot = (LAS float*)(lds + 122368);
    const int lane = tid & 63, w = __builtin_amdgcn_readfirstlane(tid >> 6);
    TICK(0);
    float g[16]; gla_prefix_load(C.LD, r0, nv, h, lane, w, g);
    u32x4 rq[2], rk[2], rv[4], rs_[2];
#pragma unroll
    for (int i = 0; i < 2; ++i) { const int t = (tid >> 3) + 64 * i; rq[i] = (u32x4){0u, 0u, 0u, 0u}; rk[i] = rq[i];
        if (t < nv) { const bf16_t* zr = C.Z + (size_t)(r0 + t) * ZP + h * 64 + (tid & 7) * 8; rq[i] = *(const u32x4*)(zr + ZGQ); rk[i] = *(const u32x4*)(zr + ZGK); } }
#pragma unroll
    for (int i = 0; i < 4; ++i) { const int t = (tid >> 4) + 32 * i; rv[i] = (u32x4){0u, 0u, 0u, 0u}; if (t < nv) rv[i] = *(const u32x4*)(C.Z + (size_t)(r0 + t) * ZP + ZGV + h * 128 + (tid & 15) * 8); }
#pragma unroll
    for (int i = 0; i < 2; ++i) { const int k = (tid >> 4) + 32 * i; rs_[i] = __builtin_nontemporal_load((const u32x4*)(C.SC + ((size_t)unit * 64 + k) * 128 + (tid & 15) * 8)); }
    (void)gla_prefix_finish(g, Gs, segtot, lane, w);
#pragma unroll
    for (int i = 0; i < 4; ++i) { const int t = (tid >> 4) + 32 * i; *(LAS u32x4*)(Vs + t * 272 + (tid & 15) * 16) = rv[i]; }
#pragma unroll
    for (int i = 0; i < 2; ++i) { const int k = (tid >> 4) + 32 * i; *(LAS u32x4*)(Ss + k * 272 + (tid & 15) * 16) = rs_[i]; }
    __syncthreads();
    TICK(1);
    {
        const int kc = tid & 7;
#pragma unroll
        for (int i = 0; i < 2; ++i) { const int t = (tid >> 3) + 64 * i; float fq_[8], fk_[8]; unpack8(rq[i], fq_); unpack8(rk[i], fk_);
#pragma unroll
            for (int e = 0; e < 8; ++e) { const float ev = __expf(Gs[t * 65 + kc * 8 + e]); fq_[e] *= ev; fk_[e] *= __builtin_amdgcn_rcpf(ev); }
            u32x4 oq, ok; oq.x = pk2(fq_[0], fq_[1]); oq.y = pk2(fq_[2], fq_[3]); oq.z = pk2(fq_[4], fq_[5]); oq.w = pk2(fq_[6], fq_[7]);
            ok.x = pk2(fk_[0], fk_[1]); ok.y = pk2(fk_[2], fk_[3]); ok.z = pk2(fk_[4], fk_[5]); ok.w = pk2(fk_[6], fk_[7]);
            *(LAS u32x4*)(qg + t * 144 + kc * 16) = oq; *(LAS u32x4*)(kg + t * 144 + kc * 16) = ok; }
    }
    __syncthreads();
    TICK(2);
    {
        const int cc = lane & 15, fq = lane >> 4;
        const int t = 16 * w + cc; const size_t row = (size_t)(r0 + (t < nv ? t : 0));
        u32x2 og[8];
#pragma unroll
        for (int Mt = 0; Mt < 8; ++Mt) og[Mt] = __builtin_nontemporal_load((const u32x2*)(C.Z + row * ZP + ZOG + h * 128 + 16 * Mt + 4 * fq));
        const bf16x8 qB0 = *(const LAS bf16x8*)(qg + (16 * w + cc) * 144 + 16 * fq), qB1 = *(const LAS bf16x8*)(qg + (16 * w + cc) * 144 + 64 + 16 * fq);
        f32x4 A[8];
#pragma unroll
        for (int T = 0; T < 8; ++T) { f32x4 sa = {0.f, 0.f, 0.f, 0.f};
            const LAS unsigned char* kp = kg + (16 * T + cc) * 144 + 16 * fq; const bf16x8 a0 = *(const LAS bf16x8*)kp, a1 = *(const LAS bf16x8*)(kp + 64);
            sa = MFMA16(a0, qB0, sa); sa = MFMA16(a1, qB1, sa);
#pragma unroll
            for (int r = 0; r < 4; ++r) sa[r] = (16 * T + 4 * fq + r > t) ? 0.f : sa[r];
            A[T] = sa; }
        bf16x8 P[4];
#pragma unroll
        for (int kk = 0; kk < 4; ++kk) { u32x4 pw; pw.x = pk2(A[2 * kk][0], A[2 * kk][1]); pw.y = pk2(A[2 * kk][2], A[2 * kk][3]); pw.z = pk2(A[2 * kk + 1][0], A[2 * kk + 1][1]); pw.w = pk2(A[2 * kk + 1][2], A[2 * kk + 1][3]); P[kk] = __builtin_bit_cast(bf16x8, pw); }
        f32x4 o[8]; float ss = 0.f;
#pragma unroll
        for (int Mt = 0; Mt < 8; ++Mt) o[Mt] = (f32x4){0.f, 0.f, 0.f, 0.f};
#pragma unroll
        for (int kk = 0; kk < 4; ++kk)
#pragma unroll
            for (int Mt = 0; Mt < 8; ++Mt) {
                const LAS unsigned char* vp = Vs + (32 * kk + 4 * fq + (cc >> 2)) * 272 + (16 * Mt + 4 * (cc & 3)) * 2;
                o[Mt] = MFMA16(mk8(tr4(vp), tr4(vp + 16 * 272)), P[kk], o[Mt]); }
#pragma unroll
        for (int ks = 0; ks < 2; ++ks)
#pragma unroll
            for (int Mt = 0; Mt < 8; ++Mt) {
                const LAS unsigned char* sp = Ss + (32 * ks + 8 * fq + (cc >> 2)) * 272 + (16 * Mt + 4 * (cc & 3)) * 2;
                o[Mt] = MFMA16(mk8(tr4(sp), tr4(sp + 4 * 272)), ks ? qB1 : qB0, o[Mt]); }
#pragma unroll
        for (int Mt = 0; Mt < 8; ++Mt) ss += (o[Mt][0] * o[Mt][0] + o[Mt][1] * o[Mt][1]) + (o[Mt][2] * o[Mt][2] + o[Mt][3] * o[Mt][3]);
        ss = red4rows(ss);
        const float rs = rsqrtf(ss * (1.0f / 128.0f) + EPS);
        if (t < nv) {
#pragma unroll
            for (int Mt = 0; Mt < 8; ++Mt) { const int v0 = 16 * Mt + 4 * fq; const f32x4 gn = *(const f32x4*)(C.gnw + v0);
                const float y0 = o[Mt][0] * rs * gn[0] * silu_f(bflo(og[Mt].x)), y1 = o[Mt][1] * rs * gn[1] * silu_f(bfhi(og[Mt].x)), y2 = o[Mt][2] * rs * gn[2] * silu_f(bflo(og[Mt].y)), y3 = o[Mt][3] * rs * gn[3] * silu_f(bfhi(og[Mt].y));
                u32x2 wv; wv.x = pk2(y0, y1); wv.y = pk2(y2, y3); *(u32x2*)(C.MRG + row * DM + 512 + h * 128 + v0) = wv; } }
    }
    __syncthreads();
    TICK(3);
}

DI void gla_scan(const Ctx& C, int gtid, int gthreads) {
    for (int idx = gtid; idx < 16 * 64 * 128; idx += gthreads) {
        const int v = idx & 127, k = (idx >> 7) & 63, bh = idx >> 13;
        const size_t u0 = (size_t)bh * NCH;
        float ds[NCH], dg[NCH];
#pragma unroll
        for (int c = 0; c < NCH; ++c) { ds[c] = __builtin_nontemporal_load(C.DS + ((u0 + c) * 64 + k) * 128 + v); dg[c] = C.GL[(u0 + c) * 64 + k]; }
        float S = 0.f;
#pragma unroll
        for (int c = 0; c < NCH; ++c) { C.SC[((u0 + c) * 64 + k) * 128 + v] = (bf16_t)(pk2(S, 0.f) & 0xffffu); S = __expf(dg[c]) * S + ds[c]; }
        const int h = bh & 3, b = bh >> 2;
        C.out[O_SP + ((size_t)((C.l * NBATCH + b) * 4 + h) * 64 + k) * 128 + v] = S;
    }
}

struct WSrc { int mat; const float* W; const float* W2; const float* gain; const float* wg2; };
DI float wsrc(const WSrc& s, int k, int n) {
    if (s.mat == 0) {
        if (n < 2304) { const int col = n < 1792 ? n : n + 16; const float sc = (n >= 768 && n < 1024) ? 0.125f : 1.0f; return s.W[(size_t)k * INW + col] * s.gain[k] * sc; }
        const int e = n - 2304; float a = 0.f;
#pragma unroll
        for (int r = 0; r < 16; ++r) a += s.W[(size_t)k * INW + 1792 + r] * s.wg2[r * 256 + e];
        return a * s.gain[k];
    } else if (s.mat == 1) { return s.W[(size_t)k * DM + n];
    } else if (s.mat == 2) { const int pn = n >> 8, j = n & 255; return (j < 128 ? s.W[(size_t)k * DFFN + 128 * pn + j] : s.W2[(size_t)k * DFFN + 128 * pn + j - 128]) * s.gain[k];
    } else { return s.W[(size_t)k * DM + n]; }
}
DI f32x4 wsrc4(const WSrc& s, int k, int n) {
    if (s.mat == 0) { const int col = n < 1792 ? n : n + 16; const float sc = ((n >= 768 && n < 1024) ? 0.125f : 1.0f) * s.gain[k]; return __builtin_nontemporal_load((const f32x4*)(s.W + (size_t)k * INW + col)) * sc; }
    else if (s.mat == 1) return __builtin_nontemporal_load((const f32x4*)(s.W + (size_t)k * DM + n));
    else if (s.mat == 2) { const int pn = n >> 8, j = n & 255; const float* src = j < 128 ? s.W + (size_t)k * DFFN + 128 * pn + j : s.W2 + (size_t)k * DFFN + 128 * pn + j - 128; return __builtin_nontemporal_load((const f32x4*)src) * s.gain[k]; }
    else return __builtin_nontemporal_load((const f32x4*)(s.W + (size_t)k * DM + n));
}
DI void conv_item_lr(const WSrc& s, int K, bf16_t* WT, LAS float* scr, int item, int lane) {
    const int kb = item >> 3, nb = item & 7, k0 = 64 * kb, n0 = 2304 + 32 * nb;
    const int e = lane & 31; float g2[16];
#pragma unroll
    for (int r = 0; r < 16; ++r) g2[r] = s.wg2[r * 256 + 32 * nb + e];
#pragma unroll 8
    for (int i = 0; i < 32; ++i) { const int kk = 2 * i + (lane >> 5); const f32x4* wp = (const f32x4*)(s.W + (size_t)(k0 + kk) * INW + 1792);
        const f32x4 a = __builtin_nontemporal_load(wp), b = __builtin_nontemporal_load(wp + 1), c4 = __builtin_nontemporal_load(wp + 2), d = __builtin_nontemporal_load(wp + 3);
        const float acc = ((a[0] * g2[0] + a[1] * g2[1]) + (a[2] * g2[2] + a[3] * g2[3])) + ((b[0] * g2[4] + b[1] * g2[5]) + (b[2] * g2[6] + b[3] * g2[7]))
                        + ((c4[0] * g2[8] + c4[1] * g2[9]) + (c4[2] * g2[10] + c4[3] * g2[11])) + ((d[0] * g2[12] + d[1] * g2[13]) + (d[2] * g2[14] + d[3] * g2[15]));
        scr[kk * 33 + e] = acc * s.gain[k0 + kk]; }
    asm volatile("s_waitcnt lgkmcnt(0)" ::: "memory");
    const int c = lane & 7;
#pragma unroll
    for (int j = 0; j < 4; ++j) { const int n = (lane >> 3) + 8 * j; const LAS float* sp = scr + (8 * c) * 33 + n;
        u32x4 o; o.x = pk2(sp[0 * 33], sp[1 * 33]); o.y = pk2(sp[2 * 33], sp[3 * 33]); o.z = pk2(sp[4 * 33], sp[5 * 33]); o.w = pk2(sp[6 * 33], sp[7 * 33]);
        *(u32x4*)(WT + (size_t)(n0 + n) * K + k0 + 8 * c) = o; }
    asm volatile("s_waitcnt lgkmcnt(0)" ::: "memory");
}
DI void conv_item(const WSrc& s, int K, int nblk, bf16_t* WT, LAS unsigned char* tile, int item, int lane) {
    const int kb = item / nblk, nb = item % nblk, k0 = 64 * kb, n0 = 64 * nb;
    const int krow = lane >> 4, n4 = (lane & 15) * 4;
    f32x4 v[16];
#pragma unroll
    for (int st = 0; st < 16; ++st) v[st] = wsrc4(s, k0 + 4 * st + krow, n0 + n4);
#pragma unroll
    for (int st = 0; st < 16; ++st) { u32x2 w; w.x = pk2(v[st][0], v[st][1]); w.y = pk2(v[st][2], v[st][3]); *(LAS u32x2*)(tile + (4 * st + krow) * 136 + n4 * 2) = w; }
    asm volatile("s_waitcnt lgkmcnt(0)" ::: "memory");
    const int i = lane & 15, fq = lane >> 4;
#pragma unroll
    for (int q = 0; q < 2; ++q)
#pragma unroll
        for (int nbk = 0; nbk < 4; ++nbk) { const int kg = 4 * q + fq;
            const LAS unsigned char* tp = tile + (8 * kg + (i >> 2)) * 136 + (16 * nbk + 4 * (i & 3)) * 2;
            const u32x2 lo = tr4(tp), hi = tr4(tp + 4 * 136);
            u32x4 o; o.x = lo.x; o.y = lo.y; o.z = hi.x; o.w = hi.y;
            *(u32x4*)(WT + (size_t)(n0 + 16 * nbk + i) * K + k0 + 8 * kg) = o; }
    asm volatile("s_waitcnt lgkmcnt(0)" ::: "memory");
}
constexpr int NI_IN = 16 * 36, NI_LR = 16 * 8, NI_O = 16 * 16, NI_GU = 16 * 88, NI_D = 44 * 16, NI_L = NI_IN + NI_LR + NI_O + NI_GU + NI_D;

DI void prologue(KA ap, const RowMap& rm, LAS unsigned char* lds, int tid, int vcu, int G) {
    const int lane = tid & 63, wave = tid >> 6, gw = vcu * 8 + wave, NGW = G * 8;
    LAS unsigned char* tile = lds + wave * 16384;
    for (int it = gw; it < DEPTH * NI_L; it += NGW) {
        const int l = it / NI_L; int r = it % NI_L;
        unsigned char* wl = ap->ws + WS_W + (size_t)l * SZ_WL;
        if (r < NI_IN) { WSrc s{0, ap->in[7] + (size_t)l * DM * INW, nullptr, ap->in[6] + l * DM, nullptr}; conv_item(s, DM, 36, (bf16_t*)wl, tile, r, lane); continue; } r -= NI_IN;
        if (r < NI_LR) { WSrc s{0, ap->in[7] + (size_t)l * DM * INW, nullptr, ap->in[6] + l * DM, ap->in[11] + l * 16 * 256}; conv_item_lr(s, DM, (bf16_t*)wl, (LAS float*)tile, r, lane); continue; } r -= NI_LR;
        if (r < NI_O) { WSrc s{1, ap->in[14] + (size_t)l * DM * DM, nullptr, nullptr, nullptr}; conv_item(s, DM, 16, (bf16_t*)(wl + SZ_WIN), tile, r, lane); continue; } r -= NI_O;
        if (r < NI_GU) { WSrc s{2, ap->in[16] + (size_t)l * DM * DFFN, ap->in[17] + (size_t)l * DM * DFFN, ap->in[15] + l * DM, nullptr}; conv_item(s, DM, 88, (bf16_t*)(wl + SZ_WIN + SZ_WO), tile, r, lane); continue; } r -= NI_GU;
        { WSrc s{3, ap->in[18] + (size_t)l * DFFN * DM, nullptr, nullptr, nullptr}; conv_item(s, DFFN, 16, (bf16_t*)(wl + SZ_WIN + SZ_WO + SZ_WGU), tile, r, lane); }
    }
    bf16_t* XB = (bf16_t*)(ap->ws + WS_XB); bf16_t* MRG = (bf16_t*)(ap->ws + WS_MRG); float* ssqA = (float*)(ap->ws + WS_SSQA);
    for (int m = gw; m < MP; m += NGW) {
        const float* ip = row_in(rm, m); f32x4 v[4]; float s = 0.f;
#pragma unroll
        for (int j = 0; j < 4; ++j) { v[j] = ip ? __builtin_nontemporal_load((const f32x4*)ip + lane + 64 * j) : (f32x4){0.f, 0.f, 0.f, 0.f}; s += (v[j][0] * v[j][0] + v[j][1] * v[j][1]) + (v[j][2] * v[j][2] + v[j][3] * v[j][3]); }
        s = sum64(s);
#pragma unroll
        for (int j = 0; j < 4; ++j) { u32x2 w; w.x = pk2(v[j][0], v[j][1]); w.y = pk2(v[j][2], v[j][3]); ((u32x2*)(XB + (size_t)m * DM))[lane + 64 * j] = w; if (!ip) ((u32x2*)(MRG + (size_t)m * DM))[lane + 64 * j] = (u32x2){0u, 0u}; }
        if (lane < 16) ssqA[(size_t)m * 16 + lane] = lane == 0 ? s : 0.f;
    }
}

#define XB_TMO      128
#define XB_XCNT(j)  (256  + 64 * (j))
#define XB_XSUB(j)  (1280 + 64 * (j))
#define XB_XGEN(j)  (2304 + 64 * (j))
#define XB_TOP      3328
#define XB_TOPGEN   3392
#define XCD_BAR_WORDS 3456
#define XB_SPIN_CAP (1u << 18)

__device__ __forceinline__ unsigned xb_ld(unsigned* p)              { return __hip_atomic_load(p, __ATOMIC_RELAXED, __HIP_MEMORY_SCOPE_AGENT); }
__device__ __forceinline__ unsigned xb_add(unsigned* p, unsigned v) { return __hip_atomic_fetch_add(p, v, __ATOMIC_RELAXED, __HIP_MEMORY_SCOPE_AGENT); }
__device__ __forceinline__ unsigned xb_xcc_id() { return (unsigned)__builtin_amdgcn_s_getreg((3 << 11) | 20) & 0xFu; }
#define XB_SPIN(cond, bar) do { unsigned _sp = 0; while (cond) { __builtin_amdgcn_s_sleep(1); \
    if ((++_sp & 255u) == 0u) { if (xb_ld(&(bar)[XB_TMO])) break; if (_sp > XB_SPIN_CAP) { atomicAdd(&(bar)[XB_TMO], 1u); break; } } } } while (0)

struct XcdBarrier {
    unsigned* bar; unsigned x;
    volatile LAS unsigned* st;
};

__device__ __forceinline__ XcdBarrier xcd_barrier_post(unsigned* bar, volatile LAS unsigned* st, const bool t0) {
    XcdBarrier b; b.bar = bar; b.x = xb_xcc_id(); b.st = st;
    if (t0) (void)xb_add(&bar[XB_XCNT(b.x)], 1u);
    return b;
}
__device__ __forceinline__ void xcd_barrier_complete(unsigned* bar, unsigned x, unsigned& nloc, unsigned& nx) {
    const unsigned G = gridDim.x * gridDim.y * gridDim.z;
    unsigned sum, cnt, mine, sp = 0u;
    for (;;) {
        sum = 0u; cnt = 0u; mine = 0u;
#pragma unroll
        for (unsigned j = 0; j < 16; ++j) { const unsigned c = xb_ld(&bar[XB_XCNT(j)]); sum += c; cnt += (c > 0u) ? 1u : 0u; mine = (j == x) ? c : mine; }
        if (sum == G) break;
        __builtin_amdgcn_s_sleep(1);
        if ((++sp & 255u) == 0u) { if (xb_ld(&bar[XB_TMO])) break; if (sp > XB_SPIN_CAP) { atomicAdd(&bar[XB_TMO], 1u); break; } }
    }
    nloc = mine > 0u ? mine : 1u; nx = cnt > 0u ? cnt : 1u;
}

__device__ __forceinline__ void xcd_barrier(const XcdBarrier& b, const bool t0) {
    asm volatile("s_waitcnt vmcnt(0)" ::: "memory");
    __syncthreads();
    if (t0) {
        unsigned* bar = b.bar;
        __builtin_amdgcn_s_waitcnt(0);
        unsigned nloc = b.st[0], nx = b.st[1];
        if (nloc == 0u) { xcd_barrier_complete(bar, b.x, nloc, nx); b.st[0] = nloc; b.st[1] = nx; }
        const unsigned old = xb_add(&bar[XB_XSUB(b.x)], 1u);
        const unsigned gen = old / nloc;
        if (old + 1u == (gen + 1u) * nloc) {
            __builtin_amdgcn_fence(__ATOMIC_RELEASE, "agent");
            asm volatile("s_waitcnt vmcnt(0)" ::: "memory");
            const unsigned og = xb_add(&bar[XB_TOP], 1u);
            const unsigned tg = og / nx;
            if (og + 1u == (tg + 1u) * nx) xb_add(&bar[XB_TOPGEN], 1u);
            else XB_SPIN(xb_ld(&bar[XB_TOPGEN]) == tg, bar);
            __builtin_amdgcn_fence(__ATOMIC_ACQUIRE, "agent");
            xb_add(&bar[XB_XGEN(b.x)], 1u);
            asm volatile("s_waitcnt vmcnt(0)" ::: "memory");
        } else {
            XB_SPIN(xb_ld(&bar[XB_XGEN(b.x)]) == gen, bar);
            __builtin_amdgcn_fence(__ATOMIC_ACQUIRE, "agent");
            asm volatile("s_waitcnt vmcnt(0)" ::: "memory");
        }
    }
    __syncthreads();
}

template <class T> DI T* opq(T* p) { asm volatile("" : "+s"(p)); return p; }
DI Ctx make_ctx(int l) {
    KA ap = ka_ptr(); unsigned char* ws = ap->ws;
    Ctx C; C.l = l; C.Z = (const bf16_t*)(ws + WS_Z); C.LD = (float*)(ws + WS_LD); C.MRG = (bf16_t*)(ws + WS_MRG); C.DS = (float*)(ws + WS_DS); C.SC = (bf16_t*)(ws + WS_SC); C.GL = (float*)(ws + WS_GL);
    C.qnw = ap->in[8] + l * 64; C.knw = ap->in[9] + l * 64; C.sinks = ap->in[10] + l * 8; C.gnw = ap->in[13] + l * 128;
    C.cache_k = ap->in[2]; C.cache_v = ap->in[3]; C.state = ap->in[4]; C.out = ap->out;
    return C;
}
DI RowMap make_rm() { KA ap = ka_ptr(); float* out = ap->out; unsigned char* ws = ap->ws; return RowMap{ap->in[0], ap->in[1], ap->in[5], out + O_YP, out + O_YS, (float*)(ws + WS_XMETA)}; }

__global__ void __launch_bounds__(512, 2) hymba_fwd(Args a) {
    extern __shared__ __attribute__((aligned(16))) unsigned char lds_raw[];
    LAS unsigned char* lds = (LAS unsigned char*)lds_raw;
    const int G = gridDim.x, bx = blockIdx.x; const int wave_s = __builtin_amdgcn_readfirstlane((int)threadIdx.x >> 6);
#define opaque_tid() mk_tid(wave_s)
    const int vcu = (G % 8 == 0) ? (bx % 8) * (G / 8) + bx / 8 : bx;
    const int lo = ka_ptr()->ph_lo, hi = ka_ptr()->ph_hi;
#define IN(k) (lo <= (k) && (k) < hi)
#ifndef FAST_BAR
#define FAST_BAR 1
#endif
    volatile LAS unsigned* MISC = (volatile LAS unsigned*)(lds + 131072 + 320);
    { const int t = opaque_tid(); if (t < 160) MISC[t] = 0u; __syncthreads(); }
    XcdBarrier bar = xcd_barrier_post((unsigned*)ka_ptr()->ws, MISC + 8, opaque_tid() == 0);
#define GSYNC() do { if (FAST_BAR) xcd_barrier(bar, opaque_tid() == 0); else cg::this_grid().sync(); } while (0)
#define STAMP(k) do { if (TIME_PH >= 0 && bx == 0 && opaque_tid() == 0) { const unsigned long long t_ = __builtin_amdgcn_s_memrealtime(); MISC[16 + 2 * (k)] = (unsigned)t_; MISC[17 + 2 * (k)] = (unsigned)(t_ >> 32); } } while (0)
#define SEAM(k) do { if (TIME_BUSY) STAMP(32 + (k)); if (IN(k) && IN((k) + 1)) { GSYNC(); } STAMP((k) + 1); } while (0)
    if (lo < 0) cg::this_grid().sync();
    STAMP(0);
    if (IN(0)) { for (int rep = 0; rep < REP_PRO; ++rep) { const RowMap rm = make_rm(); prologue(ka_ptr(), rm, lds, opaque_tid(), vcu, G); if (rep + 1 < REP_PRO) GSYNC(); }
        for (int xs = 0; xs < XSYNC; ++xs) GSYNC(); }
    SEAM(0);
#pragma unroll 1
    for (int l = 0; l < DEPTH; ++l) {
        const int pb = 1 + 7 * l;
        if (IN(pb + 0)) for (int rep = 0; rep < REP_WIN; ++rep) {
            if (rep) GSYNC();
            KA ap = ka_ptr(); unsigned char* ws = ap->ws; unsigned char* wl = ws + WS_W + (size_t)l * SZ_WL;
            pg8::Gemm g{(const bf16_t*)(ws + WS_XB), (const bf16_t*)wl, MP, NIN, DM}; pg8::StaticOrder S; S.init(MP, NIN, G, bx);
            pg8::EpiIn E{(bf16_t*)(ws + WS_Z), (float*)(ws + WS_LD), (const float*)(ws + WS_SSQA), ap->in[12] + l * 256};
            pg8::gemm_phase<pg8::EpiIn, pg8::StaticOrder, true, true>(lds, g, S, E, opaque_tid());
        }
        SEAM(pb + 0);
        if (IN(pb + 1)) {
            const Ctx C = make_ctx(l);
            constexpr int N1 = DECB * 2, N2 = 16 * NCH, N3 = DECB * 4;
#pragma unroll 1
            for (int u = vcu; u < N1 + N2 + N3; u += G) {
                if (u < N1) attn_sample_unit(C, u, lds, wave_s); else if (u < N1 + N2) gla1_unit(C, u - N1, lds, wave_s); else gla_sample_unit(C, u - N1 - N2, lds, wave_s);
            }
        }
        SEAM(pb + 1);
        if (IN(pb + 2)) for (int rep = 0; rep < REP_SCAN; ++rep) { if (rep) GSYNC(); const Ctx C = make_ctx(l); gla_scan(C, bx * 512 + opaque_tid(), G * 512); }
        SEAM(pb + 2);
        if (IN(pb + 3)) for (int rep = 0; rep < REP_MB; ++rep) {   if (rep) GSYNC();
            const Ctx C = make_ctx(l);
            constexpr int N1 = 16 * NCH, N2 = NBATCH * 2 * 65;
#pragma unroll 1
            for (int u = vcu; u < N1 + N2; u += G) { if (u < N1) gla3_unit(C, u, lds, wave_s); else attn_prompt_unit(C, u - N1, lds, wave_s); }
        }
        SEAM(pb + 3);
        if (IN(pb + 4)) for (int rep = 0; rep < 1 + DRY_WO; ++rep) {
            if (rep) GSYNC();
            KA ap = ka_ptr(); unsigned char* ws = ap->ws; unsigned char* wl = ws + WS_W + (size_t)l * SZ_WL;
            pg8::Gemm g{(const bf16_t*)(ws + WS_MRG), (const bf16_t*)(wl + SZ_WIN), MP, DM, DM}; pg8::StreamK S; S.init((MP / 256) * 4, DM / 128, G, vcu, (unsigned*)(ws + WS_FLAGS) + (2 * l) * 256 * 16, ws + WS_Z, ws + WS_ZERO);
            pg8::EpiRes E{make_rm(), 0, (bf16_t*)(ws + WS_XB), (float*)(ws + WS_SSQB), rep};
            pg8::gemm_phase<pg8::EpiRes, pg8::StreamK, true, true>(lds, g, S, E, opaque_tid());
        }
        SEAM(pb + 4);
        if (IN(pb + 5)) for (int rep = 0; rep < REP_GU; ++rep) {
            if (rep) GSYNC();
            KA ap = ka_ptr(); unsigned char* ws = ap->ws; unsigned char* wl = ws + WS_W + (size_t)l * SZ_WL;
            pg8::Gemm g{(const bf16_t*)(ws + WS_XB), (const bf16_t*)(wl + SZ_WIN + SZ_WO), MP, NGU, DM}; pg8::StaticOrder S; S.init(MP, NGU, G, bx);
            pg8::EpiGU E{(bf16_t*)(ws + WS_U), (const float*)(ws + WS_SSQB)};
            pg8::gemm_phase<pg8::EpiGU, pg8::StaticOrder, true, true>(lds, g, S, E, opaque_tid());
        }
        SEAM(pb + 5);
        if (IN(pb + 6)) for (int rep = 0; rep < 1 + DRY_DN; ++rep) {
            if (rep) GSYNC();
            KA ap = ka_ptr(); unsigned char* ws = ap->ws; unsigned char* wl = ws + WS_W + (size_t)l * SZ_WL;
            pg8::Gemm g{(const bf16_t*)(ws + WS_U), (const bf16_t*)(wl + SZ_WIN + SZ_WO + SZ_WGU), MP, DM, DFFN}; pg8::StreamK S; S.init((MP / 256) * 4, DFFN / 128, G, vcu, (unsigned*)(ws + WS_FLAGS) + (2 * l + 1) * 256 * 16, ws + WS_MRG, ws + WS_ZERO);
            pg8::EpiRes E{make_rm(), l == DEPTH - 1 ? 1 : 0, (bf16_t*)(ws + WS_XB), (float*)(ws + WS_SSQA), rep};
            pg8::gemm_phase<pg8::EpiRes, pg8::StreamK, true, true>(lds, g, S, E, opaque_tid());
        }
        if (l + 1 < DEPTH) SEAM(pb + 6);
    }
    if (TIME_SUB >= 0) { if (bx == 0 && opaque_tid() == 0) { const unsigned long long tot = MISC[100 + (TIME_SUB >= 0 ? TIME_SUB : 0)]; const unsigned long long tend = __builtin_amdgcn_s_memrealtime();
            while (__builtin_amdgcn_s_memrealtime() - tend < (unsigned long long)TIME_MULT * tot) __builtin_amdgcn_s_sleep(8); } }
    if (TIME_PH >= 0) {
        STAMP(NPHASE);
        if (bx == 0 && opaque_tid() == 0) {
            unsigned long long tot = 0;
            for (int k = 0; k < NPHASE; ++k) { const bool pick = (TIME_PH == 7) ? (k == 0) : (k >= 1 && ((k - 1) % 7) == TIME_PH);
                if (pick) { const int ke = TIME_BUSY ? 32 + k : k + 1; const unsigned long long a0 = ((unsigned long long)MISC[17 + 2 * k] << 32) | MISC[16 + 2 * k], a1 = ((unsigned long long)MISC[17 + 2 * ke] << 32) | MISC[16 + 2 * ke]; tot += a1 - a0; } }
            const unsigned long long tend = __builtin_amdgcn_s_memrealtime();
            while (__builtin_amdgcn_s_memrealtime() - tend < (unsigned long long)TIME_MULT * tot) __builtin_amdgcn_s_sleep(8);
        }
    }
#undef IN
#undef SEAM
#undef STAMP
#undef GSYNC
#undef opaque_tid
}

#ifndef N_LAUNCH_MODE
#define N_LAUNCH_MODE 0
#endif
extern "C" void kernel_launch(void* const* d_in, const int* in_sizes, int n_in, void* d_out, int out_size, void* d_ws, size_t ws_size, hipStream_t stream) {
    static int grid = 0;
    if (grid == 0) {
        if (n_in != 19 || out_size != (int)O_END || ws_size < WS_END) { fprintf(stderr, "kernel_launch: unexpected shapes: n_in %d out %d ws %zu (need %zu)\n", n_in, out_size, ws_size, (size_t)WS_END); grid = -1; return; }
        int dev = 0, cus = 0, per_cu = 0;
        (void)hipGetDevice(&dev); (void)hipDeviceGetAttribute(&cus, hipDeviceAttributeMultiprocessorCount, dev);
        if (hipFuncSetAttribute((const void*)hymba_fwd, hipFuncAttributeMaxDynamicSharedMemorySize, LDS_BYTES) != hipSuccess) { fprintf(stderr, "kernel_launch: hipFuncSetAttribute failed\n"); grid = -1; return; }
        if (hipOccupancyMaxActiveBlocksPerMultiprocessor(&per_cu, (const void*)hymba_fwd, 512, LDS_BYTES) != hipSuccess || per_cu < 1) { fprintf(stderr, "kernel_launch: occupancy query says %d\n", per_cu); per_cu = 1; }
        (void)hipGetLastError();
        grid = cus > 0 ? cus : 256;
    }
    if (grid < 0) return;
    if (hipMemsetAsync(d_ws, 0, WS_W, stream) != hipSuccess) { fprintf(stderr, "kernel_launch: memset failed\n"); return; }
    Args a{};
    for (int i = 0; i < 19; ++i) a.in[i] = (const float*)d_in[i];
    a.out = (float*)d_out; a.ws = (unsigned char*)d_ws;
#if N_LAUNCH_MODE == 1
    for (int p = 0; p < NPHASE; ++p) { a.ph_lo = p; a.ph_hi = p + 1; hipLaunchKernelGGL(hymba_fwd, dim3(grid), dim3(512), LDS_BYTES, stream, a); }
#else
    a.ph_lo = 0; a.ph_hi = NPHASE;
    void* args[] = {&a};
    hipError_t e = hipLaunchCooperativeKernel((const void*)hymba_fwd, dim3(grid), dim3(512), args, LDS_BYTES, stream);
    if (e != hipSuccess) fprintf(stderr, "cooperative launch failed: %s (grid %d)\n", hipGetErrorString(e), grid);
#endif
}
```
